# Optimizing an MI355X kernel written in HIP

```python
import jax, jax.numpy as jnp
from jax import lax
import numpy as np

D_MODEL = 1024
BATCH = 32
SEQ = 2048
DEPTH = 1
DEC_BATCH = 16
DEC_SEQ = 64
PAST_LEN = 4096

CHUNK = 64
D_MIX = D_MODEL
D_POOL = D_MIX // 2
POOL_WINDOWS = (2, 4, 8, 16)
N_POOL_GROUPS = len(POOL_WINDOWS)
POOL_GROUP_W = D_POOL // N_POOL_GROUPS
POOL_HIST = max(POOL_WINDOWS) - 1
D_FOX = D_MIX - D_POOL
FOX_HEADS = 8
FOX_HEAD_DIM = D_FOX // FOX_HEADS
Q_BLOCK = 128
N_MEM = 256
MEM_HEADS = 4
MEM_HEAD_DIM = D_MODEL // MEM_HEADS
D_FF = ((8 * D_MODEL // 3 + 127) // 128) * 128
CONV_W = 3
D_IN = D_POOL + 3 * D_FOX + FOX_HEADS
FORGET_BIAS = 3.0
EPS = 1e-6

kernel_name = 'hybrid_pool_fox_stream_encoder_step'


def rmsnorm(x, g):
    x32 = x.astype(jnp.float32)
    y = x32 * lax.rsqrt(jnp.mean(x32 * x32, axis=-1, keepdims=True) + EPS)
    return (y * g.astype(jnp.float32)).astype(x.dtype)


def pool_mixer(u, u_hist, pos0, w_pool, pool_scale):
    B, T, _ = u.shape
    nh = u_hist.shape[1]
    u_ext = jnp.concatenate([u_hist.astype(u.dtype), u], axis=1).astype(jnp.float32)
    cs = jnp.cumsum(u_ext, axis=1)
    cs = jnp.concatenate([jnp.zeros((B, 1, D_POOL), jnp.float32), cs], axis=1)
    upper = cs[:, nh + 1:]
    t_idx = jnp.arange(T)
    diffs = []
    for g, w in enumerate(POOL_WINDOWS):
        sl = slice(g * POOL_GROUP_W, (g + 1) * POOL_GROUP_W)
        lo = jnp.maximum(t_idx + nh + 1 - w, 0)
        lower = jnp.take(cs[:, :, sl], lo, axis=1)
        count = jnp.minimum(pos0 + t_idx + 1, w).astype(jnp.float32)
        mean = (upper[:, :, sl] - lower) / count[None, :, None]
        diffs.append(mean - u_ext[:, nh:, sl])
    d = jnp.stack(diffs, axis=2).astype(u.dtype)
    y = jnp.einsum('btgc,gcd->btgd', d, w_pool).reshape(B, T, D_POOL)
    return y * pool_scale


def fox_attention(q, k, v, cq, ck, q_pos, k_pos):
    B, Tq, H, Dh = q.shape
    qb = Q_BLOCK if Tq % Q_BLOCK == 0 else Tq
    nb = Tq // qb
    scale = FOX_HEAD_DIM ** -0.5
    q_blocks = q.reshape(B, nb, qb, H, Dh).transpose(1, 0, 2, 3, 4)
    cq_blocks = cq.reshape(B, nb, qb, H).transpose(1, 0, 3, 2)
    pos_blocks = q_pos.reshape(nb, qb)
    ck_t = ck.transpose(0, 2, 1)

    def one_block(args):
        qblk, cblk, pblk = args
        s = jnp.einsum('bqhd,bkhd->bhqk', qblk, k).astype(jnp.float32) * scale
        s = s + (cblk[:, :, :, None] - ck_t[:, :, None, :])
        causal = pblk[:, None] >= k_pos[None, :]
        s = jnp.where(causal[None, None], s, -jnp.inf)
        p = jax.nn.softmax(s, axis=-1)
        return jnp.einsum('bhqk,bkhd->bqhd', p.astype(v.dtype), v)

    out = lax.map(one_block, (q_blocks, cq_blocks, pos_blocks))
    return out.transpose(1, 0, 2, 3, 4).reshape(B, Tq, H, Dh)


def memory_kv(mem, g_mkv, w_mk, w_mv):
    B, M, _ = mem.shape
    m = rmsnorm(mem, g_mkv)
    mk = (m @ w_mk).reshape(B, M, MEM_HEADS, MEM_HEAD_DIM)
    mv = (m @ w_mv).reshape(B, M, MEM_HEADS, MEM_HEAD_DIM)
    return mk, mv


def encoder_layer(x, k_hist, v_hist, logf_hist, pool_hist, conv_hist, mem_k, mem_v, pos0,
                  g_mix, w_in, b_f, w_pool, pool_scale, w_o, g_xq, w_mq, w_mo,
                  g_ffn, w_up, conv_w, conv_b, w_down):
    B, T, _ = x.shape
    h = rmsnorm(x, g_mix)
    z = h @ w_in
    u = z[..., :D_POOL]
    q = z[..., D_POOL:D_POOL + D_FOX].reshape(B, T, FOX_HEADS, FOX_HEAD_DIM)
    k = z[..., D_POOL + D_FOX:D_POOL + 2 * D_FOX].reshape(B, T, FOX_HEADS, FOX_HEAD_DIM)
    v = z[..., D_POOL + 2 * D_FOX:D_POOL + 3 * D_FOX].reshape(B, T, FOX_HEADS, FOX_HEAD_DIM)
    logf = jax.nn.log_sigmoid((z[..., D_POOL + 3 * D_FOX:] + b_f).astype(jnp.float32))

    nh = k_hist.shape[1]
    k_all = jnp.concatenate([k_hist.astype(k.dtype), k], axis=1)
    v_all = jnp.concatenate([v_hist.astype(v.dtype), v], axis=1)
    c_all = jnp.cumsum(jnp.concatenate([logf_hist.astype(jnp.float32), logf], axis=1), axis=1)
    q_pos = pos0 + jnp.arange(T)
    k_pos = jnp.arange(nh + T) + (pos0 - nh)
    o_fox = fox_attention(q, k_all, v_all, c_all[:, nh:], c_all, q_pos, k_pos).reshape(B, T, D_FOX)

    o_pool = pool_mixer(u, pool_hist, pos0, w_pool, pool_scale)
    x = x + jnp.concatenate([o_pool.astype(x.dtype), o_fox.astype(x.dtype)], axis=-1) @ w_o

    mq = (rmsnorm(x, g_xq) @ w_mq).reshape(B, T, MEM_HEADS, MEM_HEAD_DIM)
    s = jnp.einsum('bthd,bmhd->bhtm', mq, mem_k.astype(mq.dtype)).astype(jnp.float32) * (MEM_HEAD_DIM ** -0.5)
    p = jax.nn.softmax(s, axis=-1)
    mo = jnp.einsum('bhtm,bmhd->bthd', p.astype(x.dtype), mem_v.astype(x.dtype)).reshape(B, T, D_MODEL)
    x = x + mo @ w_mo

    up = rmsnorm(x, g_ffn) @ w_up
    a, b = up[..., :D_FF], up[..., D_FF:]
    a_ext = jnp.concatenate([conv_hist.astype(a.dtype), a], axis=1)
    conv = conv_b + sum(a_ext[:, j:j + T] * conv_w[j] for j in range(CONV_W))
    x = x + (jax.nn.silu(conv) * b) @ w_down

    pool_new = jnp.concatenate([pool_hist.astype(u.dtype), u], axis=1)[:, -POOL_HIST:]
    conv_new = a_ext[:, -(CONV_W - 1):]
    return x, (k, v, logf, pool_new, conv_new)


def setup_inputs(seed: int = 0) -> dict:
    key = jax.random.key(seed)
    ks = jax.random.split(key, 32)
    f32 = jnp.float32
    nrm = lambda k, shape, s: jax.random.normal(k, shape, f32) * s
    inp = {
        'x_prompt': nrm(ks[0], (BATCH, SEQ, D_MODEL), 1.0),
        'x_sample': nrm(ks[1], (DEC_BATCH, DEC_SEQ, D_MODEL), 1.0),
        'cache_fox_k': nrm(ks[2], (DEPTH, DEC_BATCH, PAST_LEN, FOX_HEADS, FOX_HEAD_DIM), 1.0),
        'cache_fox_v': nrm(ks[3], (DEPTH, DEC_BATCH, PAST_LEN, FOX_HEADS, FOX_HEAD_DIM), 1.0),
        'cache_fox_logf': jax.nn.log_sigmoid(FORGET_BIAS + nrm(ks[4], (DEPTH, DEC_BATCH, PAST_LEN, FOX_HEADS), 1.0)),
        'state_pool': nrm(ks[5], (DEPTH, DEC_BATCH, POOL_HIST, D_POOL), 1.0),
        'state_ffn_conv': nrm(ks[6], (DEPTH, DEC_BATCH, CONV_W - 1, D_FF), 1.0),
        'cache_mem_k': nrm(ks[7], (DEPTH, DEC_BATCH, N_MEM, MEM_HEADS, MEM_HEAD_DIM), 1.0),
        'cache_mem_v': nrm(ks[8], (DEPTH, DEC_BATCH, N_MEM, MEM_HEADS, MEM_HEAD_DIM), 1.0),
        'mem_prompt': nrm(ks[9], (BATCH, N_MEM, D_MODEL), 1.0),
        'g_mix': 1.0 + nrm(ks[10], (DEPTH, D_MODEL), 0.05),
        'w_in': nrm(ks[11], (DEPTH, D_MODEL, D_IN), D_MODEL ** -0.5),
        'b_f': FORGET_BIAS + nrm(ks[12], (DEPTH, FOX_HEADS), 0.5),
        'w_pool': nrm(ks[13], (DEPTH, N_POOL_GROUPS, POOL_GROUP_W, POOL_GROUP_W), POOL_GROUP_W ** -0.5),
        'pool_scale': 1.0 + nrm(ks[14], (DEPTH, D_POOL), 0.1),
        'w_o': nrm(ks[15], (DEPTH, D_MIX, D_MODEL), D_MIX ** -0.5),
        'g_xq': 1.0 + nrm(ks[16], (DEPTH, D_MODEL), 0.05),
        'g_mkv': 1.0 + nrm(ks[17], (DEPTH, D_MODEL), 0.05),
        'w_mq': nrm(ks[18], (DEPTH, D_MODEL, D_MODEL), D_MODEL ** -0.5),
        'w_mk': nrm(ks[19], (DEPTH, D_MODEL, D_MODEL), D_MODEL ** -0.5),
        'w_mv': nrm(ks[20], (DEPTH, D_MODEL, D_MODEL), D_MODEL ** -0.5),
        'w_mo': nrm(ks[21], (DEPTH, D_MODEL, D_MODEL), D_MODEL ** -0.5),
        'g_ffn': 1.0 + nrm(ks[22], (DEPTH, D_MODEL), 0.05),
        'w_up': nrm(ks[23], (DEPTH, D_MODEL, 2 * D_FF), D_MODEL ** -0.5),
        'conv_w': nrm(ks[24], (DEPTH, CONV_W, D_FF), CONV_W ** -0.5),
        'conv_b': nrm(ks[25], (DEPTH, D_FF), 0.01),
        'w_down': nrm(ks[26], (DEPTH, D_FF, D_MODEL), D_FF ** -0.5),
        'g_final': 1.0 + nrm(ks[27], (D_MODEL,), 0.05),
    }
    return inp


def reference(x_prompt, x_sample, cache_fox_k, cache_fox_v, cache_fox_logf, state_pool, state_ffn_conv,
              cache_mem_k, cache_mem_v, mem_prompt, g_mix, w_in, b_f, w_pool, pool_scale, w_o,
              g_xq, g_mkv, w_mq, w_mk, w_mv, w_mo, g_ffn, w_up, conv_w, conv_b, w_down, g_final):
    xp, xs = x_prompt, x_sample
    bp = xp.shape[0]
    past = cache_fox_k.shape[2]
    pk, pv, plf, ppool, pconv, pmk, pmv = [], [], [], [], [], [], []
    sk, sv, slf, spool, sconv = [], [], [], [], []
    for l in range(DEPTH):
        lw = (g_mix[l], w_in[l], b_f[l], w_pool[l], pool_scale[l], w_o[l], g_xq[l], w_mq[l], w_mo[l],
              g_ffn[l], w_up[l], conv_w[l], conv_b[l], w_down[l])
        mk, mv = memory_kv(mem_prompt, g_mkv[l], w_mk[l], w_mv[l])
        xp, st_p = encoder_layer(
            xp,
            jnp.zeros((bp, 0, FOX_HEADS, FOX_HEAD_DIM), xp.dtype),
            jnp.zeros((bp, 0, FOX_HEADS, FOX_HEAD_DIM), xp.dtype),
            jnp.zeros((bp, 0, FOX_HEADS), jnp.float32),
            jnp.zeros((bp, 0, D_POOL), xp.dtype),
            jnp.zeros((bp, CONV_W - 1, D_FF), xp.dtype),
            mk, mv, 0, *lw)
        xs, st_s = encoder_layer(
            xs, cache_fox_k[l], cache_fox_v[l], cache_fox_logf[l], state_pool[l], state_ffn_conv[l],
            cache_mem_k[l], cache_mem_v[l], past, *lw)
        pk.append(st_p[0]); pv.append(st_p[1]); plf.append(st_p[2]); ppool.append(st_p[3]); pconv.append(st_p[4])
        pmk.append(mk); pmv.append(mv)
        sk.append(st_s[0]); sv.append(st_s[1]); slf.append(st_s[2]); spool.append(st_s[3]); sconv.append(st_s[4])
    y_prompt = rmsnorm(xp, g_final)
    y_sample = rmsnorm(xs, g_final)
    return (y_prompt, y_sample,
            jnp.stack(pk), jnp.stack(pv), jnp.stack(plf), jnp.stack(ppool), jnp.stack(pconv),
            jnp.stack(pmk), jnp.stack(pmv),
            jnp.stack(sk), jnp.stack(sv), jnp.stack(slf), jnp.stack(spool), jnp.stack(sconv))
```

```cpp
#include <hip/hip_runtime.h>
#include <hip/hip_cooperative_groups.h>
#include <cstdio>
#include <cstdint>
namespace cg = cooperative_groups;
namespace pg8 {
#define PG8_LAS __attribute__((address_space(3)))
typedef unsigned short bf16_t;
typedef short bf16x8 __attribute__((ext_vector_type(8)));
typedef float f32x4 __attribute__((ext_vector_type(4)));
typedef unsigned u32x4 __attribute__((ext_vector_type(4)));
constexpr int BM = 256, BK = 64, HALF = 128, HTB = HALF * BK * 2  , STAGE_BYTES = 8 * HTB, NXCD = 8, WGM = 8;

__host__ __device__ __forceinline__ int lds_byte(int r, int c) { const int st = (r >> 4) * 2 + (c >> 5), rr = r & 15, cc = c & 31, ob = rr * 64 + cc * 2; return st * 1024 + (ob ^ (((ob >> 9) & 1) << 5)); }
__host__ __device__ __forceinline__ void stage_rc(int b, int& R, int& C) { const int st = b / 1024, sb = b % 1024, swz = sb ^ (((sb >> 9) & 1) << 5); R = (st >> 1) * 16 + swz / 64; C = (st & 1) * 32 + (swz % 64) / 2; }
__host__ __device__ __forceinline__ int perm32(int rho) { const int n = rho >> 4, i = rho & 15; return 8 * (i >> 2) + 4 * n + (i & 3); }

struct Unit { int pm, pn; };
struct Gemm { const bf16_t* A; const bf16_t* Bt; int M, N, K; };

struct StaticOrder {
    int nM, nN, nwg, G, c;
    __host__ __device__ void init(int M, int N, int G_, int c_) { nM = M / BM; nN = N / BM; nwg = nM * nN; G = G_; c = c_; }
    __host__ __device__ bool next(int i, Unit& u) const {
        const long L = (long)i * G + c; if (L >= nwg) return false;
        int wgid = (int)L; { const int q = nwg / NXCD, r = nwg % NXCD, xcd = wgid % NXCD, off = wgid / NXCD; wgid = (xcd < r ? xcd * (q + 1) : r * (q + 1) + (xcd - r) * q) + off; }
        const int nig = WGM * nN, gid = wgid / nig, fm = gid * WGM, gsz = (nM - fm) < WGM ? (nM - fm) : WGM;
        u.pm = fm + ((wgid % nig) % gsz); u.pn = (wgid % nig) / gsz; return true;
    }
    __device__ __forceinline__ void a_ready(const Unit&) const {}
    __device__ __forceinline__ void done(const Unit&) const {}
};

__device__ __forceinline__ unsigned cvt_pk_bf16(float lo, float hi) { unsigned r; asm volatile("v_cvt_pk_bf16_f32 %0, %1, %2" : "=v"(r) : "v"(lo), "v"(hi)); return r; }
typedef float f32x2 __attribute__((ext_vector_type(2)));
template <class Epi, class Sched, bool ALIGN_EPI = false, bool SP2 = false>
__device__ __forceinline__ void gemm_phase(PG8_LAS unsigned char* lds, const Gemm g, const Sched& S, const Epi& E) {
    const int tid = threadIdx.x, wid = __builtin_amdgcn_readfirstlane(tid >> 6), lane = tid & 63, wr = wid >> 2, wc = wid & 3, fr = lane & 15, fq = lane >> 4;
    const int K = g.K, nt = K / BK;
    unsigned voffA[2], voffB[2];
#pragma unroll
    for (int i = 0; i < 2; ++i) { int R, C; stage_rc(tid * 16 + i * 8192, R, C); const int Rb = Epi::PERM ? ((R & ~31) + perm32(R & 31)) : R;
        voffA[i] = (unsigned)(R * K + C) * 2u; voffB[i] = (unsigned)(Rb * K + C) * 2u; }
    const size_t kstep = (size_t)(BK * 2);
    const size_t hstep = (size_t)HALF * K * 2;
    const size_t tstep = 2 * hstep;
    const unsigned ldsw = (unsigned)wid * 1024u;
    const int aoff = lds_byte(wr * 64 + fr, fq * 8), boff = lds_byte(wc * 32 + fr, fq * 8);
#define PG8_SA(b, h) (((b) * 2 + (h)) * HTB)
#define PG8_SB(b, h) ((4 + (b) * 2 + (h)) * HTB)
#define PG8_STAGE(bufoff, gbase, voff) do { _Pragma("unroll") for (int _i = 0; _i < 2; ++_i) \
        __builtin_amdgcn_global_load_lds((const unsigned*)((const char*)(gbase) + (voff)[_i]), (PG8_LAS unsigned*)(lds + (bufoff) + ldsw + _i * 8192), 16, 0, 0); } while (0)
#define PG8_LDA(dst, b, h) do { _Pragma("unroll") for (int m = 0; m < 4; ++m) _Pragma("unroll") for (int k = 0; k < 2; ++k) dst[m][k] = *(const PG8_LAS bf16x8*)(lds + PG8_SA(b, h) + aoff + m * 2048 + k * 1024); } while (0)
#define PG8_LDB(dst, b, h) do { _Pragma("unroll") for (int n = 0; n < 2; ++n) _Pragma("unroll") for (int k = 0; k < 2; ++k) dst[n][k] = *(const PG8_LAS bf16x8*)(lds + PG8_SB(b, h) + boff + n * 2048 + k * 1024); } while (0)
#define PG8_MMA(ai, bj, At, Bt) do { __builtin_amdgcn_s_setprio(1); _Pragma("unroll") for (int m = 0; m < 4; ++m) _Pragma("unroll") for (int n = 0; n < 2; ++n) _Pragma("unroll") for (int k = 0; k < 2; ++k) \
        acc[ai][bj][m][n] = __builtin_amdgcn_mfma_f32_16x16x32_bf16(Bt[n][k], At[m][k], acc[ai][bj][m][n], 0, 0, 0); __builtin_amdgcn_s_setprio(0); } while (0)
#define PG8_WAIT_V(n) asm volatile("s_waitcnt vmcnt(" #n ")" ::: "memory")
#define PG8_WAIT_L(n) asm volatile("s_waitcnt lgkmcnt(" #n ")" ::: "memory")
#define PG8_BAR __builtin_amdgcn_s_barrier()
#define PG8_SCHED __builtin_amdgcn_sched_barrier(0)
    Unit cur, nxt; int ui = 0;
    if (!S.next(0, cur)) return;
    f32x4 acc[2][2][4][2];
#pragma unroll
    for (int a = 0; a < 2; ++a)
#pragma unroll
        for (int b = 0; b < 2; ++b)
#pragma unroll
            for (int m = 0; m < 4; ++m)
#pragma unroll
                for (int n = 0; n < 2; ++n) acc[a][b][m][n] = (f32x4){0.f, 0.f, 0.f, 0.f};
    bf16x8 At[4][2], B0[2][2], B1[2][2];
    const char* cA = (const char*)g.A + (size_t)cur.pm * tstep; const char* cB = (const char*)g.Bt + (size_t)cur.pn * tstep;
    S.a_ready(cur);
    if constexpr (SP2) {
        PG8_STAGE(PG8_SB(0, 0), cB, voffB); PG8_STAGE(PG8_SB(0, 1), cB + hstep, voffB); PG8_STAGE(PG8_SA(0, 0), cA, voffA); PG8_STAGE(PG8_SA(0, 1), cA + hstep, voffA);
        if (wr == 1) PG8_BAR;
        PG8_WAIT_V(2); PG8_BAR;
        PG8_STAGE(PG8_SB(1, 0), cB + kstep, voffB); PG8_STAGE(PG8_SA(1, 0), cA + kstep, voffA); PG8_STAGE(PG8_SB(1, 1), cB + hstep + kstep, voffB);
        PG8_WAIT_V(6); PG8_BAR;
    } else {
        PG8_STAGE(PG8_SB(0, 0), cB, voffB); PG8_STAGE(PG8_SA(0, 0), cA, voffA); PG8_STAGE(PG8_SB(0, 1), cB + hstep, voffB); PG8_STAGE(PG8_SA(0, 1), cA + hstep, voffA);
        if (wr == 1) PG8_BAR;
        PG8_WAIT_V(4); PG8_BAR;
        PG8_STAGE(PG8_SB(1, 0), cB + kstep, voffB); PG8_STAGE(PG8_SA(1, 0), cA + kstep, voffA); PG8_STAGE(PG8_SB(1, 1), cB + hstep + kstep, voffB);
        PG8_WAIT_V(6); PG8_BAR;
    }
    for (;;) {
        const bool has_next = S.next(ui + 1, nxt);
        const char* nA = has_next ? (const char*)g.A + (size_t)nxt.pm * tstep : cA; const char* nB = has_next ? (const char*)g.Bt + (size_t)nxt.pn * tstep : cB;
        for (int t = 0; t < nt; t += 2) {
            const bool last = (t == nt - 2);
            const char* a1 = cA + (size_t)(t + 1) * kstep;
            const char* a2 = last ? nA : cA + (size_t)(t + 2) * kstep; const char* b2 = last ? nB : cB + (size_t)(t + 2) * kstep;
            const char* a3 = a2 + kstep; const char* b3 = b2 + kstep;
            if (last && has_next) S.a_ready(nxt);
            if constexpr (SP2) {
            PG8_LDB(B0, 0, 0); PG8_LDB(B1, 0, 1); PG8_SCHED; PG8_LDA(At, 0, 0); PG8_STAGE(PG8_SA(1, 1), a1 + hstep, voffA);
            PG8_WAIT_V(8); PG8_WAIT_L(0); PG8_BAR; PG8_MMA(0, 0, At, B0); PG8_MMA(0, 1, At, B1); PG8_BAR; PG8_SCHED;
            PG8_LDA(At, 0, 1); PG8_STAGE(PG8_SB(0, 0), b2, voffB); PG8_STAGE(PG8_SB(0, 1), b2 + hstep, voffB); PG8_STAGE(PG8_SA(0, 0), a2, voffA);
            PG8_WAIT_V(8); PG8_WAIT_L(0); PG8_BAR; PG8_MMA(1, 0, At, B0); PG8_MMA(1, 1, At, B1); PG8_BAR; PG8_SCHED;
            PG8_LDB(B0, 1, 0); PG8_LDB(B1, 1, 1); PG8_SCHED; PG8_LDA(At, 1, 0); PG8_STAGE(PG8_SA(0, 1), a2 + hstep, voffA);
            PG8_WAIT_V(8); PG8_WAIT_L(0); PG8_BAR; PG8_MMA(0, 0, At, B0); PG8_MMA(0, 1, At, B1); PG8_BAR; PG8_SCHED;
            PG8_LDA(At, 1, 1); PG8_STAGE(PG8_SB(1, 0), b3, voffB); PG8_STAGE(PG8_SB(1, 1), b3 + hstep, voffB); PG8_STAGE(PG8_SA(1, 0), a3, voffA);
            PG8_WAIT_V(8); PG8_WAIT_L(0); PG8_BAR; PG8_MMA(1, 0, At, B0); PG8_MMA(1, 1, At, B1); PG8_BAR; PG8_SCHED;
            } else {
            PG8_LDB(B0, 0, 0); PG8_SCHED; PG8_LDA(At, 0, 0); PG8_STAGE(PG8_SA(1, 1), a1 + hstep, voffA);
            PG8_WAIT_L(8); PG8_BAR; PG8_WAIT_L(0); PG8_MMA(0, 0, At, B0); PG8_BAR; PG8_SCHED;
            PG8_LDB(B1, 0, 1); PG8_STAGE(PG8_SB(0, 0), b2, voffB);
            PG8_BAR; PG8_WAIT_L(0); PG8_MMA(0, 1, At, B1); PG8_BAR;
            PG8_LDA(At, 0, 1); PG8_STAGE(PG8_SA(0, 0), a2, voffA);
            PG8_BAR; PG8_WAIT_L(0); PG8_MMA(1, 0, At, B0); PG8_BAR; PG8_SCHED;
            PG8_STAGE(PG8_SB(0, 1), b2 + hstep, voffB);
            PG8_WAIT_V(6); PG8_BAR; PG8_MMA(1, 1, At, B1); PG8_BAR;
            PG8_LDB(B0, 1, 0); PG8_SCHED; PG8_LDA(At, 1, 0); PG8_STAGE(PG8_SA(0, 1), a2 + hstep, voffA);
            PG8_WAIT_L(8); PG8_BAR; PG8_WAIT_L(0); PG8_MMA(0, 0, At, B0); PG8_BAR; PG8_SCHED;
            PG8_LDB(B1, 1, 1); PG8_STAGE(PG8_SB(1, 0), b3, voffB);
            PG8_BAR; PG8_WAIT_L(0); PG8_MMA(0, 1, At, B1); PG8_BAR;
            PG8_LDA(At, 1, 1); PG8_STAGE(PG8_SA(1, 0), a3, voffA);
            PG8_BAR; PG8_WAIT_L(0); PG8_MMA(1, 0, At, B0); PG8_BAR; PG8_SCHED;
            PG8_STAGE(PG8_SB(1, 1), b3 + hstep, voffB);
            PG8_WAIT_V(6); PG8_BAR; PG8_MMA(1, 1, At, B1); PG8_BAR;
            }
        }
        if constexpr (ALIGN_EPI) { if (wr == 0) PG8_BAR; }
        if constexpr (!Epi::AFTER_DRAIN) { E(acc, cur, wr, wc, fr, fq); S.done(cur); }
        if (!has_next) break;
#pragma unroll
        for (int a = 0; a < 2; ++a)
#pragma unroll
            for (int b = 0; b < 2; ++b)
#pragma unroll
                for (int m = 0; m < 4; ++m)
#pragma unroll
                    for (int n = 0; n < 2; ++n) acc[a][b][m][n] = (f32x4){0.f, 0.f, 0.f, 0.f};
        cur = nxt; cA = nA; cB = nB; ++ui;
        if constexpr (ALIGN_EPI) { if (wr == 1) PG8_BAR; }
    }
    PG8_WAIT_V(0);
    if constexpr (!ALIGN_EPI) { if (wr == 0) PG8_BAR; }
    PG8_BAR;
    if constexpr (Epi::AFTER_DRAIN) { E.fused(acc, cur, wr, wc, fr, fq, lds, wid, lane); S.done(cur); }
#undef PG8_SA
#undef PG8_SB
#undef PG8_STAGE
#undef PG8_LDA
#undef PG8_LDB
#undef PG8_MMA
#undef PG8_WAIT_V
#undef PG8_WAIT_L
#undef PG8_BAR
#undef PG8_SCHED
}
}

using pg8::bf16_t; using pg8::bf16x8; using pg8::f32x4; using pg8::u32x4; using pg8::Unit;
typedef float f32x2_t __attribute__((ext_vector_type(2))); typedef __bf16 bf16x2_t __attribute__((ext_vector_type(2)));
__device__ __forceinline__ unsigned cvt_pk_bf16(float lo, float hi) { f32x2_t v = {lo, hi}; bf16x2_t b = __builtin_convertvector(v, bf16x2_t); return __builtin_bit_cast(unsigned, b); }
typedef float f32x16 __attribute__((ext_vector_type(16)));
typedef unsigned u32x2 __attribute__((ext_vector_type(2)));
#define LAS __attribute__((address_space(3)))

constexpr int DM = 1024, MP = 65536, MS = 1024, MT = MP + MS, SEQ = 2048, DSEQ = 64, PAST = 4096, NMEM = 256;
constexpr int DFF = 2816, NUP = 2 * DFF, NSEG = MT / 64;
constexpr float EPS = 1e-6f, LOG2E = 1.4426950408889634f;
constexpr float C2F = 0.125f * LOG2E, C2M = 0.0625f * LOG2E;
constexpr float NEGBIG = -1e30f;

constexpr size_t O_YP = 0, O_YS = O_YP + (size_t)MP * DM, O_KP = O_YS + (size_t)MS * DM, O_VP = O_KP + (size_t)MP * 512, O_LFP = O_VP + (size_t)MP * 512,
    O_PSP = O_LFP + (size_t)MP * 8, O_CSP = O_PSP + 32 * 15 * 512, O_MKP = O_CSP + 32 * 2 * DFF, O_MVP = O_MKP + (size_t)8192 * 1024, O_KS = O_MVP + (size_t)8192 * 1024,
    O_VS = O_KS + (size_t)MS * 512, O_LFS = O_VS + (size_t)MS * 512, O_PSS = O_LFS + MS * 8, O_CSS = O_PSS + 16 * 15 * 512, O_END = O_CSS + 16 * 2 * DFF;

constexpr size_t MiB = 1u << 20;
constexpr size_t WS_WIN = 1 * MiB, WS_WO = 5 * MiB, WS_WMQ = 7 * MiB, WS_WMO = 9 * MiB, WS_WMKV = 11 * MiB, WS_WUP = 15 * MiB, WS_WDN = 26 * MiB, WS_WPOOL = 32 * MiB;
constexpr size_t WS_MKB = 40 * MiB, WS_MVB = 64 * MiB;
constexpr size_t WS_SSQ1 = 88 * MiB, WS_SSQ2 = 93 * MiB, WS_SSQ3 = 98 * MiB;
constexpr size_t WS_KBP = 103 * MiB, WS_KBS = 105 * MiB;
constexpr size_t WS_AHEAD = 108 * MiB, WS_ATAIL = WS_AHEAD + 23 * MiB / 1 - MiB / 2, WS_BHEAD = WS_ATAIL + 23 * MiB - MiB / 2;
constexpr size_t WS_X1B = 176 * MiB, WS_KCB = 176 * MiB, WS_VCB = 240 * MiB;
constexpr size_t WS_X2B = 306 * MiB;
constexpr size_t WS_XB = 436 * MiB, WS_MQB = 436 * MiB, WS_HFF = 436 * MiB;
constexpr size_t WS_UQKV = 566 * MiB, WS_MO = 566 * MiB;
constexpr size_t WS_MIX = 826 * MiB, WS_MEMB = 956 * MiB, WS_NEED = 972 * MiB;
static_assert((size_t)NSEG * 2 * DFF * 4 <= 22 * MiB + MiB / 2, "side buffers");
static_assert(WS_BHEAD + 22 * MiB + MiB / 2 <= WS_X1B, "side buffers end");

#define P2_ATTN_P 1
#define P2_ATTN_S 1
#define P2_POOL 1
#define DBG_HI 11
#ifndef PHMASK
#define PHMASK 0x7ff
#endif
constexpr int LDS_BYTES = 147456;

struct Params { const float* in[28]; float* out; unsigned char* ws; int ph_lo, ph_hi; };

__device__ __forceinline__ float bf_lo(unsigned w) { return __builtin_bit_cast(float, w << 16); }
__device__ __forceinline__ float bf_hi(unsigned w) { return __builtin_bit_cast(float, w & 0xffff0000u); }
__device__ __forceinline__ int crow(int r, int hi) { return (r & 3) + 8 * (r >> 2) + 4 * hi; }
__device__ __forceinline__ float wave_sum(float v) {
#pragma unroll
    for (int o = 1; o < 64; o <<= 1) v += __shfl_xor(v, o);
    return v;
}
__device__ __forceinline__ float rsq(float ssq) { return 1.0f / sqrtf(ssq * (1.0f / 1024.0f) + EPS); }
#define LDS_WAIT() asm volatile("s_waitcnt lgkmcnt(0)" ::: "memory")

typedef const f32x4 (&AccRef)[2][2][4][2];

__device__ __forceinline__ u32x4 pack8(f32x4 v0, f32x4 v1) { u32x4 w; w.x = cvt_pk_bf16(v0[0], v0[1]); w.y = cvt_pk_bf16(v0[2], v0[3]); w.z = cvt_pk_bf16(v1[0], v1[1]); w.w = cvt_pk_bf16(v1[2], v1[3]); return w; }

struct EpiIn {
    static constexpr bool PERM = true, AFTER_DRAIN = false;
    bf16_t* uqkv; float* out;
    __device__ __forceinline__ void operator()(AccRef acc, const Unit& u, int wr, int wc, int fr, int fq) const {
        const int t = u.pn >> 1;
        const int col0 = (u.pn & 1) * 256 + wc * 32 + 8 * fq;
        bf16_t* base = uqkv + (size_t)t * MT * 512;
        const float sc = (t == 1) ? C2F : 1.0f;
#pragma unroll
        for (int ai = 0; ai < 2; ++ai)
#pragma unroll
            for (int m = 0; m < 4; ++m) {
                const int row = u.pm * 256 + ai * 128 + wr * 64 + m * 16 + fr;
#pragma unroll
                for (int bj = 0; bj < 2; ++bj) {
                    const int col = col0 + bj * 128;
                    const f32x4 v0 = acc[ai][bj][m][0] * sc, v1 = acc[ai][bj][m][1] * sc;
                    *(u32x4*)(base + (size_t)row * 512 + col) = pack8(v0, v1);
                    if (t >= 2) {
                        float* o = (row < MP) ? out + (t == 2 ? O_KP : O_VP) + (size_t)row * 512 : out + (t == 2 ? O_KS : O_VS) + (size_t)(row - MP) * 512;
                        *(f32x4*)(o + col) = v0; *(f32x4*)(o + col + 4) = v1;
                    } else if (t == 0) {
                        if (row < MP) { const int tt = row & (SEQ - 1); if (tt >= SEQ - 15) { float* o = out + O_PSP + ((size_t)(row >> 11) * 15 + (tt - (SEQ - 15))) * 512 + col; *(f32x4*)o = v0; *(f32x4*)(o + 4) = v1; } }
                        else { const int rs = row - MP, tt = rs & 63; if (tt >= DSEQ - 15) { float* o = out + O_PSS + ((size_t)(rs >> 6) * 15 + (tt - (DSEQ - 15))) * 512 + col; *(f32x4*)o = v0; *(f32x4*)(o + 4) = v1; } }
                    }
                }
            }
    }
};
struct EpiMkv {
    static constexpr bool PERM = true, AFTER_DRAIN = false;
    bf16_t* mkb; bf16_t* mvb; float* out;
    __device__ __forceinline__ void operator()(AccRef acc, const Unit& u, int wr, int wc, int fr, int fq) const {
        const int t = u.pn >> 2;
        const int col0 = (u.pn & 3) * 256 + wc * 32 + 8 * fq;
        bf16_t* bb = t ? mvb : mkb; float* of = out + (t ? O_MVP : O_MKP);
#pragma unroll
        for (int ai = 0; ai < 2; ++ai)
#pragma unroll
            for (int m = 0; m < 4; ++m) {
                const int row = u.pm * 256 + ai * 128 + wr * 64 + m * 16 + fr;
#pragma unroll
                for (int bj = 0; bj < 2; ++bj) {
                    const int col = col0 + bj * 128;
                    const f32x4 v0 = acc[ai][bj][m][0], v1 = acc[ai][bj][m][1];
                    *(u32x4*)(bb + (size_t)row * 1024 + col) = pack8(v0, v1);
                    *(f32x4*)(of + (size_t)row * 1024 + col) = v0; *(f32x4*)(of + (size_t)row * 1024 + col + 4) = v1;
                }
            }
    }
};
template <int MODE> struct EpiRes {
    static constexpr bool PERM = true, AFTER_DRAIN = false;
    const float* xP; const float* xS; const bf16_t* resB; bf16_t* xo; float* yo; float* ssqp;
    __device__ __forceinline__ void operator()(AccRef acc, const Unit& u, int wr, int wc, int fr, int fq) const {
        const int col0 = u.pn * 256 + wc * 32 + 8 * fq;
#pragma unroll
        for (int ai = 0; ai < 2; ++ai)
#pragma unroll
            for (int m = 0; m < 4; ++m) {
                const int row = u.pm * 256 + ai * 128 + wr * 64 + m * 16 + fr;
                float ss = 0.f;
#pragma unroll
                for (int bj = 0; bj < 2; ++bj) {
                    const int col = col0 + bj * 128;
                    f32x4 r0, r1;
                    if (MODE == 0) { const float* xr = (row < MP) ? xP + (size_t)row * DM : xS + (size_t)(row - MP) * DM; r0 = *(const f32x4*)(xr + col); r1 = *(const f32x4*)(xr + col + 4); }
                    else { const u32x4 w = *(const u32x4*)(resB + (size_t)row * DM + col); r0 = (f32x4){bf_lo(w.x), bf_hi(w.x), bf_lo(w.y), bf_hi(w.y)}; r1 = (f32x4){bf_lo(w.z), bf_hi(w.z), bf_lo(w.w), bf_hi(w.w)}; }
                    const f32x4 v0 = acc[ai][bj][m][0] + r0, v1 = acc[ai][bj][m][1] + r1;
                    ss += (v0[0] * v0[0] + v0[1] * v0[1]) + (v0[2] * v0[2] + v0[3] * v0[3]) + (v1[0] * v1[0] + v1[1] * v1[1]) + (v1[2] * v1[2] + v1[3] * v1[3]);
                    if (MODE == 2) { float* yr = (row < MP) ? yo + O_YP + (size_t)row * DM : yo + O_YS + (size_t)(row - MP) * DM; *(f32x4*)(yr + col) = v0; *(f32x4*)(yr + col + 4) = v1; }
                    else *(u32x4*)(xo + (size_t)row * DM + col) = pack8(v0, v1);
                }
                ss += __shfl_xor(ss, 16); ss += __shfl_xor(ss, 32);
                if (fq == 0) ssqp[(size_t)row * 16 + u.pn * 4 + wc] = ss;
            }
    }
};
__device__ __forceinline__ float row_rsq(const float* ssqp, int row) {
    const f32x4* sp = (const f32x4*)(ssqp + (size_t)row * 16);
    const f32x4 a = sp[0], b = sp[1], c = sp[2], d = sp[3];
    const float s = ((a[0] + a[1]) + (a[2] + a[3])) + ((b[0] + b[1]) + (b[2] + b[3])) + ((c[0] + c[1]) + (c[2] + c[3])) + ((d[0] + d[1]) + (d[2] + d[3]));
    return rsq(s);
}
struct EpiMq {
    static constexpr bool PERM = true, AFTER_DRAIN = false;
    const float* ssqp; bf16_t* mq;
    __device__ __forceinline__ void operator()(AccRef acc, const Unit& u, int wr, int wc, int fr, int fq) const {
        const int col0 = u.pn * 256 + wc * 32 + 8 * fq;
#pragma unroll
        for (int ai = 0; ai < 2; ++ai)
#pragma unroll
            for (int m = 0; m < 4; ++m) {
                const int row = u.pm * 256 + ai * 128 + wr * 64 + m * 16 + fr;
                const float r = row_rsq(ssqp, row) * C2M;
#pragma unroll
                for (int bj = 0; bj < 2; ++bj) *(u32x4*)(mq + (size_t)row * DM + col0 + bj * 128) = pack8(acc[ai][bj][m][0] * r, acc[ai][bj][m][1] * r);
            }
    }
};
struct EpiUp {
    static constexpr bool PERM = true, AFTER_DRAIN = false;
    const float* ssqp; const float* cw; const float* cb; bf16_t* hff; float* ahead; float* atail; float* bhead;
    __device__ __forceinline__ void operator()(AccRef acc, const Unit& u, int wr, int wc, int fr, int fq) const {
        const int lane = fq * 16 + fr;
        const int c0 = u.pn * 128 + wc * 32 + 8 * fq;
        f32x4 w0[2], w1[2], w2[2], bb[2];
#pragma unroll
        for (int n = 0; n < 2; ++n) { w0[n] = *(const f32x4*)(cw + c0 + 4 * n); w1[n] = *(const f32x4*)(cw + DFF + c0 + 4 * n); w2[n] = *(const f32x4*)(cw + 2 * DFF + c0 + 4 * n); bb[n] = *(const f32x4*)(cb + c0 + 4 * n); }
        const int src1 = (lane & 48) | ((fr + 15) & 15), src2 = (lane & 48) | ((fr + 14) & 15);
#pragma unroll
        for (int ai = 0; ai < 2; ++ai) {
            const int seg = u.pm * 4 + ai * 2 + wr;
            const int rowb = u.pm * 256 + ai * 128 + wr * 64;
            f32x4 ap[2] = {{0.f, 0.f, 0.f, 0.f}, {0.f, 0.f, 0.f, 0.f}};
#pragma unroll
            for (int m = 0; m < 4; ++m) {
                const int row = rowb + m * 16 + fr;
                const float r = row_rsq(ssqp, row);
                f32x4 a[2], b[2], h[2];
#pragma unroll
                for (int n = 0; n < 2; ++n) {
                    a[n] = acc[ai][0][m][n] * r; b[n] = acc[ai][1][m][n] * r;
                    f32x4 a1, a2;
#pragma unroll
                    for (int e = 0; e < 4; ++e) {
                        const float x1 = (fr == 15) ? ap[n][e] : a[n][e]; a1[e] = __shfl(x1, src1);
                        const float x2 = (fr >= 14) ? ap[n][e] : a[n][e]; a2[e] = __shfl(x2, src2);
                    }
                    const f32x4 cv = bb[n] + w0[n] * a2 + w1[n] * a1 + w2[n] * a[n];
#pragma unroll
                    for (int e = 0; e < 4; ++e) h[n][e] = cv[e] * __builtin_amdgcn_rcpf(1.0f + __builtin_amdgcn_exp2f(-cv[e] * LOG2E)) * b[n][e];
                    ap[n] = a[n];
                }
                if (m == 0 && fr < 2) {
                    float* pa = ahead + ((size_t)seg * 2 + fr) * DFF + c0; float* pb = bhead + ((size_t)seg * 2 + fr) * DFF + c0;
                    *(f32x4*)pa = a[0]; *(f32x4*)(pa + 4) = a[1]; *(f32x4*)pb = b[0]; *(f32x4*)(pb + 4) = b[1];
                } else {
                    *(u32x4*)(hff + (size_t)row * DFF + c0) = pack8(h[0], h[1]);
                }
                if (m == 3 && fr >= 14) { float* pt = atail + ((size_t)seg * 2 + (fr - 14)) * DFF + c0; *(f32x4*)pt = a[0]; *(f32x4*)(pt + 4) = a[1]; }
            }
        }
    }
};

template <int D, int KT, bool CAUSAL, bool BIAS>
__device__ __forceinline__ void attn_unit(LAS unsigned char* L, const bf16_t* __restrict__ Q, int ldq, int nq,
                                          const bf16_t* __restrict__ K0, const bf16_t* __restrict__ V0, int nt0, const bf16_t* __restrict__ K1, const bf16_t* __restrict__ V1, int ldk, int ntiles,
                                          const float* __restrict__ kbias, int qpos0, bf16_t* __restrict__ O, int ldo) {
    constexpr int KS = D + 8, VS = KT + 4, CH = D / 8, NKI = KT * CH / 512, NVI = ((KT / 2) * CH + 511) / 512, NQF = (D == 64) ? 4 : 1, NP = KT / 32;
    const int tid = threadIdx.x, lane = tid & 63, wid = __builtin_amdgcn_readfirstlane(tid >> 6), r32 = lane & 31, hi = lane >> 5;
    LAS bf16_t* Ks = (LAS bf16_t*)L; LAS bf16_t* Vt = (LAS bf16_t*)(L + KT * KS * 2); LAS float* Bs = (LAS float*)(L + KT * KS * 2 + D * VS * 2);
    const bool wactive = wid * 32 < nq;
    const bf16_t* qrow = Q + (size_t)(wid * 32 + r32) * ldq + hi * 8;
    bf16x8 qf[NQF];
    if (D == 64) {
#pragma unroll
        for (int ds = 0; ds < NQF; ++ds) qf[ds] = wactive ? *(const bf16x8*)(qrow + ds * 16) : (bf16x8){0, 0, 0, 0, 0, 0, 0, 0};
    }
    f32x16 o[D / 32];
#pragma unroll
    for (int db = 0; db < D / 32; ++db)
#pragma unroll
        for (int r = 0; r < 16; ++r) o[db][r] = 0.f;
    float mrun = NEGBIG, lrun = 0.f;
    u32x4 kreg[NKI], vreg[NVI][2]; float breg = 0.f;
#define ATT_PREFETCH(j) do { const bf16_t* Kt_ = ((j) < nt0) ? K0 + (size_t)(j) * KT * ldk : K1 + (size_t)((j) - nt0) * KT * ldk; \
        const bf16_t* Vg_ = ((j) < nt0) ? V0 + (size_t)(j) * KT * ldk : V1 + (size_t)((j) - nt0) * KT * ldk; \
        _Pragma("unroll") for (int i_ = 0; i_ < NKI; ++i_) { const int id_ = tid + 512 * i_, row_ = id_ / CH, ch_ = id_ % CH; kreg[i_] = *(const u32x4*)(Kt_ + (size_t)row_ * ldk + ch_ * 8); } \
        _Pragma("unroll") for (int i_ = 0; i_ < NVI; ++i_) { const int id_ = tid + 512 * i_; if (id_ < (KT / 2) * CH) { const int pr_ = id_ / CH, ch_ = id_ % CH; \
            vreg[i_][0] = *(const u32x4*)(Vg_ + (size_t)(2 * pr_) * ldk + ch_ * 8); vreg[i_][1] = *(const u32x4*)(Vg_ + (size_t)(2 * pr_ + 1) * ldk + ch_ * 8); } } \
        if (BIAS && tid < KT) breg = kbias[(j) * KT + tid]; } while (0)
    ATT_PREFETCH(0);
    for (int j = 0; j < ntiles; ++j) {
        __syncthreads();
#pragma unroll
        for (int i = 0; i < NKI; ++i) { const int id = tid + 512 * i, row = id / CH, ch = id % CH; *(LAS u32x4*)(Ks + row * KS + ch * 8) = kreg[i]; }
#pragma unroll
        for (int i = 0; i < NVI; ++i) { const int id = tid + 512 * i; if (id < (KT / 2) * CH) { const int pr = id / CH, ch = id % CH;
#pragma unroll
                for (int e = 0; e < 4; ++e) { const unsigned lo = vreg[i][0][e], h2 = vreg[i][1][e];
                    *(LAS unsigned*)(Vt + (ch * 8 + 2 * e) * VS + 2 * pr) = (lo & 0xffffu) | (h2 << 16);
                    *(LAS unsigned*)(Vt + (ch * 8 + 2 * e + 1) * VS + 2 * pr) = (lo >> 16) | (h2 & 0xffff0000u); } } }
        if (BIAS && tid < KT) Bs[tid] = breg;
        __syncthreads();
        if (j + 1 < ntiles) ATT_PREFETCH(j + 1);
        if (wactive && (!CAUSAL || KT * j <= qpos0 + wid * 32 + 31)) {
            f32x16 p[NP];
            const bf16_t* qr_ = qrow; if (D != 64) asm volatile("" : "+v"(qr_));
#pragma unroll
            for (int h = 0; h < NP; ++h) {
                if (BIAS) {
#pragma unroll
                    for (int i = 0; i < 4; ++i) { const f32x4 t0 = *(const LAS f32x4*)(Bs + 32 * h + 8 * i + 4 * hi);
#pragma unroll
                        for (int e = 0; e < 4; ++e) p[h][4 * i + e] = t0[e]; }
                } else {
#pragma unroll
                    for (int r = 0; r < 16; ++r) p[h][r] = 0.f;
                }
            }
#pragma unroll
            for (int ds = 0; ds < D / 16; ++ds) {
                bf16x8 qv; if (D == 64) qv = qf[ds]; else qv = *(const bf16x8*)(qr_ + ds * 16);
#pragma unroll
                for (int h = 0; h < NP; ++h) { const bf16x8 kf = *(const LAS bf16x8*)(Ks + (32 * h + r32) * KS + ds * 16 + hi * 8); p[h] = __builtin_amdgcn_mfma_f32_32x32x16_bf16(kf, qv, p[h], 0, 0, 0); }
            }
            if (CAUSAL && (KT * j + KT - 1 > qpos0 + wid * 32)) {
                const int lim = qpos0 + wid * 32 + r32 - KT * j;
#pragma unroll
                for (int h = 0; h < NP; ++h)
#pragma unroll
                    for (int r = 0; r < 16; ++r) { if (crow(r, hi) + 32 * h > lim) p[h][r] = NEGBIG; }
            }
            float mx = p[0][0];
#pragma unroll
            for (int h = 0; h < NP; ++h)
#pragma unroll
                for (int r = 0; r < 16; ++r) mx = fmaxf(mx, p[h][r]);
            mx = fmaxf(mx, __shfl_xor(mx, 32));
            const float mnew = fmaxf(mrun, mx), alpha = __builtin_amdgcn_exp2f(mrun - mnew); mrun = mnew;
            float sum = 0.f;
#pragma unroll
            for (int h = 0; h < NP; ++h)
#pragma unroll
                for (int r = 0; r < 16; ++r) { p[h][r] = __builtin_amdgcn_exp2f(p[h][r] - mnew); sum += p[h][r]; }
            lrun = lrun * alpha + sum;
#pragma unroll
            for (int db = 0; db < D / 32; ++db)
#pragma unroll
                for (int r = 0; r < 16; ++r) o[db][r] *= alpha;
            u32x4 pw[2 * NP];
#pragma unroll
            for (int h = 0; h < NP; ++h)
#pragma unroll
                for (int e = 0; e < 4; ++e) { pw[2 * h][e] = pg8::cvt_pk_bf16(p[h][2 * e], p[h][2 * e + 1]); pw[2 * h + 1][e] = pg8::cvt_pk_bf16(p[h][8 + 2 * e], p[h][9 + 2 * e]); }
#pragma unroll
            for (int db = 0; db < D / 32; ++db)
#pragma unroll
                for (int ks = 0; ks < 2 * NP; ++ks) {
                    const LAS bf16_t* vp = Vt + (db * 32 + r32) * VS + ks * 16 + hi * 4;
                    const u32x2 va = *(const LAS u32x2*)vp, vb = *(const LAS u32x2*)(vp + 8);
                    const u32x4 vv = {va.x, va.y, vb.x, vb.y};
                    o[db] = __builtin_amdgcn_mfma_f32_32x32x16_bf16(__builtin_bit_cast(bf16x8, vv), __builtin_bit_cast(bf16x8, pw[ks]), o[db], 0, 0, 0);
                }
        }
    }
#undef ATT_PREFETCH
    if (wactive) {
        const float lt = lrun + __shfl_xor(lrun, 32), inv = 1.0f / lt;
        bf16_t* orow = O + (size_t)(wid * 32 + r32) * ldo;
#pragma unroll
        for (int db = 0; db < D / 32; ++db)
#pragma unroll
            for (int i = 0; i < 4; ++i) { u32x2 w; w.x = pg8::cvt_pk_bf16(o[db][4 * i] * inv, o[db][4 * i + 1] * inv); w.y = pg8::cvt_pk_bf16(o[db][4 * i + 2] * inv, o[db][4 * i + 3] * inv);
                *(u32x2*)(orow + db * 32 + 8 * i + 4 * hi) = w; }
    }
}

__device__ __forceinline__ void pool_unit(int tile, const bf16_t* __restrict__ ub, const float* __restrict__ hist, const bf16_t* __restrict__ wpt, bf16_t* __restrict__ mix) {
    const int tid = threadIdx.x, lane = tid & 63, wid = tid >> 6, r32 = lane & 31, hi = lane >> 5;
    const int row = tile * 256 + wid * 32 + r32;
    const bool samp = row >= MP;
    const int b = samp ? (row - MP) >> 6 : row >> 11, t = samp ? (row - MP) & 63 : row & (SEQ - 1);
    const bf16_t* urow = ub + (size_t)row * 512;
    bf16_t* orow = mix + (size_t)row * DM;
#pragma unroll 1
    for (int g = 0; g < 4; ++g) {
        const int w = 2 << g;
        const float cnt = samp ? (float)w : (float)((t + 1 < w) ? t + 1 : w);
        const float icnt = 1.0f / cnt;
        bf16x8 dfr[8];
#pragma unroll
        for (int ks = 0; ks < 8; ++ks) {
            const int c0 = g * 128 + ks * 16 + hi * 8;
            const u32x4 cu = *(const u32x4*)(urow + c0);
            float s[8], cur[8];
            cur[0] = bf_lo(cu.x); cur[1] = bf_hi(cu.x); cur[2] = bf_lo(cu.y); cur[3] = bf_hi(cu.y); cur[4] = bf_lo(cu.z); cur[5] = bf_hi(cu.z); cur[6] = bf_lo(cu.w); cur[7] = bf_hi(cu.w);
#pragma unroll
            for (int e = 0; e < 8; ++e) s[e] = cur[e];
#pragma unroll 1
            for (int j = 1; j < w; ++j) {
                const int tt = t - j;
                if (tt >= 0) {
                    const u32x4 v = *(const u32x4*)(urow - (size_t)j * 512 + c0);
                    s[0] += bf_lo(v.x); s[1] += bf_hi(v.x); s[2] += bf_lo(v.y); s[3] += bf_hi(v.y); s[4] += bf_lo(v.z); s[5] += bf_hi(v.z); s[6] += bf_lo(v.w); s[7] += bf_hi(v.w);
                } else if (samp) {
                    const float* hp = hist + ((size_t)b * 15 + (15 + tt)) * 512 + c0;
                    const f32x4 h0 = *(const f32x4*)hp, h1 = *(const f32x4*)(hp + 4);
                    s[0] += h0[0]; s[1] += h0[1]; s[2] += h0[2]; s[3] += h0[3]; s[4] += h1[0]; s[5] += h1[1]; s[6] += h1[2]; s[7] += h1[3];
                }
            }
            u32x4 dv;
            dv.x = cvt_pk_bf16(s[0] * icnt - cur[0], s[1] * icnt - cur[1]); dv.y = cvt_pk_bf16(s[2] * icnt - cur[2], s[3] * icnt - cur[3]);
            dv.z = cvt_pk_bf16(s[4] * icnt - cur[4], s[5] * icnt - cur[5]); dv.w = cvt_pk_bf16(s[6] * icnt - cur[6], s[7] * icnt - cur[7]);
            dfr[ks] = __builtin_bit_cast(bf16x8, dv);
        }
#pragma unroll
        for (int nb = 0; nb < 4; ++nb) {
            f32x16 acc;
#pragma unroll
            for (int r = 0; r < 16; ++r) acc[r] = 0.f;
            const bf16_t* wrow = wpt + ((size_t)g * 128 + nb * 32 + r32) * 128 + hi * 8;
#pragma unroll
            for (int ks = 0; ks < 8; ++ks) acc = __builtin_amdgcn_mfma_f32_32x32x16_bf16(*(const bf16x8*)(wrow + ks * 16), dfr[ks], acc, 0, 0, 0);
#pragma unroll
            for (int i = 0; i < 4; ++i) { u32x2 wv; wv.x = cvt_pk_bf16(acc[4 * i], acc[4 * i + 1]); wv.y = cvt_pk_bf16(acc[4 * i + 2], acc[4 * i + 3]);
                *(u32x2*)(orow + g * 128 + nb * 32 + 8 * i + 4 * hi) = wv; }
        }
    }
}

template <int MODE>
__device__ __forceinline__ void transpose_item(const float* __restrict__ W, int K, int N, int nblk, bf16_t* __restrict__ WT, int row_off, const float* __restrict__ g, LAS float* scr, int item, int lane) {
    const int kb = item / nblk, nb = item % nblk, k0 = 64 * kb, n0 = 32 * nb;
#pragma unroll 8
    for (int i = 0; i < 32; ++i) { const int kk = 2 * i + (lane >> 5); float v = W[(size_t)(k0 + kk) * N + n0 + (lane & 31)]; if (g) v *= g[k0 + kk]; scr[kk * 33 + (lane & 31)] = v; }
    LDS_WAIT();
    const int c = lane & 7;
#pragma unroll
    for (int j = 0; j < 4; ++j) {
        const int n = (lane >> 3) + 8 * j; const LAS float* s = scr + (8 * c) * 33 + n;
        const int nn = n0 + n; int drow;
        if (MODE == 0) drow = row_off + nn; else { const int half = nn / DFF, cc = nn % DFF; drow = (cc >> 7) * 256 + half * 128 + (cc & 127); }
        u32x4 o; o.x = cvt_pk_bf16(s[0 * 33], s[1 * 33]); o.y = cvt_pk_bf16(s[2 * 33], s[3 * 33]); o.z = cvt_pk_bf16(s[4 * 33], s[5 * 33]); o.w = cvt_pk_bf16(s[6 * 33], s[7 * 33]);
        *(u32x4*)(WT + (size_t)drow * K + k0 + 8 * c) = o;
    }
    LDS_WAIT();
}
__device__ __forceinline__ void prepass_row(const float* __restrict__ xrow, bf16_t* __restrict__ orow, const LAS float* wf, const float* __restrict__ b_f, float* __restrict__ lf_out, int lane) {
    const f32x4* xr = (const f32x4*)xrow + lane;
    f32x4 v[4]; float s = 0.f;
#pragma unroll
    for (int j = 0; j < 4; ++j) { v[j] = xr[64 * j]; s += (v[j][0] * v[j][0] + v[j][1] * v[j][1]) + (v[j][2] * v[j][2] + v[j][3] * v[j][3]); }
    const float r = rsq(wave_sum(s));
    u32x2* o8 = (u32x2*)orow + lane;
#pragma unroll
    for (int j = 0; j < 4; ++j) { v[j] = v[j] * r; u32x2 w; w.x = cvt_pk_bf16(v[j][0], v[j][1]); w.y = cvt_pk_bf16(v[j][2], v[j][3]); o8[64 * j] = w; }
    if (wf) {
        f32x4 fa = {0.f, 0.f, 0.f, 0.f}, fb = {0.f, 0.f, 0.f, 0.f};
#pragma unroll
        for (int j = 0; j < 4; ++j)
#pragma unroll
            for (int e = 0; e < 4; ++e) { const int k = 4 * (lane + 64 * j) + e; const LAS f32x4* w = (const LAS f32x4*)(wf + k * 8); fa += w[0] * v[j][e]; fb += w[1] * v[j][e]; }
#pragma unroll
        for (int e = 0; e < 4; ++e) { fa[e] = wave_sum(fa[e]); fb[e] = wave_sum(fb[e]); }
        float z = fa[0];
        z = (lane == 1) ? fa[1] : z; z = (lane == 2) ? fa[2] : z; z = (lane == 3) ? fa[3] : z; z = (lane == 4) ? fb[0] : z; z = (lane == 5) ? fb[1] : z; z = (lane == 6) ? fb[2] : z; z = (lane == 7) ? fb[3] : z;
        if (lane < 8) { z += b_f[lane]; lf_out[lane] = fminf(z, 0.f) - log1pf(expf(-fabsf(z))); }
    }
}
__device__ __forceinline__ void scan_seq(const float* s0, int n0, const float* s1, int n1, float* dst, int lane) {
    const int n = n0 + n1, Lc = n >> 6;
    float s = 0.f;
    for (int i = 0; i < Lc; ++i) { const int t = lane * Lc + i; const float* ptr = (t < n0) ? (s0 + (size_t)t * 8) : (s1 + (size_t)(t - n0) * 8); s += *ptr; }
    float inc = s;
    for (int o = 1; o < 64; o <<= 1) { const float v = __shfl_up(inc, o); if (lane >= o) inc += v; }
    float run = inc - s;
    for (int i = 0; i < Lc; ++i) { const int t = lane * Lc + i; const float* ptr = (t < n0) ? (s0 + (size_t)t * 8) : (s1 + (size_t)(t - n0) * 8); run += *ptr; dst[t] = -run * LOG2E; }
}
__device__ __forceinline__ void cvt_flat(const float* __restrict__ src, bf16_t* __restrict__ dst, size_t n8, size_t gtid, size_t gn) {
    for (size_t i = gtid; i < n8; i += gn) { const f32x4 a = *(const f32x4*)(src + i * 8), b = *(const f32x4*)(src + i * 8 + 4); *(u32x4*)(dst + i * 8) = pack8(a, b); }
}

__global__ void __launch_bounds__(512, 2) fwd_kernel(Params p) {
    extern __shared__ __attribute__((aligned(16))) unsigned char lds_raw[];
    LAS unsigned char* L = (LAS unsigned char*)lds_raw;
    cg::grid_group grid = cg::this_grid();
    const int tid = threadIdx.x, lane = tid & 63, wave = __builtin_amdgcn_readfirstlane(tid >> 6);
    const int G = gridDim.x, bx = blockIdx.x;
    unsigned char* ws = p.ws; float* out = p.out;
    bf16_t* Wt_in = (bf16_t*)(ws + WS_WIN); bf16_t* Wt_o = (bf16_t*)(ws + WS_WO); bf16_t* Wt_mq = (bf16_t*)(ws + WS_WMQ); bf16_t* Wt_mo = (bf16_t*)(ws + WS_WMO);
    bf16_t* Wt_mkv = (bf16_t*)(ws + WS_WMKV); bf16_t* Wt_up = (bf16_t*)(ws + WS_WUP); bf16_t* Wt_dn = (bf16_t*)(ws + WS_WDN); bf16_t* Wt_pool = (bf16_t*)(ws + WS_WPOOL);
    bf16_t* mkb = (bf16_t*)(ws + WS_MKB); bf16_t* mvb = (bf16_t*)(ws + WS_MVB);
    float* ssq1 = (float*)(ws + WS_SSQ1); float* ssq2 = (float*)(ws + WS_SSQ2); float* ssq3 = (float*)(ws + WS_SSQ3);
    float* kbP = (float*)(ws + WS_KBP); float* kbS = (float*)(ws + WS_KBS);
    float* ahead = (float*)(ws + WS_AHEAD); float* atail = (float*)(ws + WS_ATAIL); float* bhead = (float*)(ws + WS_BHEAD);
    bf16_t* x1b = (bf16_t*)(ws + WS_X1B); bf16_t* kcb = (bf16_t*)(ws + WS_KCB); bf16_t* vcb = (bf16_t*)(ws + WS_VCB); bf16_t* x2b = (bf16_t*)(ws + WS_X2B);
    bf16_t* xb = (bf16_t*)(ws + WS_XB); bf16_t* mqb = (bf16_t*)(ws + WS_MQB); bf16_t* hff = (bf16_t*)(ws + WS_HFF);
    bf16_t* uqkv = (bf16_t*)(ws + WS_UQKV); bf16_t* mo = (bf16_t*)(ws + WS_MO); bf16_t* mix = (bf16_t*)(ws + WS_MIX); bf16_t* memb = (bf16_t*)(ws + WS_MEMB);
    bf16_t* ub = uqkv; bf16_t* qb = uqkv + (size_t)MT * 512; bf16_t* kb = uqkv + (size_t)2 * MT * 512; bf16_t* vb = uqkv + (size_t)3 * MT * 512;
    const float* x_prompt = p.in[0]; const float* x_sample = p.in[1];
    const int lo = p.ph_lo, hi_ph = p.ph_hi;
#define IN(k) (lo <= (k) && (k) < hi_ph && ((PHMASK >> (k)) & 1))
#define GSYNC() do { __builtin_amdgcn_fence(__ATOMIC_RELEASE, "agent"); asm volatile("s_waitcnt vmcnt(0)" ::: "memory"); __syncthreads(); grid.sync(); \
        __builtin_amdgcn_fence(__ATOMIC_ACQUIRE, "agent"); asm volatile("s_waitcnt vmcnt(0)" ::: "memory"); __syncthreads(); } while (0)
#define SEAM(k) do { if (IN(k) && IN((k) + 1)) GSYNC(); } while (0)

    if (IN(0)) {
        const int gw = bx * 8 + wave, NGW = G * 8;
        LAS float* scr = (LAS float*)(L + wave * 8448);
        LAS float* wf = (LAS float*)(L + 8 * 8448);
        {
            const float* w_in = p.in[11]; const float* g_mix = p.in[10];
            for (int i = tid; i < 8192; i += 512) { const int k = i >> 3, h = i & 7; wf[i] = w_in[(size_t)k * 2056 + 2048 + h] * g_mix[k]; }
        }
        __syncthreads();
        constexpr int I_IN = 16 * 64, I_SQ = 16 * 32, I_UP = 16 * 176, I_DN = 44 * 32;
        constexpr int NITEMS = I_IN + 5 * I_SQ + I_UP + I_DN;
        for (int it = gw; it < NITEMS; it += NGW) {
            int r = it;
            if (r < I_IN) { transpose_item<0>(p.in[11], 1024, 2056, 64, Wt_in, 0, p.in[10], scr, r, lane); continue; } r -= I_IN;
            if (r < I_SQ) { transpose_item<0>(p.in[15], 1024, 1024, 32, Wt_o, 0, nullptr, scr, r, lane); continue; } r -= I_SQ;
            if (r < I_SQ) { transpose_item<0>(p.in[18], 1024, 1024, 32, Wt_mq, 0, p.in[16], scr, r, lane); continue; } r -= I_SQ;
            if (r < I_SQ) { transpose_item<0>(p.in[19], 1024, 1024, 32, Wt_mkv, 0, p.in[17], scr, r, lane); continue; } r -= I_SQ;
            if (r < I_SQ) { transpose_item<0>(p.in[20], 1024, 1024, 32, Wt_mkv, 1024, p.in[17], scr, r, lane); continue; } r -= I_SQ;
            if (r < I_SQ) { transpose_item<0>(p.in[21], 1024, 1024, 32, Wt_mo, 0, nullptr, scr, r, lane); continue; } r -= I_SQ;
            if (r < I_UP) { transpose_item<1>(p.in[23], 1024, NUP, 176, Wt_up, 0, p.in[22], scr, r, lane); continue; } r -= I_UP;
            transpose_item<0>(p.in[26], DFF, 1024, 32, Wt_dn, 0, nullptr, scr, r, lane);
        }
        {
            const float* w_pool = p.in[13]; const float* pscale = p.in[14];
            for (int i = bx * 512 + tid; i < 4 * 128 * 128; i += G * 512) { const int g = i >> 14, d = (i >> 7) & 127, c = i & 127; Wt_pool[i] = (bf16_t)(cvt_pk_bf16(w_pool[(g * 128 + c) * 128 + d] * pscale[g * 128 + d], 0.f) & 0xffffu); }
        }
        for (int m = gw; m < MT; m += NGW) {
            const float* xr = (m < MP) ? x_prompt + (size_t)m * DM : x_sample + (size_t)(m - MP) * DM;
            float* lf = (m < MP) ? out + O_LFP + (size_t)m * 8 : out + O_LFS + (size_t)(m - MP) * 8;
            prepass_row(xr, xb + (size_t)m * DM, wf, p.in[12], lf, lane);
        }
        for (int m = gw; m < 8192; m += NGW) prepass_row(p.in[9] + (size_t)m * DM, memb + (size_t)m * DM, (const LAS float*)nullptr, nullptr, nullptr, lane);
        const size_t gtid = (size_t)bx * 512 + tid, gn = (size_t)G * 512;
        cvt_flat(p.in[2], kcb, (size_t)16 * PAST * 512 / 8, gtid, gn);
        cvt_flat(p.in[3], vcb, (size_t)16 * PAST * 512 / 8, gtid, gn);
        cvt_flat(p.in[7], mkb + (size_t)8192 * 1024, (size_t)4096 * 1024 / 8, gtid, gn);
        cvt_flat(p.in[8], mvb + (size_t)8192 * 1024, (size_t)4096 * 1024 / 8, gtid, gn);
        __syncthreads();
    }
    SEAM(0);

    if (IN(1)) {
        if (wave == 0) { const int s = bx; if (s < 256) scan_seq(out + O_LFP + (size_t)(s >> 3) * SEQ * 8 + (s & 7), SEQ, out + O_LFP, 0, kbP + (size_t)s * SEQ, lane); }
        if (wave == 1 && bx < 128) { const int s = bx; scan_seq(p.in[4] + (size_t)(s >> 3) * PAST * 8 + (s & 7), PAST, out + O_LFS + (size_t)(s >> 3) * DSEQ * 8 + (s & 7), DSEQ, kbS + (size_t)s * (PAST + DSEQ), lane); }
        {
            pg8::Gemm g{xb, Wt_in, MT, 2048, 1024}; pg8::StaticOrder S; S.init(MT, 2048, G, bx);
            EpiIn E{uqkv, out};
            pg8::gemm_phase<EpiIn, pg8::StaticOrder, true, true>(L, g, S, E);
        }
        __syncthreads();
        {
            pg8::Gemm g{memb, Wt_mkv, 8192, 2048, 1024}; pg8::StaticOrder S; S.init(8192, 2048, G, bx);
            EpiMkv E{mkb, mvb, out};
            pg8::gemm_phase<EpiMkv, pg8::StaticOrder, true, true>(L, g, S, E);
        }
    }
    SEAM(1);

    if (IN(2)) {
        if (P2_ATTN_P) for (int bh = bx; bh < 256; bh += G) {
            const int b = bh >> 3, h = bh & 7;
            const bf16_t* Kh = kb + (size_t)b * SEQ * 512 + h * 64; const bf16_t* Vh = vb + (size_t)b * SEQ * 512 + h * 64;
            for (int qk = 7; qk >= 0; --qk) {
                const size_t r0 = (size_t)b * SEQ + 256 * qk;
                attn_unit<64, 64, true, true>(L, qb + r0 * 512 + h * 64, 512, 256, Kh, Vh, 4 * qk + 4, Kh, Vh, 512, 4 * qk + 4, kbP + (size_t)bh * SEQ, 256 * qk, mix + r0 * DM + 512 + h * 64, DM);
            }
        }
        if (P2_ATTN_S) for (int bh = bx; bh < 128; bh += G) {
            const int b = bh >> 3, h = bh & 7;
            const size_t r0 = (size_t)MP + b * DSEQ;
            attn_unit<64, 64, true, true>(L, qb + r0 * 512 + h * 64, 512, 64, kcb + (size_t)b * PAST * 512 + h * 64, vcb + (size_t)b * PAST * 512 + h * 64, 64,
                                      kb + r0 * 512 + h * 64, vb + r0 * 512 + h * 64, 512, 65, kbS + (size_t)bh * (PAST + DSEQ), PAST, mix + r0 * DM + 512 + h * 64, DM);
        }
        if (P2_POOL) for (int t = (bx + 128) % G; t < MT / 256; t += G) pool_unit(t, ub, p.in[5], Wt_pool, mix);
        __syncthreads();
    }
    SEAM(2);

    if (IN(3)) {
        pg8::Gemm g{mix, Wt_o, MT, 1024, 1024}; pg8::StaticOrder S; S.init(MT, 1024, G, bx);
        EpiRes<0> E{x_prompt, x_sample, nullptr, x1b, nullptr, ssq1};
        pg8::gemm_phase<EpiRes<0>, pg8::StaticOrder, true, true>(L, g, S, E);
    }
    SEAM(3);

    if (IN(4)) {
        pg8::Gemm g{x1b, Wt_mq, MT, 1024, 1024}; pg8::StaticOrder S; S.init(MT, 1024, G, bx);
        EpiMq E{ssq1, mqb};
        pg8::gemm_phase<EpiMq, pg8::StaticOrder, true, true>(L, g, S, E);
    }
    SEAM(4);

    if (IN(5)) {
        for (int un = bx; un < 1024 + 64; un += G) {
            if (un < 1024) {
                const int b = un >> 5, h = (un >> 3) & 3, qk = un & 7;
                const size_t r0 = (size_t)b * SEQ + 256 * qk;
                const bf16_t* Kh = mkb + (size_t)b * NMEM * 1024 + h * 256; const bf16_t* Vh = mvb + (size_t)b * NMEM * 1024 + h * 256;
                attn_unit<256, 32, false, false>(L, mqb + r0 * DM + h * 256, DM, 256, Kh, Vh, 8, Kh, Vh, 1024, 8, nullptr, 0, mo + r0 * DM + h * 256, DM);
            } else {
                const int us = un - 1024, b = us >> 2, h = us & 3;
                const size_t r0 = (size_t)MP + b * DSEQ;
                const bf16_t* Kh = mkb + (size_t)(8192 + b * NMEM) * 1024 + h * 256; const bf16_t* Vh = mvb + (size_t)(8192 + b * NMEM) * 1024 + h * 256;
                attn_unit<256, 32, false, false>(L, mqb + r0 * DM + h * 256, DM, 64, Kh, Vh, 8, Kh, Vh, 1024, 8, nullptr, 0, mo + r0 * DM + h * 256, DM);
            }
        }
        __syncthreads();
    }
    SEAM(5);

    if (IN(6)) {
        pg8::Gemm g{mo, Wt_mo, MT, 1024, 1024}; pg8::StaticOrder S; S.init(MT, 1024, G, bx);
        EpiRes<1> E{nullptr, nullptr, x1b, x2b, nullptr, ssq2};
        pg8::gemm_phase<EpiRes<1>, pg8::StaticOrder, true, true>(L, g, S, E);
    }
    SEAM(6);

    if (IN(7)) {
        pg8::Gemm g{x2b, Wt_up, MT, NUP, 1024}; pg8::StaticOrder S; S.init(MT, NUP, G, bx);
        EpiUp E{ssq2, p.in[24], p.in[25], hff, ahead, atail, bhead};
        pg8::gemm_phase<EpiUp, pg8::StaticOrder, true, true>(L, g, S, E);
    }
    SEAM(7);

    if (IN(8)) {
        const float* cw = p.in[24]; const float* cbias = p.in[25]; const float* chist = p.in[6];
        const int total = NSEG * 2 * DFF;
        for (int idx = bx * 512 + tid; idx < total; idx += G * 512) {
            const int seg = idx / (2 * DFF), rem = idx - seg * 2 * DFF, i = rem / DFF, c = rem - i * DFF;
            float prev1, prev2;
            if (seg < MP / 64) { if ((seg & 31) == 0) { prev1 = 0.f; prev2 = 0.f; } else { prev1 = atail[((size_t)(seg - 1) * 2 + 1) * DFF + c]; prev2 = atail[((size_t)(seg - 1) * 2) * DFF + c]; } }
            else { const int b = seg - MP / 64; prev1 = chist[((size_t)b * 2 + 1) * DFF + c]; prev2 = chist[((size_t)b * 2) * DFF + c]; }
            const float a_0 = ahead[((size_t)seg * 2) * DFF + c];
            float am1, am2, a0;
            if (i == 0) { am1 = prev1; am2 = prev2; a0 = a_0; } else { am1 = a_0; am2 = prev1; a0 = ahead[((size_t)seg * 2 + 1) * DFF + c]; }
            const float cv = cbias[c] + cw[c] * am2 + cw[DFF + c] * am1 + cw[2 * DFF + c] * a0;
            const float hv = cv / (1.0f + __builtin_amdgcn_exp2f(-cv * LOG2E)) * bhead[((size_t)seg * 2 + i) * DFF + c];
            hff[((size_t)seg * 64 + i) * DFF + c] = (bf16_t)(cvt_pk_bf16(hv, 0.f) & 0xffffu);
        }
        for (int idx = bx * 512 + tid; idx < 48 * 2 * DFF; idx += G * 512) {
            const int bb = idx / (2 * DFF), rem = idx - bb * 2 * DFF;
            if (bb < 32) out[O_CSP + (size_t)bb * 2 * DFF + rem] = atail[((size_t)(32 * bb + 31) * 2) * DFF + rem];
            else out[O_CSS + (size_t)(bb - 32) * 2 * DFF + rem] = atail[((size_t)(MP / 64 + bb - 32) * 2) * DFF + rem];
        }
    }
    SEAM(8);

    if (IN(9)) {
        pg8::Gemm g{hff, Wt_dn, MT, 1024, DFF}; pg8::StaticOrder S; S.init(MT, 1024, G, bx);
        EpiRes<2> E{nullptr, nullptr, x2b, nullptr, out, ssq3};
        pg8::gemm_phase<EpiRes<2>, pg8::StaticOrder, true, true>(L, g, S, E);
    }
    SEAM(9);

    if (IN(10)) {
        const float* gf = p.in[27];
        const int gw = bx * 8 + wave, NGW = G * 8;
        f32x4 gv[4];
#pragma unroll
        for (int j = 0; j < 4; ++j) gv[j] = ((const f32x4*)gf)[lane + 64 * j];
        for (int m = gw; m < MT; m += NGW) {
            float* yr = (m < MP) ? out + O_YP + (size_t)m * DM : out + O_YS + (size_t)(m - MP) * DM;
            const float r = row_rsq(ssq3, m);
            f32x4* y4 = (f32x4*)yr + lane;
#pragma unroll
            for (int j = 0; j < 4; ++j) y4[64 * j] = y4[64 * j] * r * gv[j];
        }
    }
#ifdef DBG_DUMP
    {
        GSYNC();
        const bf16_t* src = nullptr; int pitch = 1024;
        if (hi_ph == 2) src = uqkv; else if (hi_ph == 3) src = mix; else if (hi_ph == 4) src = x1b; else if (hi_ph == 5) src = mqb; else if (hi_ph == 6) src = mo; else if (hi_ph == 7) src = x2b; else if (hi_ph == 8 || hi_ph == 9) { src = hff; pitch = DFF; }
        if (src) for (size_t i = (size_t)bx * 512 + tid; i < (size_t)MT * 1024; i += (size_t)G * 512) { const size_t m = i >> 10, c = i & 1023; float v = __builtin_bit_cast(float, (unsigned)src[m * pitch + c] << 16); if (!(v == v)) v = 12345.f; if (fabsf(v) > 1e30f) v = 54321.f; out[i] = v; }
    }
#endif
#undef IN
#undef SEAM
}

extern "C" void kernel_launch(void* const* d_in, const int* in_sizes, int n_in, void* d_out, int out_size, void* d_ws, size_t ws_size, hipStream_t stream) {
    static int grid = 0;
    if (grid == 0) {
        if (n_in != 28 || (size_t)out_size != O_END || ws_size < WS_NEED) { fprintf(stderr, "kernel_launch: unexpected shapes (n_in %d, out %d, ws %zu); nothing launched\n", n_in, out_size, ws_size); grid = -1; return; }
        int dev = 0, cus = 0, per_cu = 0;
        hipGetDevice(&dev); hipDeviceGetAttribute(&cus, hipDeviceAttributeMultiprocessorCount, dev);
        hipFuncSetAttribute((const void*)fwd_kernel, hipFuncAttributeMaxDynamicSharedMemorySize, LDS_BYTES);
        hipOccupancyMaxActiveBlocksPerMultiprocessor(&per_cu, (const void*)fwd_kernel, 512, LDS_BYTES);
        if (per_cu < 1) { fprintf(stderr, "kernel_launch: occupancy query says %d blocks per CU\n", per_cu); per_cu = 1; }
        (void)hipGetLastError();
        grid = cus;
    }
    if (grid < 0) return;
    Params p{};
    for (int i = 0; i < 28; ++i) p.in[i] = (const float*)d_in[i];
    p.out = (float*)d_out; p.ws = (unsigned char*)d_ws; p.ph_lo = 0; p.ph_hi = DBG_HI;
    void* args[] = {&p};
    hipError_t e = hipLaunchCooperativeKernel((const void*)fwd_kernel, dim3(grid), dim3(512), args, LDS_BYTES, stream);
    if (e != hipSuccess) fprintf(stderr, "cooperative launch failed: %s (grid %d)\n", hipGetErrorString(e), grid);
}
```

```cpp
#include <hip/hip_runtime.h>
#include <hip/hip_cooperative_groups.h>
#include <cstdio>
#include <cstdint>
namespace cg = cooperative_groups;
namespace pg8 {
#define PG8_LAS __attribute__((address_space(3)))
typedef unsigned short bf16_t;
typedef short bf16x8 __attribute__((ext_vector_type(8)));
typedef float f32x4 __attribute__((ext_vector_type(4)));
typedef unsigned u32x4 __attribute__((ext_vector_type(4)));
constexpr int BM = 256, BK = 64, HALF = 128, HTB = HALF * BK * 2  , STAGE_BYTES = 8 * HTB, NXCD = 8, WGM = 8;

__host__ __device__ __forceinline__ int lds_byte(int r, int c) { const int st = (r >> 4) * 2 + (c >> 5), rr = r & 15, cc = c & 31, ob = rr * 64 + cc * 2; return st * 1024 + (ob ^ (((ob >> 9) & 1) << 5)); }
__host__ __device__ __forceinline__ void stage_rc(int b, int& R, int& C) { const int st = b / 1024, sb = b % 1024, swz = sb ^ (((sb >> 9) & 1) << 5); R = (st >> 1) * 16 + swz / 64; C = (st & 1) * 32 + (swz % 64) / 2; }
__host__ __device__ __forceinline__ int perm32(int rho) { const int n = rho >> 4, i = rho & 15; return 8 * (i >> 2) + 4 * n + (i & 3); }

struct Unit { int pm, pn; };
struct Gemm { const bf16_t* A; const bf16_t* Bt; int M, N, K; };

struct StaticOrder {
    int nM, nN, nwg, G, c;
    __host__ __device__ void init(int M, int N, int G_, int c_) { nM = M / BM; nN = N / BM; nwg = nM * nN; G = G_; c = c_; }
    __host__ __device__ bool next(int i, Unit& u) const {
        const long L = (long)i * G + c; if (L >= nwg) return false;
        int wgid = (int)L; { const int q = nwg / NXCD, r = nwg % NXCD, xcd = wgid % NXCD, off = wgid / NXCD; wgid = (xcd < r ? xcd * (q + 1) : r * (q + 1) + (xcd - r) * q) + off; }
        const int nig = WGM * nN, gid = wgid / nig, fm = gid * WGM, gsz = (nM - fm) < WGM ? (nM - fm) : WGM;
        u.pm = fm + ((wgid % nig) % gsz); u.pn = (wgid % nig) / gsz; return true;
    }
    __device__ __forceinline__ void a_ready(const Unit&) const {}
    __device__ __forceinline__ void done(const Unit&) const {}
};

__device__ __forceinline__ unsigned cvt_pk_bf16(float lo, float hi) { unsigned r; asm volatile("v_cvt_pk_bf16_f32 %0, %1, %2" : "=v"(r) : "v"(lo), "v"(hi)); return r; }
typedef float f32x2 __attribute__((ext_vector_type(2)));
template <class Epi, class Sched, bool ALIGN_EPI = false, bool SP2 = false>
__device__ __forceinline__ void gemm_phase(PG8_LAS unsigned char* lds, const Gemm g, const Sched& S, const Epi& E) {
    const int tid = threadIdx.x, wid = __builtin_amdgcn_readfirstlane(tid >> 6), lane = tid & 63, wr = wid >> 2, wc = wid & 3, fr = lane & 15, fq = lane >> 4;
    const int K = g.K, nt = K / BK;
    unsigned voffA[2], voffB[2];
#pragma unroll
    for (int i = 0; i < 2; ++i) { int R, C; stage_rc(tid * 16 + i * 8192, R, C); const int Rb = Epi::PERM ? ((R & ~31) + perm32(R & 31)) : R;
        voffA[i] = (unsigned)(R * K + C) * 2u; voffB[i] = (unsigned)(Rb * K + C) * 2u; }
    const size_t kstep = (size_t)(BK * 2);
    const size_t hstep = (size_t)HALF * K * 2;
    const size_t tstep = 2 * hstep;
    const unsigned ldsw = (unsigned)wid * 1024u;
    const int aoff = lds_byte(wr * 64 + fr, fq * 8), boff = lds_byte(wc * 32 + fr, fq * 8);
#define PG8_SA(b, h) (((b) * 2 + (h)) * HTB)
#define PG8_SB(b, h) ((4 + (b) * 2 + (h)) * HTB)
#define PG8_STAGE(bufoff, gbase, voff) do { _Pragma("unroll") for (int _i = 0; _i < 2; ++_i) \
        __builtin_amdgcn_global_load_lds((const unsigned*)((const char*)(gbase) + (voff)[_i]), (PG8_LAS unsigned*)(lds + (bufoff) + ldsw + _i * 8192), 16, 0, 0); } while (0)
#define PG8_LDA(dst, b, h) do { _Pragma("unroll") for (int m = 0; m < 4; ++m) _Pragma("unroll") for (int k = 0; k < 2; ++k) dst[m][k] = *(const PG8_LAS bf16x8*)(lds + PG8_SA(b, h) + aoff + m * 2048 + k * 1024); } while (0)
#define PG8_LDB(dst, b, h) do { _Pragma("unroll") for (int n = 0; n < 2; ++n) _Pragma("unroll") for (int k = 0; k < 2; ++k) dst[n][k] = *(const PG8_LAS bf16x8*)(lds + PG8_SB(b, h) + boff + n * 2048 + k * 1024); } while (0)
#define PG8_MMA(ai, bj, At, Bt) do { __builtin_amdgcn_s_setprio(1); _Pragma("unroll") for (int m = 0; m < 4; ++m) _Pragma("unroll") for (int n = 0; n < 2; ++n) _Pragma("unroll") for (int k = 0; k < 2; ++k) \
        acc[ai][bj][m][n] = __builtin_amdgcn_mfma_f32_16x16x32_bf16(Bt[n][k], At[m][k], acc[ai][bj][m][n], 0, 0, 0); __builtin_amdgcn_s_setprio(0); } while (0)
#define PG8_WAIT_V(n) asm volatile("s_waitcnt vmcnt(" #n ")" ::: "memory")
#define PG8_WAIT_L(n) asm volatile("s_waitcnt lgkmcnt(" #n ")" ::: "memory")
#define PG8_BAR __builtin_amdgcn_s_barrier()
#define PG8_SCHED __builtin_amdgcn_sched_barrier(0)
    Unit cur, nxt; int ui = 0;
    if (!S.next(0, cur)) return;
    f32x4 acc[2][2][4][2];
#pragma unroll
    for (int a = 0; a < 2; ++a)
#pragma unroll
        for (int b = 0; b < 2; ++b)
#pragma unroll
            for (int m = 0; m < 4; ++m)
#pragma unroll
                for (int n = 0; n < 2; ++n) acc[a][b][m][n] = (f32x4){0.f, 0.f, 0.f, 0.f};
    bf16x8 At[4][2], B0[2][2], B1[2][2];
    const char* cA = (const char*)g.A + (size_t)cur.pm * tstep; const char* cB = (const char*)g.Bt + (size_t)cur.pn * tstep;
    S.a_ready(cur);
    if constexpr (SP2) {
        PG8_STAGE(PG8_SB(0, 0), cB, voffB); PG8_STAGE(PG8_SB(0, 1), cB + hstep, voffB); PG8_STAGE(PG8_SA(0, 0), cA, voffA); PG8_STAGE(PG8_SA(0, 1), cA + hstep, voffA);
        if (wr == 1) PG8_BAR;
        PG8_WAIT_V(2); PG8_BAR;
        PG8_STAGE(PG8_SB(1, 0), cB + kstep, voffB); PG8_STAGE(PG8_SA(1, 0), cA + kstep, voffA); PG8_STAGE(PG8_SB(1, 1), cB + hstep + kstep, voffB);
        PG8_WAIT_V(6); PG8_BAR;
    } else {
        PG8_STAGE(PG8_SB(0, 0), cB, voffB); PG8_STAGE(PG8_SA(0, 0), cA, voffA); PG8_STAGE(PG8_SB(0, 1), cB + hstep, voffB); PG8_STAGE(PG8_SA(0, 1), cA + hstep, voffA);
        if (wr == 1) PG8_BAR;
        PG8_WAIT_V(4); PG8_BAR;
        PG8_STAGE(PG8_SB(1, 0), cB + kstep, voffB); PG8_STAGE(PG8_SA(1, 0), cA + kstep, voffA); PG8_STAGE(PG8_SB(1, 1), cB + hstep + kstep, voffB);
        PG8_WAIT_V(6); PG8_BAR;
    }
    for (;;) {
        const bool has_next = S.next(ui + 1, nxt);
        const char* nA = has_next ? (const char*)g.A + (size_t)nxt.pm * tstep : cA; const char* nB = has_next ? (const char*)g.Bt + (size_t)nxt.pn * tstep : cB;
        for (int t = 0; t < nt; t += 2) {
            const bool last = (t == nt - 2);
            const char* a1 = cA + (size_t)(t + 1) * kstep;
            const char* a2 = last ? nA : cA + (size_t)(t + 2) * kstep; const char* b2 = last ? nB : cB + (size_t)(t + 2) * kstep;
            const char* a3 = a2 + kstep; const char* b3 = b2 + kstep;
            if (last && has_next) S.a_ready(nxt);
            if constexpr (SP2) {
            PG8_LDB(B0, 0, 0); PG8_LDB(B1, 0, 1); PG8_SCHED; PG8_LDA(At, 0, 0); PG8_STAGE(PG8_SA(1, 1), a1 + hstep, voffA);
            PG8_WAIT_V(8); PG8_WAIT_L(0); PG8_BAR; PG8_MMA(0, 0, At, B0); PG8_MMA(0, 1, At, B1); PG8_BAR; PG8_SCHED;
            PG8_LDA(At, 0, 1); PG8_STAGE(PG8_SB(0, 0), b2, voffB); PG8_STAGE(PG8_SB(0, 1), b2 + hstep, voffB); PG8_STAGE(PG8_SA(0, 0), a2, voffA);
            PG8_WAIT_V(8); PG8_WAIT_L(0); PG8_BAR; PG8_MMA(1, 0, At, B0); PG8_MMA(1, 1, At, B1); PG8_BAR; PG8_SCHED;
            PG8_LDB(B0, 1, 0); PG8_LDB(B1, 1, 1); PG8_SCHED; PG8_LDA(At, 1, 0); PG8_STAGE(PG8_SA(0, 1), a2 + hstep, voffA);
            PG8_WAIT_V(8); PG8_WAIT_L(0); PG8_BAR; PG8_MMA(0, 0, At, B0); PG8_MMA(0, 1, At, B1); PG8_BAR; PG8_SCHED;
            PG8_LDA(At, 1, 1); PG8_STAGE(PG8_SB(1, 0), b3, voffB); PG8_STAGE(PG8_SB(1, 1), b3 + hstep, voffB); PG8_STAGE(PG8_SA(1, 0), a3, voffA);
            PG8_WAIT_V(8); PG8_WAIT_L(0); PG8_BAR; PG8_MMA(1, 0, At, B0); PG8_MMA(1, 1, At, B1); PG8_BAR; PG8_SCHED;
            } else {
            PG8_LDB(B0, 0, 0); PG8_SCHED; PG8_LDA(At, 0, 0); PG8_STAGE(PG8_SA(1, 1), a1 + hstep, voffA);
            PG8_WAIT_L(8); PG8_BAR; PG8_WAIT_L(0); PG8_MMA(0, 0, At, B0); PG8_BAR; PG8_SCHED;
            PG8_LDB(B1, 0, 1); PG8_STAGE(PG8_SB(0, 0), b2, voffB);
            PG8_BAR; PG8_WAIT_L(0); PG8_MMA(0, 1, At, B1); PG8_BAR;
            PG8_LDA(At, 0, 1); PG8_STAGE(PG8_SA(0, 0), a2, voffA);
            PG8_BAR; PG8_WAIT_L(0); PG8_MMA(1, 0, At, B0); PG8_BAR; PG8_SCHED;
            PG8_STAGE(PG8_SB(0, 1), b2 + hstep, voffB);
            PG8_WAIT_V(6); PG8_BAR; PG8_MMA(1, 1, At, B1); PG8_BAR;
            PG8_LDB(B0, 1, 0); PG8_SCHED; PG8_LDA(At, 1, 0); PG8_STAGE(PG8_SA(0, 1), a2 + hstep, voffA);
            PG8_WAIT_L(8); PG8_BAR; PG8_WAIT_L(0); PG8_MMA(0, 0, At, B0); PG8_BAR; PG8_SCHED;
            PG8_LDB(B1, 1, 1); PG8_STAGE(PG8_SB(1, 0), b3, voffB);
            PG8_BAR; PG8_WAIT_L(0); PG8_MMA(0, 1, At, B1); PG8_BAR;
            PG8_LDA(At, 1, 1); PG8_STAGE(PG8_SA(1, 0), a3, voffA);
            PG8_BAR; PG8_WAIT_L(0); PG8_MMA(1, 0, At, B0); PG8_BAR; PG8_SCHED;
            PG8_STAGE(PG8_SB(1, 1), b3 + hstep, voffB);
            PG8_WAIT_V(6); PG8_BAR; PG8_MMA(1, 1, At, B1); PG8_BAR;
            }
        }
        if constexpr (ALIGN_EPI) { if (wr == 0) PG8_BAR; }
        if constexpr (!Epi::AFTER_DRAIN) { E(acc, cur, wr, wc, fr, fq); S.done(cur); }
        if (!has_next) break;
#pragma unroll
        for (int a = 0; a < 2; ++a)
#pragma unroll
            for (int b = 0; b < 2; ++b)
#pragma unroll
                for (int m = 0; m < 4; ++m)
#pragma unroll
                    for (int n = 0; n < 2; ++n) acc[a][b][m][n] = (f32x4){0.f, 0.f, 0.f, 0.f};
        cur = nxt; cA = nA; cB = nB; ++ui;
        if constexpr (ALIGN_EPI) { if (wr == 1) PG8_BAR; }
    }
    PG8_WAIT_V(0);
    if constexpr (!ALIGN_EPI) { if (wr == 0) PG8_BAR; }
    PG8_BAR;
    if constexpr (Epi::AFTER_DRAIN) { E.fused(acc, cur, wr, wc, fr, fq, lds, wid, lane); S.done(cur); }
#undef PG8_SA
#undef PG8_SB
#undef PG8_STAGE
#undef PG8_LDA
#undef PG8_LDB
#undef PG8_MMA
#undef PG8_WAIT_V
#undef PG8_WAIT_L
#undef PG8_BAR
#undef PG8_SCHED
}
}

using pg8::bf16_t; using pg8::bf16x8; using pg8::f32x4; using pg8::u32x4; using pg8::Unit;
typedef float f32x2_t __attribute__((ext_vector_type(2))); typedef __bf16 bf16x2_t __attribute__((ext_vector_type(2)));
__device__ __forceinline__ unsigned cvt_pk_bf16(float lo, float hi) { f32x2_t v = {lo, hi}; bf16x2_t b = __builtin_convertvector(v, bf16x2_t); return __builtin_bit_cast(unsigned, b); }
typedef float f32x16 __attribute__((ext_vector_type(16)));
typedef unsigned u32x2 __attribute__((ext_vector_type(2)));
#define LAS __attribute__((address_space(3)))

constexpr int DM = 1024, MP = 65536, MS = 1024, MT = MP + MS, SEQ = 2048, DSEQ = 64, PAST = 4096, NMEM = 256;
constexpr int DFF = 2816, NUP = 2 * DFF, NSEG = MT / 64;
constexpr float EPS = 1e-6f, LOG2E = 1.4426950408889634f;
constexpr float C2F = 0.125f * LOG2E, C2M = 0.0625f * LOG2E;
constexpr float NEGBIG = -1e30f;

constexpr size_t O_YP = 0, O_YS = O_YP + (size_t)MP * DM, O_KP = O_YS + (size_t)MS * DM, O_VP = O_KP + (size_t)MP * 512, O_LFP = O_VP + (size_t)MP * 512,
    O_PSP = O_LFP + (size_t)MP * 8, O_CSP = O_PSP + 32 * 15 * 512, O_MKP = O_CSP + 32 * 2 * DFF, O_MVP = O_MKP + (size_t)8192 * 1024, O_KS = O_MVP + (size_t)8192 * 1024,
    O_VS = O_KS + (size_t)MS * 512, O_LFS = O_VS + (size_t)MS * 512, O_PSS = O_LFS + MS * 8, O_CSS = O_PSS + 16 * 15 * 512, O_END = O_CSS + 16 * 2 * DFF;

constexpr size_t MiB = 1u << 20;
constexpr size_t WS_WIN = 1 * MiB, WS_WO = 5 * MiB, WS_WMQ = 7 * MiB, WS_WMO = 9 * MiB, WS_WMKV = 11 * MiB, WS_WUP = 15 * MiB, WS_WDN = 26 * MiB, WS_WPOOL = 32 * MiB;
constexpr size_t WS_USX = 34 * MiB;
constexpr size_t WS_MKB = 40 * MiB, WS_MVB = 64 * MiB;
constexpr size_t WS_SSQ1 = 88 * MiB, WS_SSQ2 = 93 * MiB, WS_SSQ3 = 98 * MiB;
constexpr size_t WS_KBP = 103 * MiB, WS_KBS = 105 * MiB;
constexpr size_t WS_AHEAD = 108 * MiB, WS_ATAIL = WS_AHEAD + 23 * MiB / 1 - MiB / 2, WS_BHEAD = WS_ATAIL + 23 * MiB - MiB / 2;
constexpr size_t WS_X1B = 176 * MiB, WS_KCB = 176 * MiB, WS_VCB = 240 * MiB;
constexpr size_t WS_X2B = 306 * MiB;
constexpr size_t WS_XB = 436 * MiB, WS_MQB = 436 * MiB, WS_HFF = 436 * MiB;
constexpr size_t WS_UQKV = 566 * MiB, WS_MO = 566 * MiB;
constexpr size_t WS_MIX = 826 * MiB, WS_MEMB = 956 * MiB, WS_NEED = 972 * MiB;
static_assert((size_t)NSEG * 2 * DFF * 4 <= 22 * MiB + MiB / 2, "side buffers");
static_assert(WS_BHEAD + 22 * MiB + MiB / 2 <= WS_X1B, "side buffers end");

#define P2_ATTN_P 1
#define P2_ATTN_S 1
#define P2_POOL 1
#define DBG_HI 11
#ifndef PHMASK
#define PHMASK 0x7ff
#endif
constexpr int LDS_BYTES = 147456;

struct Params { const float* in[28]; float* out; unsigned char* ws; int ph_lo, ph_hi; };

__device__ __forceinline__ float bf_lo(unsigned w) { return __builtin_bit_cast(float, w << 16); }
__device__ __forceinline__ float bf_hi(unsigned w) { return __builtin_bit_cast(float, w & 0xffff0000u); }
__device__ __forceinline__ int crow(int r, int hi) { return (r & 3) + 8 * (r >> 2) + 4 * hi; }
__device__ __forceinline__ float wave_sum(float v) {
#pragma unroll
    for (int o = 1; o < 64; o <<= 1) v += __shfl_xor(v, o);
    return v;
}
__device__ __forceinline__ float rsq(float ssq) { return 1.0f / sqrtf(ssq * (1.0f / 1024.0f) + EPS); }
#define LDS_WAIT() asm volatile("s_waitcnt lgkmcnt(0)" ::: "memory")

typedef const f32x4 (&AccRef)[2][2][4][2];

__device__ __forceinline__ u32x4 pack8(f32x4 v0, f32x4 v1) { u32x4 w; w.x = cvt_pk_bf16(v0[0], v0[1]); w.y = cvt_pk_bf16(v0[2], v0[3]); w.z = cvt_pk_bf16(v1[0], v1[1]); w.w = cvt_pk_bf16(v1[2], v1[3]); return w; }

struct EpiIn {
    static constexpr bool PERM = true, AFTER_DRAIN = false;
    bf16_t* uqkv; float* out; bf16_t* usx;
    __device__ __forceinline__ void operator()(AccRef acc, const Unit& u, int wr, int wc, int fr, int fq) const {
        const int t = u.pn >> 1;
        const int col0 = (u.pn & 1) * 256 + wc * 32 + 8 * fq;
        bf16_t* base = uqkv + (size_t)t * MT * 512;
        const float sc = (t == 1) ? C2F : 1.0f;
#pragma unroll
        for (int ai = 0; ai < 2; ++ai)
#pragma unroll
            for (int m = 0; m < 4; ++m) {
                const int row = u.pm * 256 + ai * 128 + wr * 64 + m * 16 + fr;
#pragma unroll
                for (int bj = 0; bj < 2; ++bj) {
                    const int col = col0 + bj * 128;
                    const f32x4 v0 = acc[ai][bj][m][0] * sc, v1 = acc[ai][bj][m][1] * sc;
                    *(u32x4*)(base + (size_t)row * 512 + col) = pack8(v0, v1);
                    if (t >= 2) {
                        float* o = (row < MP) ? out + (t == 2 ? O_KP : O_VP) + (size_t)row * 512 : out + (t == 2 ? O_KS : O_VS) + (size_t)(row - MP) * 512;
                        *(f32x4*)(o + col) = v0; *(f32x4*)(o + col + 4) = v1;
                    } else if (t == 0) {
                        if (row < MP) { const int tt = row & (SEQ - 1); if (tt >= SEQ - 15) { float* o = out + O_PSP + ((size_t)(row >> 11) * 15 + (tt - (SEQ - 15))) * 512 + col; *(f32x4*)o = v0; *(f32x4*)(o + 4) = v1; } }
                        else { const int rs = row - MP, tt = rs & 63; *(u32x4*)(usx + ((size_t)(rs >> 6) * 79 + 15 + tt) * 512 + col) = pack8(v0, v1); if (tt >= DSEQ - 15) { float* o = out + O_PSS + ((size_t)(rs >> 6) * 15 + (tt - (DSEQ - 15))) * 512 + col; *(f32x4*)o = v0; *(f32x4*)(o + 4) = v1; } }
                    }
                }
            }
    }
};
struct EpiMkv {
    static constexpr bool PERM = true, AFTER_DRAIN = false;
    bf16_t* mkb; bf16_t* mvb; float* out;
    __device__ __forceinline__ void operator()(AccRef acc, const Unit& u, int wr, int wc, int fr, int fq) const {
        const int t = u.pn >> 2;
        const int col0 = (u.pn & 3) * 256 + wc * 32 + 8 * fq;
        bf16_t* bb = t ? mvb : mkb; float* of = out + (t ? O_MVP : O_MKP);
#pragma unroll
        for (int ai = 0; ai < 2; ++ai)
#pragma unroll
            for (int m = 0; m < 4; ++m) {
                const int row = u.pm * 256 + ai * 128 + wr * 64 + m * 16 + fr;
#pragma unroll
                for (int bj = 0; bj < 2; ++bj) {
                    const int col = col0 + bj * 128;
                    const f32x4 v0 = acc[ai][bj][m][0], v1 = acc[ai][bj][m][1];
                    *(u32x4*)(bb + (size_t)row * 1024 + col) = pack8(v0, v1);
                    *(f32x4*)(of + (size_t)row * 1024 + col) = v0; *(f32x4*)(of + (size_t)row * 1024 + col + 4) = v1;
                }
            }
    }
};
template <int MODE> struct EpiRes {
    static constexpr bool PERM = true, AFTER_DRAIN = false;
    const float* xP; const float* xS; const bf16_t* resB; bf16_t* xo; float* yo; float* ssqp;
    __device__ __forceinline__ void operator()(AccRef acc, const Unit& u, int wr, int wc, int fr, int fq) const {
        const int col0 = u.pn * 256 + wc * 32 + 8 * fq;
#pragma unroll
        for (int ai = 0; ai < 2; ++ai)
#pragma unroll
            for (int m = 0; m < 4; ++m) {
                const int row = u.pm * 256 + ai * 128 + wr * 64 + m * 16 + fr;
                float ss = 0.f;
#pragma unroll
                for (int bj = 0; bj < 2; ++bj) {
                    const int col = col0 + bj * 128;
                    f32x4 r0, r1;
                    if (MODE == 0) { const float* xr = (row < MP) ? xP + (size_t)row * DM : xS + (size_t)(row - MP) * DM; r0 = *(const f32x4*)(xr + col); r1 = *(const f32x4*)(xr + col + 4); }
                    else { const u32x4 w = *(const u32x4*)(resB + (size_t)row * DM + col); r0 = (f32x4){bf_lo(w.x), bf_hi(w.x), bf_lo(w.y), bf_hi(w.y)}; r1 = (f32x4){bf_lo(w.z), bf_hi(w.z), bf_lo(w.w), bf_hi(w.w)}; }
                    const f32x4 v0 = acc[ai][bj][m][0] + r0, v1 = acc[ai][bj][m][1] + r1;
                    ss += (v0[0] * v0[0] + v0[1] * v0[1]) + (v0[2] * v0[2] + v0[3] * v0[3]) + (v1[0] * v1[0] + v1[1] * v1[1]) + (v1[2] * v1[2] + v1[3] * v1[3]);
                    if (MODE == 2) { float* yr = (row < MP) ? yo + O_YP + (size_t)row * DM : yo + O_YS + (size_t)(row - MP) * DM; *(f32x4*)(yr + col) = v0; *(f32x4*)(yr + col + 4) = v1; }
                    else *(u32x4*)(xo + (size_t)row * DM + col) = pack8(v0, v1);
                }
                ss += __shfl_xor(ss, 16); ss += __shfl_xor(ss, 32);
                if (fq == 0) ssqp[(size_t)row * 16 + u.pn * 4 + wc] = ss;
            }
    }
};
__device__ __forceinline__ float row_rsq(const float* ssqp, int row) {
    const f32x4* sp = (const f32x4*)(ssqp + (size_t)row * 16);
    const f32x4 a = sp[0], b = sp[1], c = sp[2], d = sp[3];
    const float s = ((a[0] + a[1]) + (a[2] + a[3])) + ((b[0] + b[1]) + (b[2] + b[3])) + ((c[0] + c[1]) + (c[2] + c[3])) + ((d[0] + d[1]) + (d[2] + d[3]));
    return rsq(s);
}
struct EpiMq {
    static constexpr bool PERM = true, AFTER_DRAIN = false;
    const float* ssqp; bf16_t* mq;
    __device__ __forceinline__ void operator()(AccRef acc, const Unit& u, int wr, int wc, int fr, int fq) const {
        const int col0 = u.pn * 256 + wc * 32 + 8 * fq;
#pragma unroll
        for (int ai = 0; ai < 2; ++ai)
#pragma unroll
            for (int m = 0; m < 4; ++m) {
                const int row = u.pm * 256 + ai * 128 + wr * 64 + m * 16 + fr;
                const float r = row_rsq(ssqp, row) * C2M;
#pragma unroll
                for (int bj = 0; bj < 2; ++bj) *(u32x4*)(mq + (size_t)row * DM + col0 + bj * 128) = pack8(acc[ai][bj][m][0] * r, acc[ai][bj][m][1] * r);
            }
    }
};
struct EpiUp {
    static constexpr bool PERM = true, AFTER_DRAIN = false;
    const float* ssqp; const float* cw; const float* cb; bf16_t* hff; float* ahead; float* atail; float* bhead;
    __device__ __forceinline__ void operator()(AccRef acc, const Unit& u, int wr, int wc, int fr, int fq) const {
        const int lane = fq * 16 + fr;
        const int c0 = u.pn * 128 + wc * 32 + 8 * fq;
        f32x4 w0[2], w1[2], w2[2], bb[2];
#pragma unroll
        for (int n = 0; n < 2; ++n) { w0[n] = *(const f32x4*)(cw + c0 + 4 * n); w1[n] = *(const f32x4*)(cw + DFF + c0 + 4 * n); w2[n] = *(const f32x4*)(cw + 2 * DFF + c0 + 4 * n); bb[n] = *(const f32x4*)(cb + c0 + 4 * n); }
        const int src1 = (lane & 48) | ((fr + 15) & 15), src2 = (lane & 48) | ((fr + 14) & 15);
#pragma unroll
        for (int ai = 0; ai < 2; ++ai) {
            const int seg = u.pm * 4 + ai * 2 + wr;
            const int rowb = u.pm * 256 + ai * 128 + wr * 64;
            f32x4 ap[2] = {{0.f, 0.f, 0.f, 0.f}, {0.f, 0.f, 0.f, 0.f}};
#pragma unroll
            for (int m = 0; m < 4; ++m) {
                const int row = rowb + m * 16 + fr;
                const float r = row_rsq(ssqp, row);
                f32x4 a[2], b[2], h[2];
#pragma unroll
                for (int n = 0; n < 2; ++n) {
                    a[n] = acc[ai][0][m][n] * r; b[n] = acc[ai][1][m][n] * r;
                    f32x4 a1, a2;
#pragma unroll
                    for (int e = 0; e < 4; ++e) {
                        const float x1 = (fr == 15) ? ap[n][e] : a[n][e]; a1[e] = __shfl(x1, src1);
                        const float x2 = (fr >= 14) ? ap[n][e] : a[n][e]; a2[e] = __shfl(x2, src2);
                    }
                    const f32x4 cv = bb[n] + w0[n] * a2 + w1[n] * a1 + w2[n] * a[n];
#pragma unroll
                    for (int e = 0; e < 4; ++e) h[n][e] = cv[e] * __builtin_amdgcn_rcpf(1.0f + __builtin_amdgcn_exp2f(-cv[e] * LOG2E)) * b[n][e];
                    ap[n] = a[n];
                }
                if (m == 0 && fr < 2) {
                    float* pa = ahead + ((size_t)seg * 2 + fr) * DFF + c0; float* pb = bhead + ((size_t)seg * 2 + fr) * DFF + c0;
                    *(f32x4*)pa = a[0]; *(f32x4*)(pa + 4) = a[1]; *(f32x4*)pb = b[0]; *(f32x4*)(pb + 4) = b[1];
                } else {
                    *(u32x4*)(hff + (size_t)row * DFF + c0) = pack8(h[0], h[1]);
                }
                if (m == 3 && fr >= 14) { float* pt = atail + ((size_t)seg * 2 + (fr - 14)) * DFF + c0; *(f32x4*)pt = a[0]; *(f32x4*)(pt + 4) = a[1]; }
            }
        }
    }
};

template <int D, int KT, int KG, bool CAUSAL, bool BIAS>
__device__ __forceinline__ void attn_unit(LAS unsigned char* L, const bf16_t* __restrict__ Q, int ldq,
                                          const bf16_t* __restrict__ K0, const bf16_t* __restrict__ V0, int nt0, const bf16_t* __restrict__ K1, const bf16_t* __restrict__ V1, int ldk, int ntiles,
                                          const float* __restrict__ kbias, int qpos0, bf16_t* __restrict__ O, int ldo) {
    constexpr int KS = D + 8, VS = KT + 4, CH = D / 8, NKI = KT * CH / 512, NVI = ((KT / 2) * CH + 511) / 512, NQF = (D == 64) ? 4 : 1, NP = KT / 32, QW = 8 / KG;
    constexpr int TILEB = KT * KS * 2 + D * VS * 2 + (BIAS ? KT * 4 : 0);
    const int tid = threadIdx.x, lane = tid & 63, wid = __builtin_amdgcn_readfirstlane(tid >> 6), r32 = lane & 31, hi = lane >> 5;
    const int qw = wid % QW, kg = wid / QW;
    const bf16_t* qrow = Q + (size_t)(qw * 32 + r32) * ldq + hi * 8;
    bf16x8 qf[NQF];
    if (D == 64) {
#pragma unroll
        for (int ds = 0; ds < NQF; ++ds) qf[ds] = *(const bf16x8*)(qrow + ds * 16);
    }
    float ref = 0.f;
    if (BIAS) ref = kbias[qpos0 + qw * 32 + r32];
    f32x16 o[D / 32];
#pragma unroll
    for (int db = 0; db < D / 32; ++db)
#pragma unroll
        for (int r = 0; r < 16; ++r) o[db][r] = 0.f;
    float lrun = 0.f;
    u32x4 kreg[NKI], vreg[NVI][2]; float breg = 0.f;
#define ATT_LOAD(j) do { const bf16_t* Kt_ = ((j) < nt0) ? K0 + (size_t)(j) * KT * ldk : K1 + (size_t)((j) - nt0) * KT * ldk; \
        const bf16_t* Vg_ = ((j) < nt0) ? V0 + (size_t)(j) * KT * ldk : V1 + (size_t)((j) - nt0) * KT * ldk; \
        _Pragma("unroll") for (int i_ = 0; i_ < NKI; ++i_) { const int id_ = tid + 512 * i_, row_ = id_ / CH, ch_ = id_ % CH; kreg[i_] = *(const u32x4*)(Kt_ + (size_t)row_ * ldk + ch_ * 8); } \
        _Pragma("unroll") for (int i_ = 0; i_ < NVI; ++i_) { const int id_ = tid + 512 * i_; if (id_ < (KT / 2) * CH) { const int pr_ = id_ / CH, ch_ = id_ % CH; \
            vreg[i_][0] = *(const u32x4*)(Vg_ + (size_t)(2 * pr_) * ldk + ch_ * 8); vreg[i_][1] = *(const u32x4*)(Vg_ + (size_t)(2 * pr_ + 1) * ldk + ch_ * 8); } } \
        if (BIAS && tid < KT) breg = kbias[(j) * KT + tid]; } while (0)
#define ATT_STORE(TB) do { LAS bf16_t* Ks_ = (LAS bf16_t*)(TB); LAS bf16_t* Vt_ = (LAS bf16_t*)((TB) + KT * KS * 2); \
        _Pragma("unroll") for (int i_ = 0; i_ < NKI; ++i_) { const int id_ = tid + 512 * i_, row_ = id_ / CH, ch_ = id_ % CH; *(LAS u32x4*)(Ks_ + row_ * KS + ch_ * 8) = kreg[i_]; } \
        _Pragma("unroll") for (int i_ = 0; i_ < NVI; ++i_) { const int id_ = tid + 512 * i_; if (id_ < (KT / 2) * CH) { const int pr_ = id_ / CH, ch_ = id_ % CH; \
            _Pragma("unroll") for (int e_ = 0; e_ < 4; ++e_) { const unsigned lo_ = vreg[i_][0][e_], h2_ = vreg[i_][1][e_]; \
                *(LAS unsigned*)(Vt_ + (ch_ * 8 + 2 * e_) * VS + 2 * pr_) = (lo_ & 0xffffu) | (h2_ << 16); \
                *(LAS unsigned*)(Vt_ + (ch_ * 8 + 2 * e_ + 1) * VS + 2 * pr_) = (lo_ >> 16) | (h2_ & 0xffff0000u); } } } \
        if (BIAS && tid < KT) ((LAS float*)((TB) + KT * KS * 2 + D * VS * 2))[tid] = breg; } while (0)
#define ATT_COMPUTE(j, TB) do { const LAS bf16_t* Ks_ = (const LAS bf16_t*)(TB); const LAS bf16_t* Vt_ = (const LAS bf16_t*)((TB) + KT * KS * 2); const LAS float* Bs_ = (const LAS float*)((TB) + KT * KS * 2 + D * VS * 2); \
        if (!CAUSAL || KT * (j) <= qpos0 + qw * 32 + 31) { \
            f32x16 p[NP]; \
            const bf16_t* qr_ = qrow; if (D != 64) asm volatile("" : "+v"(qr_)); \
            _Pragma("unroll") for (int h_ = 0; h_ < NP; ++h_) { \
                if (BIAS) { _Pragma("unroll") for (int i_ = 0; i_ < 4; ++i_) { const f32x4 t0_ = *(const LAS f32x4*)(Bs_ + 32 * h_ + 8 * i_ + 4 * hi); \
                        _Pragma("unroll") for (int e_ = 0; e_ < 4; ++e_) p[h_][4 * i_ + e_] = t0_[e_] - ref; } } \
                else { _Pragma("unroll") for (int r_ = 0; r_ < 16; ++r_) p[h_][r_] = 0.f; } } \
            _Pragma("unroll") for (int ds_ = 0; ds_ < D / 16; ++ds_) { \
                bf16x8 qv_; if (D == 64) qv_ = qf[ds_]; else qv_ = *(const bf16x8*)(qr_ + ds_ * 16); \
                _Pragma("unroll") for (int h_ = 0; h_ < NP; ++h_) { const bf16x8 kf_ = *(const LAS bf16x8*)(Ks_ + (32 * h_ + r32) * KS + ds_ * 16 + hi * 8); p[h_] = __builtin_amdgcn_mfma_f32_32x32x16_bf16(kf_, qv_, p[h_], 0, 0, 0); } } \
            if (CAUSAL && (KT * (j) + KT - 1 > qpos0 + qw * 32)) { const int lim_ = qpos0 + qw * 32 + r32 - KT * (j); \
                _Pragma("unroll") for (int h_ = 0; h_ < NP; ++h_) _Pragma("unroll") for (int r_ = 0; r_ < 16; ++r_) { if (crow(r_, hi) + 32 * h_ > lim_) p[h_][r_] = NEGBIG; } } \
            float sum_ = 0.f; \
            _Pragma("unroll") for (int h_ = 0; h_ < NP; ++h_) _Pragma("unroll") for (int r_ = 0; r_ < 16; ++r_) { p[h_][r_] = __builtin_amdgcn_exp2f(p[h_][r_]); sum_ += p[h_][r_]; } \
            lrun += sum_; \
            u32x4 pw_[2 * NP]; \
            _Pragma("unroll") for (int h_ = 0; h_ < NP; ++h_) _Pragma("unroll") for (int e_ = 0; e_ < 4; ++e_) { pw_[2 * h_][e_] = pg8::cvt_pk_bf16(p[h_][2 * e_], p[h_][2 * e_ + 1]); pw_[2 * h_ + 1][e_] = pg8::cvt_pk_bf16(p[h_][8 + 2 * e_], p[h_][9 + 2 * e_]); } \
            _Pragma("unroll") for (int db_ = 0; db_ < D / 32; ++db_) _Pragma("unroll") for (int ks_ = 0; ks_ < 2 * NP; ++ks_) { \
                const LAS bf16_t* vp_ = Vt_ + (db_ * 32 + r32) * VS + ks_ * 16 + hi * 4; \
                const u32x2 va_ = *(const LAS u32x2*)vp_, vb_ = *(const LAS u32x2*)(vp_ + 8); const u32x4 vv_ = {va_.x, va_.y, vb_.x, vb_.y}; \
                o[db_] = __builtin_amdgcn_mfma_f32_32x32x16_bf16(__builtin_bit_cast(bf16x8, vv_), __builtin_bit_cast(bf16x8, pw_[ks_]), o[db_], 0, 0, 0); } \
        } } while (0)
    if (KG == 1) {
        ATT_LOAD(0); ATT_STORE(L); if (ntiles > 1) ATT_LOAD(1);
        __syncthreads();
        for (int j = 0; j < ntiles; ++j) {
            LAS unsigned char* cur = L + (j & 1) * TILEB; LAS unsigned char* nxt = L + ((j + 1) & 1) * TILEB;
            if (j + 1 < ntiles) ATT_STORE(nxt);
            if (j + 2 < ntiles) ATT_LOAD(j + 2);
            ATT_COMPUTE(j, cur);
            __syncthreads();
        }
    } else {
        const int nsteps = (ntiles + KG - 1) / KG;
        for (int s = 0; s < nsteps; ++s) {
            __syncthreads();
#pragma unroll
            for (int g = 0; g < KG; ++g) { const int jt = s * KG + g; if (jt < ntiles) { ATT_LOAD(jt); ATT_STORE(L + g * TILEB); } }
            __syncthreads();
            const int jm = s * KG + kg;
            if (jm < ntiles) ATT_COMPUTE(jm, L + kg * TILEB);
        }
        LAS float* Mg = (LAS float*)L;
#pragma unroll
        for (int db = 0; db < D / 32; ++db) {
            __syncthreads();
#pragma unroll
            for (int r = 0; r < 16; ++r) Mg[(wid * 17 + r) * 64 + lane] = o[db][r];
            if (db == 0) Mg[(wid * 17 + 16) * 64 + lane] = lrun;
            __syncthreads();
            if (kg == 0) {
#pragma unroll
                for (int g = 1; g < KG; ++g) {
#pragma unroll
                    for (int r = 0; r < 16; ++r) o[db][r] += Mg[((g * QW + qw) * 17 + r) * 64 + lane];
                    if (db == 0) lrun += Mg[((g * QW + qw) * 17 + 16) * 64 + lane];
                }
            }
        }
        __syncthreads();
    }
#undef ATT_LOAD
#undef ATT_STORE
#undef ATT_COMPUTE
    if (kg == 0) {
        const float lt = lrun + __shfl_xor(lrun, 32), inv = 1.0f / lt;
        bf16_t* orow = O + (size_t)(qw * 32 + r32) * ldo;
#pragma unroll
        for (int db = 0; db < D / 32; ++db)
#pragma unroll
            for (int i = 0; i < 4; ++i) { u32x2 w; w.x = pg8::cvt_pk_bf16(o[db][4 * i] * inv, o[db][4 * i + 1] * inv); w.y = pg8::cvt_pk_bf16(o[db][4 * i + 2] * inv, o[db][4 * i + 3] * inv);
                *(u32x2*)(orow + db * 32 + 8 * i + 4 * hi) = w; }
    }
}

template <int J0, int J1>
__device__ __forceinline__ void pool_acc(float (&s)[8], const char* __restrict__ ubase, unsigned off0, int nprev) {
#pragma unroll
    for (int j = J0; j < J1; ++j) {
        const bool ok = j <= nprev; const unsigned jo = ok ? (unsigned)j * 1024u : 0u; const float wt = ok ? 1.f : 0.f;
        const u32x4 v = *(const u32x4*)(ubase + (off0 - jo));
        s[0] += wt * bf_lo(v.x); s[1] += wt * bf_hi(v.x); s[2] += wt * bf_lo(v.y); s[3] += wt * bf_hi(v.y); s[4] += wt * bf_lo(v.z); s[5] += wt * bf_hi(v.z); s[6] += wt * bf_lo(v.w); s[7] += wt * bf_hi(v.w);
    }
}
template <int G>
__device__ __forceinline__ void pool_group(const char* __restrict__ ubase, unsigned rowoff, int nprev, float icnt, const bf16_t* __restrict__ wpt, bf16_t* __restrict__ orow, int r32, int hi) {
    constexpr int w = 2 << G;
    bf16x8 dfr[8];
#pragma unroll
    for (int ks = 0; ks < 8; ++ks) {
        const int c0 = G * 128 + ks * 16 + hi * 8;
        const unsigned off0 = rowoff + (unsigned)c0 * 2u;
        const u32x4 cu = *(const u32x4*)(ubase + off0);
        float s[8], cur[8];
        cur[0] = bf_lo(cu.x); cur[1] = bf_hi(cu.x); cur[2] = bf_lo(cu.y); cur[3] = bf_hi(cu.y); cur[4] = bf_lo(cu.z); cur[5] = bf_hi(cu.z); cur[6] = bf_lo(cu.w); cur[7] = bf_hi(cu.w);
#pragma unroll
        for (int e = 0; e < 8; ++e) s[e] = cur[e];
        pool_acc<1, (w < 8 ? w : 8)>(s, ubase, off0, nprev);
        if (w > 8) { __builtin_amdgcn_sched_barrier(0); pool_acc<8, w>(s, ubase, off0, nprev); }
        u32x4 dv;
        dv.x = cvt_pk_bf16(s[0] * icnt - cur[0], s[1] * icnt - cur[1]); dv.y = cvt_pk_bf16(s[2] * icnt - cur[2], s[3] * icnt - cur[3]);
        dv.z = cvt_pk_bf16(s[4] * icnt - cur[4], s[5] * icnt - cur[5]); dv.w = cvt_pk_bf16(s[6] * icnt - cur[6], s[7] * icnt - cur[7]);
        dfr[ks] = __builtin_bit_cast(bf16x8, dv);
        __builtin_amdgcn_sched_barrier(0);
    }
#pragma unroll
    for (int nb = 0; nb < 4; ++nb) {
        f32x16 acc;
#pragma unroll
        for (int r = 0; r < 16; ++r) acc[r] = 0.f;
        const bf16_t* wrow = wpt + ((size_t)G * 128 + nb * 32 + r32) * 128 + hi * 8;
#pragma unroll
        for (int ks = 0; ks < 8; ++ks) acc = __builtin_amdgcn_mfma_f32_32x32x16_bf16(*(const bf16x8*)(wrow + ks * 16), dfr[ks], acc, 0, 0, 0);
#pragma unroll
        for (int i = 0; i < 4; ++i) { u32x2 wv; wv.x = cvt_pk_bf16(acc[4 * i], acc[4 * i + 1]); wv.y = cvt_pk_bf16(acc[4 * i + 2], acc[4 * i + 3]);
            *(u32x2*)(orow + G * 128 + nb * 32 + 8 * i + 4 * hi) = wv; }
    }
}
__device__ __forceinline__ void pool_unit(int tile, const bf16_t* __restrict__ ub, const bf16_t* __restrict__ usx, const bf16_t* __restrict__ wpt, bf16_t* __restrict__ mix) {
    const int tid = threadIdx.x, lane = tid & 63, wid = tid >> 6, r32 = lane & 31, hi = lane >> 5;
    const int row = tile * 256 + wid * 32 + r32;
    const bool samp = row >= MP;
    const int b = samp ? (row - MP) >> 6 : row >> 11, t = samp ? (row - MP) & 63 : row & (SEQ - 1);
    const char* ubase = (const char*)(tile >= 256 ? usx : ub);
    const unsigned rowoff = (samp ? (unsigned)(b * 79 + 15 + t) : (unsigned)row) * 1024u;
    const int nprev = samp ? t + 15 : t;
    bf16_t* orow = mix + (size_t)row * DM;
    const int np1 = samp ? 16 : t + 1;
    pool_group<0>(ubase, rowoff, nprev, 1.0f / (float)(np1 < 2 ? np1 : 2), wpt, orow, r32, hi);
    pool_group<1>(ubase, rowoff, nprev, 1.0f / (float)(np1 < 4 ? np1 : 4), wpt, orow, r32, hi);
    pool_group<2>(ubase, rowoff, nprev, 1.0f / (float)(np1 < 8 ? np1 : 8), wpt, orow, r32, hi);
    pool_group<3>(ubase, rowoff, nprev, 1.0f / (float)(np1 < 16 ? np1 : 16), wpt, orow, r32, hi);
}

template <int MODE>
__device__ __forceinline__ void transpose_item(const float* __restrict__ W, int K, int N, int nblk, bf16_t* __restrict__ WT, int row_off, const float* __restrict__ g, LAS float* scr, int item, int lane) {
    const int kb = item / nblk, nb = item % nblk, k0 = 64 * kb, n0 = 32 * nb;
#pragma unroll 8
    for (int i = 0; i < 32; ++i) { const int kk = 2 * i + (lane >> 5); float v = W[(size_t)(k0 + kk) * N + n0 + (lane & 31)]; if (g) v *= g[k0 + kk]; scr[kk * 33 + (lane & 31)] = v; }
    LDS_WAIT();
    const int c = lane & 7;
#pragma unroll
    for (int j = 0; j < 4; ++j) {
        const int n = (lane >> 3) + 8 * j; const LAS float* s = scr + (8 * c) * 33 + n;
        const int nn = n0 + n; int drow;
        if (MODE == 0) drow = row_off + nn; else { const int half = nn / DFF, cc = nn % DFF; drow = (cc >> 7) * 256 + half * 128 + (cc & 127); }
        u32x4 o; o.x = cvt_pk_bf16(s[0 * 33], s[1 * 33]); o.y = cvt_pk_bf16(s[2 * 33], s[3 * 33]); o.z = cvt_pk_bf16(s[4 * 33], s[5 * 33]); o.w = cvt_pk_bf16(s[6 * 33], s[7 * 33]);
        *(u32x4*)(WT + (size_t)drow * K + k0 + 8 * c) = o;
    }
    LDS_WAIT();
}
__device__ __forceinline__ void prepass_row(const float* __restrict__ xrow, bf16_t* __restrict__ orow, const LAS float* wf, const float* __restrict__ b_f, float* __restrict__ lf_out, int lane) {
    const f32x4* xr = (const f32x4*)xrow + lane;
    f32x4 v[4]; float s = 0.f;
#pragma unroll
    for (int j = 0; j < 4; ++j) { v[j] = xr[64 * j]; s += (v[j][0] * v[j][0] + v[j][1] * v[j][1]) + (v[j][2] * v[j][2] + v[j][3] * v[j][3]); }
    const float r = rsq(wave_sum(s));
    u32x2* o8 = (u32x2*)orow + lane;
#pragma unroll
    for (int j = 0; j < 4; ++j) { v[j] = v[j] * r; u32x2 w; w.x = cvt_pk_bf16(v[j][0], v[j][1]); w.y = cvt_pk_bf16(v[j][2], v[j][3]); o8[64 * j] = w; }
    if (wf) {
        f32x4 fa = {0.f, 0.f, 0.f, 0.f}, fb = {0.f, 0.f, 0.f, 0.f};
#pragma unroll
        for (int j = 0; j < 4; ++j)
#pragma unroll
            for (int e = 0; e < 4; ++e) { const int k = 4 * (lane + 64 * j) + e; const LAS f32x4* w = (const LAS f32x4*)(wf + k * 8); fa += w[0] * v[j][e]; fb += w[1] * v[j][e]; }
#pragma unroll
        for (int e = 0; e < 4; ++e) { fa[e] = wave_sum(fa[e]); fb[e] = wave_sum(fb[e]); }
        float z = fa[0];
        z = (lane == 1) ? fa[1] : z; z = (lane == 2) ? fa[2] : z; z = (lane == 3) ? fa[3] : z; z = (lane == 4) ? fb[0] : z; z = (lane == 5) ? fb[1] : z; z = (lane == 6) ? fb[2] : z; z = (lane == 7) ? fb[3] : z;
        if (lane < 8) { z += b_f[lane]; lf_out[lane] = fminf(z, 0.f) - log1pf(expf(-fabsf(z))); }
    }
}
__device__ __forceinline__ void scan_seq(const float* s0, int n0, const float* s1, int n1, float* dst, int lane) {
    const int n = n0 + n1, Lc = n >> 6;
    float s = 0.f;
    for (int i = 0; i < Lc; ++i) { const int t = lane * Lc + i; const float* ptr = (t < n0) ? (s0 + (size_t)t * 8) : (s1 + (size_t)(t - n0) * 8); s += *ptr; }
    float inc = s;
    for (int o = 1; o < 64; o <<= 1) { const float v = __shfl_up(inc, o); if (lane >= o) inc += v; }
    float run = inc - s;
    for (int i = 0; i < Lc; ++i) { const int t = lane * Lc + i; const float* ptr = (t < n0) ? (s0 + (size_t)t * 8) : (s1 + (size_t)(t - n0) * 8); run += *ptr; dst[t] = -run * LOG2E; }
}
__device__ __forceinline__ void cvt_flat(const float* __restrict__ src, bf16_t* __restrict__ dst, size_t n8, size_t gtid, size_t gn) {
    for (size_t i = gtid; i < n8; i += gn) { const f32x4 a = *(const f32x4*)(src + i * 8), b = *(const f32x4*)(src + i * 8 + 4); *(u32x4*)(dst + i * 8) = pack8(a, b); }
}

__global__ void __launch_bounds__(512, 2) fwd_kernel(Params p) {
    extern __shared__ __attribute__((aligned(16))) unsigned char lds_raw[];
    LAS unsigned char* L = (LAS unsigned char*)lds_raw;
    cg::grid_group grid = cg::this_grid();
    const int tid = threadIdx.x, lane = tid & 63, wave = __builtin_amdgcn_readfirstlane(tid >> 6);
    const int G = gridDim.x, bx = blockIdx.x;
    unsigned char* ws = p.ws; float* out = p.out;
    bf16_t* Wt_in = (bf16_t*)(ws + WS_WIN); bf16_t* Wt_o = (bf16_t*)(ws + WS_WO); bf16_t* Wt_mq = (bf16_t*)(ws + WS_WMQ); bf16_t* Wt_mo = (bf16_t*)(ws + WS_WMO);
    bf16_t* Wt_mkv = (bf16_t*)(ws + WS_WMKV); bf16_t* Wt_up = (bf16_t*)(ws + WS_WUP); bf16_t* Wt_dn = (bf16_t*)(ws + WS_WDN); bf16_t* Wt_pool = (bf16_t*)(ws + WS_WPOOL);
    bf16_t* usx = (bf16_t*)(ws + WS_USX);
    bf16_t* mkb = (bf16_t*)(ws + WS_MKB); bf16_t* mvb = (bf16_t*)(ws + WS_MVB);
    float* ssq1 = (float*)(ws + WS_SSQ1); float* ssq2 = (float*)(ws + WS_SSQ2); float* ssq3 = (float*)(ws + WS_SSQ3);
    float* kbP = (float*)(ws + WS_KBP); float* kbS = (float*)(ws + WS_KBS);
    float* ahead = (float*)(ws + WS_AHEAD); float* atail = (float*)(ws + WS_ATAIL); float* bhead = (float*)(ws + WS_BHEAD);
    bf16_t* x1b = (bf16_t*)(ws + WS_X1B); bf16_t* kcb = (bf16_t*)(ws + WS_KCB); bf16_t* vcb = (bf16_t*)(ws + WS_VCB); bf16_t* x2b = (bf16_t*)(ws + WS_X2B);
    bf16_t* xb = (bf16_t*)(ws + WS_XB); bf16_t* mqb = (bf16_t*)(ws + WS_MQB); bf16_t* hff = (bf16_t*)(ws + WS_HFF);
    bf16_t* uqkv = (bf16_t*)(ws + WS_UQKV); bf16_t* mo = (bf16_t*)(ws + WS_MO); bf16_t* mix = (bf16_t*)(ws + WS_MIX); bf16_t* memb = (bf16_t*)(ws + WS_MEMB);
    bf16_t* ub = uqkv; bf16_t* qb = uqkv + (size_t)MT * 512; bf16_t* kb = uqkv + (size_t)2 * MT * 512; bf16_t* vb = uqkv + (size_t)3 * MT * 512;
    const float* x_prompt = p.in[0]; const float* x_sample = p.in[1];
    const int lo = p.ph_lo, hi_ph = p.ph_hi;
    unsigned* gbar = (unsigned*)ws; unsigned nbar = 0u;
    if (lo < 0) grid.sync();
#define IN(k) (lo <= (k) && (k) < hi_ph && ((PHMASK >> (k)) & 1))
#define GSYNC() do { asm volatile("s_waitcnt vmcnt(0)" ::: "memory"); __syncthreads(); \
        if (tid == 0) { __builtin_amdgcn_fence(__ATOMIC_RELEASE, "agent"); asm volatile("s_waitcnt vmcnt(0)" ::: "memory"); \
            nbar += (unsigned)G; __hip_atomic_fetch_add(gbar, 1u, __ATOMIC_RELAXED, __HIP_MEMORY_SCOPE_AGENT); \
            while (__hip_atomic_load(gbar, __ATOMIC_RELAXED, __HIP_MEMORY_SCOPE_AGENT) < nbar) __builtin_amdgcn_s_sleep(1); \
            __builtin_amdgcn_fence(__ATOMIC_ACQUIRE, "agent"); asm volatile("s_waitcnt vmcnt(0)" ::: "memory"); } \
        __syncthreads(); } while (0)
#define SEAM(k) do { if (IN(k) && IN((k) + 1)) GSYNC(); } while (0)

    if (IN(0)) {
        const int gw = bx * 8 + wave, NGW = G * 8;
        LAS float* scr = (LAS float*)(L + wave * 8448);
        LAS float* wf = (LAS float*)(L + 8 * 8448);
        {
            const float* w_in = p.in[11]; const float* g_mix = p.in[10];
            for (int i = tid; i < 8192; i += 512) { const int k = i >> 3, h = i & 7; wf[i] = w_in[(size_t)k * 2056 + 2048 + h] * g_mix[k]; }
        }
        __syncthreads();
        constexpr int I_IN = 16 * 64, I_SQ = 16 * 32, I_UP = 16 * 176, I_DN = 44 * 32;
        constexpr int NITEMS = I_IN + 5 * I_SQ + I_UP + I_DN;
        for (int it = gw; it < NITEMS; it += NGW) {
            int r = it;
            if (r < I_IN) { transpose_item<0>(p.in[11], 1024, 2056, 64, Wt_in, 0, p.in[10], scr, r, lane); continue; } r -= I_IN;
            if (r < I_SQ) { transpose_item<0>(p.in[15], 1024, 1024, 32, Wt_o, 0, nullptr, scr, r, lane); continue; } r -= I_SQ;
            if (r < I_SQ) { transpose_item<0>(p.in[18], 1024, 1024, 32, Wt_mq, 0, p.in[16], scr, r, lane); continue; } r -= I_SQ;
            if (r < I_SQ) { transpose_item<0>(p.in[19], 1024, 1024, 32, Wt_mkv, 0, p.in[17], scr, r, lane); continue; } r -= I_SQ;
            if (r < I_SQ) { transpose_item<0>(p.in[20], 1024, 1024, 32, Wt_mkv, 1024, p.in[17], scr, r, lane); continue; } r -= I_SQ;
            if (r < I_SQ) { transpose_item<0>(p.in[21], 1024, 1024, 32, Wt_mo, 0, nullptr, scr, r, lane); continue; } r -= I_SQ;
            if (r < I_UP) { transpose_item<1>(p.in[23], 1024, NUP, 176, Wt_up, 0, p.in[22], scr, r, lane); continue; } r -= I_UP;
            transpose_item<0>(p.in[26], DFF, 1024, 32, Wt_dn, 0, nullptr, scr, r, lane);
        }
        {
            const float* w_pool = p.in[13]; const float* pscale = p.in[14];
            for (int i = bx * 512 + tid; i < 4 * 128 * 128; i += G * 512) { const int g = i >> 14, d = (i >> 7) & 127, c = i & 127; Wt_pool[i] = (bf16_t)(cvt_pk_bf16(w_pool[(g * 128 + c) * 128 + d] * pscale[g * 128 + d], 0.f) & 0xffffu); }
        }
        for (int m = gw; m < MT; m += NGW) {
            const float* xr = (m < MP) ? x_prompt + (size_t)m * DM : x_sample + (size_t)(m - MP) * DM;
            float* lf = (m < MP) ? out + O_LFP + (size_t)m * 8 : out + O_LFS + (size_t)(m - MP) * 8;
            prepass_row(xr, xb + (size_t)m * DM, wf, p.in[12], lf, lane);
        }
        for (int m = gw; m < 8192; m += NGW) prepass_row(p.in[9] + (size_t)m * DM, memb + (size_t)m * DM, (const LAS float*)nullptr, nullptr, nullptr, lane);
        const size_t gtid = (size_t)bx * 512 + tid, gn = (size_t)G * 512;
        for (size_t i = gtid; i < (size_t)16 * 15 * 512 / 8; i += gn) { const size_t e8 = i * 8, bb = e8 / (15 * 512), rem = e8 - bb * 15 * 512; const float* sp = p.in[5] + e8; *(u32x4*)(usx + bb * 79 * 512 + rem) = pack8(*(const f32x4*)sp, *(const f32x4*)(sp + 4)); }
        cvt_flat(p.in[2], kcb, (size_t)16 * PAST * 512 / 8, gtid, gn);
        cvt_flat(p.in[3], vcb, (size_t)16 * PAST * 512 / 8, gtid, gn);
        cvt_flat(p.in[7], mkb + (size_t)8192 * 1024, (size_t)4096 * 1024 / 8, gtid, gn);
        cvt_flat(p.in[8], mvb + (size_t)8192 * 1024, (size_t)4096 * 1024 / 8, gtid, gn);
        __syncthreads();
    }
    SEAM(0);

    if (IN(1)) {
        if (wave == 0) { const int s = bx; if (s < 256) scan_seq(out + O_LFP + (size_t)(s >> 3) * SEQ * 8 + (s & 7), SEQ, out + O_LFP, 0, kbP + (size_t)s * SEQ, lane); }
        if (wave == 1 && bx < 128) { const int s = bx; scan_seq(p.in[4] + (size_t)(s >> 3) * PAST * 8 + (s & 7), PAST, out + O_LFS + (size_t)(s >> 3) * DSEQ * 8 + (s & 7), DSEQ, kbS + (size_t)s * (PAST + DSEQ), lane); }
        {
            pg8::Gemm g{xb, Wt_in, MT, 2048, 1024}; pg8::StaticOrder S; S.init(MT, 2048, G, bx);
            EpiIn E{uqkv, out, usx};
            pg8::gemm_phase<EpiIn, pg8::StaticOrder, true, true>(L, g, S, E);
        }
        __syncthreads();
        {
            pg8::Gemm g{memb, Wt_mkv, 8192, 2048, 1024}; pg8::StaticOrder S; S.init(8192, 2048, G, bx);
            EpiMkv E{mkb, mvb, out};
            pg8::gemm_phase<EpiMkv, pg8::StaticOrder, true, true>(L, g, S, E);
        }
    }
    SEAM(1);

    if (IN(2)) {
        if (P2_ATTN_P) for (int bh = bx; bh < 256; bh += G) {
            const int b = bh >> 3, h = bh & 7;
            const bf16_t* Kh = kb + (size_t)b * SEQ * 512 + h * 64; const bf16_t* Vh = vb + (size_t)b * SEQ * 512 + h * 64;
            for (int qk = 7; qk >= 0; --qk) {
                const size_t r0 = (size_t)b * SEQ + 256 * qk;
                attn_unit<64, 64, 1, true, true>(L, qb + r0 * 512 + h * 64, 512, Kh, Vh, 4 * qk + 4, Kh, Vh, 512, 4 * qk + 4, kbP + (size_t)bh * SEQ, 256 * qk, mix + r0 * DM + 512 + h * 64, DM);
            }
        }
        if (P2_ATTN_S) for (int bh = bx; bh < 128; bh += G) {
            const int b = bh >> 3, h = bh & 7;
            const size_t r0 = (size_t)MP + b * DSEQ;
            attn_unit<64, 64, 4, true, true>(L, qb + r0 * 512 + h * 64, 512, kcb + (size_t)b * PAST * 512 + h * 64, vcb + (size_t)b * PAST * 512 + h * 64, 64,
                                      kb + r0 * 512 + h * 64, vb + r0 * 512 + h * 64, 512, 65, kbS + (size_t)bh * (PAST + DSEQ), PAST, mix + r0 * DM + 512 + h * 64, DM);
        }
        if (G == 256) { if (bx >= 128) { pool_unit(2 * (bx - 128), ub, usx, Wt_pool, mix); pool_unit(2 * (bx - 128) + 1, ub, usx, Wt_pool, mix); if (bx < 132) pool_unit(256 + bx - 128, ub, usx, Wt_pool, mix); } }
        else for (int t = bx; t < MT / 256; t += G) pool_unit(t, ub, usx, Wt_pool, mix);
        __syncthreads();
    }
    SEAM(2);

    if (IN(3)) {
        pg8::Gemm g{mix, Wt_o, MT, 1024, 1024}; pg8::StaticOrder S; S.init(MT, 1024, G, bx);
        EpiRes<0> E{x_prompt, x_sample, nullptr, x1b, nullptr, ssq1};
        pg8::gemm_phase<EpiRes<0>, pg8::StaticOrder, true, true>(L, g, S, E);
    }
    SEAM(3);

    if (IN(4)) {
        pg8::Gemm g{x1b, Wt_mq, MT, 1024, 1024}; pg8::StaticOrder S; S.init(MT, 1024, G, bx);
        EpiMq E{ssq1, mqb};
        pg8::gemm_phase<EpiMq, pg8::StaticOrder, true, true>(L, g, S, E);
    }
    SEAM(4);

    if (IN(5)) {
        for (int un = bx; un < 1024 + 64; un += G) {
            if (un < 1024) {
                const int b = un >> 5, h = (un >> 3) & 3, qk = un & 7;
                const size_t r0 = (size_t)b * SEQ + 256 * qk;
                const bf16_t* Kh = mkb + (size_t)b * NMEM * 1024 + h * 256; const bf16_t* Vh = mvb + (size_t)b * NMEM * 1024 + h * 256;
                attn_unit<256, 32, 1, false, false>(L, mqb + r0 * DM + h * 256, DM, Kh, Vh, 8, Kh, Vh, 1024, 8, nullptr, 0, mo + r0 * DM + h * 256, DM);
            } else {
                const int us = un - 1024, b = us >> 2, h = us & 3;
                const size_t r0 = (size_t)MP + b * DSEQ;
                const bf16_t* Kh = mkb + (size_t)(8192 + b * NMEM) * 1024 + h * 256; const bf16_t* Vh = mvb + (size_t)(8192 + b * NMEM) * 1024 + h * 256;
                attn_unit<256, 32, 4, false, false>(L, mqb + r0 * DM + h * 256, DM, Kh, Vh, 8, Kh, Vh, 1024, 8, nullptr, 0, mo + r0 * DM + h * 256, DM);
            }
        }
        __syncthreads();
    }
    SEAM(5);

    if (IN(6)) {
        pg8::Gemm g{mo, Wt_mo, MT, 1024, 1024}; pg8::StaticOrder S; S.init(MT, 1024, G, bx);
        EpiRes<1> E{nullptr, nullptr, x1b, x2b, nullptr, ssq2};
        pg8::gemm_phase<EpiRes<1>, pg8::StaticOrder, true, true>(L, g, S, E);
    }
    SEAM(6);

    if (IN(7)) {
        pg8::Gemm g{x2b, Wt_up, MT, NUP, 1024}; pg8::StaticOrder S; S.init(MT, NUP, G, bx);
        EpiUp E{ssq2, p.in[24], p.in[25], hff, ahead, atail, bhead};
        pg8::gemm_phase<EpiUp, pg8::StaticOrder, true, true>(L, g, S, E);
    }
    SEAM(7);

    if (IN(8)) {
        const float* cw = p.in[24]; const float* cbias = p.in[25]; const float* chist = p.in[6];
        const int total = NSEG * 2 * DFF;
        for (int idx = bx * 512 + tid; idx < total; idx += G * 512) {
            const int seg = idx / (2 * DFF), rem = idx - seg * 2 * DFF, i = rem / DFF, c = rem - i * DFF;
            float prev1, prev2;
            if (seg < MP / 64) { if ((seg & 31) == 0) { prev1 = 0.f; prev2 = 0.f; } else { prev1 = atail[((size_t)(seg - 1) * 2 + 1) * DFF + c]; prev2 = atail[((size_t)(seg - 1) * 2) * DFF + c]; } }
            else { const int b = seg - MP / 64; prev1 = chist[((size_t)b * 2 + 1) * DFF + c]; prev2 = chist[((size_t)b * 2) * DFF + c]; }
            const float a_0 = ahead[((size_t)seg * 2) * DFF + c];
            float am1, am2, a0;
            if (i == 0) { am1 = prev1; am2 = prev2; a0 = a_0; } else { am1 = a_0; am2 = prev1; a0 = ahead[((size_t)seg * 2 + 1) * DFF + c]; }
            const float cv = cbias[c] + cw[c] * am2 + cw[DFF + c] * am1 + cw[2 * DFF + c] * a0;
            const float hv = cv / (1.0f + __builtin_amdgcn_exp2f(-cv * LOG2E)) * bhead[((size_t)seg * 2 + i) * DFF + c];
            hff[((size_t)seg * 64 + i) * DFF + c] = (bf16_t)(cvt_pk_bf16(hv, 0.f) & 0xffffu);
        }
        for (int idx = bx * 512 + tid; idx < 48 * 2 * DFF; idx += G * 512) {
            const int bb = idx / (2 * DFF), rem = idx - bb * 2 * DFF;
            if (bb < 32) out[O_CSP + (size_t)bb * 2 * DFF + rem] = atail[((size_t)(32 * bb + 31) * 2) * DFF + rem];
            else out[O_CSS + (size_t)(bb - 32) * 2 * DFF + rem] = atail[((size_t)(MP / 64 + bb - 32) * 2) * DFF + rem];
        }
    }
    SEAM(8);

    if (IN(9)) {
        pg8::Gemm g{hff, Wt_dn, MT, 1024, DFF}; pg8::StaticOrder S; S.init(MT, 1024, G, bx);
        EpiRes<2> E{nullptr, nullptr, x2b, nullptr, out, ssq3};
        pg8::gemm_phase<EpiRes<2>, pg8::StaticOrder, true, true>(L, g, S, E);
    }
    SEAM(9);

    if (IN(10)) {
        const float* gf = p.in[27];
        const int gw = bx * 8 + wave, NGW = G * 8;
        f32x4 gv[4];
#pragma unroll
        for (int j = 0; j < 4; ++j) gv[j] = ((const f32x4*)gf)[lane + 64 * j];
        for (int m = gw; m < MT; m += NGW) {
            float* yr = (m < MP) ? out + O_YP + (size_t)m * DM : out + O_YS + (size_t)(m - MP) * DM;
            const float r = row_rsq(ssq3, m);
            f32x4* y4 = (f32x4*)yr + lane;
#pragma unroll
            for (int j = 0; j < 4; ++j) y4[64 * j] = y4[64 * j] * r * gv[j];
        }
    }
#ifdef DBG_DUMP
    {
        GSYNC();
        const bf16_t* src = nullptr; int pitch = 1024;
        if (hi_ph == 2) src = uqkv; else if (hi_ph == 3) src = mix; else if (hi_ph == 4) src = x1b; else if (hi_ph == 5) src = mqb; else if (hi_ph == 6) src = mo; else if (hi_ph == 7) src = x2b; else if (hi_ph == 8 || hi_ph == 9) { src = hff; pitch = DFF; }
        if (src) for (size_t i = (size_t)bx * 512 + tid; i < (size_t)MT * 1024; i += (size_t)G * 512) { const size_t m = i >> 10, c = i & 1023; float v = __builtin_bit_cast(float, (unsigned)src[m * pitch + c] << 16); if (!(v == v)) v = 12345.f; if (fabsf(v) > 1e30f) v = 54321.f; out[i] = v; }
    }
#endif
#undef IN
#undef SEAM
}

extern "C" void kernel_launch(void* const* d_in, const int* in_sizes, int n_in, void* d_out, int out_size, void* d_ws, size_t ws_size, hipStream_t stream) {
    static int grid = 0;
    if (grid == 0) {
        if (n_in != 28 || (size_t)out_size != O_END || ws_size < WS_NEED) { fprintf(stderr, "kernel_launch: unexpected shapes (n_in %d, out %d, ws %zu); nothing launched\n", n_in, out_size, ws_size); grid = -1; return; }
        int dev = 0, cus = 0, per_cu = 0;
        hipGetDevice(&dev); hipDeviceGetAttribute(&cus, hipDeviceAttributeMultiprocessorCount, dev);
        hipFuncSetAttribute((const void*)fwd_kernel, hipFuncAttributeMaxDynamicSharedMemorySize, LDS_BYTES);
        hipOccupancyMaxActiveBlocksPerMultiprocessor(&per_cu, (const void*)fwd_kernel, 512, LDS_BYTES);
        if (per_cu < 1) { fprintf(stderr, "kernel_launch: occupancy query says %d blocks per CU\n", per_cu); per_cu = 1; }
        (void)hipGetLastError();
        grid = cus;
    }
    if (grid < 0) return;
    (void)hipMemsetAsync(d_ws, 0, 256, stream);
    Params p{};
    for (int i = 0; i < 28; ++i) p.in[i] = (const float*)d_in[i];
    p.out = (float*)d_out; p.ws = (unsigned char*)d_ws;
    void* args[] = {&p};
#ifdef PROBE_K
    p.ph_lo = 0; p.ph_hi = PROBE_K + 1;
    (void)hipLaunchCooperativeKernel((const void*)fwd_kernel, dim3(grid), dim3(512), args, LDS_BYTES, stream);
    (void)hipMemsetAsync(d_ws, 0, 256, stream);
    p.ph_lo = PROBE_K; p.ph_hi = 11;
#else
    p.ph_lo = 0; p.ph_hi = 11;
#endif
    hipError_t e = hipLaunchCooperativeKernel((const void*)fwd_kernel, dim3(grid), dim3(512), args, LDS_BYTES, stream);
    if (e != hipSuccess) fprintf(stderr, "cooperative launch failed: %s (grid %d)\n", hipGetErrorString(e), grid);
}
```

```cpp
#include <hip/hip_runtime.h>
#include <hip/hip_cooperative_groups.h>
#include <cstdio>
#include <cstdint>
namespace cg = cooperative_groups;
namespace pg8 {
#define PG8_LAS __attribute__((address_space(3)))
typedef unsigned short bf16_t;
typedef short bf16x8 __attribute__((ext_vector_type(8)));
typedef float f32x4 __attribute__((ext_vector_type(4)));
typedef unsigned u32x4 __attribute__((ext_vector_type(4)));
constexpr int BM = 256, BK = 64, HALF = 128, HTB = HALF * BK * 2  , STAGE_BYTES = 8 * HTB, NXCD = 8, WGM = 8;

__host__ __device__ __forceinline__ int lds_byte(int r, int c) { const int st = (r >> 4) * 2 + (c >> 5), rr = r & 15, cc = c & 31, ob = rr * 64 + cc * 2; return st * 1024 + (ob ^ (((ob >> 9) & 1) << 5)); }
__host__ __device__ __forceinline__ void stage_rc(int b, int& R, int& C) { const int st = b / 1024, sb = b % 1024, swz = sb ^ (((sb >> 9) & 1) << 5); R = (st >> 1) * 16 + swz / 64; C = (st & 1) * 32 + (swz % 64) / 2; }
__host__ __device__ __forceinline__ int perm32(int rho) { const int n = rho >> 4, i = rho & 15; return 8 * (i >> 2) + 4 * n + (i & 3); }

struct Unit { int pm, pn; };
struct Gemm { const bf16_t* A; const bf16_t* Bt; int M, N, K; };

struct StaticOrder {
    int nM, nN, nwg, G, c;
    __host__ __device__ void init(int M, int N, int G_, int c_) { nM = M / BM; nN = N / BM; nwg = nM * nN; G = G_; c = c_; }
    __host__ __device__ bool next(int i, Unit& u) const {
        const long L = (long)i * G + c; if (L >= nwg) return false;
        int wgid = (int)L; { const int q = nwg / NXCD, r = nwg % NXCD, xcd = wgid % NXCD, off = wgid / NXCD; wgid = (xcd < r ? xcd * (q + 1) : r * (q + 1) + (xcd - r) * q) + off; }
        const int nig = WGM * nN, gid = wgid / nig, fm = gid * WGM, gsz = (nM - fm) < WGM ? (nM - fm) : WGM;
        u.pm = fm + ((wgid % nig) % gsz); u.pn = (wgid % nig) / gsz; return true;
    }
    __device__ __forceinline__ void a_ready(const Unit&) const {}
    __device__ __forceinline__ void done(const Unit&) const {}
};

__device__ __forceinline__ unsigned cvt_pk_bf16(float lo, float hi) { unsigned r; asm volatile("v_cvt_pk_bf16_f32 %0, %1, %2" : "=v"(r) : "v"(lo), "v"(hi)); return r; }
typedef float f32x2 __attribute__((ext_vector_type(2)));
template <class Epi, class Sched, bool ALIGN_EPI = false, bool SP2 = false>
__device__ __forceinline__ void gemm_phase(PG8_LAS unsigned char* lds, const Gemm g, const Sched& S, const Epi& E) {
    const int tid = threadIdx.x, wid = __builtin_amdgcn_readfirstlane(tid >> 6), lane = tid & 63, wr = wid >> 2, wc = wid & 3, fr = lane & 15, fq = lane >> 4;
    const int K = g.K, nt = K / BK;
    unsigned voffA[2], voffB[2];
#pragma unroll
    for (int i = 0; i < 2; ++i) { int R, C; stage_rc(tid * 16 + i * 8192, R, C); const int Rb = Epi::PERM ? ((R & ~31) + perm32(R & 31)) : R;
        voffA[i] = (unsigned)(R * K + C) * 2u; voffB[i] = (unsigned)(Rb * K + C) * 2u; }
    const size_t kstep = (size_t)(BK * 2);
    const size_t hstep = (size_t)HALF * K * 2;
    const size_t tstep = 2 * hstep;
    const unsigned ldsw = (unsigned)wid * 1024u;
    const int aoff = lds_byte(wr * 64 + fr, fq * 8), boff = lds_byte(wc * 32 + fr, fq * 8);
#define PG8_SA(b, h) (((b) * 2 + (h)) * HTB)
#define PG8_SB(b, h) ((4 + (b) * 2 + (h)) * HTB)
#define PG8_STAGE(bufoff, gbase, voff) do { _Pragma("unroll") for (int _i = 0; _i < 2; ++_i) \
        __builtin_amdgcn_global_load_lds((const unsigned*)((const char*)(gbase) + (voff)[_i]), (PG8_LAS unsigned*)(lds + (bufoff) + ldsw + _i * 8192), 16, 0, 0); } while (0)
#define PG8_LDA(dst, b, h) do { _Pragma("unroll") for (int m = 0; m < 4; ++m) _Pragma("unroll") for (int k = 0; k < 2; ++k) dst[m][k] = *(const PG8_LAS bf16x8*)(lds + PG8_SA(b, h) + aoff + m * 2048 + k * 1024); } while (0)
#define PG8_LDB(dst, b, h) do { _Pragma("unroll") for (int n = 0; n < 2; ++n) _Pragma("unroll") for (int k = 0; k < 2; ++k) dst[n][k] = *(const PG8_LAS bf16x8*)(lds + PG8_SB(b, h) + boff + n * 2048 + k * 1024); } while (0)
#define PG8_MMA(ai, bj, At, Bt) do { __builtin_amdgcn_s_setprio(1); _Pragma("unroll") for (int m = 0; m < 4; ++m) _Pragma("unroll") for (int n = 0; n < 2; ++n) _Pragma("unroll") for (int k = 0; k < 2; ++k) \
        acc[ai][bj][m][n] = __builtin_amdgcn_mfma_f32_16x16x32_bf16(Bt[n][k], At[m][k], acc[ai][bj][m][n], 0, 0, 0); __builtin_amdgcn_s_setprio(0); } while (0)
#define PG8_WAIT_V(n) asm volatile("s_waitcnt vmcnt(" #n ")" ::: "memory")
#define PG8_WAIT_L(n) asm volatile("s_waitcnt lgkmcnt(" #n ")" ::: "memory")
#define PG8_BAR __builtin_amdgcn_s_barrier()
#define PG8_SCHED __builtin_amdgcn_sched_barrier(0)
    Unit cur, nxt; int ui = 0;
    if (!S.next(0, cur)) return;
    f32x4 acc[2][2][4][2];
#pragma unroll
    for (int a = 0; a < 2; ++a)
#pragma unroll
        for (int b = 0; b < 2; ++b)
#pragma unroll
            for (int m = 0; m < 4; ++m)
#pragma unroll
                for (int n = 0; n < 2; ++n) acc[a][b][m][n] = (f32x4){0.f, 0.f, 0.f, 0.f};
    bf16x8 At[4][2], B0[2][2], B1[2][2];
    const char* cA = (const char*)g.A + (size_t)cur.pm * tstep; const char* cB = (const char*)g.Bt + (size_t)cur.pn * tstep;
    S.a_ready(cur);
    if constexpr (SP2) {
        PG8_STAGE(PG8_SB(0, 0), cB, voffB); PG8_STAGE(PG8_SB(0, 1), cB + hstep, voffB); PG8_STAGE(PG8_SA(0, 0), cA, voffA); PG8_STAGE(PG8_SA(0, 1), cA + hstep, voffA);
        if (wr == 1) PG8_BAR;
        PG8_WAIT_V(2); PG8_BAR;
        PG8_STAGE(PG8_SB(1, 0), cB + kstep, voffB); PG8_STAGE(PG8_SA(1, 0), cA + kstep, voffA); PG8_STAGE(PG8_SB(1, 1), cB + hstep + kstep, voffB);
        PG8_WAIT_V(6); PG8_BAR;
    } else {
        PG8_STAGE(PG8_SB(0, 0), cB, voffB); PG8_STAGE(PG8_SA(0, 0), cA, voffA); PG8_STAGE(PG8_SB(0, 1), cB + hstep, voffB); PG8_STAGE(PG8_SA(0, 1), cA + hstep, voffA);
        if (wr == 1) PG8_BAR;
        PG8_WAIT_V(4); PG8_BAR;
        PG8_STAGE(PG8_SB(1, 0), cB + kstep, voffB); PG8_STAGE(PG8_SA(1, 0), cA + kstep, voffA); PG8_STAGE(PG8_SB(1, 1), cB + hstep + kstep, voffB);
        PG8_WAIT_V(6); PG8_BAR;
    }
    for (;;) {
        const bool has_next = S.next(ui + 1, nxt);
        const char* nA = has_next ? (const char*)g.A + (size_t)nxt.pm * tstep : cA; const char* nB = has_next ? (const char*)g.Bt + (size_t)nxt.pn * tstep : cB;
        for (int t = 0; t < nt; t += 2) {
            const bool last = (t == nt - 2);
            const char* a1 = cA + (size_t)(t + 1) * kstep;
            const char* a2 = last ? nA : cA + (size_t)(t + 2) * kstep; const char* b2 = last ? nB : cB + (size_t)(t + 2) * kstep;
            const char* a3 = a2 + kstep; const char* b3 = b2 + kstep;
            if (last && has_next) S.a_ready(nxt);
            if constexpr (SP2) {
            PG8_LDB(B0, 0, 0); PG8_LDB(B1, 0, 1); PG8_SCHED; PG8_LDA(At, 0, 0); PG8_STAGE(PG8_SA(1, 1), a1 + hstep, voffA);
            PG8_WAIT_V(8); PG8_WAIT_L(0); PG8_BAR; PG8_MMA(0, 0, At, B0); PG8_MMA(0, 1, At, B1); PG8_BAR; PG8_SCHED;
            PG8_LDA(At, 0, 1); PG8_STAGE(PG8_SB(0, 0), b2, voffB); PG8_STAGE(PG8_SB(0, 1), b2 + hstep, voffB); PG8_STAGE(PG8_SA(0, 0), a2, voffA);
            PG8_WAIT_V(8); PG8_WAIT_L(0); PG8_BAR; PG8_MMA(1, 0, At, B0); PG8_MMA(1, 1, At, B1); PG8_BAR; PG8_SCHED;
            PG8_LDB(B0, 1, 0); PG8_LDB(B1, 1, 1); PG8_SCHED; PG8_LDA(At, 1, 0); PG8_STAGE(PG8_SA(0, 1), a2 + hstep, voffA);
            PG8_WAIT_V(8); PG8_WAIT_L(0); PG8_BAR; PG8_MMA(0, 0, At, B0); PG8_MMA(0, 1, At, B1); PG8_BAR; PG8_SCHED;
            PG8_LDA(At, 1, 1); PG8_STAGE(PG8_SB(1, 0), b3, voffB); PG8_STAGE(PG8_SB(1, 1), b3 + hstep, voffB); PG8_STAGE(PG8_SA(1, 0), a3, voffA);
            PG8_WAIT_V(8); PG8_WAIT_L(0); PG8_BAR; PG8_MMA(1, 0, At, B0); PG8_MMA(1, 1, At, B1); PG8_BAR; PG8_SCHED;
            } else {
            PG8_LDB(B0, 0, 0); PG8_SCHED; PG8_LDA(At, 0, 0); PG8_STAGE(PG8_SA(1, 1), a1 + hstep, voffA);
            PG8_WAIT_L(8); PG8_BAR; PG8_WAIT_L(0); PG8_MMA(0, 0, At, B0); PG8_BAR; PG8_SCHED;
            PG8_LDB(B1, 0, 1); PG8_STAGE(PG8_SB(0, 0), b2, voffB);
            PG8_BAR; PG8_WAIT_L(0); PG8_MMA(0, 1, At, B1); PG8_BAR;
            PG8_LDA(At, 0, 1); PG8_STAGE(PG8_SA(0, 0), a2, voffA);
            PG8_BAR; PG8_WAIT_L(0); PG8_MMA(1, 0, At, B0); PG8_BAR; PG8_SCHED;
            PG8_STAGE(PG8_SB(0, 1), b2 + hstep, voffB);
            PG8_WAIT_V(6); PG8_BAR; PG8_MMA(1, 1, At, B1); PG8_BAR;
            PG8_LDB(B0, 1, 0); PG8_SCHED; PG8_LDA(At, 1, 0); PG8_STAGE(PG8_SA(0, 1), a2 + hstep, voffA);
            PG8_WAIT_L(8); PG8_BAR; PG8_WAIT_L(0); PG8_MMA(0, 0, At, B0); PG8_BAR; PG8_SCHED;
            PG8_LDB(B1, 1, 1); PG8_STAGE(PG8_SB(1, 0), b3, voffB);
            PG8_BAR; PG8_WAIT_L(0); PG8_MMA(0, 1, At, B1); PG8_BAR;
            PG8_LDA(At, 1, 1); PG8_STAGE(PG8_SA(1, 0), a3, voffA);
            PG8_BAR; PG8_WAIT_L(0); PG8_MMA(1, 0, At, B0); PG8_BAR; PG8_SCHED;
            PG8_STAGE(PG8_SB(1, 1), b3 + hstep, voffB);
            PG8_WAIT_V(6); PG8_BAR; PG8_MMA(1, 1, At, B1); PG8_BAR;
            }
        }
        if constexpr (ALIGN_EPI) { if (wr == 0) PG8_BAR; }
        if constexpr (!Epi::AFTER_DRAIN) { E(acc, cur, wr, wc, fr, fq); S.done(cur); }
        if (!has_next) break;
#pragma unroll
        for (int a = 0; a < 2; ++a)
#pragma unroll
            for (int b = 0; b < 2; ++b)
#pragma unroll
                for (int m = 0; m < 4; ++m)
#pragma unroll
                    for (int n = 0; n < 2; ++n) acc[a][b][m][n] = (f32x4){0.f, 0.f, 0.f, 0.f};
        cur = nxt; cA = nA; cB = nB; ++ui;
        if constexpr (ALIGN_EPI) { if (wr == 1) PG8_BAR; }
    }
    PG8_WAIT_V(0);
    if constexpr (!ALIGN_EPI) { if (wr == 0) PG8_BAR; }
    PG8_BAR;
    if constexpr (Epi::AFTER_DRAIN) { E.fused(acc, cur, wr, wc, fr, fq, lds, wid, lane); S.done(cur); }
#undef PG8_SA
#undef PG8_SB
#undef PG8_STAGE
#undef PG8_LDA
#undef PG8_LDB
#undef PG8_MMA
#undef PG8_WAIT_V
#undef PG8_WAIT_L
#undef PG8_BAR
#undef PG8_SCHED
}
}

using pg8::bf16_t; using pg8::bf16x8; using pg8::f32x4; using pg8::u32x4; using pg8::Unit;
typedef float f32x2_t __attribute__((ext_vector_type(2))); typedef __bf16 bf16x2_t __attribute__((ext_vector_type(2)));
__device__ __forceinline__ unsigned cvt_pk_bf16(float lo, float hi) { f32x2_t v = {lo, hi}; bf16x2_t b = __builtin_convertvector(v, bf16x2_t); return __builtin_bit_cast(unsigned, b); }
typedef float f32x16 __attribute__((ext_vector_type(16)));
typedef unsigned u32x2 __attribute__((ext_vector_type(2)));
#define LAS __attribute__((address_space(3)))

constexpr int DM = 1024, MP = 65536, MS = 1024, MT = MP + MS, SEQ = 2048, DSEQ = 64, PAST = 4096, NMEM = 256;
constexpr int DFF = 2816, NUP = 2 * DFF, NSEG = MT / 64;
constexpr float EPS = 1e-6f, LOG2E = 1.4426950408889634f;
constexpr float C2F = 0.125f * LOG2E, C2M = 0.0625f * LOG2E;
constexpr float NEGBIG = -1e30f;

constexpr size_t O_YP = 0, O_YS = O_YP + (size_t)MP * DM, O_KP = O_YS + (size_t)MS * DM, O_VP = O_KP + (size_t)MP * 512, O_LFP = O_VP + (size_t)MP * 512,
    O_PSP = O_LFP + (size_t)MP * 8, O_CSP = O_PSP + 32 * 15 * 512, O_MKP = O_CSP + 32 * 2 * DFF, O_MVP = O_MKP + (size_t)8192 * 1024, O_KS = O_MVP + (size_t)8192 * 1024,
    O_VS = O_KS + (size_t)MS * 512, O_LFS = O_VS + (size_t)MS * 512, O_PSS = O_LFS + MS * 8, O_CSS = O_PSS + 16 * 15 * 512, O_END = O_CSS + 16 * 2 * DFF;

constexpr size_t MiB = 1u << 20;
constexpr size_t WS_WIN = 1 * MiB, WS_WO = 5 * MiB, WS_WMQ = 7 * MiB, WS_WMO = 9 * MiB, WS_WMKV = 11 * MiB, WS_WUP = 15 * MiB, WS_WDN = 26 * MiB, WS_WPOOL = 32 * MiB;
constexpr size_t WS_USX = 34 * MiB;
constexpr size_t WS_MKB = 40 * MiB, WS_MVB = 64 * MiB;
constexpr size_t WS_SSQ1 = 88 * MiB, WS_SSQ2 = 93 * MiB, WS_SSQ3 = 98 * MiB;
constexpr size_t WS_KBP = 103 * MiB, WS_KBS = 105 * MiB;
constexpr size_t WS_AHEAD = 108 * MiB, WS_ATAIL = WS_AHEAD + 23 * MiB / 1 - MiB / 2, WS_BHEAD = WS_ATAIL + 23 * MiB - MiB / 2;
constexpr size_t WS_X1B = 176 * MiB, WS_KCB = 176 * MiB, WS_VCB = 240 * MiB;
constexpr size_t WS_X2B = 306 * MiB;
constexpr size_t WS_XB = 436 * MiB, WS_MQB = 436 * MiB, WS_HFF = 436 * MiB;
constexpr size_t WS_UQKV = 566 * MiB, WS_MO = 566 * MiB;
constexpr size_t WS_MIX = 826 * MiB, WS_MEMB = 956 * MiB, WS_NEED = 972 * MiB;
static_assert((size_t)NSEG * 2 * DFF * 4 <= 22 * MiB + MiB / 2, "side buffers");
static_assert(WS_BHEAD + 22 * MiB + MiB / 2 <= WS_X1B, "side buffers end");

#define P2_ATTN_P 1
#define P2_ATTN_S 1
#define P2_POOL 1
#define DBG_HI 11
#ifndef PHMASK
#define PHMASK 0x7ff
#endif
constexpr int LDS_BYTES = 147456;

struct Params { const float* in[28]; float* out; unsigned char* ws; int ph_lo, ph_hi; };

__device__ __forceinline__ float bf_lo(unsigned w) { return __builtin_bit_cast(float, w << 16); }
__device__ __forceinline__ float bf_hi(unsigned w) { return __builtin_bit_cast(float, w & 0xffff0000u); }
__device__ __forceinline__ int crow(int r, int hi) { return (r & 3) + 8 * (r >> 2) + 4 * hi; }
__device__ __forceinline__ float wave_sum(float v) {
#pragma unroll
    for (int o = 1; o < 64; o <<= 1) v += __shfl_xor(v, o);
    return v;
}
__device__ __forceinline__ float rsq(float ssq) { return 1.0f / sqrtf(ssq * (1.0f / 1024.0f) + EPS); }
#define LDS_WAIT() asm volatile("s_waitcnt lgkmcnt(0)" ::: "memory")

typedef const f32x4 (&AccRef)[2][2][4][2];

__device__ __forceinline__ u32x4 pack8(f32x4 v0, f32x4 v1) { u32x4 w; w.x = cvt_pk_bf16(v0[0], v0[1]); w.y = cvt_pk_bf16(v0[2], v0[3]); w.z = cvt_pk_bf16(v1[0], v1[1]); w.w = cvt_pk_bf16(v1[2], v1[3]); return w; }

struct EpiIn {
    static constexpr bool PERM = true, AFTER_DRAIN = false;
    bf16_t* uqkv; float* out; bf16_t* usx;
    __device__ __forceinline__ void operator()(AccRef acc, const Unit& u, int wr, int wc, int fr, int fq) const {
        const int t = u.pn >> 1;
        const int col0 = (u.pn & 1) * 256 + wc * 32 + 8 * fq;
        bf16_t* base = uqkv + (size_t)t * MT * 512;
        const float sc = (t == 1) ? C2F : 1.0f;
#pragma unroll
        for (int ai = 0; ai < 2; ++ai)
#pragma unroll
            for (int m = 0; m < 4; ++m) {
                const int row = u.pm * 256 + ai * 128 + wr * 64 + m * 16 + fr;
#pragma unroll
                for (int bj = 0; bj < 2; ++bj) {
                    const int col = col0 + bj * 128;
                    const f32x4 v0 = acc[ai][bj][m][0] * sc, v1 = acc[ai][bj][m][1] * sc;
                    *(u32x4*)(base + (size_t)row * 512 + col) = pack8(v0, v1);
                    if (t >= 2) {
                        float* o = (row < MP) ? out + (t == 2 ? O_KP : O_VP) + (size_t)row * 512 : out + (t == 2 ? O_KS : O_VS) + (size_t)(row - MP) * 512;
                        *(f32x4*)(o + col) = v0; *(f32x4*)(o + col + 4) = v1;
                    } else if (t == 0) {
                        if (row < MP) { const int tt = row & (SEQ - 1); if (tt >= SEQ - 15) { float* o = out + O_PSP + ((size_t)(row >> 11) * 15 + (tt - (SEQ - 15))) * 512 + col; *(f32x4*)o = v0; *(f32x4*)(o + 4) = v1; } }
                        else { const int rs = row - MP, tt = rs & 63; *(u32x4*)(usx + ((size_t)(rs >> 6) * 79 + 15 + tt) * 512 + col) = pack8(v0, v1); if (tt >= DSEQ - 15) { float* o = out + O_PSS + ((size_t)(rs >> 6) * 15 + (tt - (DSEQ - 15))) * 512 + col; *(f32x4*)o = v0; *(f32x4*)(o + 4) = v1; } }
                    }
                }
            }
    }
};
struct EpiMkv {
    static constexpr bool PERM = true, AFTER_DRAIN = false;
    bf16_t* mkb; bf16_t* mvb; float* out;
    __device__ __forceinline__ void operator()(AccRef acc, const Unit& u, int wr, int wc, int fr, int fq) const {
        const int t = u.pn >> 2;
        const int col0 = (u.pn & 3) * 256 + wc * 32 + 8 * fq;
        bf16_t* bb = t ? mvb : mkb; float* of = out + (t ? O_MVP : O_MKP);
#pragma unroll
        for (int ai = 0; ai < 2; ++ai)
#pragma unroll
            for (int m = 0; m < 4; ++m) {
                const int row = u.pm * 256 + ai * 128 + wr * 64 + m * 16 + fr;
#pragma unroll
                for (int bj = 0; bj < 2; ++bj) {
                    const int col = col0 + bj * 128;
                    const f32x4 v0 = acc[ai][bj][m][0], v1 = acc[ai][bj][m][1];
                    *(u32x4*)(bb + (size_t)row * 1024 + col) = pack8(v0, v1);
                    *(f32x4*)(of + (size_t)row * 1024 + col) = v0; *(f32x4*)(of + (size_t)row * 1024 + col + 4) = v1;
                }
            }
    }
};
template <int MODE> struct EpiRes {
    static constexpr bool PERM = true, AFTER_DRAIN = false;
    const float* xP; const float* xS; const bf16_t* resB; bf16_t* xo; float* yo; float* ssqp;
    __device__ __forceinline__ void operator()(AccRef acc, const Unit& u, int wr, int wc, int fr, int fq) const {
        const int col0 = u.pn * 256 + wc * 32 + 8 * fq;
#pragma unroll
        for (int ai = 0; ai < 2; ++ai)
#pragma unroll
            for (int m = 0; m < 4; ++m) {
                const int row = u.pm * 256 + ai * 128 + wr * 64 + m * 16 + fr;
                float ss = 0.f;
#pragma unroll
                for (int bj = 0; bj < 2; ++bj) {
                    const int col = col0 + bj * 128;
                    f32x4 r0, r1;
                    if (MODE == 0) { const float* xr = (row < MP) ? xP + (size_t)row * DM : xS + (size_t)(row - MP) * DM; r0 = *(const f32x4*)(xr + col); r1 = *(const f32x4*)(xr + col + 4); }
                    else { const u32x4 w = *(const u32x4*)(resB + (size_t)row * DM + col); r0 = (f32x4){bf_lo(w.x), bf_hi(w.x), bf_lo(w.y), bf_hi(w.y)}; r1 = (f32x4){bf_lo(w.z), bf_hi(w.z), bf_lo(w.w), bf_hi(w.w)}; }
                    const f32x4 v0 = acc[ai][bj][m][0] + r0, v1 = acc[ai][bj][m][1] + r1;
                    ss += (v0[0] * v0[0] + v0[1] * v0[1]) + (v0[2] * v0[2] + v0[3] * v0[3]) + (v1[0] * v1[0] + v1[1] * v1[1]) + (v1[2] * v1[2] + v1[3] * v1[3]);
                    if (MODE == 2) { float* yr = (row < MP) ? yo + O_YP + (size_t)row * DM : yo + O_YS + (size_t)(row - MP) * DM; *(f32x4*)(yr + col) = v0; *(f32x4*)(yr + col + 4) = v1; }
                    else *(u32x4*)(xo + (size_t)row * DM + col) = pack8(v0, v1);
                }
                ss += __shfl_xor(ss, 16); ss += __shfl_xor(ss, 32);
                if (fq == 0) ssqp[(size_t)row * 16 + u.pn * 4 + wc] = ss;
            }
    }
};
__device__ __forceinline__ float row_rsq(const float* ssqp, int row) {
    const f32x4* sp = (const f32x4*)(ssqp + (size_t)row * 16);
    const f32x4 a = sp[0], b = sp[1], c = sp[2], d = sp[3];
    const float s = ((a[0] + a[1]) + (a[2] + a[3])) + ((b[0] + b[1]) + (b[2] + b[3])) + ((c[0] + c[1]) + (c[2] + c[3])) + ((d[0] + d[1]) + (d[2] + d[3]));
    return rsq(s);
}
struct EpiMq {
    static constexpr bool PERM = true, AFTER_DRAIN = false;
    const float* ssqp; bf16_t* mq;
    __device__ __forceinline__ void operator()(AccRef acc, const Unit& u, int wr, int wc, int fr, int fq) const {
        const int col0 = u.pn * 256 + wc * 32 + 8 * fq;
#pragma unroll
        for (int ai = 0; ai < 2; ++ai)
#pragma unroll
            for (int m = 0; m < 4; ++m) {
                const int row = u.pm * 256 + ai * 128 + wr * 64 + m * 16 + fr;
                const float r = row_rsq(ssqp, row) * C2M;
#pragma unroll
                for (int bj = 0; bj < 2; ++bj) *(u32x4*)(mq + (size_t)row * DM + col0 + bj * 128) = pack8(acc[ai][bj][m][0] * r, acc[ai][bj][m][1] * r);
            }
    }
};
struct EpiUp {
    static constexpr bool PERM = true, AFTER_DRAIN = false;
    const float* ssqp; const float* cw; const float* cb; bf16_t* hff; float* ahead; float* atail; float* bhead;
    __device__ __forceinline__ void operator()(AccRef acc, const Unit& u, int wr, int wc, int fr, int fq) const {
        const int lane = fq * 16 + fr;
        const int c0 = u.pn * 128 + wc * 32 + 8 * fq;
        f32x4 w0[2], w1[2], w2[2], bb[2];
#pragma unroll
        for (int n = 0; n < 2; ++n) { w0[n] = *(const f32x4*)(cw + c0 + 4 * n); w1[n] = *(const f32x4*)(cw + DFF + c0 + 4 * n); w2[n] = *(const f32x4*)(cw + 2 * DFF + c0 + 4 * n); bb[n] = *(const f32x4*)(cb + c0 + 4 * n); }
        const int src1 = (lane & 48) | ((fr + 15) & 15), src2 = (lane & 48) | ((fr + 14) & 15);
#pragma unroll
        for (int ai = 0; ai < 2; ++ai) {
            const int seg = u.pm * 4 + ai * 2 + wr;
            const int rowb = u.pm * 256 + ai * 128 + wr * 64;
            f32x4 ap[2] = {{0.f, 0.f, 0.f, 0.f}, {0.f, 0.f, 0.f, 0.f}};
#pragma unroll
            for (int m = 0; m < 4; ++m) {
                const int row = rowb + m * 16 + fr;
                const float r = row_rsq(ssqp, row);
                f32x4 a[2], b[2], h[2];
#pragma unroll
                for (int n = 0; n < 2; ++n) {
                    a[n] = acc[ai][0][m][n] * r; b[n] = acc[ai][1][m][n] * r;
                    f32x4 a1, a2;
#pragma unroll
                    for (int e = 0; e < 4; ++e) {
                        const float x1 = (fr == 15) ? ap[n][e] : a[n][e]; a1[e] = __shfl(x1, src1);
                        const float x2 = (fr >= 14) ? ap[n][e] : a[n][e]; a2[e] = __shfl(x2, src2);
                    }
                    const f32x4 cv = bb[n] + w0[n] * a2 + w1[n] * a1 + w2[n] * a[n];
#pragma unroll
                    for (int e = 0; e < 4; ++e) h[n][e] = cv[e] * __builtin_amdgcn_rcpf(1.0f + __builtin_amdgcn_exp2f(-cv[e] * LOG2E)) * b[n][e];
                    ap[n] = a[n];
                }
                if (m == 0 && fr < 2) {
                    float* pa = ahead + ((size_t)seg * 2 + fr) * DFF + c0; float* pb = bhead + ((size_t)seg * 2 + fr) * DFF + c0;
                    *(f32x4*)pa = a[0]; *(f32x4*)(pa + 4) = a[1]; *(f32x4*)pb = b[0]; *(f32x4*)(pb + 4) = b[1];
                } else {
                    *(u32x4*)(hff + (size_t)row * DFF + c0) = pack8(h[0], h[1]);
                }
                if (m == 3 && fr >= 14) { float* pt = atail + ((size_t)seg * 2 + (fr - 14)) * DFF + c0; *(f32x4*)pt = a[0]; *(f32x4*)(pt + 4) = a[1]; }
            }
        }
    }
};

template <int D, int KT, int KG, bool PF, bool QLDS, bool CAUSAL, bool BIAS>
__device__ __forceinline__ void attn_unit(LAS unsigned char* L, const bf16_t* __restrict__ Q, int ldq, int nq,
                                          const bf16_t* __restrict__ K0, const bf16_t* __restrict__ V0, int nt0, const bf16_t* __restrict__ K1, const bf16_t* __restrict__ V1, int ldk, int ntiles,
                                          const float* __restrict__ kbias, int qpos0, bf16_t* __restrict__ O, int ldo) {
    constexpr int KS = D + 8, VS = KT + 4, CH = D / 8, NKI = KT * CH / 512, NVI = ((KT / 2) * CH + 511) / 512, NQF = (D == 64) ? 4 : 1, NP = KT / 32, QW = 8 / KG;
    constexpr int TILEB = KT * KS * 2 + D * VS * 2 + (BIAS ? KT * 4 : 0);
    constexpr int QBYTES = QLDS ? 32 * QW * KS * 2 : 0;
    constexpr int NG = (KG == 1) ? 2 : (!PF ? 1 : KG);
    const int tid = threadIdx.x, lane = tid & 63, wid = __builtin_amdgcn_readfirstlane(tid >> 6), r32 = lane & 31, hi = lane >> 5;
    const int qw = wid % QW, kg = wid / QW;
    const bool wact = qw * 32 < nq;
    LAS unsigned char* T = L + QBYTES;
    const LAS bf16_t* Qs = (const LAS bf16_t*)L + (qw * 32 + r32) * KS + hi * 8;
    const bf16_t* qrow = Q + (size_t)(qw * 32 + r32) * ldq + hi * 8;
    bf16x8 qf[NQF];
    if (D == 64 && !QLDS) {
#pragma unroll
        for (int ds = 0; ds < NQF; ++ds) qf[ds] = wact ? *(const bf16x8*)(qrow + ds * 16) : (bf16x8){0, 0, 0, 0, 0, 0, 0, 0};
    }
    if (QLDS) {
        __syncthreads();
        constexpr int NQI = 32 * QW * CH / 512;
#pragma unroll
        for (int i = 0; i < NQI; ++i) { const int id = tid + 512 * i, row = id / CH, ch = id % CH; if (row < nq) *(LAS u32x4*)((LAS bf16_t*)L + row * KS + ch * 8) = *(const u32x4*)(Q + (size_t)row * ldq + ch * 8); }
    }
    float ref = 0.f;
    if (BIAS) ref = wact ? kbias[qpos0 + qw * 32 + r32] : 0.f;
    f32x16 o[D / 32];
#pragma unroll
    for (int db = 0; db < D / 32; ++db)
#pragma unroll
        for (int r = 0; r < 16; ++r) o[db][r] = 0.f;
    float lrun = 0.f;
    u32x4 kreg[NG][NKI], vreg[NG][NVI][2]; float breg[NG];
#define ATT_LOAD(j, g) do { const bf16_t* Kt_ = ((j) < nt0) ? K0 + (size_t)(j) * KT * ldk : K1 + (size_t)((j) - nt0) * KT * ldk; \
        const bf16_t* Vg_ = ((j) < nt0) ? V0 + (size_t)(j) * KT * ldk : V1 + (size_t)((j) - nt0) * KT * ldk; \
        _Pragma("unroll") for (int i_ = 0; i_ < NKI; ++i_) { const int id_ = tid + 512 * i_, row_ = id_ / CH, ch_ = id_ % CH; kreg[g][i_] = *(const u32x4*)(Kt_ + (size_t)row_ * ldk + ch_ * 8); } \
        _Pragma("unroll") for (int i_ = 0; i_ < NVI; ++i_) { const int id_ = tid + 512 * i_; if (id_ < (KT / 2) * CH) { const int pr_ = id_ % (KT / 2), ch_ = id_ / (KT / 2); \
            vreg[g][i_][0] = *(const u32x4*)(Vg_ + (size_t)(2 * pr_) * ldk + ch_ * 8); vreg[g][i_][1] = *(const u32x4*)(Vg_ + (size_t)(2 * pr_ + 1) * ldk + ch_ * 8); } } \
        if (BIAS && tid < KT) breg[g] = kbias[(j) * KT + tid]; } while (0)
#define ATT_STORE(TB, g) do { LAS bf16_t* Ks_ = (LAS bf16_t*)(TB); LAS bf16_t* Vt_ = (LAS bf16_t*)((TB) + KT * KS * 2); \
        _Pragma("unroll") for (int i_ = 0; i_ < NKI; ++i_) { const int id_ = tid + 512 * i_, row_ = id_ / CH, ch_ = id_ % CH; *(LAS u32x4*)(Ks_ + row_ * KS + ch_ * 8) = kreg[g][i_]; } \
        _Pragma("unroll") for (int i_ = 0; i_ < NVI; ++i_) { const int id_ = tid + 512 * i_; if (id_ < (KT / 2) * CH) { const int pr_ = id_ % (KT / 2), ch_ = id_ / (KT / 2); \
            _Pragma("unroll") for (int e_ = 0; e_ < 4; ++e_) { const unsigned lo_ = vreg[g][i_][0][e_], h2_ = vreg[g][i_][1][e_]; \
                *(LAS unsigned*)(Vt_ + (ch_ * 8 + 2 * e_) * VS + 2 * pr_) = (lo_ & 0xffffu) | (h2_ << 16); \
                *(LAS unsigned*)(Vt_ + (ch_ * 8 + 2 * e_ + 1) * VS + 2 * pr_) = (lo_ >> 16) | (h2_ & 0xffff0000u); } } } \
        if (BIAS && tid < KT) ((LAS float*)((TB) + KT * KS * 2 + D * VS * 2))[tid] = breg[g]; } while (0)
#define ATT_COMPUTE(j, TB) do { const LAS bf16_t* Ks_ = (const LAS bf16_t*)(TB); const LAS bf16_t* Vt_ = (const LAS bf16_t*)((TB) + KT * KS * 2); const LAS float* Bs_ = (const LAS float*)((TB) + KT * KS * 2 + D * VS * 2); \
        if (wact && (!CAUSAL || KT * (j) <= qpos0 + qw * 32 + 31)) { \
            f32x16 p[NP]; \
            const bf16_t* qr_ = qrow; if (D != 64 && !QLDS) asm volatile("" : "+v"(qr_)); \
            _Pragma("unroll") for (int h_ = 0; h_ < NP; ++h_) { \
                if (BIAS) { _Pragma("unroll") for (int i_ = 0; i_ < 4; ++i_) { const f32x4 t0_ = *(const LAS f32x4*)(Bs_ + 32 * h_ + 8 * i_ + 4 * hi); \
                        _Pragma("unroll") for (int e_ = 0; e_ < 4; ++e_) p[h_][4 * i_ + e_] = t0_[e_] - ref; } } \
                else { _Pragma("unroll") for (int r_ = 0; r_ < 16; ++r_) p[h_][r_] = 0.f; } } \
            _Pragma("unroll") for (int ds_ = 0; ds_ < D / 16; ++ds_) { \
                bf16x8 qv_; if (QLDS) qv_ = *(const LAS bf16x8*)(Qs + ds_ * 16); else if (D == 64) qv_ = qf[ds_]; else qv_ = *(const bf16x8*)(qr_ + ds_ * 16); \
                _Pragma("unroll") for (int h_ = 0; h_ < NP; ++h_) { const bf16x8 kf_ = *(const LAS bf16x8*)(Ks_ + (32 * h_ + r32) * KS + ds_ * 16 + hi * 8); p[h_] = __builtin_amdgcn_mfma_f32_32x32x16_bf16(kf_, qv_, p[h_], 0, 0, 0); } } \
            if (CAUSAL && (KT * (j) + KT - 1 > qpos0 + qw * 32)) { const int lim_ = qpos0 + qw * 32 + r32 - KT * (j); \
                _Pragma("unroll") for (int h_ = 0; h_ < NP; ++h_) _Pragma("unroll") for (int r_ = 0; r_ < 16; ++r_) { if (crow(r_, hi) + 32 * h_ > lim_) p[h_][r_] = NEGBIG; } } \
            float sum_ = 0.f; \
            _Pragma("unroll") for (int h_ = 0; h_ < NP; ++h_) _Pragma("unroll") for (int r_ = 0; r_ < 16; ++r_) { p[h_][r_] = __builtin_amdgcn_exp2f(p[h_][r_]); sum_ += p[h_][r_]; } \
            lrun += sum_; \
            u32x4 pw_[2 * NP]; \
            _Pragma("unroll") for (int h_ = 0; h_ < NP; ++h_) _Pragma("unroll") for (int e_ = 0; e_ < 4; ++e_) { pw_[2 * h_][e_] = pg8::cvt_pk_bf16(p[h_][2 * e_], p[h_][2 * e_ + 1]); pw_[2 * h_ + 1][e_] = pg8::cvt_pk_bf16(p[h_][8 + 2 * e_], p[h_][9 + 2 * e_]); } \
            _Pragma("unroll") for (int db_ = 0; db_ < D / 32; ++db_) _Pragma("unroll") for (int ks_ = 0; ks_ < 2 * NP; ++ks_) { \
                const LAS bf16_t* vp_ = Vt_ + (db_ * 32 + r32) * VS + ks_ * 16 + hi * 4; \
                const u32x2 va_ = *(const LAS u32x2*)vp_, vb_ = *(const LAS u32x2*)(vp_ + 8); const u32x4 vv_ = {va_.x, va_.y, vb_.x, vb_.y}; \
                o[db_] = __builtin_amdgcn_mfma_f32_32x32x16_bf16(__builtin_bit_cast(bf16x8, vv_), __builtin_bit_cast(bf16x8, pw_[ks_]), o[db_], 0, 0, 0); } \
        } } while (0)
    if (KG == 1) {
        ATT_LOAD(0, 0); ATT_STORE(T, 0); if (ntiles > 1) ATT_LOAD(1, 1); if (ntiles > 2) ATT_LOAD(2, 0);
        __syncthreads();
        for (int j = 0; j < ntiles; j += 2) {
            if (j + 1 < ntiles) ATT_STORE(T + TILEB, 1);
            if (j + 3 < ntiles) ATT_LOAD(j + 3, 1);
            ATT_COMPUTE(j, T);
            __syncthreads();
            if (j + 1 < ntiles) {
                if (j + 2 < ntiles) ATT_STORE(T, 0);
                if (j + 4 < ntiles) ATT_LOAD(j + 4, 0);
                ATT_COMPUTE(j + 1, T + TILEB);
                __syncthreads();
            }
        }
    } else {
        const int nsteps = (ntiles + KG - 1) / KG;
        if (PF) {
#pragma unroll
            for (int g = 0; g < NG; ++g) { if (g < ntiles) ATT_LOAD(g, g); }
        }
        for (int s = 0; s < nsteps; ++s) {
            __syncthreads();
            if (PF) {
#pragma unroll
                for (int g = 0; g < NG; ++g) { if (s * KG + g < ntiles) ATT_STORE(T + g * TILEB, g); }
            } else {
#pragma unroll
                for (int g = 0; g < KG; ++g) { const int jt = s * KG + g; if (jt < ntiles) { ATT_LOAD(jt, 0); ATT_STORE(T + g * TILEB, 0); } }
            }
            __syncthreads();
            if (PF && s + 1 < nsteps) {
#pragma unroll
                for (int g = 0; g < NG; ++g) { const int jt = (s + 1) * KG + g; if (jt < ntiles) ATT_LOAD(jt, g); }
            }
            const int jm = s * KG + kg;
            if (jm < ntiles) ATT_COMPUTE(jm, T + kg * TILEB);
        }
        LAS float* Mg = (LAS float*)T;
#pragma unroll
        for (int db = 0; db < D / 32; ++db) {
            __syncthreads();
#pragma unroll
            for (int r = 0; r < 16; ++r) Mg[(wid * 17 + r) * 64 + lane] = o[db][r];
            if (db == 0) Mg[(wid * 17 + 16) * 64 + lane] = lrun;
            __syncthreads();
            if (kg == 0) {
#pragma unroll
                for (int g = 1; g < KG; ++g) {
#pragma unroll
                    for (int r = 0; r < 16; ++r) o[db][r] += Mg[((g * QW + qw) * 17 + r) * 64 + lane];
                    if (db == 0) lrun += Mg[((g * QW + qw) * 17 + 16) * 64 + lane];
                }
            }
        }
        __syncthreads();
    }
#undef ATT_LOAD
#undef ATT_STORE
#undef ATT_COMPUTE
    if (kg == 0 && wact) {
        const float lt = lrun + __shfl_xor(lrun, 32), inv = 1.0f / lt;
        bf16_t* orow = O + (size_t)(qw * 32 + r32) * ldo;
#pragma unroll
        for (int db = 0; db < D / 32; ++db)
#pragma unroll
            for (int i = 0; i < 4; ++i) { u32x2 w; w.x = pg8::cvt_pk_bf16(o[db][4 * i] * inv, o[db][4 * i + 1] * inv); w.y = pg8::cvt_pk_bf16(o[db][4 * i + 2] * inv, o[db][4 * i + 3] * inv);
                *(u32x2*)(orow + db * 32 + 8 * i + 4 * hi) = w; }
    }
}

template <int J0, int J1>
__device__ __forceinline__ void pool_acc(float (&s)[8], const char* __restrict__ ubase, unsigned off0, int nprev) {
#pragma unroll
    for (int j = J0; j < J1; ++j) {
        const bool ok = j <= nprev; const unsigned jo = ok ? (unsigned)j * 1024u : 0u; const float wt = ok ? 1.f : 0.f;
        const u32x4 v = *(const u32x4*)(ubase + (off0 - jo));
        s[0] += wt * bf_lo(v.x); s[1] += wt * bf_hi(v.x); s[2] += wt * bf_lo(v.y); s[3] += wt * bf_hi(v.y); s[4] += wt * bf_lo(v.z); s[5] += wt * bf_hi(v.z); s[6] += wt * bf_lo(v.w); s[7] += wt * bf_hi(v.w);
    }
}
template <int G>
__device__ __forceinline__ void pool_group(const char* __restrict__ ubase, unsigned rowoff, int nprev, float icnt, const bf16_t* __restrict__ wpt, bf16_t* __restrict__ orow, int r32, int hi) {
    constexpr int w = 2 << G;
    bf16x8 dfr[8];
#pragma unroll
    for (int ks = 0; ks < 8; ++ks) {
        const int c0 = G * 128 + ks * 16 + hi * 8;
        const unsigned off0 = rowoff + (unsigned)c0 * 2u;
        const u32x4 cu = *(const u32x4*)(ubase + off0);
        float s[8], cur[8];
        cur[0] = bf_lo(cu.x); cur[1] = bf_hi(cu.x); cur[2] = bf_lo(cu.y); cur[3] = bf_hi(cu.y); cur[4] = bf_lo(cu.z); cur[5] = bf_hi(cu.z); cur[6] = bf_lo(cu.w); cur[7] = bf_hi(cu.w);
#pragma unroll
        for (int e = 0; e < 8; ++e) s[e] = cur[e];
        pool_acc<1, (w < 8 ? w : 8)>(s, ubase, off0, nprev);
        if (w > 8) { __builtin_amdgcn_sched_barrier(0); pool_acc<8, w>(s, ubase, off0, nprev); }
        u32x4 dv;
        dv.x = cvt_pk_bf16(s[0] * icnt - cur[0], s[1] * icnt - cur[1]); dv.y = cvt_pk_bf16(s[2] * icnt - cur[2], s[3] * icnt - cur[3]);
        dv.z = cvt_pk_bf16(s[4] * icnt - cur[4], s[5] * icnt - cur[5]); dv.w = cvt_pk_bf16(s[6] * icnt - cur[6], s[7] * icnt - cur[7]);
        dfr[ks] = __builtin_bit_cast(bf16x8, dv);
        if (((ks + 1) % (G == 0 ? 4 : G == 1 ? 2 : 1)) == 0) __builtin_amdgcn_sched_barrier(0);
    }
#pragma unroll
    for (int nb = 0; nb < 4; ++nb) {
        f32x16 acc;
#pragma unroll
        for (int r = 0; r < 16; ++r) acc[r] = 0.f;
        const bf16_t* wrow = wpt + ((size_t)G * 128 + nb * 32 + r32) * 128 + hi * 8;
#pragma unroll
        for (int ks = 0; ks < 8; ++ks) acc = __builtin_amdgcn_mfma_f32_32x32x16_bf16(*(const bf16x8*)(wrow + ks * 16), dfr[ks], acc, 0, 0, 0);
#pragma unroll
        for (int i = 0; i < 4; ++i) { u32x2 wv; wv.x = cvt_pk_bf16(acc[4 * i], acc[4 * i + 1]); wv.y = cvt_pk_bf16(acc[4 * i + 2], acc[4 * i + 3]);
            *(u32x2*)(orow + G * 128 + nb * 32 + 8 * i + 4 * hi) = wv; }
    }
}
__device__ __forceinline__ void pool_unit(int tile, const bf16_t* __restrict__ ub, const bf16_t* __restrict__ usx, const bf16_t* __restrict__ wpt, bf16_t* __restrict__ mix) {
    const int tid = threadIdx.x, lane = tid & 63, wid = tid >> 6, r32 = lane & 31, hi = lane >> 5;
    const int row = tile * 256 + wid * 32 + r32;
    const bool samp = row >= MP;
    const int b = samp ? (row - MP) >> 6 : row >> 11, t = samp ? (row - MP) & 63 : row & (SEQ - 1);
    const char* ubase = (const char*)(tile >= 256 ? usx : ub);
    const unsigned rowoff = (samp ? (unsigned)(b * 79 + 15 + t) : (unsigned)row) * 1024u;
    const int nprev = samp ? t + 15 : t;
    bf16_t* orow = mix + (size_t)row * DM;
    const int np1 = samp ? 16 : t + 1;
    pool_group<0>(ubase, rowoff, nprev, 1.0f / (float)(np1 < 2 ? np1 : 2), wpt, orow, r32, hi);
    pool_group<1>(ubase, rowoff, nprev, 1.0f / (float)(np1 < 4 ? np1 : 4), wpt, orow, r32, hi);
    pool_group<2>(ubase, rowoff, nprev, 1.0f / (float)(np1 < 8 ? np1 : 8), wpt, orow, r32, hi);
    pool_group<3>(ubase, rowoff, nprev, 1.0f / (float)(np1 < 16 ? np1 : 16), wpt, orow, r32, hi);
}

template <int MODE>
__device__ __forceinline__ void transpose_item(const float* __restrict__ W, int K, int N, int nblk, bf16_t* __restrict__ WT, int row_off, const float* __restrict__ g, LAS float* scr, int item, int lane) {
    const int kb = item / nblk, nb = item % nblk, k0 = 64 * kb, n0 = 32 * nb;
#pragma unroll 8
    for (int i = 0; i < 32; ++i) { const int kk = 2 * i + (lane >> 5); float v = W[(size_t)(k0 + kk) * N + n0 + (lane & 31)]; if (g) v *= g[k0 + kk]; scr[kk * 33 + (lane & 31)] = v; }
    LDS_WAIT();
    const int c = lane & 7;
#pragma unroll
    for (int j = 0; j < 4; ++j) {
        const int n = (lane >> 3) + 8 * j; const LAS float* s = scr + (8 * c) * 33 + n;
        const int nn = n0 + n; int drow;
        if (MODE == 0) drow = row_off + nn; else { const int half = nn / DFF, cc = nn % DFF; drow = (cc >> 7) * 256 + half * 128 + (cc & 127); }
        u32x4 o; o.x = cvt_pk_bf16(s[0 * 33], s[1 * 33]); o.y = cvt_pk_bf16(s[2 * 33], s[3 * 33]); o.z = cvt_pk_bf16(s[4 * 33], s[5 * 33]); o.w = cvt_pk_bf16(s[6 * 33], s[7 * 33]);
        *(u32x4*)(WT + (size_t)drow * K + k0 + 8 * c) = o;
    }
    LDS_WAIT();
}
__device__ __forceinline__ void prepass_row(const float* __restrict__ xrow, bf16_t* __restrict__ orow, const LAS float* wf, const float* __restrict__ b_f, float* __restrict__ lf_out, int lane) {
    const f32x4* xr = (const f32x4*)xrow + lane;
    f32x4 v[4]; float s = 0.f;
#pragma unroll
    for (int j = 0; j < 4; ++j) { v[j] = xr[64 * j]; s += (v[j][0] * v[j][0] + v[j][1] * v[j][1]) + (v[j][2] * v[j][2] + v[j][3] * v[j][3]); }
    const float r = rsq(wave_sum(s));
    u32x2* o8 = (u32x2*)orow + lane;
#pragma unroll
    for (int j = 0; j < 4; ++j) { v[j] = v[j] * r; u32x2 w; w.x = cvt_pk_bf16(v[j][0], v[j][1]); w.y = cvt_pk_bf16(v[j][2], v[j][3]); o8[64 * j] = w; }
    if (wf) {
        f32x4 fa = {0.f, 0.f, 0.f, 0.f}, fb = {0.f, 0.f, 0.f, 0.f};
#pragma unroll
        for (int j = 0; j < 4; ++j)
#pragma unroll
            for (int e = 0; e < 4; ++e) { const int k = 4 * (lane + 64 * j) + e; const LAS f32x4* w = (const LAS f32x4*)(wf + k * 8); fa += w[0] * v[j][e]; fb += w[1] * v[j][e]; }
#pragma unroll
        for (int e = 0; e < 4; ++e) { fa[e] = wave_sum(fa[e]); fb[e] = wave_sum(fb[e]); }
        float z = fa[0];
        z = (lane == 1) ? fa[1] : z; z = (lane == 2) ? fa[2] : z; z = (lane == 3) ? fa[3] : z; z = (lane == 4) ? fb[0] : z; z = (lane == 5) ? fb[1] : z; z = (lane == 6) ? fb[2] : z; z = (lane == 7) ? fb[3] : z;
        if (lane < 8) { z += b_f[lane]; lf_out[lane] = fminf(z, 0.f) - log1pf(expf(-fabsf(z))); }
    }
}
__device__ __forceinline__ void scan_seq(const float* s0, int n0, const float* s1, int n1, float* dst, int lane) {
    const int n = n0 + n1, Lc = n >> 6;
    float s = 0.f;
    for (int i = 0; i < Lc; ++i) { const int t = lane * Lc + i; const float* ptr = (t < n0) ? (s0 + (size_t)t * 8) : (s1 + (size_t)(t - n0) * 8); s += *ptr; }
    float inc = s;
    for (int o = 1; o < 64; o <<= 1) { const float v = __shfl_up(inc, o); if (lane >= o) inc += v; }
    float run = inc - s;
    for (int i = 0; i < Lc; ++i) { const int t = lane * Lc + i; const float* ptr = (t < n0) ? (s0 + (size_t)t * 8) : (s1 + (size_t)(t - n0) * 8); run += *ptr; dst[t] = -run * LOG2E; }
}
__device__ __forceinline__ void cvt_flat(const float* __restrict__ src, bf16_t* __restrict__ dst, size_t n8, size_t gtid, size_t gn) {
    for (size_t i = gtid; i < n8; i += gn) { const f32x4 a = *(const f32x4*)(src + i * 8), b = *(const f32x4*)(src + i * 8 + 4); *(u32x4*)(dst + i * 8) = pack8(a, b); }
}

#define Wt_in ((bf16_t*)(ws + WS_WIN))
#define Wt_o ((bf16_t*)(ws + WS_WO))
#define Wt_mq ((bf16_t*)(ws + WS_WMQ))
#define Wt_mo ((bf16_t*)(ws + WS_WMO))
#define Wt_mkv ((bf16_t*)(ws + WS_WMKV))
#define Wt_up ((bf16_t*)(ws + WS_WUP))
#define Wt_dn ((bf16_t*)(ws + WS_WDN))
#define Wt_pool ((bf16_t*)(ws + WS_WPOOL))
#define usx ((bf16_t*)(ws + WS_USX))
#define mkb ((bf16_t*)(ws + WS_MKB))
#define mvb ((bf16_t*)(ws + WS_MVB))
#define ssq1 ((float*)(ws + WS_SSQ1))
#define ssq2 ((float*)(ws + WS_SSQ2))
#define ssq3 ((float*)(ws + WS_SSQ3))
#define kbP ((float*)(ws + WS_KBP))
#define kbS ((float*)(ws + WS_KBS))
#define ahead ((float*)(ws + WS_AHEAD))
#define atail ((float*)(ws + WS_ATAIL))
#define bhead ((float*)(ws + WS_BHEAD))
#define x1b ((bf16_t*)(ws + WS_X1B))
#define kcb ((bf16_t*)(ws + WS_KCB))
#define vcb ((bf16_t*)(ws + WS_VCB))
#define x2b ((bf16_t*)(ws + WS_X2B))
#define xb ((bf16_t*)(ws + WS_XB))
#define mqb ((bf16_t*)(ws + WS_MQB))
#define hff ((bf16_t*)(ws + WS_HFF))
#define uqkv ((bf16_t*)(ws + WS_UQKV))
#define mo ((bf16_t*)(ws + WS_MO))
#define mix ((bf16_t*)(ws + WS_MIX))
#define memb ((bf16_t*)(ws + WS_MEMB))
#define ub uqkv
#define qb (uqkv + (size_t)MT * 512)
#define kb (uqkv + (size_t)2 * MT * 512)
#define vb (uqkv + (size_t)3 * MT * 512)
__global__ void __launch_bounds__(512, 2) fwd_kernel(Params p) {
    extern __shared__ __attribute__((aligned(16))) unsigned char lds_raw[];
    LAS unsigned char* L = (LAS unsigned char*)lds_raw;
    cg::grid_group grid = cg::this_grid();
    const int tid = threadIdx.x, lane = tid & 63, wave = __builtin_amdgcn_readfirstlane(tid >> 6);
    const int G = gridDim.x, bx = blockIdx.x;
    unsigned char* ws = p.ws; float* out = p.out;
    const float* x_prompt = p.in[0]; const float* x_sample = p.in[1];
    const int lo = p.ph_lo, hi_ph = p.ph_hi;
    unsigned* gbar = (unsigned*)ws; unsigned nbar = 0u;
    if (lo < 0) grid.sync();
#define IN(k) (lo <= (k) && (k) < hi_ph && ((PHMASK >> (k)) & 1))
#define GSYNC() do { asm volatile("s_waitcnt vmcnt(0)" ::: "memory"); __syncthreads(); \
        if (tid == 0) { __builtin_amdgcn_fence(__ATOMIC_RELEASE, "agent"); asm volatile("s_waitcnt vmcnt(0)" ::: "memory"); \
            nbar += (unsigned)G; __hip_atomic_fetch_add(gbar, 1u, __ATOMIC_RELAXED, __HIP_MEMORY_SCOPE_AGENT); \
            while (__hip_atomic_load(gbar, __ATOMIC_RELAXED, __HIP_MEMORY_SCOPE_AGENT) < nbar) __builtin_amdgcn_s_sleep(1); \
            __builtin_amdgcn_fence(__ATOMIC_ACQUIRE, "agent"); asm volatile("s_waitcnt vmcnt(0)" ::: "memory"); } \
        __syncthreads(); } while (0)
#define SEAM(k) do { if (IN(k) && IN((k) + 1)) GSYNC(); } while (0)

    if (IN(0)) {
        const int gw = bx * 8 + wave, NGW = G * 8;
        LAS float* scr = (LAS float*)(L + wave * 8448);
        LAS float* wf = (LAS float*)(L + 8 * 8448);
        {
            const float* w_in = p.in[11]; const float* g_mix = p.in[10];
            for (int i = tid; i < 8192; i += 512) { const int k = i >> 3, h = i & 7; wf[i] = w_in[(size_t)k * 2056 + 2048 + h] * g_mix[k]; }
        }
        __syncthreads();
        constexpr int I_IN = 16 * 64, I_SQ = 16 * 32, I_UP = 16 * 176, I_DN = 44 * 32;
        constexpr int NITEMS = I_IN + 5 * I_SQ + I_UP + I_DN;
        for (int it = gw; it < NITEMS; it += NGW) {
            int r = it;
            if (r < I_IN) { transpose_item<0>(p.in[11], 1024, 2056, 64, Wt_in, 0, p.in[10], scr, r, lane); continue; } r -= I_IN;
            if (r < I_SQ) { transpose_item<0>(p.in[15], 1024, 1024, 32, Wt_o, 0, nullptr, scr, r, lane); continue; } r -= I_SQ;
            if (r < I_SQ) { transpose_item<0>(p.in[18], 1024, 1024, 32, Wt_mq, 0, p.in[16], scr, r, lane); continue; } r -= I_SQ;
            if (r < I_SQ) { transpose_item<0>(p.in[19], 1024, 1024, 32, Wt_mkv, 0, p.in[17], scr, r, lane); continue; } r -= I_SQ;
            if (r < I_SQ) { transpose_item<0>(p.in[20], 1024, 1024, 32, Wt_mkv, 1024, p.in[17], scr, r, lane); continue; } r -= I_SQ;
            if (r < I_SQ) { transpose_item<0>(p.in[21], 1024, 1024, 32, Wt_mo, 0, nullptr, scr, r, lane); continue; } r -= I_SQ;
            if (r < I_UP) { transpose_item<1>(p.in[23], 1024, NUP, 176, Wt_up, 0, p.in[22], scr, r, lane); continue; } r -= I_UP;
            transpose_item<0>(p.in[26], DFF, 1024, 32, Wt_dn, 0, nullptr, scr, r, lane);
        }
        {
            const float* w_pool = p.in[13]; const float* pscale = p.in[14];
            for (int i = bx * 512 + tid; i < 4 * 128 * 128; i += G * 512) { const int g = i >> 14, d = (i >> 7) & 127, c = i & 127; Wt_pool[i] = (bf16_t)(cvt_pk_bf16(w_pool[(g * 128 + c) * 128 + d] * pscale[g * 128 + d], 0.f) & 0xffffu); }
        }
        for (int m = gw; m < MT; m += NGW) {
            const float* xr = (m < MP) ? x_prompt + (size_t)m * DM : x_sample + (size_t)(m - MP) * DM;
            float* lf = (m < MP) ? out + O_LFP + (size_t)m * 8 : out + O_LFS + (size_t)(m - MP) * 8;
            prepass_row(xr, xb + (size_t)m * DM, wf, p.in[12], lf, lane);
        }
        for (int m = gw; m < 8192; m += NGW) prepass_row(p.in[9] + (size_t)m * DM, memb + (size_t)m * DM, (const LAS float*)nullptr, nullptr, nullptr, lane);
        const size_t gtid = (size_t)bx * 512 + tid, gn = (size_t)G * 512;
        for (size_t i = gtid; i < (size_t)16 * 15 * 512 / 8; i += gn) { const size_t e8 = i * 8, bb = e8 / (15 * 512), rem = e8 - bb * 15 * 512; const float* sp = p.in[5] + e8; *(u32x4*)(usx + bb * 79 * 512 + rem) = pack8(*(const f32x4*)sp, *(const f32x4*)(sp + 4)); }
        cvt_flat(p.in[2], kcb, (size_t)16 * PAST * 512 / 8, gtid, gn);
        cvt_flat(p.in[3], vcb, (size_t)16 * PAST * 512 / 8, gtid, gn);
        cvt_flat(p.in[7], mkb + (size_t)8192 * 1024, (size_t)4096 * 1024 / 8, gtid, gn);
        cvt_flat(p.in[8], mvb + (size_t)8192 * 1024, (size_t)4096 * 1024 / 8, gtid, gn);
        __syncthreads();
    }
    SEAM(0);

    if (IN(1)) {
        if (wave == 0) { const int s = bx; if (s < 256) scan_seq(out + O_LFP + (size_t)(s >> 3) * SEQ * 8 + (s & 7), SEQ, out + O_LFP, 0, kbP + (size_t)s * SEQ, lane); }
        if (wave == 1 && bx < 128) { const int s = bx; scan_seq(p.in[4] + (size_t)(s >> 3) * PAST * 8 + (s & 7), PAST, out + O_LFS + (size_t)(s >> 3) * DSEQ * 8 + (s & 7), DSEQ, kbS + (size_t)s * (PAST + DSEQ), lane); }
        {
            pg8::Gemm g{xb, Wt_in, MT, 2048, 1024}; pg8::StaticOrder S; S.init(MT, 2048, G, bx);
            EpiIn E{uqkv, out, usx};
            pg8::gemm_phase<EpiIn, pg8::StaticOrder, true, true>(L, g, S, E);
        }
        __syncthreads();
        {
            pg8::Gemm g{memb, Wt_mkv, 8192, 2048, 1024}; pg8::StaticOrder S; S.init(8192, 2048, G, bx);
            EpiMkv E{mkb, mvb, out};
            pg8::gemm_phase<EpiMkv, pg8::StaticOrder, true, true>(L, g, S, E);
        }
    }
    SEAM(1);

    if (IN(2)) {
        for (int it = 0; it < 8 * ((256 + G - 1) / G); ++it) {
            int bh, qk;
            if (G == 256) { const int xcd = bx & 7, l = bx >> 3, r = it >> 1, pi = l & 3; bh = xcd * 32 + r * 8 + (l >> 2); qk = (it & 1) ? pi : 7 - pi; }
            else { bh = bx + (it >> 3) * G; qk = 7 - (it & 7); if (bh >= 256) break; }
            const int b = bh >> 3, h = bh & 7;
            const bf16_t* Kh = kb + (size_t)b * SEQ * 512 + h * 64; const bf16_t* Vh = vb + (size_t)b * SEQ * 512 + h * 64;
            const size_t r0 = (size_t)b * SEQ + 256 * qk;
            attn_unit<64, 64, 1, true, false, true, true>(L, qb + r0 * 512 + h * 64, 512, 256, Kh, Vh, 4 * qk + 4, Kh, Vh, 512, 4 * qk + 4, kbP + (size_t)bh * SEQ, 256 * qk, mix + r0 * DM + 512 + h * 64, DM);
        }
        if (P2_ATTN_S) for (int bh = bx; bh < 128; bh += G) {
            const int b = bh >> 3, h = bh & 7;
            const size_t r0 = (size_t)MP + b * DSEQ;
            attn_unit<64, 64, 4, true, false, true, true>(L, qb + r0 * 512 + h * 64, 512, 64, kcb + (size_t)b * PAST * 512 + h * 64, vcb + (size_t)b * PAST * 512 + h * 64, 64,
                                      kb + r0 * 512 + h * 64, vb + r0 * 512 + h * 64, 512, 65, kbS + (size_t)bh * (PAST + DSEQ), PAST, mix + r0 * DM + 512 + h * 64, DM);
        }
        for (int t = bx; t < MT / 256; t += G) pool_unit(t, ub, usx, Wt_pool, mix);
        if (G == 256 && bx >= 128 && bx < 132) {}
        __syncthreads();
    }
    SEAM(2);

    if (IN(3)) {
        pg8::Gemm g{mix, Wt_o, MT, 1024, 1024}; pg8::StaticOrder S; S.init(MT, 1024, G, bx);
        EpiRes<0> E{x_prompt, x_sample, nullptr, x1b, nullptr, ssq1};
        pg8::gemm_phase<EpiRes<0>, pg8::StaticOrder, true, true>(L, g, S, E);
    }
    SEAM(3);

    if (IN(4)) {
        pg8::Gemm g{x1b, Wt_mq, MT, 1024, 1024}; pg8::StaticOrder S; S.init(MT, 1024, G, bx);
        EpiMq E{ssq1, mqb};
        pg8::gemm_phase<EpiMq, pg8::StaticOrder, true, true>(L, g, S, E);
    }
    SEAM(4);

    if (IN(5)) {
        for (int k5 = 0; k5 * G < 2048 + 64; ++k5) {
            const int un = (G == 256 && k5 < 8) ? (((k5 * 8 + (bx & 7)) * 32) + (bx >> 3)) : (k5 * G + bx);
            if (un >= 2048 + 64) break;
            if (un < 2048) {
                const int b = un >> 6, h = (un >> 4) & 3, qk = un & 15;
                const size_t r0 = (size_t)b * SEQ + 128 * qk;
                const bf16_t* Kh = mkb + (size_t)b * NMEM * 1024 + h * 256; const bf16_t* Vh = mvb + (size_t)b * NMEM * 1024 + h * 256;
                attn_unit<256, 32, 2, false, true, false, false>(L, mqb + r0 * DM + h * 256, DM, 128, Kh, Vh, 8, Kh, Vh, 1024, 8, nullptr, 0, mo + r0 * DM + h * 256, DM);
            } else {
                const int us = un - 2048, b = us >> 2, h = us & 3;
                const size_t r0 = (size_t)MP + b * DSEQ;
                const bf16_t* Kh = mkb + (size_t)(8192 + b * NMEM) * 1024 + h * 256; const bf16_t* Vh = mvb + (size_t)(8192 + b * NMEM) * 1024 + h * 256;
                attn_unit<256, 32, 2, false, true, false, false>(L, mqb + r0 * DM + h * 256, DM, 64, Kh, Vh, 8, Kh, Vh, 1024, 8, nullptr, 0, mo + r0 * DM + h * 256, DM);
            }
        }
        __syncthreads();
    }
    SEAM(5);

    if (IN(6)) {
        pg8::Gemm g{mo, Wt_mo, MT, 1024, 1024}; pg8::StaticOrder S; S.init(MT, 1024, G, bx);
        EpiRes<1> E{nullptr, nullptr, x1b, x2b, nullptr, ssq2};
        pg8::gemm_phase<EpiRes<1>, pg8::StaticOrder, true, true>(L, g, S, E);
    }
    SEAM(6);

    if (IN(7)) {
        pg8::Gemm g{x2b, Wt_up, MT, NUP, 1024}; pg8::StaticOrder S; S.init(MT, NUP, G, bx);
        EpiUp E{ssq2, p.in[24], p.in[25], hff, ahead, atail, bhead};
        pg8::gemm_phase<EpiUp, pg8::StaticOrder, true, true>(L, g, S, E);
    }
    SEAM(7);

    if (IN(8)) {
        const float* cw = p.in[24]; const float* cbias = p.in[25]; const float* chist = p.in[6];
        const int total4 = NSEG * 2 * (DFF / 4);
        for (int idx = bx * 512 + tid; idx < total4; idx += G * 512) {
            const int seg = idx / (2 * (DFF / 4)), rem = idx - seg * 2 * (DFF / 4), i = rem / (DFF / 4), c = (rem - i * (DFF / 4)) * 4;
            f32x4 prev1, prev2;
            if (seg < MP / 64) { if ((seg & 31) == 0) { prev1 = (f32x4){0.f, 0.f, 0.f, 0.f}; prev2 = prev1; } else { prev1 = *(const f32x4*)(atail + ((size_t)(seg - 1) * 2 + 1) * DFF + c); prev2 = *(const f32x4*)(atail + ((size_t)(seg - 1) * 2) * DFF + c); } }
            else { const int b = seg - MP / 64; prev1 = *(const f32x4*)(chist + ((size_t)b * 2 + 1) * DFF + c); prev2 = *(const f32x4*)(chist + ((size_t)b * 2) * DFF + c); }
            const f32x4 a_0 = *(const f32x4*)(ahead + ((size_t)seg * 2) * DFF + c);
            f32x4 am1, am2, a0;
            if (i == 0) { am1 = prev1; am2 = prev2; a0 = a_0; } else { am1 = a_0; am2 = prev1; a0 = *(const f32x4*)(ahead + ((size_t)seg * 2 + 1) * DFF + c); }
            const f32x4 cv = *(const f32x4*)(cbias + c) + *(const f32x4*)(cw + c) * am2 + *(const f32x4*)(cw + DFF + c) * am1 + *(const f32x4*)(cw + 2 * DFF + c) * a0;
            const f32x4 bh = *(const f32x4*)(bhead + ((size_t)seg * 2 + i) * DFF + c);
            f32x4 hv;
#pragma unroll
            for (int e = 0; e < 4; ++e) hv[e] = cv[e] / (1.0f + __builtin_amdgcn_exp2f(-cv[e] * LOG2E)) * bh[e];
            u32x2 w; w.x = cvt_pk_bf16(hv[0], hv[1]); w.y = cvt_pk_bf16(hv[2], hv[3]);
            *(u32x2*)(hff + ((size_t)seg * 64 + i) * DFF + c) = w;
        }
        for (int idx = bx * 512 + tid; idx < 48 * 2 * DFF; idx += G * 512) {
            const int bb = idx / (2 * DFF), rem = idx - bb * 2 * DFF;
            if (bb < 32) out[O_CSP + (size_t)bb * 2 * DFF + rem] = atail[((size_t)(32 * bb + 31) * 2) * DFF + rem];
            else out[O_CSS + (size_t)(bb - 32) * 2 * DFF + rem] = atail[((size_t)(MP / 64 + bb - 32) * 2) * DFF + rem];
        }
    }
    SEAM(8);

    if (IN(9)) {
        pg8::Gemm g{hff, Wt_dn, MT, 1024, DFF}; pg8::StaticOrder S; S.init(MT, 1024, G, bx);
        EpiRes<2> E{nullptr, nullptr, x2b, nullptr, out, ssq3};
        pg8::gemm_phase<EpiRes<2>, pg8::StaticOrder, true, true>(L, g, S, E);
    }
    SEAM(9);

    if (IN(10)) {
        const float* gf = p.in[27];
        const int gw = bx * 8 + wave, NGW = G * 8;
        f32x4 gv[4];
#pragma unroll
        for (int j = 0; j < 4; ++j) gv[j] = ((const f32x4*)gf)[lane + 64 * j];
        for (int m0 = gw; m0 < MT; m0 += 4 * NGW) {
            f32x4 v[4][4]; float r[4];
#pragma unroll
            for (int q = 0; q < 4; ++q) { const int m = m0 + q * NGW; if (m < MT) { const f32x4* y4 = (const f32x4*)(out + (size_t)m * DM) + lane; r[q] = row_rsq(ssq3, m);
#pragma unroll
                    for (int j = 0; j < 4; ++j) v[q][j] = y4[64 * j]; } }
#pragma unroll
            for (int q = 0; q < 4; ++q) { const int m = m0 + q * NGW; if (m < MT) { f32x4* y4 = (f32x4*)(out + (size_t)m * DM) + lane;
#pragma unroll
                    for (int j = 0; j < 4; ++j) y4[64 * j] = v[q][j] * r[q] * gv[j]; } }
        }
    }
#ifdef DBG_DUMP
    {
        GSYNC();
        const bf16_t* src = nullptr; int pitch = 1024;
        if (hi_ph == 2) src = uqkv; else if (hi_ph == 3) src = mix; else if (hi_ph == 4) src = x1b; else if (hi_ph == 5) src = mqb; else if (hi_ph == 6) src = mo; else if (hi_ph == 7) src = x2b; else if (hi_ph == 8 || hi_ph == 9) { src = hff; pitch = DFF; }
        if (src) for (size_t i = (size_t)bx * 512 + tid; i < (size_t)MT * 1024; i += (size_t)G * 512) { const size_t m = i >> 10, c = i & 1023; float v = __builtin_bit_cast(float, (unsigned)src[m * pitch + c] << 16); if (!(v == v)) v = 12345.f; if (fabsf(v) > 1e30f) v = 54321.f; out[i] = v; }
    }
#endif
#undef IN
#undef SEAM
}

extern "C" void kernel_launch(void* const* d_in, const int* in_sizes, int n_in, void* d_out, int out_size, void* d_ws, size_t ws_size, hipStream_t stream) {
    static int grid = 0;
    if (grid == 0) {
        if (n_in != 28 || (size_t)out_size != O_END || ws_size < WS_NEED) { fprintf(stderr, "kernel_launch: unexpected shapes (n_in %d, out %d, ws %zu); nothing launched\n", n_in, out_size, ws_size); grid = -1; return; }
        int dev = 0, cus = 0, per_cu = 0;
        hipGetDevice(&dev); hipDeviceGetAttribute(&cus, hipDeviceAttributeMultiprocessorCount, dev);
        hipFuncSetAttribute((const void*)fwd_kernel, hipFuncAttributeMaxDynamicSharedMemorySize, LDS_BYTES);
        hipOccupancyMaxActiveBlocksPerMultiprocessor(&per_cu, (const void*)fwd_kernel, 512, LDS_BYTES);
        if (per_cu < 1) { fprintf(stderr, "kernel_launch: occupancy query says %d blocks per CU\n", per_cu); per_cu = 1; }
        (void)hipGetLastError();
        grid = cus;
    }
    if (grid < 0) return;
    (void)hipMemsetAsync(d_ws, 0, 256, stream);
    Params p{};
    for (int i = 0; i < 28; ++i) p.in[i] = (const float*)d_in[i];
    p.out = (float*)d_out; p.ws = (unsigned char*)d_ws;
    void* args[] = {&p};
#ifdef PROBE_K
    p.ph_lo = 0; p.ph_hi = PROBE_K + 1;
    (void)hipLaunchCooperativeKernel((const void*)fwd_kernel, dim3(grid), dim3(512), args, LDS_BYTES, stream);
    (void)hipMemsetAsync(d_ws, 0, 256, stream);
    p.ph_lo = PROBE_K; p.ph_hi = 11;
#else
    p.ph_lo = 0; p.ph_hi = 11;
#endif
    hipError_t e = hipLaunchCooperativeKernel((const void*)fwd_kernel, dim3(grid), dim3(512), args, LDS_BYTES, stream);
    if (e != hipSuccess) fprintf(stderr, "cooperative launch failed: %s (grid %d)\n", hipGetErrorString(e), grid);
}
```

```cpp
#include <hip/hip_runtime.h>
#include <hip/hip_cooperative_groups.h>
#include <cstdio>
#include <cstdint>
namespace cg = cooperative_groups;
namespace pg8 {
#define PG8_LAS __attribute__((address_space(3)))
typedef unsigned short bf16_t;
typedef short bf16x8 __attribute__((ext_vector_type(8)));
typedef float f32x4 __attribute__((ext_vector_type(4)));
typedef unsigned u32x4 __attribute__((ext_vector_type(4)));
constexpr int BM = 256, BK = 64, HALF = 128, HTB = HALF * BK * 2  , STAGE_BYTES = 8 * HTB, NXCD = 8, WGM = 8;

__host__ __device__ __forceinline__ int lds_byte(int r, int c) { const int st = (r >> 4) * 2 + (c >> 5), rr = r & 15, cc = c & 31, ob = rr * 64 + cc * 2; return st * 1024 + (ob ^ (((ob >> 9) & 1) << 5)); }
__host__ __device__ __forceinline__ void stage_rc(int b, int& R, int& C) { const int st = b / 1024, sb = b % 1024, swz = sb ^ (((sb >> 9) & 1) << 5); R = (st >> 1) * 16 + swz / 64; C = (st & 1) * 32 + (swz % 64) / 2; }
__host__ __device__ __forceinline__ int perm32(int rho) { const int n = rho >> 4, i = rho & 15; return 8 * (i >> 2) + 4 * n + (i & 3); }

struct Unit { int pm, pn; };
struct Gemm { const bf16_t* A; const bf16_t* Bt; int M, N, K; };

struct StaticOrder {
    int nM, nN, nwg, G, c;
    __host__ __device__ void init(int M, int N, int G_, int c_) { nM = M / BM; nN = N / BM; nwg = nM * nN; G = G_; c = c_; }
    __host__ __device__ bool next(int i, Unit& u) const {
        const long L = (long)i * G + c; if (L >= nwg) return false;
        int wgid = (int)L; { const int q = nwg / NXCD, r = nwg % NXCD, xcd = wgid % NXCD, off = wgid / NXCD; wgid = (xcd < r ? xcd * (q + 1) : r * (q + 1) + (xcd - r) * q) + off; }
        const int nig = WGM * nN, gid = wgid / nig, fm = gid * WGM, gsz = (nM - fm) < WGM ? (nM - fm) : WGM;
        u.pm = fm + ((wgid % nig) % gsz); u.pn = (wgid % nig) / gsz; return true;
    }
    __device__ __forceinline__ void a_ready(const Unit&) const {}
    __device__ __forceinline__ void done(const Unit&) const {}
};

__device__ __forceinline__ unsigned cvt_pk_bf16(float lo, float hi) { unsigned r; asm volatile("v_cvt_pk_bf16_f32 %0, %1, %2" : "=v"(r) : "v"(lo), "v"(hi)); return r; }
typedef float f32x2 __attribute__((ext_vector_type(2)));
template <class Epi, class Sched, bool ALIGN_EPI = false, bool SP2 = false>
__device__ __forceinline__ void gemm_phase(PG8_LAS unsigned char* lds, const Gemm g, const Sched& S, const Epi& E) {
    const int tid = threadIdx.x, wid = __builtin_amdgcn_readfirstlane(tid >> 6), lane = tid & 63, wr = wid >> 2, wc = wid & 3, fr = lane & 15, fq = lane >> 4;
    const int K = g.K, nt = K / BK;
    unsigned voffA[2], voffB[2];
#pragma unroll
    for (int i = 0; i < 2; ++i) { int R, C; stage_rc(tid * 16 + i * 8192, R, C); const int Rb = Epi::PERM ? ((R & ~31) + perm32(R & 31)) : R;
        voffA[i] = (unsigned)(R * K + C) * 2u; voffB[i] = (unsigned)(Rb * K + C) * 2u; }
    const size_t kstep = (size_t)(BK * 2);
    const size_t hstep = (size_t)HALF * K * 2;
    const size_t tstep = 2 * hstep;
    const unsigned ldsw = (unsigned)wid * 1024u;
    const int aoff = lds_byte(wr * 64 + fr, fq * 8), boff = lds_byte(wc * 32 + fr, fq * 8);
#define PG8_SA(b, h) (((b) * 2 + (h)) * HTB)
#define PG8_SB(b, h) ((4 + (b) * 2 + (h)) * HTB)
#define PG8_STAGE(bufoff, gbase, voff) do { _Pragma("unroll") for (int _i = 0; _i < 2; ++_i) \
        __builtin_amdgcn_global_load_lds((const unsigned*)((const char*)(gbase) + (voff)[_i]), (PG8_LAS unsigned*)(lds + (bufoff) + ldsw + _i * 8192), 16, 0, 0); } while (0)
#define PG8_LDA(dst, b, h) do { _Pragma("unroll") for (int m = 0; m < 4; ++m) _Pragma("unroll") for (int k = 0; k < 2; ++k) dst[m][k] = *(const PG8_LAS bf16x8*)(lds + PG8_SA(b, h) + aoff + m * 2048 + k * 1024); } while (0)
#define PG8_LDB(dst, b, h) do { _Pragma("unroll") for (int n = 0; n < 2; ++n) _Pragma("unroll") for (int k = 0; k < 2; ++k) dst[n][k] = *(const PG8_LAS bf16x8*)(lds + PG8_SB(b, h) + boff + n * 2048 + k * 1024); } while (0)
#define PG8_MMA(ai, bj, At, Bt) do { __builtin_amdgcn_s_setprio(1); _Pragma("unroll") for (int m = 0; m < 4; ++m) _Pragma("unroll") for (int n = 0; n < 2; ++n) _Pragma("unroll") for (int k = 0; k < 2; ++k) \
        acc[ai][bj][m][n] = __builtin_amdgcn_mfma_f32_16x16x32_bf16(Bt[n][k], At[m][k], acc[ai][bj][m][n], 0, 0, 0); __builtin_amdgcn_s_setprio(0); } while (0)
#define PG8_WAIT_V(n) asm volatile("s_waitcnt vmcnt(" #n ")" ::: "memory")
#define PG8_WAIT_L(n) asm volatile("s_waitcnt lgkmcnt(" #n ")" ::: "memory")
#define PG8_BAR __builtin_amdgcn_s_barrier()
#define PG8_SCHED __builtin_amdgcn_sched_barrier(0)
    Unit cur, nxt; int ui = 0;
    if (!S.next(0, cur)) return;
    f32x4 acc[2][2][4][2];
#pragma unroll
    for (int a = 0; a < 2; ++a)
#pragma unroll
        for (int b = 0; b < 2; ++b)
#pragma unroll
            for (int m = 0; m < 4; ++m)
#pragma unroll
                for (int n = 0; n < 2; ++n) acc[a][b][m][n] = (f32x4){0.f, 0.f, 0.f, 0.f};
    bf16x8 At[4][2], B0[2][2], B1[2][2];
    const char* cA = (const char*)g.A + (size_t)cur.pm * tstep; const char* cB = (const char*)g.Bt + (size_t)cur.pn * tstep;
    S.a_ready(cur);
    if constexpr (SP2) {
        PG8_STAGE(PG8_SB(0, 0), cB, voffB); PG8_STAGE(PG8_SB(0, 1), cB + hstep, voffB); PG8_STAGE(PG8_SA(0, 0), cA, voffA); PG8_STAGE(PG8_SA(0, 1), cA + hstep, voffA);
        if (wr == 1) PG8_BAR;
        PG8_WAIT_V(2); PG8_BAR;
        PG8_STAGE(PG8_SB(1, 0), cB + kstep, voffB); PG8_STAGE(PG8_SA(1, 0), cA + kstep, voffA); PG8_STAGE(PG8_SB(1, 1), cB + hstep + kstep, voffB);
        PG8_WAIT_V(6); PG8_BAR;
    } else {
        PG8_STAGE(PG8_SB(0, 0), cB, voffB); PG8_STAGE(PG8_SA(0, 0), cA, voffA); PG8_STAGE(PG8_SB(0, 1), cB + hstep, voffB); PG8_STAGE(PG8_SA(0, 1), cA + hstep, voffA);
        if (wr == 1) PG8_BAR;
        PG8_WAIT_V(4); PG8_BAR;
        PG8_STAGE(PG8_SB(1, 0), cB + kstep, voffB); PG8_STAGE(PG8_SA(1, 0), cA + kstep, voffA); PG8_STAGE(PG8_SB(1, 1), cB + hstep + kstep, voffB);
        PG8_WAIT_V(6); PG8_BAR;
    }
    for (;;) {
        const bool has_next = S.next(ui + 1, nxt);
        const char* nA = has_next ? (const char*)g.A + (size_t)nxt.pm * tstep : cA; const char* nB = has_next ? (const char*)g.Bt + (size_t)nxt.pn * tstep : cB;
        for (int t = 0; t < nt; t += 2) {
            const bool last = (t == nt - 2);
            const char* a1 = cA + (size_t)(t + 1) * kstep;
            const char* a2 = last ? nA : cA + (size_t)(t + 2) * kstep; const char* b2 = last ? nB : cB + (size_t)(t + 2) * kstep;
            const char* a3 = a2 + kstep; const char* b3 = b2 + kstep;
            if (last && has_next) S.a_ready(nxt);
            if constexpr (SP2) {
            PG8_LDB(B0, 0, 0); PG8_LDB(B1, 0, 1); PG8_SCHED; PG8_LDA(At, 0, 0); PG8_STAGE(PG8_SA(1, 1), a1 + hstep, voffA);
            PG8_WAIT_V(8); PG8_WAIT_L(0); PG8_BAR; PG8_MMA(0, 0, At, B0); PG8_MMA(0, 1, At, B1); PG8_BAR; PG8_SCHED;
            PG8_LDA(At, 0, 1); PG8_STAGE(PG8_SB(0, 0), b2, voffB); PG8_STAGE(PG8_SB(0, 1), b2 + hstep, voffB); PG8_STAGE(PG8_SA(0, 0), a2, voffA);
            PG8_WAIT_V(8); PG8_WAIT_L(0); PG8_BAR; PG8_MMA(1, 0, At, B0); PG8_MMA(1, 1, At, B1); PG8_BAR; PG8_SCHED;
            PG8_LDB(B0, 1, 0); PG8_LDB(B1, 1, 1); PG8_SCHED; PG8_LDA(At, 1, 0); PG8_STAGE(PG8_SA(0, 1), a2 + hstep, voffA);
            PG8_WAIT_V(8); PG8_WAIT_L(0); PG8_BAR; PG8_MMA(0, 0, At, B0); PG8_MMA(0, 1, At, B1); PG8_BAR; PG8_SCHED;
            PG8_LDA(At, 1, 1); PG8_STAGE(PG8_SB(1, 0), b3, voffB); PG8_STAGE(PG8_SB(1, 1), b3 + hstep, voffB); PG8_STAGE(PG8_SA(1, 0), a3, voffA);
            PG8_WAIT_V(8); PG8_WAIT_L(0); PG8_BAR; PG8_MMA(1, 0, At, B0); PG8_MMA(1, 1, At, B1); PG8_BAR; PG8_SCHED;
            } else {
            PG8_LDB(B0, 0, 0); PG8_SCHED; PG8_LDA(At, 0, 0); PG8_STAGE(PG8_SA(1, 1), a1 + hstep, voffA);
            PG8_WAIT_L(8); PG8_BAR; PG8_WAIT_L(0); PG8_MMA(0, 0, At, B0); PG8_BAR; PG8_SCHED;
            PG8_LDB(B1, 0, 1); PG8_STAGE(PG8_SB(0, 0), b2, voffB);
            PG8_BAR; PG8_WAIT_L(0); PG8_MMA(0, 1, At, B1); PG8_BAR;
            PG8_LDA(At, 0, 1); PG8_STAGE(PG8_SA(0, 0), a2, voffA);
            PG8_BAR; PG8_WAIT_L(0); PG8_MMA(1, 0, At, B0); PG8_BAR; PG8_SCHED;
            PG8_STAGE(PG8_SB(0, 1), b2 + hstep, voffB);
            PG8_WAIT_V(6); PG8_BAR; PG8_MMA(1, 1, At, B1); PG8_BAR;
            PG8_LDB(B0, 1, 0); PG8_SCHED; PG8_LDA(At, 1, 0); PG8_STAGE(PG8_SA(0, 1), a2 + hstep, voffA);
            PG8_WAIT_L(8); PG8_BAR; PG8_WAIT_L(0); PG8_MMA(0, 0, At, B0); PG8_BAR; PG8_SCHED;
            PG8_LDB(B1, 1, 1); PG8_STAGE(PG8_SB(1, 0), b3, voffB);
            PG8_BAR; PG8_WAIT_L(0); PG8_MMA(0, 1, At, B1); PG8_BAR;
            PG8_LDA(At, 1, 1); PG8_STAGE(PG8_SA(1, 0), a3, voffA);
            PG8_BAR; PG8_WAIT_L(0); PG8_MMA(1, 0, At, B0); PG8_BAR; PG8_SCHED;
            PG8_STAGE(PG8_SB(1, 1), b3 + hstep, voffB);
            PG8_WAIT_V(6); PG8_BAR; PG8_MMA(1, 1, At, B1); PG8_BAR;
            }
        }
        if constexpr (ALIGN_EPI) { if (wr == 0) PG8_BAR; }
        if constexpr (!Epi::AFTER_DRAIN) { E(acc, cur, wr, wc, fr, fq); S.done(cur); }
        if (!has_next) break;
#pragma unroll
        for (int a = 0; a < 2; ++a)
#pragma unroll
            for (int b = 0; b < 2; ++b)
#pragma unroll
                for (int m = 0; m < 4; ++m)
#pragma unroll
                    for (int n = 0; n < 2; ++n) acc[a][b][m][n] = (f32x4){0.f, 0.f, 0.f, 0.f};
        cur = nxt; cA = nA; cB = nB; ++ui;
        if constexpr (ALIGN_EPI) { if (wr == 1) PG8_BAR; }
    }
    PG8_WAIT_V(0);
    if constexpr (!ALIGN_EPI) { if (wr == 0) PG8_BAR; }
    PG8_BAR;
    if constexpr (Epi::AFTER_DRAIN) { E.fused(acc, cur, wr, wc, fr, fq, lds, wid, lane); S.done(cur); }
#undef PG8_SA
#undef PG8_SB
#undef PG8_STAGE
#undef PG8_LDA
#undef PG8_LDB
#undef PG8_MMA
#undef PG8_WAIT_V
#undef PG8_WAIT_L
#undef PG8_BAR
#undef PG8_SCHED
}
}

using pg8::bf16_t; using pg8::bf16x8; using pg8::f32x4; using pg8::u32x4; using pg8::Unit;
typedef float f32x2_t __attribute__((ext_vector_type(2))); typedef __bf16 bf16x2_t __attribute__((ext_vector_type(2)));
__device__ __forceinline__ unsigned cvt_pk_bf16(float lo, float hi) { f32x2_t v = {lo, hi}; bf16x2_t b = __builtin_convertvector(v, bf16x2_t); return __builtin_bit_cast(unsigned, b); }
typedef float f32x16 __attribute__((ext_vector_type(16)));
typedef unsigned u32x2 __attribute__((ext_vector_type(2)));
#define LAS __attribute__((address_space(3)))

constexpr int DM = 1024, MP = 65536, MS = 1024, MT = MP + MS, SEQ = 2048, DSEQ = 64, PAST = 4096, NMEM = 256;
constexpr int DFF = 2816, NUP = 2 * DFF, NSEG = MT / 64;
constexpr float EPS = 1e-6f, LOG2E = 1.4426950408889634f;
constexpr float C2F = 0.125f * LOG2E, C2M = 0.0625f * LOG2E;
constexpr float NEGBIG = -1e30f;

constexpr size_t O_YP = 0, O_YS = O_YP + (size_t)MP * DM, O_KP = O_YS + (size_t)MS * DM, O_VP = O_KP + (size_t)MP * 512, O_LFP = O_VP + (size_t)MP * 512,
    O_PSP = O_LFP + (size_t)MP * 8, O_CSP = O_PSP + 32 * 15 * 512, O_MKP = O_CSP + 32 * 2 * DFF, O_MVP = O_MKP + (size_t)8192 * 1024, O_KS = O_MVP + (size_t)8192 * 1024,
    O_VS = O_KS + (size_t)MS * 512, O_LFS = O_VS + (size_t)MS * 512, O_PSS = O_LFS + MS * 8, O_CSS = O_PSS + 16 * 15 * 512, O_END = O_CSS + 16 * 2 * DFF;

constexpr size_t MiB = 1u << 20;
constexpr size_t WS_WIN = 1 * MiB, WS_WO = 5 * MiB, WS_WMQ = 7 * MiB, WS_WMO = 9 * MiB, WS_WMKV = 11 * MiB, WS_WUP = 15 * MiB, WS_WDN = 26 * MiB, WS_WPOOL = 32 * MiB;
constexpr size_t WS_USX = 34 * MiB;
constexpr size_t WS_MKB = 40 * MiB, WS_MVB = 64 * MiB;
constexpr size_t WS_SSQ1 = 88 * MiB, WS_SSQ2 = 93 * MiB, WS_SSQ3 = 98 * MiB;
constexpr size_t WS_KBP = 103 * MiB, WS_KBS = 105 * MiB;
constexpr size_t WS_AHEAD = 108 * MiB, WS_ATAIL = WS_AHEAD + 23 * MiB / 1 - MiB / 2, WS_BHEAD = WS_ATAIL + 23 * MiB - MiB / 2;
constexpr size_t WS_X1B = 176 * MiB, WS_KCB = 176 * MiB, WS_VCB = 240 * MiB;
constexpr size_t WS_X2B = 306 * MiB;
constexpr size_t WS_XB = 436 * MiB, WS_MQB = 436 * MiB, WS_HFF = 436 * MiB;
constexpr size_t WS_UQKV = 566 * MiB, WS_MO = 566 * MiB;
constexpr size_t WS_MIX = 826 * MiB, WS_MEMB = 956 * MiB, WS_NEED = 972 * MiB;
static_assert((size_t)NSEG * 2 * DFF * 4 <= 22 * MiB + MiB / 2, "side buffers");
static_assert(WS_BHEAD + 22 * MiB + MiB / 2 <= WS_X1B, "side buffers end");

#define P2_ATTN_P 1
#define P2_ATTN_S 1
#define P2_POOL 1
#define DBG_HI 11
#ifndef PHMASK
#define PHMASK 0x7ff
#endif
constexpr int LDS_BYTES = 147456;

struct Params { const float* in[28]; float* out; unsigned char* ws; int ph_lo, ph_hi; };

__device__ __forceinline__ float bf_lo(unsigned w) { return __builtin_bit_cast(float, w << 16); }
__device__ __forceinline__ float bf_hi(unsigned w) { return __builtin_bit_cast(float, w & 0xffff0000u); }
__device__ __forceinline__ int crow(int r, int hi) { return (r & 3) + 8 * (r >> 2) + 4 * hi; }
__device__ __forceinline__ float wave_sum(float v) {
#pragma unroll
    for (int o = 1; o < 64; o <<= 1) v += __shfl_xor(v, o);
    return v;
}
__device__ __forceinline__ float rsq(float ssq) { return 1.0f / sqrtf(ssq * (1.0f / 1024.0f) + EPS); }
#define LDS_WAIT() asm volatile("s_waitcnt lgkmcnt(0)" ::: "memory")

typedef const f32x4 (&AccRef)[2][2][4][2];

__device__ __forceinline__ u32x4 pack8(f32x4 v0, f32x4 v1) { u32x4 w; w.x = cvt_pk_bf16(v0[0], v0[1]); w.y = cvt_pk_bf16(v0[2], v0[3]); w.z = cvt_pk_bf16(v1[0], v1[1]); w.w = cvt_pk_bf16(v1[2], v1[3]); return w; }

struct EpiIn {
    static constexpr bool PERM = true, AFTER_DRAIN = false;
    bf16_t* uqkv; float* out; bf16_t* usx;
    __device__ __forceinline__ void operator()(AccRef acc, const Unit& u, int wr, int wc, int fr, int fq) const {
        const int t = u.pn >> 1;
        const int col0 = (u.pn & 1) * 256 + wc * 32 + 8 * fq;
        bf16_t* base = uqkv + (size_t)t * MT * 512;
        const float sc = (t == 1) ? C2F : 1.0f;
#pragma unroll
        for (int ai = 0; ai < 2; ++ai)
#pragma unroll
            for (int m = 0; m < 4; ++m) {
                const int row = u.pm * 256 + ai * 128 + wr * 64 + m * 16 + fr;
#pragma unroll
                for (int bj = 0; bj < 2; ++bj) {
                    const int col = col0 + bj * 128;
                    const f32x4 v0 = acc[ai][bj][m][0] * sc, v1 = acc[ai][bj][m][1] * sc;
                    *(u32x4*)(base + (size_t)row * 512 + col) = pack8(v0, v1);
                    if (t >= 2) {
                        float* o = (row < MP) ? out + (t == 2 ? O_KP : O_VP) + (size_t)row * 512 : out + (t == 2 ? O_KS : O_VS) + (size_t)(row - MP) * 512;
                        *(f32x4*)(o + col) = v0; *(f32x4*)(o + col + 4) = v1;
                    } else if (t == 0) {
                        if (row < MP) { const int tt = row & (SEQ - 1); if (tt >= SEQ - 15) { float* o = out + O_PSP + ((size_t)(row >> 11) * 15 + (tt - (SEQ - 15))) * 512 + col; *(f32x4*)o = v0; *(f32x4*)(o + 4) = v1; } }
                        else { const int rs = row - MP, tt = rs & 63; *(u32x4*)(usx + ((size_t)(rs >> 6) * 79 + 15 + tt) * 512 + col) = pack8(v0, v1); if (tt >= DSEQ - 15) { float* o = out + O_PSS + ((size_t)(rs >> 6) * 15 + (tt - (DSEQ - 15))) * 512 + col; *(f32x4*)o = v0; *(f32x4*)(o + 4) = v1; } }
                    }
                }
            }
    }
};
struct EpiMkv {
    static constexpr bool PERM = true, AFTER_DRAIN = false;
    bf16_t* mkb; bf16_t* mvb; float* out;
    __device__ __forceinline__ void operator()(AccRef acc, const Unit& u, int wr, int wc, int fr, int fq) const {
        const int t = u.pn >> 2;
        const int col0 = (u.pn & 3) * 256 + wc * 32 + 8 * fq;
        bf16_t* bb = t ? mvb : mkb; float* of = out + (t ? O_MVP : O_MKP);
#pragma unroll
        for (int ai = 0; ai < 2; ++ai)
#pragma unroll
            for (int m = 0; m < 4; ++m) {
                const int row = u.pm * 256 + ai * 128 + wr * 64 + m * 16 + fr;
#pragma unroll
                for (int bj = 0; bj < 2; ++bj) {
                    const int col = col0 + bj * 128;
                    const f32x4 v0 = acc[ai][bj][m][0], v1 = acc[ai][bj][m][1];
                    *(u32x4*)(bb + (size_t)row * 1024 + col) = pack8(v0, v1);
                    *(f32x4*)(of + (size_t)row * 1024 + col) = v0; *(f32x4*)(of + (size_t)row * 1024 + col + 4) = v1;
                }
            }
    }
};
template <int MODE> struct EpiRes {
    static constexpr bool PERM = true, AFTER_DRAIN = false;
    const float* xP; const float* xS; const bf16_t* resB; bf16_t* xo; float* yo; float* ssqp;
    __device__ __forceinline__ void operator()(AccRef acc, const Unit& u, int wr, int wc, int fr, int fq) const {
        const int col0 = u.pn * 256 + wc * 32 + 8 * fq;
#pragma unroll
        for (int ai = 0; ai < 2; ++ai)
#pragma unroll
            for (int m = 0; m < 4; ++m) {
                const int row = u.pm * 256 + ai * 128 + wr * 64 + m * 16 + fr;
                float ss = 0.f;
#pragma unroll
                for (int bj = 0; bj < 2; ++bj) {
                    const int col = col0 + bj * 128;
                    f32x4 r0, r1;
                    if (MODE == 0) { const float* xr = (row < MP) ? xP + (size_t)row * DM : xS + (size_t)(row - MP) * DM; r0 = *(const f32x4*)(xr + col); r1 = *(const f32x4*)(xr + col + 4); }
                    else { const u32x4 w = *(const u32x4*)(resB + (size_t)row * DM + col); r0 = (f32x4){bf_lo(w.x), bf_hi(w.x), bf_lo(w.y), bf_hi(w.y)}; r1 = (f32x4){bf_lo(w.z), bf_hi(w.z), bf_lo(w.w), bf_hi(w.w)}; }
                    const f32x4 v0 = acc[ai][bj][m][0] + r0, v1 = acc[ai][bj][m][1] + r1;
                    ss += (v0[0] * v0[0] + v0[1] * v0[1]) + (v0[2] * v0[2] + v0[3] * v0[3]) + (v1[0] * v1[0] + v1[1] * v1[1]) + (v1[2] * v1[2] + v1[3] * v1[3]);
                    if (MODE == 2) { float* yr = (row < MP) ? yo + O_YP + (size_t)row * DM : yo + O_YS + (size_t)(row - MP) * DM; *(f32x4*)(yr + col) = v0; *(f32x4*)(yr + col + 4) = v1; }
                    else *(u32x4*)(xo + (size_t)row * DM + col) = pack8(v0, v1);
                }
                ss += __shfl_xor(ss, 16); ss += __shfl_xor(ss, 32);
                if (fq == 0) ssqp[(size_t)row * 16 + u.pn * 4 + wc] = ss;
            }
    }
};
__device__ __forceinline__ float row_rsq(const float* ssqp, int row) {
    const f32x4* sp = (const f32x4*)(ssqp + (size_t)row * 16);
    const f32x4 a = sp[0], b = sp[1], c = sp[2], d = sp[3];
    const float s = ((a[0] + a[1]) + (a[2] + a[3])) + ((b[0] + b[1]) + (b[2] + b[3])) + ((c[0] + c[1]) + (c[2] + c[3])) + ((d[0] + d[1]) + (d[2] + d[3]));
    return rsq(s);
}
struct EpiMq {
    static constexpr bool PERM = true, AFTER_DRAIN = false;
    const float* ssqp; bf16_t* mq;
    __device__ __forceinline__ void operator()(AccRef acc, const Unit& u, int wr, int wc, int fr, int fq) const {
        const int col0 = u.pn * 256 + wc * 32 + 8 * fq;
#pragma unroll
        for (int ai = 0; ai < 2; ++ai)
#pragma unroll
            for (int m = 0; m < 4; ++m) {
                const int row = u.pm * 256 + ai * 128 + wr * 64 + m * 16 + fr;
                const float r = row_rsq(ssqp, row) * C2M;
#pragma unroll
                for (int bj = 0; bj < 2; ++bj) *(u32x4*)(mq + (size_t)row * DM + col0 + bj * 128) = pack8(acc[ai][bj][m][0] * r, acc[ai][bj][m][1] * r);
            }
    }
};
struct EpiUp {
    static constexpr bool PERM = true, AFTER_DRAIN = false;
    const float* ssqp; const float* cw; const float* cb; bf16_t* hff; float* ahead; float* atail; float* bhead;
    __device__ __forceinline__ void operator()(AccRef acc, const Unit& u, int wr, int wc, int fr, int fq) const {
        const int lane = fq * 16 + fr;
        const int c0 = u.pn * 128 + wc * 32 + 8 * fq;
        f32x4 w0[2], w1[2], w2[2], bb[2];
#pragma unroll
        for (int n = 0; n < 2; ++n) { w0[n] = *(const f32x4*)(cw + c0 + 4 * n); w1[n] = *(const f32x4*)(cw + DFF + c0 + 4 * n); w2[n] = *(const f32x4*)(cw + 2 * DFF + c0 + 4 * n); bb[n] = *(const f32x4*)(cb + c0 + 4 * n); }
        const int src1 = (lane & 48) | ((fr + 15) & 15), src2 = (lane & 48) | ((fr + 14) & 15);
#pragma unroll
        for (int ai = 0; ai < 2; ++ai) {
            const int seg = u.pm * 4 + ai * 2 + wr;
            const int rowb = u.pm * 256 + ai * 128 + wr * 64;
            f32x4 ap[2] = {{0.f, 0.f, 0.f, 0.f}, {0.f, 0.f, 0.f, 0.f}};
#pragma unroll
            for (int m = 0; m < 4; ++m) {
                const int row = rowb + m * 16 + fr;
                const float r = row_rsq(ssqp, row);
                f32x4 a[2], b[2], h[2];
#pragma unroll
                for (int n = 0; n < 2; ++n) {
                    a[n] = acc[ai][0][m][n] * r; b[n] = acc[ai][1][m][n] * r;
                    f32x4 a1, a2;
#pragma unroll
                    for (int e = 0; e < 4; ++e) {
                        const float x1 = (fr == 15) ? ap[n][e] : a[n][e]; a1[e] = __shfl(x1, src1);
                        const float x2 = (fr >= 14) ? ap[n][e] : a[n][e]; a2[e] = __shfl(x2, src2);
                    }
                    const f32x4 cv = bb[n] + w0[n] * a2 + w1[n] * a1 + w2[n] * a[n];
#pragma unroll
                    for (int e = 0; e < 4; ++e) h[n][e] = cv[e] * __builtin_amdgcn_rcpf(1.0f + __builtin_amdgcn_exp2f(-cv[e] * LOG2E)) * b[n][e];
                    ap[n] = a[n];
                }
                if (m == 0 && fr < 2) {
                    float* pa = ahead + ((size_t)seg * 2 + fr) * DFF + c0; float* pb = bhead + ((size_t)seg * 2 + fr) * DFF + c0;
                    *(f32x4*)pa = a[0]; *(f32x4*)(pa + 4) = a[1]; *(f32x4*)pb = b[0]; *(f32x4*)(pb + 4) = b[1];
                } else {
                    *(u32x4*)(hff + (size_t)row * DFF + c0) = pack8(h[0], h[1]);
                }
                if (m == 3 && fr >= 14) { float* pt = atail + ((size_t)seg * 2 + (fr - 14)) * DFF + c0; *(f32x4*)pt = a[0]; *(f32x4*)(pt + 4) = a[1]; }
            }
        }
    }
};

template <int D, int KT, int KG, bool PF, bool QLDS, bool CAUSAL, bool BIAS>
__device__ __forceinline__ void attn_unit(LAS unsigned char* L, const bf16_t* __restrict__ Q, int ldq, int nq,
                                          const bf16_t* __restrict__ K0, const bf16_t* __restrict__ V0, int nt0, const bf16_t* __restrict__ K1, const bf16_t* __restrict__ V1, int ldk, int ntiles,
                                          const float* __restrict__ kbias, int qpos0, bf16_t* __restrict__ O, int ldo) {
    constexpr int KS = D + 8, VS = KT + 4, CH = D / 8, NKI = KT * CH / 512, NVI = ((KT / 2) * CH + 511) / 512, NQF = (D == 64) ? 4 : 1, NP = KT / 32, QW = 8 / KG;
    constexpr int TILEB = KT * KS * 2 + D * VS * 2 + (BIAS ? KT * 4 : 0);
    constexpr int QBYTES = QLDS ? 32 * QW * KS * 2 : 0;
    constexpr int NG = (KG == 1) ? 2 : (!PF ? 1 : KG);
    const int tid = threadIdx.x, lane = tid & 63, wid = __builtin_amdgcn_readfirstlane(tid >> 6), r32 = lane & 31, hi = lane >> 5;
    const int qw = wid % QW, kg = wid / QW;
    const bool wact = qw * 32 < nq;
    LAS unsigned char* T = L + QBYTES;
    const LAS bf16_t* Qs = (const LAS bf16_t*)L + (qw * 32 + r32) * KS + hi * 8;
    const bf16_t* qrow = Q + (size_t)(qw * 32 + r32) * ldq + hi * 8;
    bf16x8 qf[NQF];
    if (D == 64 && !QLDS) {
#pragma unroll
        for (int ds = 0; ds < NQF; ++ds) qf[ds] = wact ? *(const bf16x8*)(qrow + ds * 16) : (bf16x8){0, 0, 0, 0, 0, 0, 0, 0};
    }
    if (QLDS) {
        __syncthreads();
        constexpr int NQI = 32 * QW * CH / 512;
#pragma unroll
        for (int i = 0; i < NQI; ++i) { const int id = tid + 512 * i, row = id / CH, ch = id % CH; if (row < nq) *(LAS u32x4*)((LAS bf16_t*)L + row * KS + ch * 8) = *(const u32x4*)(Q + (size_t)row * ldq + ch * 8); }
    }
    float ref = 0.f;
    if (BIAS) ref = wact ? kbias[qpos0 + qw * 32 + r32] : 0.f;
    f32x16 o[D / 32];
#pragma unroll
    for (int db = 0; db < D / 32; ++db)
#pragma unroll
        for (int r = 0; r < 16; ++r) o[db][r] = 0.f;
    float lrun = 0.f;
    u32x4 kreg[NG][NKI], vreg[NG][NVI][2]; float breg[NG];
#define ATT_LOAD(j, g) do { const bf16_t* Kt_ = ((j) < nt0) ? K0 + (size_t)(j) * KT * ldk : K1 + (size_t)((j) - nt0) * KT * ldk; \
        const bf16_t* Vg_ = ((j) < nt0) ? V0 + (size_t)(j) * KT * ldk : V1 + (size_t)((j) - nt0) * KT * ldk; \
        _Pragma("unroll") for (int i_ = 0; i_ < NKI; ++i_) { const int id_ = tid + 512 * i_, row_ = id_ / CH, ch_ = id_ % CH; kreg[g][i_] = *(const u32x4*)(Kt_ + (size_t)row_ * ldk + ch_ * 8); } \
        _Pragma("unroll") for (int i_ = 0; i_ < NVI; ++i_) { const int id_ = tid + 512 * i_; if (id_ < (KT / 2) * CH) { const int pr_ = id_ % (KT / 2), ch_ = id_ / (KT / 2); \
            vreg[g][i_][0] = *(const u32x4*)(Vg_ + (size_t)(2 * pr_) * ldk + ch_ * 8); vreg[g][i_][1] = *(const u32x4*)(Vg_ + (size_t)(2 * pr_ + 1) * ldk + ch_ * 8); } } \
        if (BIAS && tid < KT) breg[g] = kbias[(j) * KT + tid]; } while (0)
#define ATT_STORE(TB, g) do { LAS bf16_t* Ks_ = (LAS bf16_t*)(TB); LAS bf16_t* Vt_ = (LAS bf16_t*)((TB) + KT * KS * 2); \
        _Pragma("unroll") for (int i_ = 0; i_ < NKI; ++i_) { const int id_ = tid + 512 * i_, row_ = id_ / CH, ch_ = id_ % CH; *(LAS u32x4*)(Ks_ + row_ * KS + ch_ * 8) = kreg[g][i_]; } \
        _Pragma("unroll") for (int i_ = 0; i_ < NVI; ++i_) { const int id_ = tid + 512 * i_; if (id_ < (KT / 2) * CH) { const int pr_ = id_ % (KT / 2), ch_ = id_ / (KT / 2); \
            _Pragma("unroll") for (int e_ = 0; e_ < 4; ++e_) { const unsigned lo_ = vreg[g][i_][0][e_], h2_ = vreg[g][i_][1][e_]; \
                *(LAS unsigned*)(Vt_ + (ch_ * 8 + 2 * e_) * VS + 2 * pr_) = (lo_ & 0xffffu) | (h2_ << 16); \
                *(LAS unsigned*)(Vt_ + (ch_ * 8 + 2 * e_ + 1) * VS + 2 * pr_) = (lo_ >> 16) | (h2_ & 0xffff0000u); } } } \
        if (BIAS && tid < KT) ((LAS float*)((TB) + KT * KS * 2 + D * VS * 2))[tid] = breg[g]; } while (0)
#define ATT_COMPUTE(j, TB) do { const LAS bf16_t* Ks_ = (const LAS bf16_t*)(TB); const LAS bf16_t* Vt_ = (const LAS bf16_t*)((TB) + KT * KS * 2); const LAS float* Bs_ = (const LAS float*)((TB) + KT * KS * 2 + D * VS * 2); \
        if (wact && (!CAUSAL || KT * (j) <= qpos0 + qw * 32 + 31)) { \
            f32x16 p[NP]; \
            const bf16_t* qr_ = qrow; if (D != 64 && !QLDS) asm volatile("" : "+v"(qr_)); \
            _Pragma("unroll") for (int h_ = 0; h_ < NP; ++h_) { \
                if (BIAS) { _Pragma("unroll") for (int i_ = 0; i_ < 4; ++i_) { const f32x4 t0_ = *(const LAS f32x4*)(Bs_ + 32 * h_ + 8 * i_ + 4 * hi); \
                        _Pragma("unroll") for (int e_ = 0; e_ < 4; ++e_) p[h_][4 * i_ + e_] = t0_[e_] - ref; } } \
                else { _Pragma("unroll") for (int r_ = 0; r_ < 16; ++r_) p[h_][r_] = 0.f; } } \
            _Pragma("unroll") for (int ds_ = 0; ds_ < D / 16; ++ds_) { \
                bf16x8 qv_; if (QLDS) qv_ = *(const LAS bf16x8*)(Qs + ds_ * 16); else if (D == 64) qv_ = qf[ds_]; else qv_ = *(const bf16x8*)(qr_ + ds_ * 16); \
                _Pragma("unroll") for (int h_ = 0; h_ < NP; ++h_) { const bf16x8 kf_ = *(const LAS bf16x8*)(Ks_ + (32 * h_ + r32) * KS + ds_ * 16 + hi * 8); p[h_] = __builtin_amdgcn_mfma_f32_32x32x16_bf16(kf_, qv_, p[h_], 0, 0, 0); } } \
            if (CAUSAL && (KT * (j) + KT - 1 > qpos0 + qw * 32)) { const int lim_ = qpos0 + qw * 32 + r32 - KT * (j); \
                _Pragma("unroll") for (int h_ = 0; h_ < NP; ++h_) _Pragma("unroll") for (int r_ = 0; r_ < 16; ++r_) { if (crow(r_, hi) + 32 * h_ > lim_) p[h_][r_] = NEGBIG; } } \
            float sum_ = 0.f; \
            _Pragma("unroll") for (int h_ = 0; h_ < NP; ++h_) _Pragma("unroll") for (int r_ = 0; r_ < 16; ++r_) { p[h_][r_] = __builtin_amdgcn_exp2f(p[h_][r_]); sum_ += p[h_][r_]; } \
            lrun += sum_; \
            u32x4 pw_[2 * NP]; \
            _Pragma("unroll") for (int h_ = 0; h_ < NP; ++h_) _Pragma("unroll") for (int e_ = 0; e_ < 4; ++e_) { pw_[2 * h_][e_] = pg8::cvt_pk_bf16(p[h_][2 * e_], p[h_][2 * e_ + 1]); pw_[2 * h_ + 1][e_] = pg8::cvt_pk_bf16(p[h_][8 + 2 * e_], p[h_][9 + 2 * e_]); } \
            _Pragma("unroll") for (int db_ = 0; db_ < D / 32; ++db_) _Pragma("unroll") for (int ks_ = 0; ks_ < 2 * NP; ++ks_) { \
                const LAS bf16_t* vp_ = Vt_ + (db_ * 32 + r32) * VS + ks_ * 16 + hi * 4; \
                const u32x2 va_ = *(const LAS u32x2*)vp_, vb_ = *(const LAS u32x2*)(vp_ + 8); const u32x4 vv_ = {va_.x, va_.y, vb_.x, vb_.y}; \
                o[db_] = __builtin_amdgcn_mfma_f32_32x32x16_bf16(__builtin_bit_cast(bf16x8, vv_), __builtin_bit_cast(bf16x8, pw_[ks_]), o[db_], 0, 0, 0); } \
        } } while (0)
    if (KG == 1) {
        ATT_LOAD(0, 0); ATT_STORE(T, 0); if (ntiles > 1) ATT_LOAD(1, 1); if (ntiles > 2) ATT_LOAD(2, 0);
        __syncthreads();
        for (int j = 0; j < ntiles; j += 2) {
            if (j + 1 < ntiles) ATT_STORE(T + TILEB, 1);
            if (j + 3 < ntiles) ATT_LOAD(j + 3, 1);
            ATT_COMPUTE(j, T);
            __syncthreads();
            if (j + 1 < ntiles) {
                if (j + 2 < ntiles) ATT_STORE(T, 0);
                if (j + 4 < ntiles) ATT_LOAD(j + 4, 0);
                ATT_COMPUTE(j + 1, T + TILEB);
                __syncthreads();
            }
        }
    } else {
        const int nsteps = (ntiles + KG - 1) / KG;
        if (PF) {
#pragma unroll
            for (int g = 0; g < NG; ++g) { if (g < ntiles) ATT_LOAD(g, g); }
        }
        for (int s = 0; s < nsteps; ++s) {
            __syncthreads();
            if (PF) {
#pragma unroll
                for (int g = 0; g < NG; ++g) { if (s * KG + g < ntiles) ATT_STORE(T + g * TILEB, g); }
            } else {
#pragma unroll
                for (int g = 0; g < KG; ++g) { const int jt = s * KG + g; if (jt < ntiles) { ATT_LOAD(jt, 0); ATT_STORE(T + g * TILEB, 0); } }
            }
            __syncthreads();
            if (PF && s + 1 < nsteps) {
#pragma unroll
                for (int g = 0; g < NG; ++g) { const int jt = (s + 1) * KG + g; if (jt < ntiles) ATT_LOAD(jt, g); }
            }
            const int jm = s * KG + kg;
            if (jm < ntiles) ATT_COMPUTE(jm, T + kg * TILEB);
        }
        LAS float* Mg = (LAS float*)T;
#pragma unroll
        for (int db = 0; db < D / 32; ++db) {
            __syncthreads();
#pragma unroll
            for (int r = 0; r < 16; ++r) Mg[(wid * 17 + r) * 64 + lane] = o[db][r];
            if (db == 0) Mg[(wid * 17 + 16) * 64 + lane] = lrun;
            __syncthreads();
            if (kg == 0) {
#pragma unroll
                for (int g = 1; g < KG; ++g) {
#pragma unroll
                    for (int r = 0; r < 16; ++r) o[db][r] += Mg[((g * QW + qw) * 17 + r) * 64 + lane];
                    if (db == 0) lrun += Mg[((g * QW + qw) * 17 + 16) * 64 + lane];
                }
            }
        }
        __syncthreads();
    }
#undef ATT_LOAD
#undef ATT_STORE
#undef ATT_COMPUTE
    if (kg == 0 && wact) {
        const float lt = lrun + __shfl_xor(lrun, 32), inv = 1.0f / lt;
        bf16_t* orow = O + (size_t)(qw * 32 + r32) * ldo;
#pragma unroll
        for (int db = 0; db < D / 32; ++db)
#pragma unroll
            for (int i = 0; i < 4; ++i) { u32x2 w; w.x = pg8::cvt_pk_bf16(o[db][4 * i] * inv, o[db][4 * i + 1] * inv); w.y = pg8::cvt_pk_bf16(o[db][4 * i + 2] * inv, o[db][4 * i + 3] * inv);
                *(u32x2*)(orow + db * 32 + 8 * i + 4 * hi) = w; }
    }
}

template <int J0, int J1>
__device__ __forceinline__ void pool_acc(float (&s)[8], const char* __restrict__ ubase, unsigned off0, int nprev) {
#pragma unroll
    for (int j = J0; j < J1; ++j) {
        const bool ok = j <= nprev; const unsigned jo = ok ? (unsigned)j * 1024u : 0u; const float wt = ok ? 1.f : 0.f;
        const u32x4 v = *(const u32x4*)(ubase + (off0 - jo));
        s[0] += wt * bf_lo(v.x); s[1] += wt * bf_hi(v.x); s[2] += wt * bf_lo(v.y); s[3] += wt * bf_hi(v.y); s[4] += wt * bf_lo(v.z); s[5] += wt * bf_hi(v.z); s[6] += wt * bf_lo(v.w); s[7] += wt * bf_hi(v.w);
    }
}
template <int G>
__device__ __forceinline__ void pool_group(const char* __restrict__ ubase, unsigned rowoff, int nprev, float icnt, const bf16_t* __restrict__ wpt, bf16_t* __restrict__ orow, int r32, int hi) {
    constexpr int w = 2 << G;
    bf16x8 dfr[8];
#pragma unroll
    for (int ks = 0; ks < 8; ++ks) {
        const int c0 = G * 128 + ks * 16 + hi * 8;
        const unsigned off0 = rowoff + (unsigned)c0 * 2u;
        const u32x4 cu = *(const u32x4*)(ubase + off0);
        float s[8], cur[8];
        cur[0] = bf_lo(cu.x); cur[1] = bf_hi(cu.x); cur[2] = bf_lo(cu.y); cur[3] = bf_hi(cu.y); cur[4] = bf_lo(cu.z); cur[5] = bf_hi(cu.z); cur[6] = bf_lo(cu.w); cur[7] = bf_hi(cu.w);
#pragma unroll
        for (int e = 0; e < 8; ++e) s[e] = cur[e];
        pool_acc<1, (w < 8 ? w : 8)>(s, ubase, off0, nprev);
        if (w > 8) { __builtin_amdgcn_sched_barrier(0); pool_acc<8, w>(s, ubase, off0, nprev); }
        u32x4 dv;
        dv.x = cvt_pk_bf16(s[0] * icnt - cur[0], s[1] * icnt - cur[1]); dv.y = cvt_pk_bf16(s[2] * icnt - cur[2], s[3] * icnt - cur[3]);
        dv.z = cvt_pk_bf16(s[4] * icnt - cur[4], s[5] * icnt - cur[5]); dv.w = cvt_pk_bf16(s[6] * icnt - cur[6], s[7] * icnt - cur[7]);
        dfr[ks] = __builtin_bit_cast(bf16x8, dv);
        if (((ks + 1) % (G == 0 ? 4 : G == 1 ? 2 : 1)) == 0) __builtin_amdgcn_sched_barrier(0);
    }
#pragma unroll
    for (int nb = 0; nb < 4; ++nb) {
        f32x16 acc;
#pragma unroll
        for (int r = 0; r < 16; ++r) acc[r] = 0.f;
        const bf16_t* wrow = wpt + ((size_t)G * 128 + nb * 32 + r32) * 128 + hi * 8;
#pragma unroll
        for (int ks = 0; ks < 8; ++ks) acc = __builtin_amdgcn_mfma_f32_32x32x16_bf16(*(const bf16x8*)(wrow + ks * 16), dfr[ks], acc, 0, 0, 0);
#pragma unroll
        for (int i = 0; i < 4; ++i) { u32x2 wv; wv.x = cvt_pk_bf16(acc[4 * i], acc[4 * i + 1]); wv.y = cvt_pk_bf16(acc[4 * i + 2], acc[4 * i + 3]);
            *(u32x2*)(orow + G * 128 + nb * 32 + 8 * i + 4 * hi) = wv; }
    }
}
__device__ __forceinline__ void pool_unit(int tile, const bf16_t* __restrict__ ub, const bf16_t* __restrict__ usx, const bf16_t* __restrict__ wpt, bf16_t* __restrict__ mix) {
    const int tid = threadIdx.x, lane = tid & 63, wid = tid >> 6, r32 = lane & 31, hi = lane >> 5;
    const int row = tile * 256 + wid * 32 + r32;
    const bool samp = row >= MP;
    const int b = samp ? (row - MP) >> 6 : row >> 11, t = samp ? (row - MP) & 63 : row & (SEQ - 1);
    const char* ubase = (const char*)(tile >= 256 ? usx : ub);
    const unsigned rowoff = (samp ? (unsigned)(b * 79 + 15 + t) : (unsigned)row) * 1024u;
    const int nprev = samp ? t + 15 : t;
    bf16_t* orow = mix + (size_t)row * DM;
    const int np1 = samp ? 16 : t + 1;
    pool_group<0>(ubase, rowoff, nprev, 1.0f / (float)(np1 < 2 ? np1 : 2), wpt, orow, r32, hi);
    pool_group<1>(ubase, rowoff, nprev, 1.0f / (float)(np1 < 4 ? np1 : 4), wpt, orow, r32, hi);
    pool_group<2>(ubase, rowoff, nprev, 1.0f / (float)(np1 < 8 ? np1 : 8), wpt, orow, r32, hi);
    pool_group<3>(ubase, rowoff, nprev, 1.0f / (float)(np1 < 16 ? np1 : 16), wpt, orow, r32, hi);
}

template <int MODE>
__device__ __forceinline__ void transpose_item(const float* __restrict__ W, int K, int N, int nblk, bf16_t* __restrict__ WT, int row_off, const float* __restrict__ g, LAS float* scr, int item, int lane) {
    const int kb = item / nblk, nb = item % nblk, k0 = 64 * kb, n0 = 32 * nb;
#pragma unroll 8
    for (int i = 0; i < 32; ++i) { const int kk = 2 * i + (lane >> 5); float v = W[(size_t)(k0 + kk) * N + n0 + (lane & 31)]; if (g) v *= g[k0 + kk]; scr[kk * 33 + (lane & 31)] = v; }
    LDS_WAIT();
    const int c = lane & 7;
#pragma unroll
    for (int j = 0; j < 4; ++j) {
        const int n = (lane >> 3) + 8 * j; const LAS float* s = scr + (8 * c) * 33 + n;
        const int nn = n0 + n; int drow;
        if (MODE == 0) drow = row_off + nn; else { const int half = nn / DFF, cc = nn % DFF; drow = (cc >> 7) * 256 + half * 128 + (cc & 127); }
        u32x4 o; o.x = cvt_pk_bf16(s[0 * 33], s[1 * 33]); o.y = cvt_pk_bf16(s[2 * 33], s[3 * 33]); o.z = cvt_pk_bf16(s[4 * 33], s[5 * 33]); o.w = cvt_pk_bf16(s[6 * 33], s[7 * 33]);
        *(u32x4*)(WT + (size_t)drow * K + k0 + 8 * c) = o;
    }
    LDS_WAIT();
}
__device__ __forceinline__ void prepass_row(const float* __restrict__ xrow, bf16_t* __restrict__ orow, const LAS float* wf, const float* __restrict__ b_f, float* __restrict__ lf_out, int lane) {
    const f32x4* xr = (const f32x4*)xrow + lane;
    f32x4 v[4]; float s = 0.f;
#pragma unroll
    for (int j = 0; j < 4; ++j) { v[j] = xr[64 * j]; s += (v[j][0] * v[j][0] + v[j][1] * v[j][1]) + (v[j][2] * v[j][2] + v[j][3] * v[j][3]); }
    const float r = rsq(wave_sum(s));
    u32x2* o8 = (u32x2*)orow + lane;
#pragma unroll
    for (int j = 0; j < 4; ++j) { v[j] = v[j] * r; u32x2 w; w.x = cvt_pk_bf16(v[j][0], v[j][1]); w.y = cvt_pk_bf16(v[j][2], v[j][3]); o8[64 * j] = w; }
    if (wf) {
        f32x4 fa = {0.f, 0.f, 0.f, 0.f}, fb = {0.f, 0.f, 0.f, 0.f};
#pragma unroll
        for (int j = 0; j < 4; ++j)
#pragma unroll
            for (int e = 0; e < 4; ++e) { const int k = 4 * (lane + 64 * j) + e; const LAS f32x4* w = (const LAS f32x4*)(wf + k * 8); fa += w[0] * v[j][e]; fb += w[1] * v[j][e]; }
#pragma unroll
        for (int e = 0; e < 4; ++e) { fa[e] = wave_sum(fa[e]); fb[e] = wave_sum(fb[e]); }
        float z = fa[0];
        z = (lane == 1) ? fa[1] : z; z = (lane == 2) ? fa[2] : z; z = (lane == 3) ? fa[3] : z; z = (lane == 4) ? fb[0] : z; z = (lane == 5) ? fb[1] : z; z = (lane == 6) ? fb[2] : z; z = (lane == 7) ? fb[3] : z;
        if (lane < 8) { z += b_f[lane]; lf_out[lane] = fminf(z, 0.f) - log1pf(expf(-fabsf(z))); }
    }
}
__device__ __forceinline__ void scan_seq(const float* s0, int n0, const float* s1, int n1, float* dst, int lane) {
    const int n = n0 + n1, Lc = n >> 6;
    float s = 0.f;
    for (int i = 0; i < Lc; ++i) { const int t = lane * Lc + i; const float* ptr = (t < n0) ? (s0 + (size_t)t * 8) : (s1 + (size_t)(t - n0) * 8); s += *ptr; }
    float inc = s;
    for (int o = 1; o < 64; o <<= 1) { const float v = __shfl_up(inc, o); if (lane >= o) inc += v; }
    float run = inc - s;
    for (int i = 0; i < Lc; ++i) { const int t = lane * Lc + i; const float* ptr = (t < n0) ? (s0 + (size_t)t * 8) : (s1 + (size_t)(t - n0) * 8); run += *ptr; dst[t] = -run * LOG2E; }
}
__device__ __forceinline__ void cvt_flat(const float* __restrict__ src, bf16_t* __restrict__ dst, size_t n8, size_t gtid, size_t gn) {
    for (size_t i = gtid; i < n8; i += gn) { const f32x4 a = *(const f32x4*)(src + i * 8), b = *(const f32x4*)(src + i * 8 + 4); *(u32x4*)(dst + i * 8) = pack8(a, b); }
}

#define Wt_in ((bf16_t*)(ws + WS_WIN))
#define Wt_o ((bf16_t*)(ws + WS_WO))
#define Wt_mq ((bf16_t*)(ws + WS_WMQ))
#define Wt_mo ((bf16_t*)(ws + WS_WMO))
#define Wt_mkv ((bf16_t*)(ws + WS_WMKV))
#define Wt_up ((bf16_t*)(ws + WS_WUP))
#define Wt_dn ((bf16_t*)(ws + WS_WDN))
#define Wt_pool ((bf16_t*)(ws + WS_WPOOL))
#define usx ((bf16_t*)(ws + WS_USX))
#define mkb ((bf16_t*)(ws + WS_MKB))
#define mvb ((bf16_t*)(ws + WS_MVB))
#define ssq1 ((float*)(ws + WS_SSQ1))
#define ssq2 ((float*)(ws + WS_SSQ2))
#define ssq3 ((float*)(ws + WS_SSQ3))
#define kbP ((float*)(ws + WS_KBP))
#define kbS ((float*)(ws + WS_KBS))
#define ahead ((float*)(ws + WS_AHEAD))
#define atail ((float*)(ws + WS_ATAIL))
#define bhead ((float*)(ws + WS_BHEAD))
#define x1b ((bf16_t*)(ws + WS_X1B))
#define kcb ((bf16_t*)(ws + WS_KCB))
#define vcb ((bf16_t*)(ws + WS_VCB))
#define x2b ((bf16_t*)(ws + WS_X2B))
#define xb ((bf16_t*)(ws + WS_XB))
#define mqb ((bf16_t*)(ws + WS_MQB))
#define hff ((bf16_t*)(ws + WS_HFF))
#define uqkv ((bf16_t*)(ws + WS_UQKV))
#define mo ((bf16_t*)(ws + WS_MO))
#define mix ((bf16_t*)(ws + WS_MIX))
#define memb ((bf16_t*)(ws + WS_MEMB))
#define ub uqkv
#define qb (uqkv + (size_t)MT * 512)
#define kb (uqkv + (size_t)2 * MT * 512)
#define vb (uqkv + (size_t)3 * MT * 512)
__global__ void __launch_bounds__(512, 2) fwd_kernel(Params p) {
    extern __shared__ __attribute__((aligned(16))) unsigned char lds_raw[];
    LAS unsigned char* L = (LAS unsigned char*)lds_raw;
    cg::grid_group grid = cg::this_grid();
    const int tid = threadIdx.x, lane = tid & 63, wave = __builtin_amdgcn_readfirstlane(tid >> 6);
    const int G = gridDim.x, bx = blockIdx.x;
    unsigned char* ws = p.ws; float* out = p.out;
    const float* x_prompt = p.in[0]; const float* x_sample = p.in[1];
    const int lo = p.ph_lo, hi_ph = p.ph_hi;
    unsigned* gbar = (unsigned*)ws; unsigned nbar = 0u;
    if (lo < 0) grid.sync();
#define IN(k) (lo <= (k) && (k) < hi_ph && ((PHMASK >> (k)) & 1))
#define GSYNC() do { asm volatile("s_waitcnt vmcnt(0)" ::: "memory"); __syncthreads(); \
        if (tid == 0) { __builtin_amdgcn_fence(__ATOMIC_RELEASE, "agent"); asm volatile("s_waitcnt vmcnt(0)" ::: "memory"); \
            nbar += (unsigned)G; __hip_atomic_fetch_add(gbar, 1u, __ATOMIC_RELAXED, __HIP_MEMORY_SCOPE_AGENT); \
            while (__hip_atomic_load(gbar, __ATOMIC_RELAXED, __HIP_MEMORY_SCOPE_AGENT) < nbar) __builtin_amdgcn_s_sleep(6); \
            __builtin_amdgcn_fence(__ATOMIC_ACQUIRE, "agent"); asm volatile("s_waitcnt vmcnt(0)" ::: "memory"); } \
        __syncthreads(); } while (0)
#define SEAM(k) do { if (IN(k) && IN((k) + 1)) GSYNC(); } while (0)

    if (IN(0)) {
        const int gw = bx * 8 + wave, NGW = G * 8;
        LAS float* scr = (LAS float*)(L + wave * 8448);
        LAS float* wf = (LAS float*)(L + 8 * 8448);
        {
            const float* w_in = p.in[11]; const float* g_mix = p.in[10];
            for (int i = tid; i < 8192; i += 512) { const int k = i >> 3, h = i & 7; wf[i] = w_in[(size_t)k * 2056 + 2048 + h] * g_mix[k]; }
        }
        __syncthreads();
        constexpr int I_IN = 16 * 64, I_SQ = 16 * 32, I_UP = 16 * 176, I_DN = 44 * 32;
        constexpr int NITEMS = I_IN + 5 * I_SQ + I_UP + I_DN;
        for (int it = gw; it < NITEMS; it += NGW) {
            int r = it;
            if (r < I_IN) { transpose_item<0>(p.in[11], 1024, 2056, 64, Wt_in, 0, p.in[10], scr, r, lane); continue; } r -= I_IN;
            if (r < I_SQ) { transpose_item<0>(p.in[15], 1024, 1024, 32, Wt_o, 0, nullptr, scr, r, lane); continue; } r -= I_SQ;
            if (r < I_SQ) { transpose_item<0>(p.in[18], 1024, 1024, 32, Wt_mq, 0, p.in[16], scr, r, lane); continue; } r -= I_SQ;
            if (r < I_SQ) { transpose_item<0>(p.in[19], 1024, 1024, 32, Wt_mkv, 0, p.in[17], scr, r, lane); continue; } r -= I_SQ;
            if (r < I_SQ) { transpose_item<0>(p.in[20], 1024, 1024, 32, Wt_mkv, 1024, p.in[17], scr, r, lane); continue; } r -= I_SQ;
            if (r < I_SQ) { transpose_item<0>(p.in[21], 1024, 1024, 32, Wt_mo, 0, nullptr, scr, r, lane); continue; } r -= I_SQ;
            if (r < I_UP) { transpose_item<1>(p.in[23], 1024, NUP, 176, Wt_up, 0, p.in[22], scr, r, lane); continue; } r -= I_UP;
            transpose_item<0>(p.in[26], DFF, 1024, 32, Wt_dn, 0, nullptr, scr, r, lane);
        }
        {
            const float* w_pool = p.in[13]; const float* pscale = p.in[14];
            for (int i = bx * 512 + tid; i < 4 * 128 * 128; i += G * 512) { const int g = i >> 14, d = (i >> 7) & 127, c = i & 127; Wt_pool[i] = (bf16_t)(cvt_pk_bf16(w_pool[(g * 128 + c) * 128 + d] * pscale[g * 128 + d], 0.f) & 0xffffu); }
        }
        for (int m = gw; m < MT; m += NGW) {
            const float* xr = (m < MP) ? x_prompt + (size_t)m * DM : x_sample + (size_t)(m - MP) * DM;
            float* lf = (m < MP) ? out + O_LFP + (size_t)m * 8 : out + O_LFS + (size_t)(m - MP) * 8;
            prepass_row(xr, xb + (size_t)m * DM, wf, p.in[12], lf, lane);
        }
        for (int m = gw; m < 8192; m += NGW) prepass_row(p.in[9] + (size_t)m * DM, memb + (size_t)m * DM, (const LAS float*)nullptr, nullptr, nullptr, lane);
        const size_t gtid = (size_t)bx * 512 + tid, gn = (size_t)G * 512;
        for (size_t i = gtid; i < (size_t)16 * 15 * 512 / 8; i += gn) { const size_t e8 = i * 8, bb = e8 / (15 * 512), rem = e8 - bb * 15 * 512; const float* sp = p.in[5] + e8; *(u32x4*)(usx + bb * 79 * 512 + rem) = pack8(*(const f32x4*)sp, *(const f32x4*)(sp + 4)); }
        cvt_flat(p.in[2], kcb, (size_t)16 * PAST * 512 / 8, gtid, gn);
        cvt_flat(p.in[3], vcb, (size_t)16 * PAST * 512 / 8, gtid, gn);
        cvt_flat(p.in[7], mkb + (size_t)8192 * 1024, (size_t)4096 * 1024 / 8, gtid, gn);
        cvt_flat(p.in[8], mvb + (size_t)8192 * 1024, (size_t)4096 * 1024 / 8, gtid, gn);
        __syncthreads();
    }
    SEAM(0);

    if (IN(1)) {
        if (wave == 0) { const int s = bx; if (s < 256) scan_seq(out + O_LFP + (size_t)(s >> 3) * SEQ * 8 + (s & 7), SEQ, out + O_LFP, 0, kbP + (size_t)s * SEQ, lane); }
        if (wave == 1 && bx < 128) { const int s = bx; scan_seq(p.in[4] + (size_t)(s >> 3) * PAST * 8 + (s & 7), PAST, out + O_LFS + (size_t)(s >> 3) * DSEQ * 8 + (s & 7), DSEQ, kbS + (size_t)s * (PAST + DSEQ), lane); }
        {
            pg8::Gemm g{xb, Wt_in, MT, 2048, 1024}; pg8::StaticOrder S; S.init(MT, 2048, G, bx);
            EpiIn E{uqkv, out, usx};
            pg8::gemm_phase<EpiIn, pg8::StaticOrder, true, true>(L, g, S, E);
        }
        __syncthreads();
        {
            pg8::Gemm g{memb, Wt_mkv, 8192, 2048, 1024}; pg8::StaticOrder S; S.init(8192, 2048, G, bx);
            EpiMkv E{mkb, mvb, out};
            pg8::gemm_phase<EpiMkv, pg8::StaticOrder, true, true>(L, g, S, E);
        }
    }
    SEAM(1);

    if (IN(2)) {
        for (int it = 0; it < 8 * ((256 + G - 1) / G); ++it) {
            int bh, qk;
            if (G == 256) { const int xcd = bx & 7, l = bx >> 3, r = it >> 1, pi = l & 3; bh = xcd * 32 + r * 8 + (l >> 2); qk = (it & 1) ? pi : 7 - pi; }
            else { bh = bx + (it >> 3) * G; qk = 7 - (it & 7); if (bh >= 256) break; }
            const int b = bh >> 3, h = bh & 7;
            const bf16_t* Kh = kb + (size_t)b * SEQ * 512 + h * 64; const bf16_t* Vh = vb + (size_t)b * SEQ * 512 + h * 64;
            const size_t r0 = (size_t)b * SEQ + 256 * qk;
            attn_unit<64, 64, 1, true, false, true, true>(L, qb + r0 * 512 + h * 64, 512, 256, Kh, Vh, 4 * qk + 4, Kh, Vh, 512, 4 * qk + 4, kbP + (size_t)bh * SEQ, 256 * qk, mix + r0 * DM + 512 + h * 64, DM);
        }
        if (P2_ATTN_S) for (int bh = bx; bh < 128; bh += G) {
            const int b = bh >> 3, h = bh & 7;
            const size_t r0 = (size_t)MP + b * DSEQ;
            attn_unit<64, 64, 4, true, false, true, true>(L, qb + r0 * 512 + h * 64, 512, 64, kcb + (size_t)b * PAST * 512 + h * 64, vcb + (size_t)b * PAST * 512 + h * 64, 64,
                                      kb + r0 * 512 + h * 64, vb + r0 * 512 + h * 64, 512, 65, kbS + (size_t)bh * (PAST + DSEQ), PAST, mix + r0 * DM + 512 + h * 64, DM);
        }
        for (int t = bx; t < MT / 256; t += G) pool_unit(t, ub, usx, Wt_pool, mix);
        if (G == 256 && bx >= 128 && bx < 132) {}
        __syncthreads();
    }
    SEAM(2);

    if (IN(3)) {
        pg8::Gemm g{mix, Wt_o, MT, 1024, 1024}; pg8::StaticOrder S; S.init(MT, 1024, G, bx);
        EpiRes<0> E{x_prompt, x_sample, nullptr, x1b, nullptr, ssq1};
        pg8::gemm_phase<EpiRes<0>, pg8::StaticOrder, true, true>(L, g, S, E);
    }
    SEAM(3);

    if (IN(4)) {
        pg8::Gemm g{x1b, Wt_mq, MT, 1024, 1024}; pg8::StaticOrder S; S.init(MT, 1024, G, bx);
        EpiMq E{ssq1, mqb};
        pg8::gemm_phase<EpiMq, pg8::StaticOrder, true, true>(L, g, S, E);
    }
    SEAM(4);

    if (IN(5)) {
        for (int k5 = 0; k5 * G < 2048 + 64; ++k5) {
            const int un = (G == 256 && k5 < 8) ? (((k5 * 8 + (bx & 7)) * 32) + (bx >> 3)) : (k5 * G + bx);
            if (un >= 2048 + 64) break;
            if (un < 2048) {
                const int b = un >> 6, h = (un >> 4) & 3, qk = un & 15;
                const size_t r0 = (size_t)b * SEQ + 128 * qk;
                const bf16_t* Kh = mkb + (size_t)b * NMEM * 1024 + h * 256; const bf16_t* Vh = mvb + (size_t)b * NMEM * 1024 + h * 256;
                attn_unit<256, 32, 2, false, true, false, false>(L, mqb + r0 * DM + h * 256, DM, 128, Kh, Vh, 8, Kh, Vh, 1024, 8, nullptr, 0, mo + r0 * DM + h * 256, DM);
            } else {
                const int us = un - 2048, b = us >> 2, h = us & 3;
                const size_t r0 = (size_t)MP + b * DSEQ;
                const bf16_t* Kh = mkb + (size_t)(8192 + b * NMEM) * 1024 + h * 256; const bf16_t* Vh = mvb + (size_t)(8192 + b * NMEM) * 1024 + h * 256;
                attn_unit<256, 32, 2, false, true, false, false>(L, mqb + r0 * DM + h * 256, DM, 64, Kh, Vh, 8, Kh, Vh, 1024, 8, nullptr, 0, mo + r0 * DM + h * 256, DM);
            }
        }
        __syncthreads();
    }
    SEAM(5);

    if (IN(6)) {
        pg8::Gemm g{mo, Wt_mo, MT, 1024, 1024}; pg8::StaticOrder S; S.init(MT, 1024, G, bx);
        EpiRes<1> E{nullptr, nullptr, x1b, x2b, nullptr, ssq2};
        pg8::gemm_phase<EpiRes<1>, pg8::StaticOrder, true, true>(L, g, S, E);
    }
    SEAM(6);

    if (IN(7)) {
        pg8::Gemm g{x2b, Wt_up, MT, NUP, 1024}; pg8::StaticOrder S; S.init(MT, NUP, G, bx);
        EpiUp E{ssq2, p.in[24], p.in[25], hff, ahead, atail, bhead};
        pg8::gemm_phase<EpiUp, pg8::StaticOrder, true, true>(L, g, S, E);
    }
    SEAM(7);

    if (IN(8)) {
        const float* cw = p.in[24]; const float* cbias = p.in[25]; const float* chist = p.in[6];
        const int total4 = NSEG * 2 * (DFF / 4);
        for (int idx = bx * 512 + tid; idx < total4; idx += G * 512) {
            const int seg = idx / (2 * (DFF / 4)), rem = idx - seg * 2 * (DFF / 4), i = rem / (DFF / 4), c = (rem - i * (DFF / 4)) * 4;
            f32x4 prev1, prev2;
            if (seg < MP / 64) { if ((seg & 31) == 0) { prev1 = (f32x4){0.f, 0.f, 0.f, 0.f}; prev2 = prev1; } else { prev1 = *(const f32x4*)(atail + ((size_t)(seg - 1) * 2 + 1) * DFF + c); prev2 = *(const f32x4*)(atail + ((size_t)(seg - 1) * 2) * DFF + c); } }
            else { const int b = seg - MP / 64; prev1 = *(const f32x4*)(chist + ((size_t)b * 2 + 1) * DFF + c); prev2 = *(const f32x4*)(chist + ((size_t)b * 2) * DFF + c); }
            const f32x4 a_0 = *(const f32x4*)(ahead + ((size_t)seg * 2) * DFF + c);
            f32x4 am1, am2, a0;
            if (i == 0) { am1 = prev1; am2 = prev2; a0 = a_0; } else { am1 = a_0; am2 = prev1; a0 = *(const f32x4*)(ahead + ((size_t)seg * 2 + 1) * DFF + c); }
            const f32x4 cv = *(const f32x4*)(cbias + c) + *(const f32x4*)(cw + c) * am2 + *(const f32x4*)(cw + DFF + c) * am1 + *(const f32x4*)(cw + 2 * DFF + c) * a0;
            const f32x4 bh = *(const f32x4*)(bhead + ((size_t)seg * 2 + i) * DFF + c);
            f32x4 hv;
#pragma unroll
            for (int e = 0; e < 4; ++e) hv[e] = cv[e] / (1.0f + __builtin_amdgcn_exp2f(-cv[e] * LOG2E)) * bh[e];
            u32x2 w; w.x = cvt_pk_bf16(hv[0], hv[1]); w.y = cvt_pk_bf16(hv[2], hv[3]);
            *(u32x2*)(hff + ((size_t)seg * 64 + i) * DFF + c) = w;
        }
        for (int idx = bx * 512 + tid; idx < 48 * 2 * DFF; idx += G * 512) {
            const int bb = idx / (2 * DFF), rem = idx - bb * 2 * DFF;
            if (bb < 32) out[O_CSP + (size_t)bb * 2 * DFF + rem] = atail[((size_t)(32 * bb + 31) * 2) * DFF + rem];
            else out[O_CSS + (size_t)(bb - 32) * 2 * DFF + rem] = atail[((size_t)(MP / 64 + bb - 32) * 2) * DFF + rem];
        }
    }
    SEAM(8);

    if (IN(9)) {
        pg8::Gemm g{hff, Wt_dn, MT, 1024, DFF}; pg8::StaticOrder S; S.init(MT, 1024, G, bx);
        EpiRes<2> E{nullptr, nullptr, x2b, nullptr, out, ssq3};
        pg8::gemm_phase<EpiRes<2>, pg8::StaticOrder, true, true>(L, g, S, E);
    }
    SEAM(9);

    if (IN(10)) {
        const float* gf = p.in[27];
        const int gw = bx * 8 + wave, NGW = G * 8;
        f32x4 gv[4];
#pragma unroll
        for (int j = 0; j < 4; ++j) gv[j] = ((const f32x4*)gf)[lane + 64 * j];
        for (int m0 = gw; m0 < MT; m0 += 4 * NGW) {
            f32x4 v[4][4]; float r[4];
#pragma unroll
            for (int q = 0; q < 4; ++q) { const int m = m0 + q * NGW; if (m < MT) { const f32x4* y4 = (const f32x4*)(out + (size_t)m * DM) + lane; r[q] = row_rsq(ssq3, m);
#pragma unroll
                    for (int j = 0; j < 4; ++j) v[q][j] = y4[64 * j]; } }
#pragma unroll
            for (int q = 0; q < 4; ++q) { const int m = m0 + q * NGW; if (m < MT) { f32x4* y4 = (f32x4*)(out + (size_t)m * DM) + lane;
#pragma unroll
                    for (int j = 0; j < 4; ++j) y4[64 * j] = v[q][j] * r[q] * gv[j]; } }
        }
    }
#ifdef DBG_DUMP
    {
        GSYNC();
        const bf16_t* src = nullptr; int pitch = 1024;
        if (hi_ph == 2) src = uqkv; else if (hi_ph == 3) src = mix; else if (hi_ph == 4) src = x1b; else if (hi_ph == 5) src = mqb; else if (hi_ph == 6) src = mo; else if (hi_ph == 7) src = x2b; else if (hi_ph == 8 || hi_ph == 9) { src = hff; pitch = DFF; }
        if (src) for (size_t i = (size_t)bx * 512 + tid; i < (size_t)MT * 1024; i += (size_t)G * 512) { const size_t m = i >> 10, c = i & 1023; float v = __builtin_bit_cast(float, (unsigned)src[m * pitch + c] << 16); if (!(v == v)) v = 12345.f; if (fabsf(v) > 1e30f) v = 54321.f; out[i] = v; }
    }
#endif
#undef IN
#undef SEAM
}

extern "C" void kernel_launch(void* const* d_in, const int* in_sizes, int n_in, void* d_out, int out_size, void* d_ws, size_t ws_size, hipStream_t stream) {
    static int grid = 0;
    if (grid == 0) {
        if (n_in != 28 || (size_t)out_size != O_END || ws_size < WS_NEED) { fprintf(stderr, "kernel_launch: unexpected shapes (n_in %d, out %d, ws %zu); nothing launched\n", n_in, out_size, ws_size); grid = -1; return; }
        int dev = 0, cus = 0, per_cu = 0;
        hipGetDevice(&dev); hipDeviceGetAttribute(&cus, hipDeviceAttributeMultiprocessorCount, dev);
        hipFuncSetAttribute((const void*)fwd_kernel, hipFuncAttributeMaxDynamicSharedMemorySize, LDS_BYTES);
        hipOccupancyMaxActiveBlocksPerMultiprocessor(&per_cu, (const void*)fwd_kernel, 512, LDS_BYTES);
        if (per_cu < 1) { fprintf(stderr, "kernel_launch: occupancy query says %d blocks per CU\n", per_cu); per_cu = 1; }
        (void)hipGetLastError();
        grid = cus;
    }
    if (grid < 0) return;
    (void)hipMemsetAsync(d_ws, 0, 256, stream);
    Params p{};
    for (int i = 0; i < 28; ++i) p.in[i] = (const float*)d_in[i];
    p.out = (float*)d_out; p.ws = (unsigned char*)d_ws;
    void* args[] = {&p};
#ifdef PROBE_K
    p.ph_lo = 0; p.ph_hi = PROBE_K + 1;
    (void)hipLaunchCooperativeKernel((const void*)fwd_kernel, dim3(grid), dim3(512), args, LDS_BYTES, stream);
    (void)hipMemsetAsync(d_ws, 0, 256, stream);
    p.ph_lo = PROBE_K; p.ph_hi = 11;
#else
    p.ph_lo = 0; p.ph_hi = 11;
#endif
    hipError_t e = hipLaunchCooperativeKernel((const void*)fwd_kernel, dim3(grid), dim3(512), args, LDS_BYTES, stream);
    if (e != hipSuccess) fprintf(stderr, "cooperative launch failed: %s (grid %d)\n", hipGetErrorString(e), grid);
}
```

```cpp
#include <hip/hip_runtime.h>
#include <hip/hip_cooperative_groups.h>
#include <cstdio>
#include <cstdint>
namespace cg = cooperative_groups;
namespace pg8 {
#define PG8_LAS __attribute__((address_space(3)))
typedef unsigned short bf16_t;
typedef short bf16x8 __attribute__((ext_vector_type(8)));
typedef float f32x4 __attribute__((ext_vector_type(4)));
typedef unsigned u32x4 __attribute__((ext_vector_type(4)));
constexpr int BM = 256, BK = 64, HALF = 128, HTB = HALF * BK * 2  , STAGE_BYTES = 8 * HTB, NXCD = 8, WGM = 8;

__host__ __device__ __forceinline__ int lds_byte(int r, int c) { const int st = (r >> 4) * 2 + (c >> 5), rr = r & 15, cc = c & 31, ob = rr * 64 + cc * 2; return st * 1024 + (ob ^ (((ob >> 9) & 1) << 5)); }
__host__ __device__ __forceinline__ void stage_rc(int b, int& R, int& C) { const int st = b / 1024, sb = b % 1024, swz = sb ^ (((sb >> 9) & 1) << 5); R = (st >> 1) * 16 + swz / 64; C = (st & 1) * 32 + (swz % 64) / 2; }
__host__ __device__ __forceinline__ int perm32(int rho) { const int n = rho >> 4, i = rho & 15; return 8 * (i >> 2) + 4 * n + (i & 3); }

struct Unit { int pm, pn; };
struct Gemm { const bf16_t* A; const bf16_t* Bt; int M, N, K; };

struct StaticOrder {
    int nM, nN, nwg, G, c;
    __host__ __device__ void init(int M, int N, int G_, int c_) { nM = M / BM; nN = N / BM; nwg = nM * nN; G = G_; c = c_; }
    __host__ __device__ bool next(int i, Unit& u) const {
        const long L = (long)i * G + c; if (L >= nwg) return false;
        int wgid = (int)L; { const int q = nwg / NXCD, r = nwg % NXCD, xcd = wgid % NXCD, off = wgid / NXCD; wgid = (xcd < r ? xcd * (q + 1) : r * (q + 1) + (xcd - r) * q) + off; }
        const int nig = WGM * nN, gid = wgid / nig, fm = gid * WGM, gsz = (nM - fm) < WGM ? (nM - fm) : WGM;
        u.pm = fm + ((wgid % nig) % gsz); u.pn = (wgid % nig) / gsz; return true;
    }
    __device__ __forceinline__ void a_ready(const Unit&) const {}
    __device__ __forceinline__ void done(const Unit&) const {}
};

__device__ __forceinline__ unsigned cvt_pk_bf16(float lo, float hi) { unsigned r; asm volatile("v_cvt_pk_bf16_f32 %0, %1, %2" : "=v"(r) : "v"(lo), "v"(hi)); return r; }
typedef float f32x2 __attribute__((ext_vector_type(2)));
template <class Epi, class Sched, bool ALIGN_EPI = false, bool SP2 = false>
__device__ __forceinline__ void gemm_phase(PG8_LAS unsigned char* lds, const Gemm g, const Sched& S, const Epi& E) {
    const int tid = threadIdx.x, wid = __builtin_amdgcn_readfirstlane(tid >> 6), lane = tid & 63, wr = wid >> 2, wc = wid & 3, fr = lane & 15, fq = lane >> 4;
    const int K = g.K, nt = K / BK;
    unsigned voffA[2], voffB[2];
#pragma unroll
    for (int i = 0; i < 2; ++i) { int R, C; stage_rc(tid * 16 + i * 8192, R, C); const int Rb = Epi::PERM ? ((R & ~31) + perm32(R & 31)) : R;
        voffA[i] = (unsigned)(R * K + C) * 2u; voffB[i] = (unsigned)(Rb * K + C) * 2u; }
    const size_t kstep = (size_t)(BK * 2);
    const size_t hstep = (size_t)HALF * K * 2;
    const size_t tstep = 2 * hstep;
    const unsigned ldsw = (unsigned)wid * 1024u;
    const int aoff = lds_byte(wr * 64 + fr, fq * 8), boff = lds_byte(wc * 32 + fr, fq * 8);
#define PG8_SA(b, h) (((b) * 2 + (h)) * HTB)
#define PG8_SB(b, h) ((4 + (b) * 2 + (h)) * HTB)
#define PG8_STAGE(bufoff, gbase, voff) do { _Pragma("unroll") for (int _i = 0; _i < 2; ++_i) \
        __builtin_amdgcn_global_load_lds((const unsigned*)((const char*)(gbase) + (voff)[_i]), (PG8_LAS unsigned*)(lds + (bufoff) + ldsw + _i * 8192), 16, 0, 0); } while (0)
#define PG8_LDA(dst, b, h) do { _Pragma("unroll") for (int m = 0; m < 4; ++m) _Pragma("unroll") for (int k = 0; k < 2; ++k) dst[m][k] = *(const PG8_LAS bf16x8*)(lds + PG8_SA(b, h) + aoff + m * 2048 + k * 1024); } while (0)
#define PG8_LDB(dst, b, h) do { _Pragma("unroll") for (int n = 0; n < 2; ++n) _Pragma("unroll") for (int k = 0; k < 2; ++k) dst[n][k] = *(const PG8_LAS bf16x8*)(lds + PG8_SB(b, h) + boff + n * 2048 + k * 1024); } while (0)
#define PG8_MMA(ai, bj, At, Bt) do { __builtin_amdgcn_s_setprio(1); _Pragma("unroll") for (int m = 0; m < 4; ++m) _Pragma("unroll") for (int n = 0; n < 2; ++n) _Pragma("unroll") for (int k = 0; k < 2; ++k) \
        acc[ai][bj][m][n] = __builtin_amdgcn_mfma_f32_16x16x32_bf16(Bt[n][k], At[m][k], acc[ai][bj][m][n], 0, 0, 0); __builtin_amdgcn_s_setprio(0); } while (0)
#define PG8_WAIT_V(n) asm volatile("s_waitcnt vmcnt(" #n ")" ::: "memory")
#define PG8_WAIT_L(n) asm volatile("s_waitcnt lgkmcnt(" #n ")" ::: "memory")
#define PG8_BAR __builtin_amdgcn_s_barrier()
#define PG8_SCHED __builtin_amdgcn_sched_barrier(0)
    Unit cur, nxt; int ui = 0;
    if (!S.next(0, cur)) return;
    f32x4 acc[2][2][4][2];
#pragma unroll
    for (int a = 0; a < 2; ++a)
#pragma unroll
        for (int b = 0; b < 2; ++b)
#pragma unroll
            for (int m = 0; m < 4; ++m)
#pragma unroll
                for (int n = 0; n < 2; ++n) acc[a][b][m][n] = (f32x4){0.f, 0.f, 0.f, 0.f};
    bf16x8 At[4][2], B0[2][2], B1[2][2];
    const char* cA = (const char*)g.A + (size_t)cur.pm * tstep; const char* cB = (const char*)g.Bt + (size_t)cur.pn * tstep;
    S.a_ready(cur);
    if constexpr (SP2) {
        PG8_STAGE(PG8_SB(0, 0), cB, voffB); PG8_STAGE(PG8_SB(0, 1), cB + hstep, voffB); PG8_STAGE(PG8_SA(0, 0), cA, voffA); PG8_STAGE(PG8_SA(0, 1), cA + hstep, voffA);
        if (wr == 1) PG8_BAR;
        PG8_WAIT_V(2); PG8_BAR;
        PG8_STAGE(PG8_SB(1, 0), cB + kstep, voffB); PG8_STAGE(PG8_SA(1, 0), cA + kstep, voffA); PG8_STAGE(PG8_SB(1, 1), cB + hstep + kstep, voffB);
        PG8_WAIT_V(6); PG8_BAR;
    } else {
        PG8_STAGE(PG8_SB(0, 0), cB, voffB); PG8_STAGE(PG8_SA(0, 0), cA, voffA); PG8_STAGE(PG8_SB(0, 1), cB + hstep, voffB); PG8_STAGE(PG8_SA(0, 1), cA + hstep, voffA);
        if (wr == 1) PG8_BAR;
        PG8_WAIT_V(4); PG8_BAR;
        PG8_STAGE(PG8_SB(1, 0), cB + kstep, voffB); PG8_STAGE(PG8_SA(1, 0), cA + kstep, voffA); PG8_STAGE(PG8_SB(1, 1), cB + hstep + kstep, voffB);
        PG8_WAIT_V(6); PG8_BAR;
    }
    for (;;) {
        const bool has_next = S.next(ui + 1, nxt);
        const char* nA = has_next ? (const char*)g.A + (size_t)nxt.pm * tstep : cA; const char* nB = has_next ? (const char*)g.Bt + (size_t)nxt.pn * tstep : cB;
        for (int t = 0; t < nt; t += 2) {
            const bool last = (t == nt - 2);
            const char* a1 = cA + (size_t)(t + 1) * kstep;
            const char* a2 = last ? nA : cA + (size_t)(t + 2) * kstep; const char* b2 = last ? nB : cB + (size_t)(t + 2) * kstep;
            const char* a3 = a2 + kstep; const char* b3 = b2 + kstep;
            if (last && has_next) S.a_ready(nxt);
            if constexpr (SP2) {
            PG8_LDB(B0, 0, 0); PG8_LDB(B1, 0, 1); PG8_SCHED; PG8_LDA(At, 0, 0); PG8_STAGE(PG8_SA(1, 1), a1 + hstep, voffA);
            PG8_WAIT_V(8); PG8_WAIT_L(0); PG8_BAR; PG8_MMA(0, 0, At, B0); PG8_MMA(0, 1, At, B1); PG8_BAR; PG8_SCHED;
            PG8_LDA(At, 0, 1); PG8_STAGE(PG8_SB(0, 0), b2, voffB); PG8_STAGE(PG8_SB(0, 1), b2 + hstep, voffB); PG8_STAGE(PG8_SA(0, 0), a2, voffA);
            PG8_WAIT_V(8); PG8_WAIT_L(0); PG8_BAR; PG8_MMA(1, 0, At, B0); PG8_MMA(1, 1, At, B1); PG8_BAR; PG8_SCHED;
            PG8_LDB(B0, 1, 0); PG8_LDB(B1, 1, 1); PG8_SCHED; PG8_LDA(At, 1, 0); PG8_STAGE(PG8_SA(0, 1), a2 + hstep, voffA);
            PG8_WAIT_V(8); PG8_WAIT_L(0); PG8_BAR; PG8_MMA(0, 0, At, B0); PG8_MMA(0, 1, At, B1); PG8_BAR; PG8_SCHED;
            PG8_LDA(At, 1, 1); PG8_STAGE(PG8_SB(1, 0), b3, voffB); PG8_STAGE(PG8_SB(1, 1), b3 + hstep, voffB); PG8_STAGE(PG8_SA(1, 0), a3, voffA);
            PG8_WAIT_V(8); PG8_WAIT_L(0); PG8_BAR; PG8_MMA(1, 0, At, B0); PG8_MMA(1, 1, At, B1); PG8_BAR; PG8_SCHED;
            } else {
            PG8_LDB(B0, 0, 0); PG8_SCHED; PG8_LDA(At, 0, 0); PG8_STAGE(PG8_SA(1, 1), a1 + hstep, voffA);
            PG8_WAIT_L(8); PG8_BAR; PG8_WAIT_L(0); PG8_MMA(0, 0, At, B0); PG8_BAR; PG8_SCHED;
            PG8_LDB(B1, 0, 1); PG8_STAGE(PG8_SB(0, 0), b2, voffB);
            PG8_BAR; PG8_WAIT_L(0); PG8_MMA(0, 1, At, B1); PG8_BAR;
            PG8_LDA(At, 0, 1); PG8_STAGE(PG8_SA(0, 0), a2, voffA);
            PG8_BAR; PG8_WAIT_L(0); PG8_MMA(1, 0, At, B0); PG8_BAR; PG8_SCHED;
            PG8_STAGE(PG8_SB(0, 1), b2 + hstep, voffB);
            PG8_WAIT_V(6); PG8_BAR; PG8_MMA(1, 1, At, B1); PG8_BAR;
            PG8_LDB(B0, 1, 0); PG8_SCHED; PG8_LDA(At, 1, 0); PG8_STAGE(PG8_SA(0, 1), a2 + hstep, voffA);
            PG8_WAIT_L(8); PG8_BAR; PG8_WAIT_L(0); PG8_MMA(0, 0, At, B0); PG8_BAR; PG8_SCHED;
            PG8_LDB(B1, 1, 1); PG8_STAGE(PG8_SB(1, 0), b3, voffB);
            PG8_BAR; PG8_WAIT_L(0); PG8_MMA(0, 1, At, B1); PG8_BAR;
            PG8_LDA(At, 1, 1); PG8_STAGE(PG8_SA(1, 0), a3, voffA);
            PG8_BAR; PG8_WAIT_L(0); PG8_MMA(1, 0, At, B0); PG8_BAR; PG8_SCHED;
            PG8_STAGE(PG8_SB(1, 1), b3 + hstep, voffB);
            PG8_WAIT_V(6); PG8_BAR; PG8_MMA(1, 1, At, B1); PG8_BAR;
            }
        }
        if constexpr (ALIGN_EPI) { if (wr == 0) PG8_BAR; }
        if constexpr (!Epi::AFTER_DRAIN) { E(acc, cur, wr, wc, fr, fq); S.done(cur); }
        if (!has_next) break;
#pragma unroll
        for (int a = 0; a < 2; ++a)
#pragma unroll
            for (int b = 0; b < 2; ++b)
#pragma unroll
                for (int m = 0; m < 4; ++m)
#pragma unroll
                    for (int n = 0; n < 2; ++n) acc[a][b][m][n] = (f32x4){0.f, 0.f, 0.f, 0.f};
        cur = nxt; cA = nA; cB = nB; ++ui;
        if constexpr (ALIGN_EPI) { if (wr == 1) PG8_BAR; }
    }
    PG8_WAIT_V(0);
    if constexpr (!ALIGN_EPI) { if (wr == 0) PG8_BAR; }
    PG8_BAR;
    if constexpr (Epi::AFTER_DRAIN) { E.fused(acc, cur, wr, wc, fr, fq, lds, wid, lane); S.done(cur); }
#undef PG8_SA
#undef PG8_SB
#undef PG8_STAGE
#undef PG8_LDA
#undef PG8_LDB
#undef PG8_MMA
#undef PG8_WAIT_V
#undef PG8_WAIT_L
#undef PG8_BAR
#undef PG8_SCHED
}
}

using pg8::bf16_t; using pg8::bf16x8; using pg8::f32x4; using pg8::u32x4; using pg8::Unit;
typedef float f32x2_t __attribute__((ext_vector_type(2))); typedef __bf16 bf16x2_t __attribute__((ext_vector_type(2)));
__device__ __forceinline__ unsigned cvt_pk_bf16(float lo, float hi) { f32x2_t v = {lo, hi}; bf16x2_t b = __builtin_convertvector(v, bf16x2_t); return __builtin_bit_cast(unsigned, b); }
typedef float f32x16 __attribute__((ext_vector_type(16)));
typedef unsigned u32x2 __attribute__((ext_vector_type(2)));
#define LAS __attribute__((address_space(3)))

constexpr int DM = 1024, MP = 65536, MS = 1024, MT = MP + MS, SEQ = 2048, DSEQ = 64, PAST = 4096, NMEM = 256;
constexpr int DFF = 2816, NUP = 2 * DFF, NSEG = MT / 64;
constexpr float EPS = 1e-6f, LOG2E = 1.4426950408889634f;
constexpr float C2F = 0.125f * LOG2E, C2M = 0.0625f * LOG2E;
constexpr float NEGBIG = -1e30f;

constexpr size_t O_YP = 0, O_YS = O_YP + (size_t)MP * DM, O_KP = O_YS + (size_t)MS * DM, O_VP = O_KP + (size_t)MP * 512, O_LFP = O_VP + (size_t)MP * 512,
    O_PSP = O_LFP + (size_t)MP * 8, O_CSP = O_PSP + 32 * 15 * 512, O_MKP = O_CSP + 32 * 2 * DFF, O_MVP = O_MKP + (size_t)8192 * 1024, O_KS = O_MVP + (size_t)8192 * 1024,
    O_VS = O_KS + (size_t)MS * 512, O_LFS = O_VS + (size_t)MS * 512, O_PSS = O_LFS + MS * 8, O_CSS = O_PSS + 16 * 15 * 512, O_END = O_CSS + 16 * 2 * DFF;

constexpr size_t MiB = 1u << 20;
constexpr size_t WS_WIN = 1 * MiB, WS_WO = 5 * MiB, WS_WMQ = 7 * MiB, WS_WMO = 9 * MiB, WS_WMKV = 11 * MiB, WS_WUP = 15 * MiB, WS_WDN = 26 * MiB, WS_WPOOL = 32 * MiB;
constexpr size_t WS_USX = 34 * MiB;
constexpr size_t WS_MKB = 40 * MiB, WS_MVB = 64 * MiB;
constexpr size_t WS_SSQ1 = 88 * MiB, WS_SSQ2 = 93 * MiB, WS_SSQ3 = 98 * MiB;
constexpr size_t WS_KBP = 103 * MiB, WS_KBS = 105 * MiB;
constexpr size_t WS_AHEAD = 108 * MiB, WS_ATAIL = WS_AHEAD + 23 * MiB / 1 - MiB / 2, WS_BHEAD = WS_ATAIL + 23 * MiB - MiB / 2;
constexpr size_t WS_X1B = 176 * MiB, WS_KCB = 176 * MiB, WS_VCB = 240 * MiB;
constexpr size_t WS_X2B = 306 * MiB;
constexpr size_t WS_XB = 436 * MiB, WS_MQB = 436 * MiB, WS_HFF = 436 * MiB;
constexpr size_t WS_UQKV = 566 * MiB, WS_MO = 566 * MiB;
constexpr size_t WS_MIX = 826 * MiB, WS_MEMB = 956 * MiB, WS_NEED = 972 * MiB;
static_assert((size_t)NSEG * 2 * DFF * 4 <= 22 * MiB + MiB / 2, "side buffers");
static_assert(WS_BHEAD + 22 * MiB + MiB / 2 <= WS_X1B, "side buffers end");

#define P2_ATTN_P 1
#define P2_ATTN_S 1
#define P2_POOL 1
#define DBG_HI 11
#ifndef PHMASK
#define PHMASK 0x7ff
#endif
constexpr int LDS_BYTES = 147456;

struct Params { const float* in[28]; float* out; unsigned char* ws; int ph_lo, ph_hi; };

__device__ __forceinline__ float bf_lo(unsigned w) { return __builtin_bit_cast(float, w << 16); }
__device__ __forceinline__ float bf_hi(unsigned w) { return __builtin_bit_cast(float, w & 0xffff0000u); }
__device__ __forceinline__ int crow(int r, int hi) { return (r & 3) + 8 * (r >> 2) + 4 * hi; }
__device__ __forceinline__ float wave_sum(float v) {
#pragma unroll
    for (int o = 1; o < 64; o <<= 1) v += __shfl_xor(v, o);
    return v;
}
__device__ __forceinline__ float rsq(float ssq) { return 1.0f / sqrtf(ssq * (1.0f / 1024.0f) + EPS); }
#define LDS_WAIT() asm volatile("s_waitcnt lgkmcnt(0)" ::: "memory")

typedef const f32x4 (&AccRef)[2][2][4][2];

__device__ __forceinline__ u32x4 pack8(f32x4 v0, f32x4 v1) { u32x4 w; w.x = cvt_pk_bf16(v0[0], v0[1]); w.y = cvt_pk_bf16(v0[2], v0[3]); w.z = cvt_pk_bf16(v1[0], v1[1]); w.w = cvt_pk_bf16(v1[2], v1[3]); return w; }

struct EpiIn {
    static constexpr bool PERM = true, AFTER_DRAIN = false;
    bf16_t* uqkv; float* out; bf16_t* usx;
    __device__ __forceinline__ void operator()(AccRef acc, const Unit& u, int wr, int wc, int fr, int fq) const {
        const int t = u.pn >> 1;
        const int col0 = (u.pn & 1) * 256 + wc * 32 + 8 * fq;
        bf16_t* base = uqkv + (size_t)t * MT * 512;
        const float sc = (t == 1) ? C2F : 1.0f;
#pragma unroll
        for (int ai = 0; ai < 2; ++ai)
#pragma unroll
            for (int m = 0; m < 4; ++m) {
                const int row = u.pm * 256 + ai * 128 + wr * 64 + m * 16 + fr;
#pragma unroll
                for (int bj = 0; bj < 2; ++bj) {
                    const int col = col0 + bj * 128;
                    const f32x4 v0 = acc[ai][bj][m][0] * sc, v1 = acc[ai][bj][m][1] * sc;
                    *(u32x4*)(base + (size_t)row * 512 + col) = pack8(v0, v1);
                    if (t >= 2) {
                        float* o = (row < MP) ? out + (t == 2 ? O_KP : O_VP) + (size_t)row * 512 : out + (t == 2 ? O_KS : O_VS) + (size_t)(row - MP) * 512;
                        *(f32x4*)(o + col) = v0; *(f32x4*)(o + col + 4) = v1;
                    } else if (t == 0) {
                        if (row < MP) { const int tt = row & (SEQ - 1); if (tt >= SEQ - 15) { float* o = out + O_PSP + ((size_t)(row >> 11) * 15 + (tt - (SEQ - 15))) * 512 + col; *(f32x4*)o = v0; *(f32x4*)(o + 4) = v1; } }
                        else { const int rs = row - MP, tt = rs & 63; *(u32x4*)(usx + ((size_t)(rs >> 6) * 79 + 15 + tt) * 512 + col) = pack8(v0, v1); if (tt >= DSEQ - 15) { float* o = out + O_PSS + ((size_t)(rs >> 6) * 15 + (tt - (DSEQ - 15))) * 512 + col; *(f32x4*)o = v0; *(f32x4*)(o + 4) = v1; } }
                    }
                }
            }
    }
};
struct EpiMkv {
    static constexpr bool PERM = true, AFTER_DRAIN = false;
    bf16_t* mkb; bf16_t* mvb; float* out;
    __device__ __forceinline__ void operator()(AccRef acc, const Unit& u, int wr, int wc, int fr, int fq) const {
        const int t = u.pn >> 2;
        const int col0 = (u.pn & 3) * 256 + wc * 32 + 8 * fq;
        bf16_t* bb = t ? mvb : mkb; float* of = out + (t ? O_MVP : O_MKP);
#pragma unroll
        for (int ai = 0; ai < 2; ++ai)
#pragma unroll
            for (int m = 0; m < 4; ++m) {
                const int row = u.pm * 256 + ai * 128 + wr * 64 + m * 16 + fr;
#pragma unroll
                for (int bj = 0; bj < 2; ++bj) {
                    const int col = col0 + bj * 128;
                    const f32x4 v0 = acc[ai][bj][m][0], v1 = acc[ai][bj][m][1];
                    *(u32x4*)(bb + (size_t)row * 1024 + col) = pack8(v0, v1);
                    *(f32x4*)(of + (size_t)row * 1024 + col) = v0; *(f32x4*)(of + (size_t)row * 1024 + col + 4) = v1;
                }
            }
    }
};
template <int MODE> struct EpiRes {
    static constexpr bool PERM = true, AFTER_DRAIN = false;
    const float* xP; const float* xS; const bf16_t* resB; bf16_t* xo; float* yo; float* ssqp;
    __device__ __forceinline__ void operator()(AccRef acc, const Unit& u, int wr, int wc, int fr, int fq) const {
        const int col0 = u.pn * 256 + wc * 32 + 8 * fq;
#pragma unroll
        for (int ai = 0; ai < 2; ++ai)
#pragma unroll
            for (int m = 0; m < 4; ++m) {
                const int row = u.pm * 256 + ai * 128 + wr * 64 + m * 16 + fr;
                float ss = 0.f;
#pragma unroll
                for (int bj = 0; bj < 2; ++bj) {
                    const int col = col0 + bj * 128;
                    f32x4 r0, r1;
                    if (MODE == 0) { const float* xr = (row < MP) ? xP + (size_t)row * DM : xS + (size_t)(row - MP) * DM; r0 = *(const f32x4*)(xr + col); r1 = *(const f32x4*)(xr + col + 4); }
                    else { const u32x4 w = *(const u32x4*)(resB + (size_t)row * DM + col); r0 = (f32x4){bf_lo(w.x), bf_hi(w.x), bf_lo(w.y), bf_hi(w.y)}; r1 = (f32x4){bf_lo(w.z), bf_hi(w.z), bf_lo(w.w), bf_hi(w.w)}; }
                    const f32x4 v0 = acc[ai][bj][m][0] + r0, v1 = acc[ai][bj][m][1] + r1;
                    ss += (v0[0] * v0[0] + v0[1] * v0[1]) + (v0[2] * v0[2] + v0[3] * v0[3]) + (v1[0] * v1[0] + v1[1] * v1[1]) + (v1[2] * v1[2] + v1[3] * v1[3]);
                    if (MODE == 2) { float* yr = (row < MP) ? yo + O_YP + (size_t)row * DM : yo + O_YS + (size_t)(row - MP) * DM; *(f32x4*)(yr + col) = v0; *(f32x4*)(yr + col + 4) = v1; }
                    else *(u32x4*)(xo + (size_t)row * DM + col) = pack8(v0, v1);
                }
                ss += __shfl_xor(ss, 16); ss += __shfl_xor(ss, 32);
                if (fq == 0) ssqp[(size_t)row * 16 + u.pn * 4 + wc] = ss;
            }
    }
};
__device__ __forceinline__ float row_rsq(const float* ssqp, int row) {
    const f32x4* sp = (const f32x4*)(ssqp + (size_t)row * 16);
    const f32x4 a = sp[0], b = sp[1], c = sp[2], d = sp[3];
    const float s = ((a[0] + a[1]) + (a[2] + a[3])) + ((b[0] + b[1]) + (b[2] + b[3])) + ((c[0] + c[1]) + (c[2] + c[3])) + ((d[0] + d[1]) + (d[2] + d[3]));
    return rsq(s);
}
struct EpiMq {
    static constexpr bool PERM = true, AFTER_DRAIN = false;
    const float* ssqp; bf16_t* mq;
    __device__ __forceinline__ void operator()(AccRef acc, const Unit& u, int wr, int wc, int fr, int fq) const {
        const int col0 = u.pn * 256 + wc * 32 + 8 * fq;
#pragma unroll
        for (int ai = 0; ai < 2; ++ai)
#pragma unroll
            for (int m = 0; m < 4; ++m) {
                const int row = u.pm * 256 + ai * 128 + wr * 64 + m * 16 + fr;
                const float r = row_rsq(ssqp, row) * C2M;
#pragma unroll
                for (int bj = 0; bj < 2; ++bj) *(u32x4*)(mq + (size_t)row * DM + col0 + bj * 128) = pack8(acc[ai][bj][m][0] * r, acc[ai][bj][m][1] * r);
            }
    }
};
struct EpiUp {
    static constexpr bool PERM = true, AFTER_DRAIN = false;
    const float* ssqp; const float* cw; const float* cb; bf16_t* hff; float* ahead; float* atail; float* bhead;
    __device__ __forceinline__ void operator()(AccRef acc, const Unit& u, int wr, int wc, int fr, int fq) const {
        const int lane = fq * 16 + fr;
        const int c0 = u.pn * 128 + wc * 32 + 8 * fq;
        f32x4 w0[2], w1[2], w2[2], bb[2];
#pragma unroll
        for (int n = 0; n < 2; ++n) { w0[n] = *(const f32x4*)(cw + c0 + 4 * n); w1[n] = *(const f32x4*)(cw + DFF + c0 + 4 * n); w2[n] = *(const f32x4*)(cw + 2 * DFF + c0 + 4 * n); bb[n] = *(const f32x4*)(cb + c0 + 4 * n); }
        const int src1 = (lane & 48) | ((fr + 15) & 15), src2 = (lane & 48) | ((fr + 14) & 15);
#pragma unroll
        for (int ai = 0; ai < 2; ++ai) {
            const int seg = u.pm * 4 + ai * 2 + wr;
            const int rowb = u.pm * 256 + ai * 128 + wr * 64;
            f32x4 ap[2] = {{0.f, 0.f, 0.f, 0.f}, {0.f, 0.f, 0.f, 0.f}};
#pragma unroll
            for (int m = 0; m < 4; ++m) {
                const int row = rowb + m * 16 + fr;
                const float r = row_rsq(ssqp, row);
                f32x4 a[2], b[2], h[2];
#pragma unroll
                for (int n = 0; n < 2; ++n) {
                    a[n] = acc[ai][0][m][n] * r; b[n] = acc[ai][1][m][n] * r;
                    f32x4 a1, a2;
#pragma unroll
                    for (int e = 0; e < 4; ++e) {
                        const float x1 = (fr == 15) ? ap[n][e] : a[n][e]; a1[e] = __shfl(x1, src1);
                        const float x2 = (fr >= 14) ? ap[n][e] : a[n][e]; a2[e] = __shfl(x2, src2);
                    }
                    const f32x4 cv = bb[n] + w0[n] * a2 + w1[n] * a1 + w2[n] * a[n];
#pragma unroll
                    for (int e = 0; e < 4; ++e) h[n][e] = cv[e] * __builtin_amdgcn_rcpf(1.0f + __builtin_amdgcn_exp2f(-cv[e] * LOG2E)) * b[n][e];
                    ap[n] = a[n];
                }
                if (m == 0 && fr < 2) {
                    float* pa = ahead + ((size_t)seg * 2 + fr) * DFF + c0; float* pb = bhead + ((size_t)seg * 2 + fr) * DFF + c0;
                    *(f32x4*)pa = a[0]; *(f32x4*)(pa + 4) = a[1]; *(f32x4*)pb = b[0]; *(f32x4*)(pb + 4) = b[1];
                } else {
                    *(u32x4*)(hff + (size_t)row * DFF + c0) = pack8(h[0], h[1]);
                }
                if (m == 3 && fr >= 14) { float* pt = atail + ((size_t)seg * 2 + (fr - 14)) * DFF + c0; *(f32x4*)pt = a[0]; *(f32x4*)(pt + 4) = a[1]; }
            }
        }
    }
};

template <int D, int KT, int KG, bool PF, bool QLDS, bool CAUSAL, bool BIAS>
__device__ __forceinline__ void attn_unit(LAS unsigned char* L, const bf16_t* __restrict__ Q, int ldq, int nq,
                                          const bf16_t* __restrict__ K0, const bf16_t* __restrict__ V0, int nt0, const bf16_t* __restrict__ K1, const bf16_t* __restrict__ V1, int ldk, int ntiles,
                                          const float* __restrict__ kbias, int qpos0, bf16_t* __restrict__ O, int ldo) {
    constexpr int KS = D + 8, VS = KT + 4, CH = D / 8, NKI = KT * CH / 512, NVI = ((KT / 2) * CH + 511) / 512, NQF = (D == 64) ? 4 : 1, NP = KT / 32, QW = 8 / KG;
    constexpr int TILEB = KT * KS * 2 + D * VS * 2 + (BIAS ? KT * 4 : 0);
    constexpr int QBYTES = QLDS ? 32 * QW * KS * 2 : 0;
    constexpr int NG = (KG == 1) ? 2 : (!PF ? 1 : KG);
    const int tid = threadIdx.x, lane = tid & 63, wid = __builtin_amdgcn_readfirstlane(tid >> 6), r32 = lane & 31, hi = lane >> 5;
    const int qw = wid % QW, kg = wid / QW;
    const bool wact = qw * 32 < nq;
    LAS unsigned char* T = L + QBYTES;
    const LAS bf16_t* Qs = (const LAS bf16_t*)L + (qw * 32 + r32) * KS + hi * 8;
    const bf16_t* qrow = Q + (size_t)(qw * 32 + r32) * ldq + hi * 8;
    bf16x8 qf[NQF];
    if (D == 64 && !QLDS) {
#pragma unroll
        for (int ds = 0; ds < NQF; ++ds) qf[ds] = wact ? *(const bf16x8*)(qrow + ds * 16) : (bf16x8){0, 0, 0, 0, 0, 0, 0, 0};
    }
    if (QLDS) {
        __syncthreads();
        constexpr int NQI = 32 * QW * CH / 512;
#pragma unroll
        for (int i = 0; i < NQI; ++i) { const int id = tid + 512 * i, row = id / CH, ch = id % CH; if (row < nq) *(LAS u32x4*)((LAS bf16_t*)L + row * KS + ch * 8) = *(const u32x4*)(Q + (size_t)row * ldq + ch * 8); }
    }
    float ref = 0.f;
    if (BIAS) ref = wact ? kbias[qpos0 + qw * 32 + r32] : 0.f;
    f32x16 o[D / 32];
#pragma unroll
    for (int db = 0; db < D / 32; ++db)
#pragma unroll
        for (int r = 0; r < 16; ++r) o[db][r] = 0.f;
    float lrun = 0.f;
    u32x4 kreg[NG][NKI], vreg[NG][NVI][2]; float breg[NG];
#define ATT_LOAD(j, g) do { const bf16_t* Kt_ = ((j) < nt0) ? K0 + (size_t)(j) * KT * ldk : K1 + (size_t)((j) - nt0) * KT * ldk; \
        const bf16_t* Vg_ = ((j) < nt0) ? V0 + (size_t)(j) * KT * ldk : V1 + (size_t)((j) - nt0) * KT * ldk; \
        _Pragma("unroll") for (int i_ = 0; i_ < NKI; ++i_) { const int id_ = tid + 512 * i_, row_ = id_ / CH, ch_ = id_ % CH; kreg[g][i_] = *(const u32x4*)(Kt_ + (size_t)row_ * ldk + ch_ * 8); } \
        _Pragma("unroll") for (int i_ = 0; i_ < NVI; ++i_) { const int id_ = tid + 512 * i_; if (id_ < (KT / 2) * CH) { const int pr_ = id_ % (KT / 2), ch_ = id_ / (KT / 2); \
            vreg[g][i_][0] = *(const u32x4*)(Vg_ + (size_t)(2 * pr_) * ldk + ch_ * 8); vreg[g][i_][1] = *(const u32x4*)(Vg_ + (size_t)(2 * pr_ + 1) * ldk + ch_ * 8); } } \
        if (BIAS && tid < KT) breg[g] = kbias[(j) * KT + tid]; } while (0)
#define ATT_STORE(TB, g) do { LAS bf16_t* Ks_ = (LAS bf16_t*)(TB); LAS bf16_t* Vt_ = (LAS bf16_t*)((TB) + KT * KS * 2); \
        _Pragma("unroll") for (int i_ = 0; i_ < NKI; ++i_) { const int id_ = tid + 512 * i_, row_ = id_ / CH, ch_ = id_ % CH; *(LAS u32x4*)(Ks_ + row_ * KS + ch_ * 8) = kreg[g][i_]; } \
        _Pragma("unroll") for (int i_ = 0; i_ < NVI; ++i_) { const int id_ = tid + 512 * i_; if (id_ < (KT / 2) * CH) { const int pr_ = id_ % (KT / 2), ch_ = id_ / (KT / 2); \
            _Pragma("unroll") for (int e_ = 0; e_ < 4; ++e_) { const unsigned lo_ = vreg[g][i_][0][e_], h2_ = vreg[g][i_][1][e_]; \
                *(LAS unsigned*)(Vt_ + (ch_ * 8 + 2 * e_) * VS + 2 * pr_) = (lo_ & 0xffffu) | (h2_ << 16); \
                *(LAS unsigned*)(Vt_ + (ch_ * 8 + 2 * e_ + 1) * VS + 2 * pr_) = (lo_ >> 16) | (h2_ & 0xffff0000u); } } } \
        if (BIAS && tid < KT) ((LAS float*)((TB) + KT * KS * 2 + D * VS * 2))[tid] = breg[g]; } while (0)
#define ATT_COMPUTE(j, TB) do { const LAS bf16_t* Ks_ = (const LAS bf16_t*)(TB); const LAS bf16_t* Vt_ = (const LAS bf16_t*)((TB) + KT * KS * 2); const LAS float* Bs_ = (const LAS float*)((TB) + KT * KS * 2 + D * VS * 2); \
        if (wact && (!CAUSAL || KT * (j) <= qpos0 + qw * 32 + 31)) { \
            f32x16 p[NP]; \
            const bf16_t* qr_ = qrow; if (D != 64 && !QLDS) asm volatile("" : "+v"(qr_)); \
            _Pragma("unroll") for (int h_ = 0; h_ < NP; ++h_) { \
                if (BIAS) { _Pragma("unroll") for (int i_ = 0; i_ < 4; ++i_) { const f32x4 t0_ = *(const LAS f32x4*)(Bs_ + 32 * h_ + 8 * i_ + 4 * hi); \
                        _Pragma("unroll") for (int e_ = 0; e_ < 4; ++e_) p[h_][4 * i_ + e_] = t0_[e_] - ref; } } \
                else { _Pragma("unroll") for (int r_ = 0; r_ < 16; ++r_) p[h_][r_] = 0.f; } } \
            _Pragma("unroll") for (int ds_ = 0; ds_ < D / 16; ++ds_) { \
                bf16x8 qv_; if (QLDS) qv_ = *(const LAS bf16x8*)(Qs + ds_ * 16); else if (D == 64) qv_ = qf[ds_]; else qv_ = *(const bf16x8*)(qr_ + ds_ * 16); \
                _Pragma("unroll") for (int h_ = 0; h_ < NP; ++h_) { const bf16x8 kf_ = *(const LAS bf16x8*)(Ks_ + (32 * h_ + r32) * KS + ds_ * 16 + hi * 8); p[h_] = __builtin_amdgcn_mfma_f32_32x32x16_bf16(kf_, qv_, p[h_], 0, 0, 0); } } \
            if (CAUSAL && (KT * (j) + KT - 1 > qpos0 + qw * 32)) { const int lim_ = qpos0 + qw * 32 + r32 - KT * (j); \
                _Pragma("unroll") for (int h_ = 0; h_ < NP; ++h_) _Pragma("unroll") for (int r_ = 0; r_ < 16; ++r_) { if (crow(r_, hi) + 32 * h_ > lim_) p[h_][r_] = NEGBIG; } } \
            float sum_ = 0.f; \
            _Pragma("unroll") for (int h_ = 0; h_ < NP; ++h_) _Pragma("unroll") for (int r_ = 0; r_ < 16; ++r_) { p[h_][r_] = __builtin_amdgcn_exp2f(p[h_][r_]); sum_ += p[h_][r_]; } \
            lrun += sum_; \
            u32x4 pw_[2 * NP]; \
            _Pragma("unroll") for (int h_ = 0; h_ < NP; ++h_) _Pragma("unroll") for (int e_ = 0; e_ < 4; ++e_) { pw_[2 * h_][e_] = pg8::cvt_pk_bf16(p[h_][2 * e_], p[h_][2 * e_ + 1]); pw_[2 * h_ + 1][e_] = pg8::cvt_pk_bf16(p[h_][8 + 2 * e_], p[h_][9 + 2 * e_]); } \
            _Pragma("unroll") for (int db_ = 0; db_ < D / 32; ++db_) _Pragma("unroll") for (int ks_ = 0; ks_ < 2 * NP; ++ks_) { \
                const LAS bf16_t* vp_ = Vt_ + (db_ * 32 + r32) * VS + ks_ * 16 + hi * 4; \
                const u32x2 va_ = *(const LAS u32x2*)vp_, vb_ = *(const LAS u32x2*)(vp_ + 8); const u32x4 vv_ = {va_.x, va_.y, vb_.x, vb_.y}; \
                o[db_] = __builtin_amdgcn_mfma_f32_32x32x16_bf16(__builtin_bit_cast(bf16x8, vv_), __builtin_bit_cast(bf16x8, pw_[ks_]), o[db_], 0, 0, 0); } \
        } } while (0)
    if (KG == 1) {
        ATT_LOAD(0, 0); ATT_STORE(T, 0); if (ntiles > 1) ATT_LOAD(1, 1); if (ntiles > 2) ATT_LOAD(2, 0);
        __syncthreads();
        for (int j = 0; j < ntiles; j += 2) {
            if (j + 1 < ntiles) ATT_STORE(T + TILEB, 1);
            if (j + 3 < ntiles) ATT_LOAD(j + 3, 1);
            ATT_COMPUTE(j, T);
            __syncthreads();
            if (j + 1 < ntiles) {
                if (j + 2 < ntiles) ATT_STORE(T, 0);
                if (j + 4 < ntiles) ATT_LOAD(j + 4, 0);
                ATT_COMPUTE(j + 1, T + TILEB);
                __syncthreads();
            }
        }
    } else {
        const int nsteps = (ntiles + KG - 1) / KG;
        if (PF) {
#pragma unroll
            for (int g = 0; g < NG; ++g) { if (g < ntiles) ATT_LOAD(g, g); }
        }
        for (int s = 0; s < nsteps; ++s) {
            __syncthreads();
            if (PF) {
#pragma unroll
                for (int g = 0; g < NG; ++g) { if (s * KG + g < ntiles) ATT_STORE(T + g * TILEB, g); }
            } else {
#pragma unroll
                for (int g = 0; g < KG; ++g) { const int jt = s * KG + g; if (jt < ntiles) { ATT_LOAD(jt, 0); ATT_STORE(T + g * TILEB, 0); } }
            }
            __syncthreads();
            if (PF && s + 1 < nsteps) {
#pragma unroll
                for (int g = 0; g < NG; ++g) { const int jt = (s + 1) * KG + g; if (jt < ntiles) ATT_LOAD(jt, g); }
            }
            const int jm = s * KG + kg;
            if (jm < ntiles) ATT_COMPUTE(jm, T + kg * TILEB);
        }
        LAS float* Mg = (LAS float*)T;
#pragma unroll
        for (int db = 0; db < D / 32; ++db) {
            __syncthreads();
#pragma unroll
            for (int r = 0; r < 16; ++r) Mg[(wid * 17 + r) * 64 + lane] = o[db][r];
            if (db == 0) Mg[(wid * 17 + 16) * 64 + lane] = lrun;
            __syncthreads();
            if (kg == 0) {
#pragma unroll
                for (int g = 1; g < KG; ++g) {
#pragma unroll
                    for (int r = 0; r < 16; ++r) o[db][r] += Mg[((g * QW + qw) * 17 + r) * 64 + lane];
                    if (db == 0) lrun += Mg[((g * QW + qw) * 17 + 16) * 64 + lane];
                }
            }
        }
        __syncthreads();
    }
#undef ATT_LOAD
#undef ATT_STORE
#undef ATT_COMPUTE
    if (kg == 0 && wact) {
        const float lt = lrun + __shfl_xor(lrun, 32), inv = 1.0f / lt;
        bf16_t* orow = O + (size_t)(qw * 32 + r32) * ldo;
#pragma unroll
        for (int db = 0; db < D / 32; ++db)
#pragma unroll
            for (int i = 0; i < 4; ++i) { u32x2 w; w.x = pg8::cvt_pk_bf16(o[db][4 * i] * inv, o[db][4 * i + 1] * inv); w.y = pg8::cvt_pk_bf16(o[db][4 * i + 2] * inv, o[db][4 * i + 3] * inv);
                *(u32x2*)(orow + db * 32 + 8 * i + 4 * hi) = w; }
    }
}

template <int J0, int J1>
__device__ __forceinline__ void pool_acc(float (&s)[8], const char* __restrict__ ubase, unsigned off0, int nprev) {
#pragma unroll
    for (int j = J0; j < J1; ++j) {
        const bool ok = j <= nprev; const unsigned jo = ok ? (unsigned)j * 1024u : 0u; const float wt = ok ? 1.f : 0.f;
        const u32x4 v = *(const u32x4*)(ubase + (off0 - jo));
        s[0] += wt * bf_lo(v.x); s[1] += wt * bf_hi(v.x); s[2] += wt * bf_lo(v.y); s[3] += wt * bf_hi(v.y); s[4] += wt * bf_lo(v.z); s[5] += wt * bf_hi(v.z); s[6] += wt * bf_lo(v.w); s[7] += wt * bf_hi(v.w);
    }
}
template <int G>
__device__ __forceinline__ void pool_group(const char* __restrict__ ubase, unsigned rowoff, int nprev, float icnt, const bf16_t* __restrict__ wpt, bf16_t* __restrict__ orow, int r32, int hi) {
    constexpr int w = 2 << G;
    bf16x8 dfr[8];
#pragma unroll
    for (int ks = 0; ks < 8; ++ks) {
        const int c0 = G * 128 + ks * 16 + hi * 8;
        const unsigned off0 = rowoff + (unsigned)c0 * 2u;
        const u32x4 cu = *(const u32x4*)(ubase + off0);
        float s[8], cur[8];
        cur[0] = bf_lo(cu.x); cur[1] = bf_hi(cu.x); cur[2] = bf_lo(cu.y); cur[3] = bf_hi(cu.y); cur[4] = bf_lo(cu.z); cur[5] = bf_hi(cu.z); cur[6] = bf_lo(cu.w); cur[7] = bf_hi(cu.w);
#pragma unroll
        for (int e = 0; e < 8; ++e) s[e] = cur[e];
        pool_acc<1, (w < 8 ? w : 8)>(s, ubase, off0, nprev);
        if (w > 8) { __builtin_amdgcn_sched_barrier(0); pool_acc<8, w>(s, ubase, off0, nprev); }
        u32x4 dv;
        dv.x = cvt_pk_bf16(s[0] * icnt - cur[0], s[1] * icnt - cur[1]); dv.y = cvt_pk_bf16(s[2] * icnt - cur[2], s[3] * icnt - cur[3]);
        dv.z = cvt_pk_bf16(s[4] * icnt - cur[4], s[5] * icnt - cur[5]); dv.w = cvt_pk_bf16(s[6] * icnt - cur[6], s[7] * icnt - cur[7]);
        dfr[ks] = __builtin_bit_cast(bf16x8, dv);
        if (((ks + 1) % (G == 0 ? 4 : G == 1 ? 2 : 1)) == 0) __builtin_amdgcn_sched_barrier(0);
    }
#pragma unroll
    for (int nb = 0; nb < 4; ++nb) {
        f32x16 acc;
#pragma unroll
        for (int r = 0; r < 16; ++r) acc[r] = 0.f;
        const bf16_t* wrow = wpt + ((size_t)G * 128 + nb * 32 + r32) * 128 + hi * 8;
#pragma unroll
        for (int ks = 0; ks < 8; ++ks) acc = __builtin_amdgcn_mfma_f32_32x32x16_bf16(*(const bf16x8*)(wrow + ks * 16), dfr[ks], acc, 0, 0, 0);
#pragma unroll
        for (int i = 0; i < 4; ++i) { u32x2 wv; wv.x = cvt_pk_bf16(acc[4 * i], acc[4 * i + 1]); wv.y = cvt_pk_bf16(acc[4 * i + 2], acc[4 * i + 3]);
            *(u32x2*)(orow + G * 128 + nb * 32 + 8 * i + 4 * hi) = wv; }
    }
}
__device__ __forceinline__ void pool_unit(int tile, const bf16_t* __restrict__ ub, const bf16_t* __restrict__ usx, const bf16_t* __restrict__ wpt, bf16_t* __restrict__ mix) {
    const int tid = threadIdx.x, lane = tid & 63, wid = tid >> 6, r32 = lane & 31, hi = lane >> 5;
    const int row = tile * 256 + wid * 32 + r32;
    const bool samp = row >= MP;
    const int b = samp ? (row - MP) >> 6 : row >> 11, t = samp ? (row - MP) & 63 : row & (SEQ - 1);
    const char* ubase = (const char*)(tile >= 256 ? usx : ub);
    const unsigned rowoff = (samp ? (unsigned)(b * 79 + 15 + t) : (unsigned)row) * 1024u;
    const int nprev = samp ? t + 15 : t;
    bf16_t* orow = mix + (size_t)row * DM;
    const int np1 = samp ? 16 : t + 1;
    pool_group<0>(ubase, rowoff, nprev, 1.0f / (float)(np1 < 2 ? np1 : 2), wpt, orow, r32, hi);
    pool_group<1>(ubase, rowoff, nprev, 1.0f / (float)(np1 < 4 ? np1 : 4), wpt, orow, r32, hi);
    pool_group<2>(ubase, rowoff, nprev, 1.0f / (float)(np1 < 8 ? np1 : 8), wpt, orow, r32, hi);
    pool_group<3>(ubase, rowoff, nprev, 1.0f / (float)(np1 < 16 ? np1 : 16), wpt, orow, r32, hi);
}

template <int MODE>
__device__ __forceinline__ void transpose_item(const float* __restrict__ W, int K, int N, int nblk, bf16_t* __restrict__ WT, int row_off, const float* __restrict__ g, LAS float* scr, int item, int lane) {
    const int kb = item / nblk, nb = item % nblk, k0 = 64 * kb, n0 = 32 * nb;
#pragma unroll 8
    for (int i = 0; i < 32; ++i) { const int kk = 2 * i + (lane >> 5); float v = W[(size_t)(k0 + kk) * N + n0 + (lane & 31)]; if (g) v *= g[k0 + kk]; scr[kk * 33 + (lane & 31)] = v; }
    LDS_WAIT();
    const int c = lane & 7;
#pragma unroll
    for (int j = 0; j < 4; ++j) {
        const int n = (lane >> 3) + 8 * j; const LAS float* s = scr + (8 * c) * 33 + n;
        const int nn = n0 + n; int drow;
        if (MODE == 0) drow = row_off + nn; else { const int half = nn / DFF, cc = nn % DFF; drow = (cc >> 7) * 256 + half * 128 + (cc & 127); }
        u32x4 o; o.x = cvt_pk_bf16(s[0 * 33], s[1 * 33]); o.y = cvt_pk_bf16(s[2 * 33], s[3 * 33]); o.z = cvt_pk_bf16(s[4 * 33], s[5 * 33]); o.w = cvt_pk_bf16(s[6 * 33], s[7 * 33]);
        *(u32x4*)(WT + (size_t)drow * K + k0 + 8 * c) = o;
    }
    LDS_WAIT();
}
__device__ __forceinline__ void prepass_row(const float* __restrict__ xrow, bf16_t* __restrict__ orow, const LAS float* wf, const float* __restrict__ b_f, float* __restrict__ lf_out, int lane) {
    const f32x4* xr = (const f32x4*)xrow + lane;
    f32x4 v[4]; float s = 0.f;
#pragma unroll
    for (int j = 0; j < 4; ++j) { v[j] = xr[64 * j]; s += (v[j][0] * v[j][0] + v[j][1] * v[j][1]) + (v[j][2] * v[j][2] + v[j][3] * v[j][3]); }
    const float r = rsq(wave_sum(s));
    u32x2* o8 = (u32x2*)orow + lane;
#pragma unroll
    for (int j = 0; j < 4; ++j) { v[j] = v[j] * r; u32x2 w; w.x = cvt_pk_bf16(v[j][0], v[j][1]); w.y = cvt_pk_bf16(v[j][2], v[j][3]); o8[64 * j] = w; }
    if (wf) {
        f32x4 fa = {0.f, 0.f, 0.f, 0.f}, fb = {0.f, 0.f, 0.f, 0.f};
#pragma unroll
        for (int j = 0; j < 4; ++j)
#pragma unroll
            for (int e = 0; e < 4; ++e) { const int k = 4 * (lane + 64 * j) + e; const LAS f32x4* w = (const LAS f32x4*)(wf + k * 8); fa += w[0] * v[j][e]; fb += w[1] * v[j][e]; }
#pragma unroll
        for (int e = 0; e < 4; ++e) { fa[e] = wave_sum(fa[e]); fb[e] = wave_sum(fb[e]); }
        float z = fa[0];
        z = (lane == 1) ? fa[1] : z; z = (lane == 2) ? fa[2] : z; z = (lane == 3) ? fa[3] : z; z = (lane == 4) ? fb[0] : z; z = (lane == 5) ? fb[1] : z; z = (lane == 6) ? fb[2] : z; z = (lane == 7) ? fb[3] : z;
        if (lane < 8) { z += b_f[lane]; lf_out[lane] = fminf(z, 0.f) - log1pf(expf(-fabsf(z))); }
    }
}
__device__ __forceinline__ void scan_seq(const float* s0, int n0, const float* s1, int n1, float* dst, int lane) {
    const int n = n0 + n1, Lc = n >> 6;
    float s = 0.f;
    for (int i = 0; i < Lc; ++i) { const int t = lane * Lc + i; const float* ptr = (t < n0) ? (s0 + (size_t)t * 8) : (s1 + (size_t)(t - n0) * 8); s += *ptr; }
    float inc = s;
    for (int o = 1; o < 64; o <<= 1) { const float v = __shfl_up(inc, o); if (lane >= o) inc += v; }
    float run = inc - s;
    for (int i = 0; i < Lc; ++i) { const int t = lane * Lc + i; const float* ptr = (t < n0) ? (s0 + (size_t)t * 8) : (s1 + (size_t)(t - n0) * 8); run += *ptr; dst[t] = -run * LOG2E; }
}
__device__ __forceinline__ void cvt_flat(const float* __restrict__ src, bf16_t* __restrict__ dst, size_t n8, size_t gtid, size_t gn) {
    for (size_t i = gtid; i < n8; i += gn) { const f32x4 a = *(const f32x4*)(src + i * 8), b = *(const f32x4*)(src + i * 8 + 4); *(u32x4*)(dst + i * 8) = pack8(a, b); }
}

#define Wt_in ((bf16_t*)(ws + WS_WIN))
#define Wt_o ((bf16_t*)(ws + WS_WO))
#define Wt_mq ((bf16_t*)(ws + WS_WMQ))
#define Wt_mo ((bf16_t*)(ws + WS_WMO))
#define Wt_mkv ((bf16_t*)(ws + WS_WMKV))
#define Wt_up ((bf16_t*)(ws + WS_WUP))
#define Wt_dn ((bf16_t*)(ws + WS_WDN))
#define Wt_pool ((bf16_t*)(ws + WS_WPOOL))
#define usx ((bf16_t*)(ws + WS_USX))
#define mkb ((bf16_t*)(ws + WS_MKB))
#define mvb ((bf16_t*)(ws + WS_MVB))
#define ssq1 ((float*)(ws + WS_SSQ1))
#define ssq2 ((float*)(ws + WS_SSQ2))
#define ssq3 ((float*)(ws + WS_SSQ3))
#define kbP ((float*)(ws + WS_KBP))
#define kbS ((float*)(ws + WS_KBS))
#define ahead ((float*)(ws + WS_AHEAD))
#define atail ((float*)(ws + WS_ATAIL))
#define bhead ((float*)(ws + WS_BHEAD))
#define x1b ((bf16_t*)(ws + WS_X1B))
#define kcb ((bf16_t*)(ws + WS_KCB))
#define vcb ((bf16_t*)(ws + WS_VCB))
#define x2b ((bf16_t*)(ws + WS_X2B))
#define xb ((bf16_t*)(ws + WS_XB))
#define mqb ((bf16_t*)(ws + WS_MQB))
#define hff ((bf16_t*)(ws + WS_HFF))
#define uqkv ((bf16_t*)(ws + WS_UQKV))
#define mo ((bf16_t*)(ws + WS_MO))
#define mix ((bf16_t*)(ws + WS_MIX))
#define memb ((bf16_t*)(ws + WS_MEMB))
#define ub uqkv
#define qb (uqkv + (size_t)MT * 512)
#define kb (uqkv + (size_t)2 * MT * 512)
#define vb (uqkv + (size_t)3 * MT * 512)
__global__ void __launch_bounds__(512, 2) fwd_kernel(Params p) {
    extern __shared__ __attribute__((aligned(16))) unsigned char lds_raw[];
    LAS unsigned char* L = (LAS unsigned char*)lds_raw;
    cg::grid_group grid = cg::this_grid();
    const int tid = threadIdx.x, lane = tid & 63, wave = __builtin_amdgcn_readfirstlane(tid >> 6);
    const int G = gridDim.x, bx = blockIdx.x;
    unsigned char* ws = p.ws; float* out = p.out;
    const float* x_prompt = p.in[0]; const float* x_sample = p.in[1];
    const int lo = p.ph_lo, hi_ph = p.ph_hi;
    unsigned* gbar = (unsigned*)ws; unsigned nbar = 0u;
    if (lo < 0) grid.sync();
#define IN(k) (lo <= (k) && (k) < hi_ph && ((PHMASK >> (k)) & 1))
#define GSYNC() do { asm volatile("s_waitcnt vmcnt(0)" ::: "memory"); __syncthreads(); \
        if (tid == 0) { __builtin_amdgcn_fence(__ATOMIC_RELEASE, "agent"); asm volatile("s_waitcnt vmcnt(0)" ::: "memory"); \
            nbar += (unsigned)G; __hip_atomic_fetch_add(gbar, 1u, __ATOMIC_RELAXED, __HIP_MEMORY_SCOPE_AGENT); \
            while (__hip_atomic_load(gbar, __ATOMIC_RELAXED, __HIP_MEMORY_SCOPE_AGENT) < nbar) __builtin_amdgcn_s_sleep(6); \
            __builtin_amdgcn_fence(__ATOMIC_ACQUIRE, "agent"); asm volatile("s_waitcnt vmcnt(0)" ::: "memory"); } \
        __syncthreads(); } while (0)
#define SEAM(k) do { if (IN(k) && IN((k) + 1)) GSYNC(); } while (0)

    if (IN(0)) {
        const int gw = bx * 8 + wave, NGW = G * 8;
        LAS float* scr = (LAS float*)(L + wave * 8448);
        LAS float* wf = (LAS float*)(L + 8 * 8448);
        {
            const float* w_in = p.in[11]; const float* g_mix = p.in[10];
            for (int i = tid; i < 8192; i += 512) { const int k = i >> 3, h = i & 7; wf[i] = w_in[(size_t)k * 2056 + 2048 + h] * g_mix[k]; }
        }
        __syncthreads();
        constexpr int I_IN = 16 * 64, I_SQ = 16 * 32, I_UP = 16 * 176, I_DN = 44 * 32;
        constexpr int NITEMS = I_IN + 5 * I_SQ + I_UP + I_DN;
        for (int it = gw; it < NITEMS; it += NGW) {
            int r = it;
            if (r < I_IN) { transpose_item<0>(p.in[11], 1024, 2056, 64, Wt_in, 0, p.in[10], scr, r, lane); continue; } r -= I_IN;
            if (r < I_SQ) { transpose_item<0>(p.in[15], 1024, 1024, 32, Wt_o, 0, nullptr, scr, r, lane); continue; } r -= I_SQ;
            if (r < I_SQ) { transpose_item<0>(p.in[18], 1024, 1024, 32, Wt_mq, 0, p.in[16], scr, r, lane); continue; } r -= I_SQ;
            if (r < I_SQ) { transpose_item<0>(p.in[19], 1024, 1024, 32, Wt_mkv, 0, p.in[17], scr, r, lane); continue; } r -= I_SQ;
            if (r < I_SQ) { transpose_item<0>(p.in[20], 1024, 1024, 32, Wt_mkv, 1024, p.in[17], scr, r, lane); continue; } r -= I_SQ;
            if (r < I_SQ) { transpose_item<0>(p.in[21], 1024, 1024, 32, Wt_mo, 0, nullptr, scr, r, lane); continue; } r -= I_SQ;
            if (r < I_UP) { transpose_item<1>(p.in[23], 1024, NUP, 176, Wt_up, 0, p.in[22], scr, r, lane); continue; } r -= I_UP;
            transpose_item<0>(p.in[26], DFF, 1024, 32, Wt_dn, 0, nullptr, scr, r, lane);
        }
        {
            const float* w_pool = p.in[13]; const float* pscale = p.in[14];
            for (int i = bx * 512 + tid; i < 4 * 128 * 128; i += G * 512) { const int g = i >> 14, d = (i >> 7) & 127, c = i & 127; Wt_pool[i] = (bf16_t)(cvt_pk_bf16(w_pool[(g * 128 + c) * 128 + d] * pscale[g * 128 + d], 0.f) & 0xffffu); }
        }
        for (int m = gw; m < MT; m += NGW) {
            const float* xr = (m < MP) ? x_prompt + (size_t)m * DM : x_sample + (size_t)(m - MP) * DM;
            float* lf = (m < MP) ? out + O_LFP + (size_t)m * 8 : out + O_LFS + (size_t)(m - MP) * 8;
            prepass_row(xr, xb + (size_t)m * DM, wf, p.in[12], lf, lane);
        }
        for (int m = gw; m < 8192; m += NGW) prepass_row(p.in[9] + (size_t)m * DM, memb + (size_t)m * DM, (const LAS float*)nullptr, nullptr, nullptr, lane);
        const size_t gtid = (size_t)bx * 512 + tid, gn = (size_t)G * 512;
        for (size_t i = gtid; i < (size_t)16 * 15 * 512 / 8; i += gn) { const size_t e8 = i * 8, bb = e8 / (15 * 512), rem = e8 - bb * 15 * 512; const float* sp = p.in[5] + e8; *(u32x4*)(usx + bb * 79 * 512 + rem) = pack8(*(const f32x4*)sp, *(const f32x4*)(sp + 4)); }
        cvt_flat(p.in[2], kcb, (size_t)16 * PAST * 512 / 8, gtid, gn);
        cvt_flat(p.in[3], vcb, (size_t)16 * PAST * 512 / 8, gtid, gn);
        cvt_flat(p.in[7], mkb + (size_t)8192 * 1024, (size_t)4096 * 1024 / 8, gtid, gn);
        cvt_flat(p.in[8], mvb + (size_t)8192 * 1024, (size_t)4096 * 1024 / 8, gtid, gn);
        __syncthreads();
    }
    SEAM(0);

    if (IN(1)) {
        if (wave == 0) { const int s = bx; if (s < 256) scan_seq(out + O_LFP + (size_t)(s >> 3) * SEQ * 8 + (s & 7), SEQ, out + O_LFP, 0, kbP + (size_t)s * SEQ, lane); }
        if (wave == 1 && bx < 128) { const int s = bx; scan_seq(p.in[4] + (size_t)(s >> 3) * PAST * 8 + (s & 7), PAST, out + O_LFS + (size_t)(s >> 3) * DSEQ * 8 + (s & 7), DSEQ, kbS + (size_t)s * (PAST + DSEQ), lane); }
        {
            pg8::Gemm g{xb, Wt_in, MT, 2048, 1024}; pg8::StaticOrder S; S.init(MT, 2048, G, bx);
            EpiIn E{uqkv, out, usx};
            pg8::gemm_phase<EpiIn, pg8::StaticOrder, true, true>(L, g, S, E);
        }
        __syncthreads();
        {
            pg8::Gemm g{memb, Wt_mkv, 8192, 2048, 1024}; pg8::StaticOrder S; S.init(8192, 2048, G, bx);
            EpiMkv E{mkb, mvb, out};
            pg8::gemm_phase<EpiMkv, pg8::StaticOrder, true, true>(L, g, S, E);
        }
    }
    SEAM(1);

    if (IN(2)) {
        for (int it = 0; it < 8 * ((256 + G - 1) / G); ++it) {
            int bh, qk;
            if (G == 256) { const int xcd = bx & 7, l = bx >> 3, r = it >> 1, pi = l & 3; bh = xcd * 32 + r * 8 + (l >> 2); qk = (it & 1) ? pi : 7 - pi; }
            else { bh = bx + (it >> 3) * G; qk = 7 - (it & 7); if (bh >= 256) break; }
            const int b = bh >> 3, h = bh & 7;
            const bf16_t* Kh = kb + (size_t)b * SEQ * 512 + h * 64; const bf16_t* Vh = vb + (size_t)b * SEQ * 512 + h * 64;
            const size_t r0 = (size_t)b * SEQ + 256 * qk;
            attn_unit<64, 64, 1, true, false, true, true>(L, qb + r0 * 512 + h * 64, 512, 256, Kh, Vh, 4 * qk + 4, Kh, Vh, 512, 4 * qk + 4, kbP + (size_t)bh * SEQ, 256 * qk, mix + r0 * DM + 512 + h * 64, DM);
        }
        if (P2_ATTN_S) for (int bh = bx; bh < 128; bh += G) {
            const int b = bh >> 3, h = bh & 7;
            const size_t r0 = (size_t)MP + b * DSEQ;
            attn_unit<64, 64, 4, true, false, true, true>(L, qb + r0 * 512 + h * 64, 512, 64, kcb + (size_t)b * PAST * 512 + h * 64, vcb + (size_t)b * PAST * 512 + h * 64, 64,
                                      kb + r0 * 512 + h * 64, vb + r0 * 512 + h * 64, 512, 65, kbS + (size_t)bh * (PAST + DSEQ), PAST, mix + r0 * DM + 512 + h * 64, DM);
        }
        if (G == 256) { pool_unit(bx, ub, usx, Wt_pool, mix); if (bx >= 128 && bx < 132) pool_unit(128 + bx, ub, usx, Wt_pool, mix); }
        else for (int t = bx; t < MT / 256; t += G) pool_unit(t, ub, usx, Wt_pool, mix);
        __syncthreads();
    }
    SEAM(2);

    if (IN(3)) {
        pg8::Gemm g{mix, Wt_o, MT, 1024, 1024}; pg8::StaticOrder S; S.init(MT, 1024, G, bx);
        EpiRes<0> E{x_prompt, x_sample, nullptr, x1b, nullptr, ssq1};
        pg8::gemm_phase<EpiRes<0>, pg8::StaticOrder, true, true>(L, g, S, E);
    }
    SEAM(3);

    if (IN(4)) {
        pg8::Gemm g{x1b, Wt_mq, MT, 1024, 1024}; pg8::StaticOrder S; S.init(MT, 1024, G, bx);
        EpiMq E{ssq1, mqb};
        pg8::gemm_phase<EpiMq, pg8::StaticOrder, true, true>(L, g, S, E);
    }
    SEAM(4);

    if (IN(5)) {
        for (int k5 = 0; k5 * G < 2048 + 64; ++k5) {
            const int un = (G == 256 && k5 < 8) ? (((k5 * 8 + (bx & 7)) * 32) + (bx >> 3)) : (k5 * G + bx);
            if (un >= 2048 + 64) break;
            if (un < 2048) {
                const int b = un >> 6, h = (un >> 4) & 3, qk = un & 15;
                const size_t r0 = (size_t)b * SEQ + 128 * qk;
                const bf16_t* Kh = mkb + (size_t)b * NMEM * 1024 + h * 256; const bf16_t* Vh = mvb + (size_t)b * NMEM * 1024 + h * 256;
                attn_unit<256, 32, 2, false, true, false, false>(L, mqb + r0 * DM + h * 256, DM, 128, Kh, Vh, 8, Kh, Vh, 1024, 8, nullptr, 0, mo + r0 * DM + h * 256, DM);
            } else {
                const int us = un - 2048, b = us >> 2, h = us & 3;
                const size_t r0 = (size_t)MP + b * DSEQ;
                const bf16_t* Kh = mkb + (size_t)(8192 + b * NMEM) * 1024 + h * 256; const bf16_t* Vh = mvb + (size_t)(8192 + b * NMEM) * 1024 + h * 256;
                attn_unit<256, 32, 2, false, true, false, false>(L, mqb + r0 * DM + h * 256, DM, 64, Kh, Vh, 8, Kh, Vh, 1024, 8, nullptr, 0, mo + r0 * DM + h * 256, DM);
            }
        }
        __syncthreads();
    }
    SEAM(5);

    if (IN(6)) {
        pg8::Gemm g{mo, Wt_mo, MT, 1024, 1024}; pg8::StaticOrder S; S.init(MT, 1024, G, bx);
        EpiRes<1> E{nullptr, nullptr, x1b, x2b, nullptr, ssq2};
        pg8::gemm_phase<EpiRes<1>, pg8::StaticOrder, true, true>(L, g, S, E);
    }
    SEAM(6);

    if (IN(7)) {
        pg8::Gemm g{x2b, Wt_up, MT, NUP, 1024}; pg8::StaticOrder S; S.init(MT, NUP, G, bx);
        EpiUp E{ssq2, p.in[24], p.in[25], hff, ahead, atail, bhead};
        pg8::gemm_phase<EpiUp, pg8::StaticOrder, true, true>(L, g, S, E);
    }
    SEAM(7);

    if (IN(8)) {
        const float* cw = p.in[24]; const float* cbias = p.in[25]; const float* chist = p.in[6];
        const int total4 = NSEG * 2 * (DFF / 4);
        for (int idx = bx * 512 + tid; idx < total4; idx += G * 512) {
            const int seg = idx / (2 * (DFF / 4)), rem = idx - seg * 2 * (DFF / 4), i = rem / (DFF / 4), c = (rem - i * (DFF / 4)) * 4;
            f32x4 prev1, prev2;
            if (seg < MP / 64) { if ((seg & 31) == 0) { prev1 = (f32x4){0.f, 0.f, 0.f, 0.f}; prev2 = prev1; } else { prev1 = *(const f32x4*)(atail + ((size_t)(seg - 1) * 2 + 1) * DFF + c); prev2 = *(const f32x4*)(atail + ((size_t)(seg - 1) * 2) * DFF + c); } }
            else { const int b = seg - MP / 64; prev1 = *(const f32x4*)(chist + ((size_t)b * 2 + 1) * DFF + c); prev2 = *(const f32x4*)(chist + ((size_t)b * 2) * DFF + c); }
            const f32x4 a_0 = *(const f32x4*)(ahead + ((size_t)seg * 2) * DFF + c);
            f32x4 am1, am2, a0;
            if (i == 0) { am1 = prev1; am2 = prev2; a0 = a_0; } else { am1 = a_0; am2 = prev1; a0 = *(const f32x4*)(ahead + ((size_t)seg * 2 + 1) * DFF + c); }
            const f32x4 cv = *(const f32x4*)(cbias + c) + *(const f32x4*)(cw + c) * am2 + *(const f32x4*)(cw + DFF + c) * am1 + *(const f32x4*)(cw + 2 * DFF + c) * a0;
            const f32x4 bh = *(const f32x4*)(bhead + ((size_t)seg * 2 + i) * DFF + c);
            f32x4 hv;
#pragma unroll
            for (int e = 0; e < 4; ++e) hv[e] = cv[e] / (1.0f + __builtin_amdgcn_exp2f(-cv[e] * LOG2E)) * bh[e];
            u32x2 w; w.x = cvt_pk_bf16(hv[0], hv[1]); w.y = cvt_pk_bf16(hv[2], hv[3]);
            *(u32x2*)(hff + ((size_t)seg * 64 + i) * DFF + c) = w;
        }
        for (int idx = bx * 512 + tid; idx < 48 * 2 * DFF; idx += G * 512) {
            const int bb = idx / (2 * DFF), rem = idx - bb * 2 * DFF;
            if (bb < 32) out[O_CSP + (size_t)bb * 2 * DFF + rem] = atail[((size_t)(32 * bb + 31) * 2) * DFF + rem];
            else out[O_CSS + (size_t)(bb - 32) * 2 * DFF + rem] = atail[((size_t)(MP / 64 + bb - 32) * 2) * DFF + rem];
        }
    }
    SEAM(8);

    if (IN(9)) {
        pg8::Gemm g{hff, Wt_dn, MT, 1024, DFF}; pg8::StaticOrder S; S.init(MT, 1024, G, bx);
        EpiRes<2> E{nullptr, nullptr, x2b, nullptr, out, ssq3};
        pg8::gemm_phase<EpiRes<2>, pg8::StaticOrder, true, true>(L, g, S, E);
    }
    SEAM(9);

    if (IN(10)) {
        const float* gf = p.in[27];
        const int gw = bx * 8 + wave, NGW = G * 8;
        f32x4 gv[4];
#pragma unroll
        for (int j = 0; j < 4; ++j) gv[j] = ((const f32x4*)gf)[lane + 64 * j];
        for (int m0 = gw; m0 < MT; m0 += 4 * NGW) {
            f32x4 v[4][4]; float r[4];
#pragma unroll
            for (int q = 0; q < 4; ++q) { const int m = m0 + q * NGW; if (m < MT) { const f32x4* y4 = (const f32x4*)(out + (size_t)m * DM) + lane; r[q] = row_rsq(ssq3, m);
#pragma unroll
                    for (int j = 0; j < 4; ++j) v[q][j] = y4[64 * j]; } }
#pragma unroll
            for (int q = 0; q < 4; ++q) { const int m = m0 + q * NGW; if (m < MT) { f32x4* y4 = (f32x4*)(out + (size_t)m * DM) + lane;
#pragma unroll
                    for (int j = 0; j < 4; ++j) y4[64 * j] = v[q][j] * r[q] * gv[j]; } }
        }
    }
#ifdef DBG_DUMP
    {
        GSYNC();
        const bf16_t* src = nullptr; int pitch = 1024;
        if (hi_ph == 2) src = uqkv; else if (hi_ph == 3) src = mix; else if (hi_ph == 4) src = x1b; else if (hi_ph == 5) src = mqb; else if (hi_ph == 6) src = mo; else if (hi_ph == 7) src = x2b; else if (hi_ph == 8 || hi_ph == 9) { src = hff; pitch = DFF; }
        if (src) for (size_t i = (size_t)bx * 512 + tid; i < (size_t)MT * 1024; i += (size_t)G * 512) { const size_t m = i >> 10, c = i & 1023; float v = __builtin_bit_cast(float, (unsigned)src[m * pitch + c] << 16); if (!(v == v)) v = 12345.f; if (fabsf(v) > 1e30f) v = 54321.f; out[i] = v; }
    }
#endif
#undef IN
#undef SEAM
}

extern "C" void kernel_launch(void* const* d_in, const int* in_sizes, int n_in, void* d_out, int out_size, void* d_ws, size_t ws_size, hipStream_t stream) {
    static int grid = 0;
    if (grid == 0) {
        if (n_in != 28 || (size_t)out_size != O_END || ws_size < WS_NEED) { fprintf(stderr, "kernel_launch: unexpected shapes (n_in %d, out %d, ws %zu); nothing launched\n", n_in, out_size, ws_size); grid = -1; return; }
        int dev = 0, cus = 0, per_cu = 0;
        hipGetDevice(&dev); hipDeviceGetAttribute(&cus, hipDeviceAttributeMultiprocessorCount, dev);
        hipFuncSetAttribute((const void*)fwd_kernel, hipFuncAttributeMaxDynamicSharedMemorySize, LDS_BYTES);
        hipOccupancyMaxActiveBlocksPerMultiprocessor(&per_cu, (const void*)fwd_kernel, 512, LDS_BYTES);
        if (per_cu < 1) { fprintf(stderr, "kernel_launch: occupancy query says %d blocks per CU\n", per_cu); per_cu = 1; }
        (void)hipGetLastError();
        grid = cus;
    }
    if (grid < 0) return;
    (void)hipMemsetAsync(d_ws, 0, 256, stream);
    Params p{};
    for (int i = 0; i < 28; ++i) p.in[i] = (const float*)d_in[i];
    p.out = (float*)d_out; p.ws = (unsigned char*)d_ws;
    void* args[] = {&p};
#ifdef PROBE_K
    p.ph_lo = 0; p.ph_hi = PROBE_K + 1;
    (void)hipLaunchCooperativeKernel((const void*)fwd_kernel, dim3(grid), dim3(512), args, LDS_BYTES, stream);
    (void)hipMemsetAsync(d_ws, 0, 256, stream);
    p.ph_lo = PROBE_K; p.ph_hi = 11;
#else
    p.ph_lo = 0; p.ph_hi = 11;
#endif
    hipError_t e = hipLaunchCooperativeKernel((const void*)fwd_kernel, dim3(grid), dim3(512), args, LDS_BYTES, stream);
    if (e != hipSuccess) fprintf(stderr, "cooperative launch failed: %s (grid %d)\n", hipGetErrorString(e), grid);
}
```

```cpp
#include <hip/hip_runtime.h>
#include <hip/hip_cooperative_groups.h>
#include <cstdio>
#include <cstdint>
namespace cg = cooperative_groups;
namespace pg8 {
#define PG8_LAS __attribute__((address_space(3)))
typedef unsigned short bf16_t;
typedef short bf16x8 __attribute__((ext_vector_type(8)));
typedef float f32x4 __attribute__((ext_vector_type(4)));
typedef unsigned u32x4 __attribute__((ext_vector_type(4)));
constexpr int BM = 256, BK = 64, HALF = 128, HTB = HALF * BK * 2  , STAGE_BYTES = 8 * HTB, NXCD = 8, WGM = 8;

__host__ __device__ __forceinline__ int lds_byte(int r, int c) { const int st = (r >> 4) * 2 + (c >> 5), rr = r & 15, cc = c & 31, ob = rr * 64 + cc * 2; return st * 1024 + (ob ^ (((ob >> 9) & 1) << 5)); }
__host__ __device__ __forceinline__ void stage_rc(int b, int& R, int& C) { const int st = b / 1024, sb = b % 1024, swz = sb ^ (((sb >> 9) & 1) << 5); R = (st >> 1) * 16 + swz / 64; C = (st & 1) * 32 + (swz % 64) / 2; }
__host__ __device__ __forceinline__ int perm32(int rho) { const int n = rho >> 4, i = rho & 15; return 8 * (i >> 2) + 4 * n + (i & 3); }

struct Unit { int pm, pn; };
struct Gemm { const bf16_t* A; const bf16_t* Bt; int M, N, K; };

struct StaticOrder {
    int nM, nN, nwg, G, c;
    __host__ __device__ void init(int M, int N, int G_, int c_) { nM = M / BM; nN = N / BM; nwg = nM * nN; G = G_; c = c_; }
    __host__ __device__ bool next(int i, Unit& u) const {
        const long L = (long)i * G + c; if (L >= nwg) return false;
        int wgid = (int)L; { const int q = nwg / NXCD, r = nwg % NXCD, xcd = wgid % NXCD, off = wgid / NXCD; wgid = (xcd < r ? xcd * (q + 1) : r * (q + 1) + (xcd - r) * q) + off; }
        const int nig = WGM * nN, gid = wgid / nig, fm = gid * WGM, gsz = (nM - fm) < WGM ? (nM - fm) : WGM;
        u.pm = fm + ((wgid % nig) % gsz); u.pn = (wgid % nig) / gsz; return true;
    }
    __device__ __forceinline__ void a_ready(const Unit&) const {}
    __device__ __forceinline__ void done(const Unit&) const {}
};

__device__ __forceinline__ unsigned cvt_pk_bf16(float lo, float hi) { unsigned r; asm volatile("v_cvt_pk_bf16_f32 %0, %1, %2" : "=v"(r) : "v"(lo), "v"(hi)); return r; }
typedef float f32x2 __attribute__((ext_vector_type(2)));
template <class Epi, class Sched, bool ALIGN_EPI = false, bool SP2 = false>
__device__ __forceinline__ void gemm_phase(PG8_LAS unsigned char* lds, const Gemm g, const Sched& S, const Epi& E) {
    const int tid = threadIdx.x, wid = __builtin_amdgcn_readfirstlane(tid >> 6), lane = tid & 63, wr = wid >> 2, wc = wid & 3, fr = lane & 15, fq = lane >> 4;
    const int K = g.K, nt = K / BK;
    unsigned voffA[2], voffB[2];
#pragma unroll
    for (int i = 0; i < 2; ++i) { int R, C; stage_rc(tid * 16 + i * 8192, R, C); const int Rb = Epi::PERM ? ((R & ~31) + perm32(R & 31)) : R;
        voffA[i] = (unsigned)(R * K + C) * 2u; voffB[i] = (unsigned)(Rb * K + C) * 2u; }
    const size_t kstep = (size_t)(BK * 2);
    const size_t hstep = (size_t)HALF * K * 2;
    const size_t tstep = 2 * hstep;
    const unsigned ldsw = (unsigned)wid * 1024u;
    const int aoff = lds_byte(wr * 64 + fr, fq * 8), boff = lds_byte(wc * 32 + fr, fq * 8);
#define PG8_SA(b, h) (((b) * 2 + (h)) * HTB)
#define PG8_SB(b, h) ((4 + (b) * 2 + (h)) * HTB)
#define PG8_STAGE(bufoff, gbase, voff) do { _Pragma("unroll") for (int _i = 0; _i < 2; ++_i) \
        __builtin_amdgcn_global_load_lds((const unsigned*)((const char*)(gbase) + (voff)[_i]), (PG8_LAS unsigned*)(lds + (bufoff) + ldsw + _i * 8192), 16, 0, 0); } while (0)
#define PG8_LDA(dst, b, h) do { _Pragma("unroll") for (int m = 0; m < 4; ++m) _Pragma("unroll") for (int k = 0; k < 2; ++k) dst[m][k] = *(const PG8_LAS bf16x8*)(lds + PG8_SA(b, h) + aoff + m * 2048 + k * 1024); } while (0)
#define PG8_LDB(dst, b, h) do { _Pragma("unroll") for (int n = 0; n < 2; ++n) _Pragma("unroll") for (int k = 0; k < 2; ++k) dst[n][k] = *(const PG8_LAS bf16x8*)(lds + PG8_SB(b, h) + boff + n * 2048 + k * 1024); } while (0)
#define PG8_MMA(ai, bj, At, Bt) do { __builtin_amdgcn_s_setprio(1); _Pragma("unroll") for (int m = 0; m < 4; ++m) _Pragma("unroll") for (int n = 0; n < 2; ++n) _Pragma("unroll") for (int k = 0; k < 2; ++k) \
        acc[ai][bj][m][n] = __builtin_amdgcn_mfma_f32_16x16x32_bf16(Bt[n][k], At[m][k], acc[ai][bj][m][n], 0, 0, 0); __builtin_amdgcn_s_setprio(0); } while (0)
#define PG8_WAIT_V(n) asm volatile("s_waitcnt vmcnt(" #n ")" ::: "memory")
#define PG8_WAIT_L(n) asm volatile("s_waitcnt lgkmcnt(" #n ")" ::: "memory")
#define PG8_BAR __builtin_amdgcn_s_barrier()
#define PG8_SCHED __builtin_amdgcn_sched_barrier(0)
    Unit cur, nxt; int ui = 0;
    if (!S.next(0, cur)) return;
    f32x4 acc[2][2][4][2];
#pragma unroll
    for (int a = 0; a < 2; ++a)
#pragma unroll
        for (int b = 0; b < 2; ++b)
#pragma unroll
            for (int m = 0; m < 4; ++m)
#pragma unroll
                for (int n = 0; n < 2; ++n) acc[a][b][m][n] = (f32x4){0.f, 0.f, 0.f, 0.f};
    bf16x8 At[4][2], B0[2][2], B1[2][2];
    const char* cA = (const char*)g.A + (size_t)cur.pm * tstep; const char* cB = (const char*)g.Bt + (size_t)cur.pn * tstep;
    S.a_ready(cur);
    if constexpr (SP2) {
        PG8_STAGE(PG8_SB(0, 0), cB, voffB); PG8_STAGE(PG8_SB(0, 1), cB + hstep, voffB); PG8_STAGE(PG8_SA(0, 0), cA, voffA); PG8_STAGE(PG8_SA(0, 1), cA + hstep, voffA);
        if (wr == 1) PG8_BAR;
        PG8_WAIT_V(2); PG8_BAR;
        PG8_STAGE(PG8_SB(1, 0), cB + kstep, voffB); PG8_STAGE(PG8_SA(1, 0), cA + kstep, voffA); PG8_STAGE(PG8_SB(1, 1), cB + hstep + kstep, voffB);
        PG8_WAIT_V(6); PG8_BAR;
    } else {
        PG8_STAGE(PG8_SB(0, 0), cB, voffB); PG8_STAGE(PG8_SA(0, 0), cA, voffA); PG8_STAGE(PG8_SB(0, 1), cB + hstep, voffB); PG8_STAGE(PG8_SA(0, 1), cA + hstep, voffA);
        if (wr == 1) PG8_BAR;
        PG8_WAIT_V(4); PG8_BAR;
        PG8_STAGE(PG8_SB(1, 0), cB + kstep, voffB); PG8_STAGE(PG8_SA(1, 0), cA + kstep, voffA); PG8_STAGE(PG8_SB(1, 1), cB + hstep + kstep, voffB);
        PG8_WAIT_V(6); PG8_BAR;
    }
    for (;;) {
        const bool has_next = S.next(ui + 1, nxt);
        const char* nA = has_next ? (const char*)g.A + (size_t)nxt.pm * tstep : cA; const char* nB = has_next ? (const char*)g.Bt + (size_t)nxt.pn * tstep : cB;
        for (int t = 0; t < nt; t += 2) {
            const bool last = (t == nt - 2);
            const char* a1 = cA + (size_t)(t + 1) * kstep;
            const char* a2 = last ? nA : cA + (size_t)(t + 2) * kstep; const char* b2 = last ? nB : cB + (size_t)(t + 2) * kstep;
            const char* a3 = a2 + kstep; const char* b3 = b2 + kstep;
            if (last && has_next) S.a_ready(nxt);
            if constexpr (SP2) {
            PG8_LDB(B0, 0, 0); PG8_LDB(B1, 0, 1); PG8_SCHED; PG8_LDA(At, 0, 0); PG8_STAGE(PG8_SA(1, 1), a1 + hstep, voffA);
            PG8_WAIT_V(8); PG8_WAIT_L(0); PG8_BAR; PG8_MMA(0, 0, At, B0); PG8_MMA(0, 1, At, B1); PG8_BAR; PG8_SCHED;
            PG8_LDA(At, 0, 1); PG8_STAGE(PG8_SB(0, 0), b2, voffB); PG8_STAGE(PG8_SB(0, 1), b2 + hstep, voffB); PG8_STAGE(PG8_SA(0, 0), a2, voffA);
            PG8_WAIT_V(8); PG8_WAIT_L(0); PG8_BAR; PG8_MMA(1, 0, At, B0); PG8_MMA(1, 1, At, B1); PG8_BAR; PG8_SCHED;
            PG8_LDB(B0, 1, 0); PG8_LDB(B1, 1, 1); PG8_SCHED; PG8_LDA(At, 1, 0); PG8_STAGE(PG8_SA(0, 1), a2 + hstep, voffA);
            PG8_WAIT_V(8); PG8_WAIT_L(0); PG8_BAR; PG8_MMA(0, 0, At, B0); PG8_MMA(0, 1, At, B1); PG8_BAR; PG8_SCHED;
            PG8_LDA(At, 1, 1); PG8_STAGE(PG8_SB(1, 0), b3, voffB); PG8_STAGE(PG8_SB(1, 1), b3 + hstep, voffB); PG8_STAGE(PG8_SA(1, 0), a3, voffA);
            PG8_WAIT_V(8); PG8_WAIT_L(0); PG8_BAR; PG8_MMA(1, 0, At, B0); PG8_MMA(1, 1, At, B1); PG8_BAR; PG8_SCHED;
            } else {
            PG8_LDB(B0, 0, 0); PG8_SCHED; PG8_LDA(At, 0, 0); PG8_STAGE(PG8_SA(1, 1), a1 + hstep, voffA);
            PG8_WAIT_L(8); PG8_BAR; PG8_WAIT_L(0); PG8_MMA(0, 0, At, B0); PG8_BAR; PG8_SCHED;
            PG8_LDB(B1, 0, 1); PG8_STAGE(PG8_SB(0, 0), b2, voffB);
            PG8_BAR; PG8_WAIT_L(0); PG8_MMA(0, 1, At, B1); PG8_BAR;
            PG8_LDA(At, 0, 1); PG8_STAGE(PG8_SA(0, 0), a2, voffA);
            PG8_BAR; PG8_WAIT_L(0); PG8_MMA(1, 0, At, B0); PG8_BAR; PG8_SCHED;
            PG8_STAGE(PG8_SB(0, 1), b2 + hstep, voffB);
            PG8_WAIT_V(6); PG8_BAR; PG8_MMA(1, 1, At, B1); PG8_BAR;
            PG8_LDB(B0, 1, 0); PG8_SCHED; PG8_LDA(At, 1, 0); PG8_STAGE(PG8_SA(0, 1), a2 + hstep, voffA);
            PG8_WAIT_L(8); PG8_BAR; PG8_WAIT_L(0); PG8_MMA(0, 0, At, B0); PG8_BAR; PG8_SCHED;
            PG8_LDB(B1, 1, 1); PG8_STAGE(PG8_SB(1, 0), b3, voffB);
            PG8_BAR; PG8_WAIT_L(0); PG8_MMA(0, 1, At, B1); PG8_BAR;
            PG8_LDA(At, 1, 1); PG8_STAGE(PG8_SA(1, 0), a3, voffA);
            PG8_BAR; PG8_WAIT_L(0); PG8_MMA(1, 0, At, B0); PG8_BAR; PG8_SCHED;
            PG8_STAGE(PG8_SB(1, 1), b3 + hstep, voffB);
            PG8_WAIT_V(6); PG8_BAR; PG8_MMA(1, 1, At, B1); PG8_BAR;
            }
        }
        if constexpr (ALIGN_EPI) { if (wr == 0) PG8_BAR; }
        if constexpr (!Epi::AFTER_DRAIN) { E(acc, cur, wr, wc, fr, fq); S.done(cur); }
        if (!has_next) break;
#pragma unroll
        for (int a = 0; a < 2; ++a)
#pragma unroll
            for (int b = 0; b < 2; ++b)
#pragma unroll
                for (int m = 0; m < 4; ++m)
#pragma unroll
                    for (int n = 0; n < 2; ++n) acc[a][b][m][n] = (f32x4){0.f, 0.f, 0.f, 0.f};
        cur = nxt; cA = nA; cB = nB; ++ui;
        if constexpr (ALIGN_EPI) { if (wr == 1) PG8_BAR; }
    }
    PG8_WAIT_V(0);
    if constexpr (!ALIGN_EPI) { if (wr == 0) PG8_BAR; }
    PG8_BAR;
    if constexpr (Epi::AFTER_DRAIN) { E.fused(acc, cur, wr, wc, fr, fq, lds, wid, lane); S.done(cur); }
#undef PG8_SA
#undef PG8_SB
#undef PG8_STAGE
#undef PG8_LDA
#undef PG8_LDB
#undef PG8_MMA
#undef PG8_WAIT_V
#undef PG8_WAIT_L
#undef PG8_BAR
#undef PG8_SCHED
}
}

using pg8::bf16_t; using pg8::bf16x8; using pg8::f32x4; using pg8::u32x4; using pg8::Unit;
typedef float f32x2_t __attribute__((ext_vector_type(2))); typedef __bf16 bf16x2_t __attribute__((ext_vector_type(2)));
__device__ __forceinline__ unsigned cvt_pk_bf16(float lo, float hi) { f32x2_t v = {lo, hi}; bf16x2_t b = __builtin_convertvector(v, bf16x2_t); return __builtin_bit_cast(unsigned, b); }
typedef float f32x16 __attribute__((ext_vector_type(16)));
typedef unsigned u32x2 __attribute__((ext_vector_type(2)));
#define LAS __attribute__((address_space(3)))

constexpr int DM = 1024, MP = 65536, MS = 1024, MT = MP + MS, SEQ = 2048, DSEQ = 64, PAST = 4096, NMEM = 256;
constexpr int DFF = 2816, NUP = 2 * DFF, NSEG = MT / 64;
constexpr float EPS = 1e-6f, LOG2E = 1.4426950408889634f;
constexpr float C2F = 0.125f * LOG2E, C2M = 0.0625f * LOG2E;
constexpr float NEGBIG = -1e30f;

constexpr size_t O_YP = 0, O_YS = O_YP + (size_t)MP * DM, O_KP = O_YS + (size_t)MS * DM, O_VP = O_KP + (size_t)MP * 512, O_LFP = O_VP + (size_t)MP * 512,
    O_PSP = O_LFP + (size_t)MP * 8, O_CSP = O_PSP + 32 * 15 * 512, O_MKP = O_CSP + 32 * 2 * DFF, O_MVP = O_MKP + (size_t)8192 * 1024, O_KS = O_MVP + (size_t)8192 * 1024,
    O_VS = O_KS + (size_t)MS * 512, O_LFS = O_VS + (size_t)MS * 512, O_PSS = O_LFS + MS * 8, O_CSS = O_PSS + 16 * 15 * 512, O_END = O_CSS + 16 * 2 * DFF;

constexpr size_t MiB = 1u << 20;
constexpr size_t WS_WIN = 1 * MiB, WS_WO = 5 * MiB, WS_WMQ = 7 * MiB, WS_WMO = 9 * MiB, WS_WMKV = 11 * MiB, WS_WUP = 15 * MiB, WS_WDN = 26 * MiB, WS_WPOOL = 32 * MiB;
constexpr size_t WS_USX = 34 * MiB;
constexpr size_t WS_MKB = 40 * MiB, WS_MVB = 64 * MiB;
constexpr size_t WS_SSQ1 = 88 * MiB, WS_SSQ2 = 93 * MiB, WS_SSQ3 = 98 * MiB;
constexpr size_t WS_KBP = 103 * MiB, WS_KBS = 105 * MiB;
constexpr size_t WS_AHEAD = 108 * MiB, WS_ATAIL = WS_AHEAD + 23 * MiB / 1 - MiB / 2, WS_BHEAD = WS_ATAIL + 23 * MiB - MiB / 2;
constexpr size_t WS_X1B = 176 * MiB, WS_KCB = 176 * MiB, WS_VCB = 240 * MiB;
constexpr size_t WS_X2B = 306 * MiB;
constexpr size_t WS_XB = 436 * MiB, WS_MQB = 436 * MiB, WS_HFF = 436 * MiB;
constexpr size_t WS_UQKV = 566 * MiB, WS_MO = 566 * MiB;
constexpr size_t WS_MIX = 826 * MiB, WS_MEMB = 956 * MiB, WS_NEED = 972 * MiB;
static_assert((size_t)NSEG * 2 * DFF * 4 <= 22 * MiB + MiB / 2, "side buffers");
static_assert(WS_BHEAD + 22 * MiB + MiB / 2 <= WS_X1B, "side buffers end");

#define P2_ATTN_P 1
#define P2_ATTN_S 1
#define P2_POOL 1
#define DBG_HI 11
#ifndef PHMASK
#define PHMASK 0x7ff
#endif
constexpr int LDS_BYTES = 147456;

struct Params { const float* in[28]; float* out; unsigned char* ws; int ph_lo, ph_hi; };

__device__ __forceinline__ float bf_lo(unsigned w) { return __builtin_bit_cast(float, w << 16); }
__device__ __forceinline__ float bf_hi(unsigned w) { return __builtin_bit_cast(float, w & 0xffff0000u); }
__device__ __forceinline__ int crow(int r, int hi) { return (r & 3) + 8 * (r >> 2) + 4 * hi; }
__device__ __forceinline__ float wave_sum(float v) {
#pragma unroll
    for (int o = 1; o < 64; o <<= 1) v += __shfl_xor(v, o);
    return v;
}
__device__ __forceinline__ float rsq(float ssq) { return 1.0f / sqrtf(ssq * (1.0f / 1024.0f) + EPS); }
#define LDS_WAIT() asm volatile("s_waitcnt lgkmcnt(0)" ::: "memory")

typedef const f32x4 (&AccRef)[2][2][4][2];

__device__ __forceinline__ u32x4 pack8(f32x4 v0, f32x4 v1) { u32x4 w; w.x = cvt_pk_bf16(v0[0], v0[1]); w.y = cvt_pk_bf16(v0[2], v0[3]); w.z = cvt_pk_bf16(v1[0], v1[1]); w.w = cvt_pk_bf16(v1[2], v1[3]); return w; }

struct EpiIn {
    static constexpr bool PERM = true, AFTER_DRAIN = false;
    bf16_t* uqkv; float* out; bf16_t* usx;
    __device__ __forceinline__ void operator()(AccRef acc, const Unit& u, int wr, int wc, int fr, int fq) const {
        const int t = u.pn >> 1;
        const int col0 = (u.pn & 1) * 256 + wc * 32 + 8 * fq;
        bf16_t* base = uqkv + (size_t)t * MT * 512;
        const float sc = (t == 1) ? C2F : 1.0f;
#pragma unroll
        for (int ai = 0; ai < 2; ++ai)
#pragma unroll
            for (int m = 0; m < 4; ++m) {
                const int row = u.pm * 256 + ai * 128 + wr * 64 + m * 16 + fr;
#pragma unroll
                for (int bj = 0; bj < 2; ++bj) {
                    const int col = col0 + bj * 128;
                    const f32x4 v0 = acc[ai][bj][m][0] * sc, v1 = acc[ai][bj][m][1] * sc;
                    *(u32x4*)(base + (size_t)row * 512 + col) = pack8(v0, v1);
                    if (t >= 2) {
                        float* o = (row < MP) ? out + (t == 2 ? O_KP : O_VP) + (size_t)row * 512 : out + (t == 2 ? O_KS : O_VS) + (size_t)(row - MP) * 512;
                        *(f32x4*)(o + col) = v0; *(f32x4*)(o + col + 4) = v1;
                    } else if (t == 0) {
                        if (row < MP) { const int tt = row & (SEQ - 1); if (tt >= SEQ - 15) { float* o = out + O_PSP + ((size_t)(row >> 11) * 15 + (tt - (SEQ - 15))) * 512 + col; *(f32x4*)o = v0; *(f32x4*)(o + 4) = v1; } }
                        else { const int rs = row - MP, tt = rs & 63; *(u32x4*)(usx + ((size_t)(rs >> 6) * 79 + 15 + tt) * 512 + col) = pack8(v0, v1); if (tt >= DSEQ - 15) { float* o = out + O_PSS + ((size_t)(rs >> 6) * 15 + (tt - (DSEQ - 15))) * 512 + col; *(f32x4*)o = v0; *(f32x4*)(o + 4) = v1; } }
                    }
                }
            }
    }
};
struct EpiMkv {
    static constexpr bool PERM = true, AFTER_DRAIN = false;
    bf16_t* mkb; bf16_t* mvb; float* out;
    __device__ __forceinline__ void operator()(AccRef acc, const Unit& u, int wr, int wc, int fr, int fq) const {
        const int t = u.pn >> 2;
        const int col0 = (u.pn & 3) * 256 + wc * 32 + 8 * fq;
        bf16_t* bb = t ? mvb : mkb; float* of = out + (t ? O_MVP : O_MKP);
#pragma unroll
        for (int ai = 0; ai < 2; ++ai)
#pragma unroll
            for (int m = 0; m < 4; ++m) {
                const int row = u.pm * 256 + ai * 128 + wr * 64 + m * 16 + fr;
#pragma unroll
                for (int bj = 0; bj < 2; ++bj) {
                    const int col = col0 + bj * 128;
                    const f32x4 v0 = acc[ai][bj][m][0], v1 = acc[ai][bj][m][1];
                    *(u32x4*)(bb + (size_t)row * 1024 + col) = pack8(v0, v1);
                    *(f32x4*)(of + (size_t)row * 1024 + col) = v0; *(f32x4*)(of + (size_t)row * 1024 + col + 4) = v1;
                }
            }
    }
};
template <int MODE> struct EpiRes {
    static constexpr bool PERM = true, AFTER_DRAIN = false;
    const float* xP; const float* xS; const bf16_t* resB; bf16_t* xo; float* yo; float* ssqp;
    __device__ __forceinline__ void operator()(AccRef acc, const Unit& u, int wr, int wc, int fr, int fq) const {
        const int col0 = u.pn * 256 + wc * 32 + 8 * fq;
#pragma unroll
        for (int ai = 0; ai < 2; ++ai)
#pragma unroll
            for (int m = 0; m < 4; ++m) {
                const int row = u.pm * 256 + ai * 128 + wr * 64 + m * 16 + fr;
                float ss = 0.f;
#pragma unroll
                for (int bj = 0; bj < 2; ++bj) {
                    const int col = col0 + bj * 128;
                    f32x4 r0, r1;
                    if (MODE == 0) { const float* xr = (row < MP) ? xP + (size_t)row * DM : xS + (size_t)(row - MP) * DM; r0 = *(const f32x4*)(xr + col); r1 = *(const f32x4*)(xr + col + 4); }
                    else { const u32x4 w = *(const u32x4*)(resB + (size_t)row * DM + col); r0 = (f32x4){bf_lo(w.x), bf_hi(w.x), bf_lo(w.y), bf_hi(w.y)}; r1 = (f32x4){bf_lo(w.z), bf_hi(w.z), bf_lo(w.w), bf_hi(w.w)}; }
                    const f32x4 v0 = acc[ai][bj][m][0] + r0, v1 = acc[ai][bj][m][1] + r1;
                    ss += (v0[0] * v0[0] + v0[1] * v0[1]) + (v0[2] * v0[2] + v0[3] * v0[3]) + (v1[0] * v1[0] + v1[1] * v1[1]) + (v1[2] * v1[2] + v1[3] * v1[3]);
                    if (MODE == 2) { float* yr = (row < MP) ? yo + O_YP + (size_t)row * DM : yo + O_YS + (size_t)(row - MP) * DM; *(f32x4*)(yr + col) = v0; *(f32x4*)(yr + col + 4) = v1; }
                    else *(u32x4*)(xo + (size_t)row * DM + col) = pack8(v0, v1);
                }
                ss += __shfl_xor(ss, 16); ss += __shfl_xor(ss, 32);
                if (fq == 0) ssqp[(size_t)row * 16 + u.pn * 4 + wc] = ss;
            }
    }
};
__device__ __forceinline__ float row_rsq(const float* ssqp, int row) {
    const f32x4* sp = (const f32x4*)(ssqp + (size_t)row * 16);
    const f32x4 a = sp[0], b = sp[1], c = sp[2], d = sp[3];
    const float s = ((a[0] + a[1]) + (a[2] + a[3])) + ((b[0] + b[1]) + (b[2] + b[3])) + ((c[0] + c[1]) + (c[2] + c[3])) + ((d[0] + d[1]) + (d[2] + d[3]));
    return rsq(s);
}
struct EpiMq {
    static constexpr bool PERM = true, AFTER_DRAIN = false;
    const float* ssqp; bf16_t* mq;
    __device__ __forceinline__ void operator()(AccRef acc, const Unit& u, int wr, int wc, int fr, int fq) const {
        const int col0 = u.pn * 256 + wc * 32 + 8 * fq;
#pragma unroll
        for (int ai = 0; ai < 2; ++ai)
#pragma unroll
            for (int m = 0; m < 4; ++m) {
                const int row = u.pm * 256 + ai * 128 + wr * 64 + m * 16 + fr;
                const float r = row_rsq(ssqp, row) * C2M;
#pragma unroll
                for (int bj = 0; bj < 2; ++bj) *(u32x4*)(mq + (size_t)row * DM + col0 + bj * 128) = pack8(acc[ai][bj][m][0] * r, acc[ai][bj][m][1] * r);
            }
    }
};
struct EpiUp {
    static constexpr bool PERM = true, AFTER_DRAIN = false;
    const float* ssqp; const float* cw; const float* cb; bf16_t* hff; float* ahead; float* atail; float* bhead;
    __device__ __forceinline__ void operator()(AccRef acc, const Unit& u, int wr, int wc, int fr, int fq) const {
        const int lane = fq * 16 + fr;
        const int c0 = u.pn * 128 + wc * 32 + 8 * fq;
        f32x4 w0[2], w1[2], w2[2], bb[2];
#pragma unroll
        for (int n = 0; n < 2; ++n) { w0[n] = *(const f32x4*)(cw + c0 + 4 * n); w1[n] = *(const f32x4*)(cw + DFF + c0 + 4 * n); w2[n] = *(const f32x4*)(cw + 2 * DFF + c0 + 4 * n); bb[n] = *(const f32x4*)(cb + c0 + 4 * n); }
        const int src1 = (lane & 48) | ((fr + 15) & 15), src2 = (lane & 48) | ((fr + 14) & 15);
#pragma unroll
        for (int ai = 0; ai < 2; ++ai) {
            const int seg = u.pm * 4 + ai * 2 + wr;
            const int rowb = u.pm * 256 + ai * 128 + wr * 64;
            f32x4 ap[2] = {{0.f, 0.f, 0.f, 0.f}, {0.f, 0.f, 0.f, 0.f}};
#pragma unroll
            for (int m = 0; m < 4; ++m) {
                const int row = rowb + m * 16 + fr;
                const float r = row_rsq(ssqp, row);
                f32x4 a[2], b[2], h[2];
#pragma unroll
                for (int n = 0; n < 2; ++n) {
                    a[n] = acc[ai][0][m][n] * r; b[n] = acc[ai][1][m][n] * r;
                    f32x4 a1, a2;
#pragma unroll
                    for (int e = 0; e < 4; ++e) {
                        const float x1 = (fr == 15) ? ap[n][e] : a[n][e]; a1[e] = __shfl(x1, src1);
                        const float x2 = (fr >= 14) ? ap[n][e] : a[n][e]; a2[e] = __shfl(x2, src2);
                    }
                    const f32x4 cv = bb[n] + w0[n] * a2 + w1[n] * a1 + w2[n] * a[n];
#pragma unroll
                    for (int e = 0; e < 4; ++e) h[n][e] = cv[e] * __builtin_amdgcn_rcpf(1.0f + __builtin_amdgcn_exp2f(-cv[e] * LOG2E)) * b[n][e];
                    ap[n] = a[n];
                }
                if (m == 0 && fr < 2) {
                    float* pa = ahead + ((size_t)seg * 2 + fr) * DFF + c0; float* pb = bhead + ((size_t)seg * 2 + fr) * DFF + c0;
                    *(f32x4*)pa = a[0]; *(f32x4*)(pa + 4) = a[1]; *(f32x4*)pb = b[0]; *(f32x4*)(pb + 4) = b[1];
                } else {
                    *(u32x4*)(hff + (size_t)row * DFF + c0) = pack8(h[0], h[1]);
                }
                if (m == 3 && fr >= 14) { float* pt = atail + ((size_t)seg * 2 + (fr - 14)) * DFF + c0; *(f32x4*)pt = a[0]; *(f32x4*)(pt + 4) = a[1]; }
            }
        }
    }
};

template <int D, int KT, int KG, bool PF, bool QLDS, bool CAUSAL, bool BIAS>
__device__ __forceinline__ void attn_unit(LAS unsigned char* L, const bf16_t* __restrict__ Q, int ldq, int nq,
                                          const bf16_t* __restrict__ K0, const bf16_t* __restrict__ V0, int nt0, const bf16_t* __restrict__ K1, const bf16_t* __restrict__ V1, int ldk, int ntiles,
                                          const float* __restrict__ kbias, int qpos0, bf16_t* __restrict__ O, int ldo) {
    constexpr int KS = D + 8, VS = KT + 4, CH = D / 8, NKI = KT * CH / 512, NVI = ((KT / 2) * CH + 511) / 512, NQF = (D == 64) ? 4 : 1, NP = KT / 32, QW = 8 / KG;
    constexpr int TILEB = KT * KS * 2 + D * VS * 2 + (BIAS ? KT * 4 : 0);
    constexpr int QBYTES = QLDS ? 32 * QW * KS * 2 : 0;
    constexpr int NG = (KG == 1) ? 2 : (!PF ? 1 : KG);
    const int tid = threadIdx.x, lane = tid & 63, wid = __builtin_amdgcn_readfirstlane(tid >> 6), r32 = lane & 31, hi = lane >> 5;
    const int qw = wid % QW, kg = wid / QW;
    const bool wact = qw * 32 < nq;
    LAS unsigned char* T = L + QBYTES;
    const LAS bf16_t* Qs = (const LAS bf16_t*)L + (qw * 32 + r32) * KS + hi * 8;
    const bf16_t* qrow = Q + (size_t)(qw * 32 + r32) * ldq + hi * 8;
    bf16x8 qf[NQF];
    if (D == 64 && !QLDS) {
#pragma unroll
        for (int ds = 0; ds < NQF; ++ds) qf[ds] = wact ? *(const bf16x8*)(qrow + ds * 16) : (bf16x8){0, 0, 0, 0, 0, 0, 0, 0};
    }
    if (QLDS) {
        __syncthreads();
        constexpr int NQI = 32 * QW * CH / 512;
#pragma unroll
        for (int i = 0; i < NQI; ++i) { const int id = tid + 512 * i, row = id / CH, ch = id % CH; if (row < nq) *(LAS u32x4*)((LAS bf16_t*)L + row * KS + ch * 8) = *(const u32x4*)(Q + (size_t)row * ldq + ch * 8); }
    }
    float ref = 0.f;
    if (BIAS) ref = wact ? kbias[qpos0 + qw * 32 + r32] : 0.f;
    f32x16 o[D / 32];
#pragma unroll
    for (int db = 0; db < D / 32; ++db)
#pragma unroll
        for (int r = 0; r < 16; ++r) o[db][r] = 0.f;
    float lrun = 0.f;
    u32x4 kreg[NG][NKI], vreg[NG][NVI][2]; float breg[NG];
#define ATT_LOAD(j, g) do { const bf16_t* Kt_ = ((j) < nt0) ? K0 + (size_t)(j) * KT * ldk : K1 + (size_t)((j) - nt0) * KT * ldk; \
        const bf16_t* Vg_ = ((j) < nt0) ? V0 + (size_t)(j) * KT * ldk : V1 + (size_t)((j) - nt0) * KT * ldk; \
        _Pragma("unroll") for (int i_ = 0; i_ < NKI; ++i_) { const int id_ = tid + 512 * i_, row_ = id_ / CH, ch_ = id_ % CH; kreg[g][i_] = *(const u32x4*)(Kt_ + (size_t)row_ * ldk + ch_ * 8); } \
        _Pragma("unroll") for (int i_ = 0; i_ < NVI; ++i_) { const int id_ = tid + 512 * i_; if (id_ < (KT / 2) * CH) { const int pr_ = id_ % (KT / 2), ch_ = id_ / (KT / 2); \
            vreg[g][i_][0] = *(const u32x4*)(Vg_ + (size_t)(2 * pr_) * ldk + ch_ * 8); vreg[g][i_][1] = *(const u32x4*)(Vg_ + (size_t)(2 * pr_ + 1) * ldk + ch_ * 8); } } \
        if (BIAS && tid < KT) breg[g] = kbias[(j) * KT + tid]; } while (0)
#define ATT_STORE(TB, g) do { LAS bf16_t* Ks_ = (LAS bf16_t*)(TB); LAS bf16_t* Vt_ = (LAS bf16_t*)((TB) + KT * KS * 2); \
        _Pragma("unroll") for (int i_ = 0; i_ < NKI; ++i_) { const int id_ = tid + 512 * i_, row_ = id_ / CH, ch_ = id_ % CH; *(LAS u32x4*)(Ks_ + row_ * KS + ch_ * 8) = kreg[g][i_]; } \
        _Pragma("unroll") for (int i_ = 0; i_ < NVI; ++i_) { const int id_ = tid + 512 * i_; if (id_ < (KT / 2) * CH) { const int pr_ = id_ % (KT / 2), ch_ = id_ / (KT / 2); \
            _Pragma("unroll") for (int e_ = 0; e_ < 4; ++e_) { const unsigned lo_ = vreg[g][i_][0][e_], h2_ = vreg[g][i_][1][e_]; \
                *(LAS unsigned*)(Vt_ + (ch_ * 8 + 2 * e_) * VS + 2 * pr_) = (lo_ & 0xffffu) | (h2_ << 16); \
                *(LAS unsigned*)(Vt_ + (ch_ * 8 + 2 * e_ + 1) * VS + 2 * pr_) = (lo_ >> 16) | (h2_ & 0xffff0000u); } } } \
        if (BIAS && tid < KT) ((LAS float*)((TB) + KT * KS * 2 + D * VS * 2))[tid] = breg[g]; } while (0)
#define ATT_COMPUTE(j, TB) do { const LAS bf16_t* Ks_ = (const LAS bf16_t*)(TB); const LAS bf16_t* Vt_ = (const LAS bf16_t*)((TB) + KT * KS * 2); const LAS float* Bs_ = (const LAS float*)((TB) + KT * KS * 2 + D * VS * 2); \
        if (wact && (!CAUSAL || KT * (j) <= qpos0 + qw * 32 + 31)) { \
            f32x16 p[NP]; \
            const bf16_t* qr_ = qrow; if (D != 64 && !QLDS) asm volatile("" : "+v"(qr_)); \
            _Pragma("unroll") for (int h_ = 0; h_ < NP; ++h_) { \
                if (BIAS) { _Pragma("unroll") for (int i_ = 0; i_ < 4; ++i_) { const f32x4 t0_ = *(const LAS f32x4*)(Bs_ + 32 * h_ + 8 * i_ + 4 * hi); \
                        _Pragma("unroll") for (int e_ = 0; e_ < 4; ++e_) p[h_][4 * i_ + e_] = t0_[e_] - ref; } } \
                else { _Pragma("unroll") for (int r_ = 0; r_ < 16; ++r_) p[h_][r_] = 0.f; } } \
            _Pragma("unroll") for (int ds_ = 0; ds_ < D / 16; ++ds_) { \
                bf16x8 qv_; if (QLDS) qv_ = *(const LAS bf16x8*)(Qs + ds_ * 16); else if (D == 64) qv_ = qf[ds_]; else qv_ = *(const bf16x8*)(qr_ + ds_ * 16); \
                _Pragma("unroll") for (int h_ = 0; h_ < NP; ++h_) { const bf16x8 kf_ = *(const LAS bf16x8*)(Ks_ + (32 * h_ + r32) * KS + ds_ * 16 + hi * 8); p[h_] = __builtin_amdgcn_mfma_f32_32x32x16_bf16(kf_, qv_, p[h_], 0, 0, 0); } } \
            if (CAUSAL && (KT * (j) + KT - 1 > qpos0 + qw * 32)) { const int lim_ = qpos0 + qw * 32 + r32 - KT * (j); \
                _Pragma("unroll") for (int h_ = 0; h_ < NP; ++h_) _Pragma("unroll") for (int r_ = 0; r_ < 16; ++r_) { if (crow(r_, hi) + 32 * h_ > lim_) p[h_][r_] = NEGBIG; } } \
            float sum_ = 0.f; \
            _Pragma("unroll") for (int h_ = 0; h_ < NP; ++h_) _Pragma("unroll") for (int r_ = 0; r_ < 16; ++r_) { p[h_][r_] = __builtin_amdgcn_exp2f(p[h_][r_]); sum_ += p[h_][r_]; } \
            lrun += sum_; \
            u32x4 pw_[2 * NP]; \
            _Pragma("unroll") for (int h_ = 0; h_ < NP; ++h_) _Pragma("unroll") for (int e_ = 0; e_ < 4; ++e_) { pw_[2 * h_][e_] = pg8::cvt_pk_bf16(p[h_][2 * e_], p[h_][2 * e_ + 1]); pw_[2 * h_ + 1][e_] = pg8::cvt_pk_bf16(p[h_][8 + 2 * e_], p[h_][9 + 2 * e_]); } \
            _Pragma("unroll") for (int db_ = 0; db_ < D / 32; ++db_) _Pragma("unroll") for (int ks_ = 0; ks_ < 2 * NP; ++ks_) { \
                const LAS bf16_t* vp_ = Vt_ + (db_ * 32 + r32) * VS + ks_ * 16 + hi * 4; \
                const u32x2 va_ = *(const LAS u32x2*)vp_, vb_ = *(const LAS u32x2*)(vp_ + 8); const u32x4 vv_ = {va_.x, va_.y, vb_.x, vb_.y}; \
                o[db_] = __builtin_amdgcn_mfma_f32_32x32x16_bf16(__builtin_bit_cast(bf16x8, vv_), __builtin_bit_cast(bf16x8, pw_[ks_]), o[db_], 0, 0, 0); } \
        } } while (0)
    if (KG == 1) {
        ATT_LOAD(0, 0); ATT_STORE(T, 0); if (ntiles > 1) ATT_LOAD(1, 1); if (ntiles > 2) ATT_LOAD(2, 0);
        __syncthreads();
        for (int j = 0; j < ntiles; j += 2) {
            if (j + 1 < ntiles) ATT_STORE(T + TILEB, 1);
            if (j + 3 < ntiles) ATT_LOAD(j + 3, 1);
            ATT_COMPUTE(j, T);
            __syncthreads();
            if (j + 1 < ntiles) {
                if (j + 2 < ntiles) ATT_STORE(T, 0);
                if (j + 4 < ntiles) ATT_LOAD(j + 4, 0);
                ATT_COMPUTE(j + 1, T + TILEB);
                __syncthreads();
            }
        }
    } else {
        const int nsteps = (ntiles + KG - 1) / KG;
        if (PF) {
#pragma unroll
            for (int g = 0; g < NG; ++g) { if (g < ntiles) ATT_LOAD(g, g); }
        }
        for (int s = 0; s < nsteps; ++s) {
            __syncthreads();
            if (PF) {
#pragma unroll
                for (int g = 0; g < NG; ++g) { if (s * KG + g < ntiles) ATT_STORE(T + g * TILEB, g); }
            } else {
#pragma unroll
                for (int g = 0; g < KG; ++g) { const int jt = s * KG + g; if (jt < ntiles) { ATT_LOAD(jt, 0); ATT_STORE(T + g * TILEB, 0); } }
            }
            __syncthreads();
            if (PF && s + 1 < nsteps) {
#pragma unroll
                for (int g = 0; g < NG; ++g) { const int jt = (s + 1) * KG + g; if (jt < ntiles) ATT_LOAD(jt, g); }
            }
            const int jm = s * KG + kg;
            if (jm < ntiles) ATT_COMPUTE(jm, T + kg * TILEB);
        }
        LAS float* Mg = (LAS float*)T;
#pragma unroll
        for (int db = 0; db < D / 32; ++db) {
            __syncthreads();
#pragma unroll
            for (int r = 0; r < 16; ++r) Mg[(wid * 17 + r) * 64 + lane] = o[db][r];
            if (db == 0) Mg[(wid * 17 + 16) * 64 + lane] = lrun;
            __syncthreads();
            if (kg == 0) {
#pragma unroll
                for (int g = 1; g < KG; ++g) {
#pragma unroll
                    for (int r = 0; r < 16; ++r) o[db][r] += Mg[((g * QW + qw) * 17 + r) * 64 + lane];
                    if (db == 0) lrun += Mg[((g * QW + qw) * 17 + 16) * 64 + lane];
                }
            }
        }
        __syncthreads();
    }
#undef ATT_LOAD
#undef ATT_STORE
#undef ATT_COMPUTE
    if (kg == 0 && wact) {
        const float lt = lrun + __shfl_xor(lrun, 32), inv = 1.0f / lt;
        bf16_t* orow = O + (size_t)(qw * 32 + r32) * ldo;
#pragma unroll
        for (int db = 0; db < D / 32; ++db)
#pragma unroll
            for (int i = 0; i < 4; ++i) { u32x2 w; w.x = pg8::cvt_pk_bf16(o[db][4 * i] * inv, o[db][4 * i + 1] * inv); w.y = pg8::cvt_pk_bf16(o[db][4 * i + 2] * inv, o[db][4 * i + 3] * inv);
                *(u32x2*)(orow + db * 32 + 8 * i + 4 * hi) = w; }
    }
}

constexpr int POOL_RS = 272, POOL_SLAB = 48 * POOL_RS;
template <int G>
__device__ __forceinline__ void pool_group(LAS unsigned char* slab, const char* __restrict__ ubase, unsigned rowoff0, int nprev0, int nprev, float icnt, const bf16_t* __restrict__ wpt, bf16_t* __restrict__ orow, int lane, int r32, int hi) {
    constexpr int w = 2 << G;
    {
        u32x4 st[12];
#pragma unroll
        for (int k = 0; k < 12; ++k) { const int id = lane + 64 * k, row = id >> 4, ch = id & 15; const int rr = (15 - row <= nprev0) ? row : 15;
            if (row < 47) st[k] = *(const u32x4*)(ubase + (rowoff0 + (unsigned)(rr - 15) * 1024u + (unsigned)(G * 256 + ch * 16))); }
#pragma unroll
        for (int k = 0; k < 12; ++k) { const int id = lane + 64 * k, row = id >> 4, ch = id & 15; if (row < 47) *(LAS u32x4*)(slab + row * POOL_RS + ch * 16) = st[k]; }
    }
    bf16x8 dfr[8];
#pragma unroll
    for (int ks = 0; ks < 8; ++ks) {
        const LAS unsigned char* cp = slab + (15 + r32) * POOL_RS + (ks * 16 + hi * 8) * 2;
        const u32x4 cu = *(const LAS u32x4*)cp;
        float s[8], cur[8];
        cur[0] = bf_lo(cu.x); cur[1] = bf_hi(cu.x); cur[2] = bf_lo(cu.y); cur[3] = bf_hi(cu.y); cur[4] = bf_lo(cu.z); cur[5] = bf_hi(cu.z); cur[6] = bf_lo(cu.w); cur[7] = bf_hi(cu.w);
#pragma unroll
        for (int e = 0; e < 8; ++e) s[e] = cur[e];
#pragma unroll
        for (int j = 1; j < w; ++j) {
            const float wt = (j <= nprev) ? 1.f : 0.f;
            const u32x4 v = *(const LAS u32x4*)(cp - j * POOL_RS);
            s[0] += wt * bf_lo(v.x); s[1] += wt * bf_hi(v.x); s[2] += wt * bf_lo(v.y); s[3] += wt * bf_hi(v.y); s[4] += wt * bf_lo(v.z); s[5] += wt * bf_hi(v.z); s[6] += wt * bf_lo(v.w); s[7] += wt * bf_hi(v.w);
        }
        u32x4 dv;
        dv.x = cvt_pk_bf16(s[0] * icnt - cur[0], s[1] * icnt - cur[1]); dv.y = cvt_pk_bf16(s[2] * icnt - cur[2], s[3] * icnt - cur[3]);
        dv.z = cvt_pk_bf16(s[4] * icnt - cur[4], s[5] * icnt - cur[5]); dv.w = cvt_pk_bf16(s[6] * icnt - cur[6], s[7] * icnt - cur[7]);
        dfr[ks] = __builtin_bit_cast(bf16x8, dv);
        __builtin_amdgcn_sched_barrier(0);
    }
#pragma unroll
    for (int nb = 0; nb < 4; ++nb) {
        f32x16 acc;
#pragma unroll
        for (int r = 0; r < 16; ++r) acc[r] = 0.f;
        const bf16_t* wrow = wpt + ((size_t)G * 128 + nb * 32 + r32) * 128 + hi * 8;
#pragma unroll
        for (int ks = 0; ks < 8; ++ks) acc = __builtin_amdgcn_mfma_f32_32x32x16_bf16(*(const bf16x8*)(wrow + ks * 16), dfr[ks], acc, 0, 0, 0);
#pragma unroll
        for (int i = 0; i < 4; ++i) { u32x2 wv; wv.x = cvt_pk_bf16(acc[4 * i], acc[4 * i + 1]); wv.y = cvt_pk_bf16(acc[4 * i + 2], acc[4 * i + 3]);
            *(u32x2*)(orow + G * 128 + nb * 32 + 8 * i + 4 * hi) = wv; }
    }
}
__device__ __forceinline__ void pool_unit(LAS unsigned char* L, int tile, const bf16_t* __restrict__ ub, const bf16_t* __restrict__ usx, const bf16_t* __restrict__ wpt, bf16_t* __restrict__ mix) {
    const int tid = threadIdx.x, lane = tid & 63, wid = __builtin_amdgcn_readfirstlane(tid >> 6), r32 = lane & 31, hi = lane >> 5;
    const int row0 = tile * 256 + wid * 32, row = row0 + r32;
    const bool samp = tile >= 256;
    const int b0 = samp ? (row0 - MP) >> 6 : row0 >> 11, t0 = samp ? (row0 - MP) & 63 : row0 & (SEQ - 1);
    const char* ubase = (const char*)(samp ? usx : ub);
    const unsigned rowoff0 = (samp ? (unsigned)(b0 * 79 + 15 + t0) : (unsigned)row0) * 1024u;
    const int nprev0 = samp ? t0 + 15 : t0, nprev = nprev0 + r32;
    bf16_t* orow = mix + (size_t)row * DM;
    const int np1 = nprev + 1;
    LAS unsigned char* slab = L + wid * POOL_SLAB;
    pool_group<0>(slab, ubase, rowoff0, nprev0, nprev, 1.0f / (float)(np1 < 2 ? np1 : 2), wpt, orow, lane, r32, hi);
    pool_group<1>(slab, ubase, rowoff0, nprev0, nprev, 1.0f / (float)(np1 < 4 ? np1 : 4), wpt, orow, lane, r32, hi);
    pool_group<2>(slab, ubase, rowoff0, nprev0, nprev, 1.0f / (float)(np1 < 8 ? np1 : 8), wpt, orow, lane, r32, hi);
    pool_group<3>(slab, ubase, rowoff0, nprev0, nprev, 1.0f / (float)(np1 < 16 ? np1 : 16), wpt, orow, lane, r32, hi);
}

template <int MODE>
__device__ __forceinline__ void transpose_item(const float* __restrict__ W, int K, int N, int nblk, bf16_t* __restrict__ WT, int row_off, const float* __restrict__ g, LAS float* scr, int item, int lane) {
    const int kb = item / nblk, nb = item % nblk, k0 = 64 * kb, n0 = 32 * nb;
#pragma unroll 8
    for (int i = 0; i < 32; ++i) { const int kk = 2 * i + (lane >> 5); float v = W[(size_t)(k0 + kk) * N + n0 + (lane & 31)]; if (g) v *= g[k0 + kk]; scr[kk * 33 + (lane & 31)] = v; }
    LDS_WAIT();
    const int c = lane & 7;
#pragma unroll
    for (int j = 0; j < 4; ++j) {
        const int n = (lane >> 3) + 8 * j; const LAS float* s = scr + (8 * c) * 33 + n;
        const int nn = n0 + n; int drow;
        if (MODE == 0) drow = row_off + nn; else { const int half = nn / DFF, cc = nn % DFF; drow = (cc >> 7) * 256 + half * 128 + (cc & 127); }
        u32x4 o; o.x = cvt_pk_bf16(s[0 * 33], s[1 * 33]); o.y = cvt_pk_bf16(s[2 * 33], s[3 * 33]); o.z = cvt_pk_bf16(s[4 * 33], s[5 * 33]); o.w = cvt_pk_bf16(s[6 * 33], s[7 * 33]);
        *(u32x4*)(WT + (size_t)drow * K + k0 + 8 * c) = o;
    }
    LDS_WAIT();
}
__device__ __forceinline__ void prepass_row(const float* __restrict__ xrow, bf16_t* __restrict__ orow, const LAS float* wf, const float* __restrict__ b_f, float* __restrict__ lf_out, int lane) {
    const f32x4* xr = (const f32x4*)xrow + lane;
    f32x4 v[4]; float s = 0.f;
#pragma unroll
    for (int j = 0; j < 4; ++j) { v[j] = xr[64 * j]; s += (v[j][0] * v[j][0] + v[j][1] * v[j][1]) + (v[j][2] * v[j][2] + v[j][3] * v[j][3]); }
    const float r = rsq(wave_sum(s));
    u32x2* o8 = (u32x2*)orow + lane;
#pragma unroll
    for (int j = 0; j < 4; ++j) { v[j] = v[j] * r; u32x2 w; w.x = cvt_pk_bf16(v[j][0], v[j][1]); w.y = cvt_pk_bf16(v[j][2], v[j][3]); o8[64 * j] = w; }
    if (wf) {
        f32x4 fa = {0.f, 0.f, 0.f, 0.f}, fb = {0.f, 0.f, 0.f, 0.f};
#pragma unroll
        for (int j = 0; j < 4; ++j)
#pragma unroll
            for (int e = 0; e < 4; ++e) { const int k = 4 * (lane + 64 * j) + e; const LAS f32x4* w = (const LAS f32x4*)(wf + k * 8); fa += w[0] * v[j][e]; fb += w[1] * v[j][e]; }
#pragma unroll
        for (int e = 0; e < 4; ++e) { fa[e] = wave_sum(fa[e]); fb[e] = wave_sum(fb[e]); }
        float z = fa[0];
        z = (lane == 1) ? fa[1] : z; z = (lane == 2) ? fa[2] : z; z = (lane == 3) ? fa[3] : z; z = (lane == 4) ? fb[0] : z; z = (lane == 5) ? fb[1] : z; z = (lane == 6) ? fb[2] : z; z = (lane == 7) ? fb[3] : z;
        if (lane < 8) { z += b_f[lane]; lf_out[lane] = fminf(z, 0.f) - log1pf(expf(-fabsf(z))); }
    }
}
__device__ __forceinline__ void scan_seq(const float* s0, int n0, const float* s1, int n1, float* dst, int lane) {
    const int n = n0 + n1, Lc = n >> 6;
    float s = 0.f;
    for (int i = 0; i < Lc; ++i) { const int t = lane * Lc + i; const float* ptr = (t < n0) ? (s0 + (size_t)t * 8) : (s1 + (size_t)(t - n0) * 8); s += *ptr; }
    float inc = s;
    for (int o = 1; o < 64; o <<= 1) { const float v = __shfl_up(inc, o); if (lane >= o) inc += v; }
    float run = inc - s;
    for (int i = 0; i < Lc; ++i) { const int t = lane * Lc + i; const float* ptr = (t < n0) ? (s0 + (size_t)t * 8) : (s1 + (size_t)(t - n0) * 8); run += *ptr; dst[t] = -run * LOG2E; }
}
__device__ __forceinline__ void cvt_flat(const float* __restrict__ src, bf16_t* __restrict__ dst, size_t n8, size_t gtid, size_t gn) {
    for (size_t i = gtid; i < n8; i += gn) { const f32x4 a = *(const f32x4*)(src + i * 8), b = *(const f32x4*)(src + i * 8 + 4); *(u32x4*)(dst + i * 8) = pack8(a, b); }
}

#define Wt_in ((bf16_t*)(ws + WS_WIN))
#define Wt_o ((bf16_t*)(ws + WS_WO))
#define Wt_mq ((bf16_t*)(ws + WS_WMQ))
#define Wt_mo ((bf16_t*)(ws + WS_WMO))
#define Wt_mkv ((bf16_t*)(ws + WS_WMKV))
#define Wt_up ((bf16_t*)(ws + WS_WUP))
#define Wt_dn ((bf16_t*)(ws + WS_WDN))
#define Wt_pool ((bf16_t*)(ws + WS_WPOOL))
#define usx ((bf16_t*)(ws + WS_USX))
#define mkb ((bf16_t*)(ws + WS_MKB))
#define mvb ((bf16_t*)(ws + WS_MVB))
#define ssq1 ((float*)(ws + WS_SSQ1))
#define ssq2 ((float*)(ws + WS_SSQ2))
#define ssq3 ((float*)(ws + WS_SSQ3))
#define kbP ((float*)(ws + WS_KBP))
#define kbS ((float*)(ws + WS_KBS))
#define ahead ((float*)(ws + WS_AHEAD))
#define atail ((float*)(ws + WS_ATAIL))
#define bhead ((float*)(ws + WS_BHEAD))
#define x1b ((bf16_t*)(ws + WS_X1B))
#define kcb ((bf16_t*)(ws + WS_KCB))
#define vcb ((bf16_t*)(ws + WS_VCB))
#define x2b ((bf16_t*)(ws + WS_X2B))
#define xb ((bf16_t*)(ws + WS_XB))
#define mqb ((bf16_t*)(ws + WS_MQB))
#define hff ((bf16_t*)(ws + WS_HFF))
#define uqkv ((bf16_t*)(ws + WS_UQKV))
#define mo ((bf16_t*)(ws + WS_MO))
#define mix ((bf16_t*)(ws + WS_MIX))
#define memb ((bf16_t*)(ws + WS_MEMB))
#define ub uqkv
#define qb (uqkv + (size_t)MT * 512)
#define kb (uqkv + (size_t)2 * MT * 512)
#define vb (uqkv + (size_t)3 * MT * 512)
__global__ void __launch_bounds__(512, 2) fwd_kernel(Params p) {
    extern __shared__ __attribute__((aligned(16))) unsigned char lds_raw[];
    LAS unsigned char* L = (LAS unsigned char*)lds_raw;
    cg::grid_group grid = cg::this_grid();
    const int tid = threadIdx.x, lane = tid & 63, wave = __builtin_amdgcn_readfirstlane(tid >> 6);
    const int G = gridDim.x, bx = blockIdx.x;
    unsigned char* ws = p.ws; float* out = p.out;
    const float* x_prompt = p.in[0]; const float* x_sample = p.in[1];
    const int lo = p.ph_lo, hi_ph = p.ph_hi;
    unsigned* gbar = (unsigned*)ws; unsigned nbar = 0u;
    if (lo < 0) grid.sync();
#define IN(k) (lo <= (k) && (k) < hi_ph && ((PHMASK >> (k)) & 1))
#define GSYNC() do { asm volatile("s_waitcnt vmcnt(0)" ::: "memory"); __syncthreads(); \
        if (tid == 0) { __builtin_amdgcn_fence(__ATOMIC_RELEASE, "agent"); asm volatile("s_waitcnt vmcnt(0)" ::: "memory"); \
            nbar += (unsigned)G; __hip_atomic_fetch_add(gbar, 1u, __ATOMIC_RELAXED, __HIP_MEMORY_SCOPE_AGENT); \
            while (__hip_atomic_load(gbar, __ATOMIC_RELAXED, __HIP_MEMORY_SCOPE_AGENT) < nbar) __builtin_amdgcn_s_sleep(6); \
            __builtin_amdgcn_fence(__ATOMIC_ACQUIRE, "agent"); asm volatile("s_waitcnt vmcnt(0)" ::: "memory"); } \
        __syncthreads(); } while (0)
#define SEAM(k) do { if (IN(k) && IN((k) + 1)) GSYNC(); } while (0)

    if (IN(0)) {
        const int gw = bx * 8 + wave, NGW = G * 8;
        LAS float* scr = (LAS float*)(L + wave * 8448);
        LAS float* wf = (LAS float*)(L + 8 * 8448);
        {
            const float* w_in = p.in[11]; const float* g_mix = p.in[10];
            for (int i = tid; i < 8192; i += 512) { const int k = i >> 3, h = i & 7; wf[i] = w_in[(size_t)k * 2056 + 2048 + h] * g_mix[k]; }
        }
        __syncthreads();
        constexpr int I_IN = 16 * 64, I_SQ = 16 * 32, I_UP = 16 * 176, I_DN = 44 * 32;
        constexpr int NITEMS = I_IN + 5 * I_SQ + I_UP + I_DN;
        for (int it = gw; it < NITEMS; it += NGW) {
            int r = it;
            if (r < I_IN) { transpose_item<0>(p.in[11], 1024, 2056, 64, Wt_in, 0, p.in[10], scr, r, lane); continue; } r -= I_IN;
            if (r < I_SQ) { transpose_item<0>(p.in[15], 1024, 1024, 32, Wt_o, 0, nullptr, scr, r, lane); continue; } r -= I_SQ;
            if (r < I_SQ) { transpose_item<0>(p.in[18], 1024, 1024, 32, Wt_mq, 0, p.in[16], scr, r, lane); continue; } r -= I_SQ;
            if (r < I_SQ) { transpose_item<0>(p.in[19], 1024, 1024, 32, Wt_mkv, 0, p.in[17], scr, r, lane); continue; } r -= I_SQ;
            if (r < I_SQ) { transpose_item<0>(p.in[20], 1024, 1024, 32, Wt_mkv, 1024, p.in[17], scr, r, lane); continue; } r -= I_SQ;
            if (r < I_SQ) { transpose_item<0>(p.in[21], 1024, 1024, 32, Wt_mo, 0, nullptr, scr, r, lane); continue; } r -= I_SQ;
            if (r < I_UP) { transpose_item<1>(p.in[23], 1024, NUP, 176, Wt_up, 0, p.in[22], scr, r, lane); continue; } r -= I_UP;
            transpose_item<0>(p.in[26], DFF, 1024, 32, Wt_dn, 0, nullptr, scr, r, lane);
        }
        {
            const float* w_pool = p.in[13]; const float* pscale = p.in[14];
            for (int i = bx * 512 + tid; i < 4 * 128 * 128; i += G * 512) { const int g = i >> 14, d = (i >> 7) & 127, c = i & 127; Wt_pool[i] = (bf16_t)(cvt_pk_bf16(w_pool[(g * 128 + c) * 128 + d] * pscale[g * 128 + d], 0.f) & 0xffffu); }
        }
        for (int m = gw; m < MT; m += NGW) {
            const float* xr = (m < MP) ? x_prompt + (size_t)m * DM : x_sample + (size_t)(m - MP) * DM;
            float* lf = (m < MP) ? out + O_LFP + (size_t)m * 8 : out + O_LFS + (size_t)(m - MP) * 8;
            prepass_row(xr, xb + (size_t)m * DM, wf, p.in[12], lf, lane);
        }
        for (int m = gw; m < 8192; m += NGW) prepass_row(p.in[9] + (size_t)m * DM, memb + (size_t)m * DM, (const LAS float*)nullptr, nullptr, nullptr, lane);
        const size_t gtid = (size_t)bx * 512 + tid, gn = (size_t)G * 512;
        for (size_t i = gtid; i < (size_t)16 * 15 * 512 / 8; i += gn) { const size_t e8 = i * 8, bb = e8 / (15 * 512), rem = e8 - bb * 15 * 512; const float* sp = p.in[5] + e8; *(u32x4*)(usx + bb * 79 * 512 + rem) = pack8(*(const f32x4*)sp, *(const f32x4*)(sp + 4)); }
        cvt_flat(p.in[2], kcb, (size_t)16 * PAST * 512 / 8, gtid, gn);
        cvt_flat(p.in[3], vcb, (size_t)16 * PAST * 512 / 8, gtid, gn);
        cvt_flat(p.in[7], mkb + (size_t)8192 * 1024, (size_t)4096 * 1024 / 8, gtid, gn);
        cvt_flat(p.in[8], mvb + (size_t)8192 * 1024, (size_t)4096 * 1024 / 8, gtid, gn);
        __syncthreads();
    }
    SEAM(0);

    if (IN(1)) {
        if (wave == 0) { const int s = bx; if (s < 256) scan_seq(out + O_LFP + (size_t)(s >> 3) * SEQ * 8 + (s & 7), SEQ, out + O_LFP, 0, kbP + (size_t)s * SEQ, lane); }
        if (wave == 1 && bx < 128) { const int s = bx; scan_seq(p.in[4] + (size_t)(s >> 3) * PAST * 8 + (s & 7), PAST, out + O_LFS + (size_t)(s >> 3) * DSEQ * 8 + (s & 7), DSEQ, kbS + (size_t)s * (PAST + DSEQ), lane); }
        {
            pg8::Gemm g{xb, Wt_in, MT, 2048, 1024}; pg8::StaticOrder S; S.init(MT, 2048, G, bx);
            EpiIn E{uqkv, out, usx};
            pg8::gemm_phase<EpiIn, pg8::StaticOrder, true, true>(L, g, S, E);
        }
        __syncthreads();
        {
            pg8::Gemm g{memb, Wt_mkv, 8192, 2048, 1024}; pg8::StaticOrder S; S.init(8192, 2048, G, bx);
            EpiMkv E{mkb, mvb, out};
            pg8::gemm_phase<EpiMkv, pg8::StaticOrder, true, true>(L, g, S, E);
        }
    }
    SEAM(1);

    if (IN(2)) {
        for (int it = 0; it < 8 * ((256 + G - 1) / G); ++it) {
            int bh, qk;
            if (G == 256) { const int xcd = bx & 7, l = bx >> 3, r = it >> 1, pi = l & 3; bh = xcd * 32 + r * 8 + (l >> 2); qk = (it & 1) ? pi : 7 - pi; }
            else { bh = bx + (it >> 3) * G; qk = 7 - (it & 7); if (bh >= 256) break; }
            const int b = bh >> 3, h = bh & 7;
            const bf16_t* Kh = kb + (size_t)b * SEQ * 512 + h * 64; const bf16_t* Vh = vb + (size_t)b * SEQ * 512 + h * 64;
            const size_t r0 = (size_t)b * SEQ + 256 * qk;
            attn_unit<64, 64, 1, true, false, true, true>(L, qb + r0 * 512 + h * 64, 512, 256, Kh, Vh, 4 * qk + 4, Kh, Vh, 512, 4 * qk + 4, kbP + (size_t)bh * SEQ, 256 * qk, mix + r0 * DM + 512 + h * 64, DM);
        }
        if (P2_ATTN_S) for (int bh = bx; bh < 128; bh += G) {
            const int b = bh >> 3, h = bh & 7;
            const size_t r0 = (size_t)MP + b * DSEQ;
            attn_unit<64, 64, 4, true, false, true, true>(L, qb + r0 * 512 + h * 64, 512, 64, kcb + (size_t)b * PAST * 512 + h * 64, vcb + (size_t)b * PAST * 512 + h * 64, 64,
                                      kb + r0 * 512 + h * 64, vb + r0 * 512 + h * 64, 512, 65, kbS + (size_t)bh * (PAST + DSEQ), PAST, mix + r0 * DM + 512 + h * 64, DM);
        }
        if (G == 256) { __syncthreads(); pool_unit(L, bx, ub, usx, Wt_pool, mix); if (bx >= 128 && bx < 132) pool_unit(L, 128 + bx, ub, usx, Wt_pool, mix); }
        else { __syncthreads(); for (int t = bx; t < MT / 256; t += G) pool_unit(L, t, ub, usx, Wt_pool, mix); }
        __syncthreads();
    }
    SEAM(2);

    if (IN(3)) {
        pg8::Gemm g{mix, Wt_o, MT, 1024, 1024}; pg8::StaticOrder S; S.init(MT, 1024, G, bx);
        EpiRes<0> E{x_prompt, x_sample, nullptr, x1b, nullptr, ssq1};
        pg8::gemm_phase<EpiRes<0>, pg8::StaticOrder, true, true>(L, g, S, E);
    }
    SEAM(3);

    if (IN(4)) {
        pg8::Gemm g{x1b, Wt_mq, MT, 1024, 1024}; pg8::StaticOrder S; S.init(MT, 1024, G, bx);
        EpiMq E{ssq1, mqb};
        pg8::gemm_phase<EpiMq, pg8::StaticOrder, true, true>(L, g, S, E);
    }
    SEAM(4);

    if (IN(5)) {
        for (int k5 = 0; k5 * G < 2048 + 64; ++k5) {
            const int un = (G == 256 && k5 < 8) ? (((k5 * 8 + (bx & 7)) * 32) + (bx >> 3)) : (k5 * G + bx);
            if (un >= 2048 + 64) break;
            if (un < 2048) {
                const int b = un >> 6, h = (un >> 4) & 3, qk = un & 15;
                const size_t r0 = (size_t)b * SEQ + 128 * qk;
                const bf16_t* Kh = mkb + (size_t)b * NMEM * 1024 + h * 256; const bf16_t* Vh = mvb + (size_t)b * NMEM * 1024 + h * 256;
                attn_unit<256, 32, 2, false, true, false, false>(L, mqb + r0 * DM + h * 256, DM, 128, Kh, Vh, 8, Kh, Vh, 1024, 8, nullptr, 0, mo + r0 * DM + h * 256, DM);
            } else {
                const int us = un - 2048, b = us >> 2, h = us & 3;
                const size_t r0 = (size_t)MP + b * DSEQ;
                const bf16_t* Kh = mkb + (size_t)(8192 + b * NMEM) * 1024 + h * 256; const bf16_t* Vh = mvb + (size_t)(8192 + b * NMEM) * 1024 + h * 256;
                attn_unit<256, 32, 2, false, true, false, false>(L, mqb + r0 * DM + h * 256, DM, 64, Kh, Vh, 8, Kh, Vh, 1024, 8, nullptr, 0, mo + r0 * DM + h * 256, DM);
            }
        }
        __syncthreads();
    }
    SEAM(5);

    if (IN(6)) {
        pg8::Gemm g{mo, Wt_mo, MT, 1024, 1024}; pg8::StaticOrder S; S.init(MT, 1024, G, bx);
        EpiRes<1> E{nullptr, nullptr, x1b, x2b, nullptr, ssq2};
        pg8::gemm_phase<EpiRes<1>, pg8::StaticOrder, true, true>(L, g, S, E);
    }
    SEAM(6);

    if (IN(7)) {
        pg8::Gemm g{x2b, Wt_up, MT, NUP, 1024}; pg8::StaticOrder S; S.init(MT, NUP, G, bx);
        EpiUp E{ssq2, p.in[24], p.in[25], hff, ahead, atail, bhead};
        pg8::gemm_phase<EpiUp, pg8::StaticOrder, true, true>(L, g, S, E);
    }
    SEAM(7);

    if (IN(8)) {
        const float* cw = p.in[24]; const float* cbias = p.in[25]; const float* chist = p.in[6];
        const int total4 = NSEG * 2 * (DFF / 4);
        for (int idx = bx * 512 + tid; idx < total4; idx += G * 512) {
            const int seg = idx / (2 * (DFF / 4)), rem = idx - seg * 2 * (DFF / 4), i = rem / (DFF / 4), c = (rem - i * (DFF / 4)) * 4;
            f32x4 prev1, prev2;
            if (seg < MP / 64) { if ((seg & 31) == 0) { prev1 = (f32x4){0.f, 0.f, 0.f, 0.f}; prev2 = prev1; } else { prev1 = *(const f32x4*)(atail + ((size_t)(seg - 1) * 2 + 1) * DFF + c); prev2 = *(const f32x4*)(atail + ((size_t)(seg - 1) * 2) * DFF + c); } }
            else { const int b = seg - MP / 64; prev1 = *(const f32x4*)(chist + ((size_t)b * 2 + 1) * DFF + c); prev2 = *(const f32x4*)(chist + ((size_t)b * 2) * DFF + c); }
            const f32x4 a_0 = *(const f32x4*)(ahead + ((size_t)seg * 2) * DFF + c);
            f32x4 am1, am2, a0;
            if (i == 0) { am1 = prev1; am2 = prev2; a0 = a_0; } else { am1 = a_0; am2 = prev1; a0 = *(const f32x4*)(ahead + ((size_t)seg * 2 + 1) * DFF + c); }
            const f32x4 cv = *(const f32x4*)(cbias + c) + *(const f32x4*)(cw + c) * am2 + *(const f32x4*)(cw + DFF + c) * am1 + *(const f32x4*)(cw + 2 * DFF + c) * a0;
            const f32x4 bh = *(const f32x4*)(bhead + ((size_t)seg * 2 + i) * DFF + c);
            f32x4 hv;
#pragma unroll
            for (int e = 0; e < 4; ++e) hv[e] = cv[e] / (1.0f + __builtin_amdgcn_exp2f(-cv[e] * LOG2E)) * bh[e];
            u32x2 w; w.x = cvt_pk_bf16(hv[0], hv[1]); w.y = cvt_pk_bf16(hv[2], hv[3]);
            *(u32x2*)(hff + ((size_t)seg * 64 + i) * DFF + c) = w;
        }
        for (int idx = bx * 512 + tid; idx < 48 * 2 * DFF; idx += G * 512) {
            const int bb = idx / (2 * DFF), rem = idx - bb * 2 * DFF;
            if (bb < 32) out[O_CSP + (size_t)bb * 2 * DFF + rem] = atail[((size_t)(32 * bb + 31) * 2) * DFF + rem];
            else out[O_CSS + (size_t)(bb - 32) * 2 * DFF + rem] = atail[((size_t)(MP / 64 + bb - 32) * 2) * DFF + rem];
        }
    }
    SEAM(8);

    if (IN(9)) {
        pg8::Gemm g{hff, Wt_dn, MT, 1024, DFF}; pg8::StaticOrder S; S.init(MT, 1024, G, bx);
        EpiRes<2> E{nullptr, nullptr, x2b, nullptr, out, ssq3};
        pg8::gemm_phase<EpiRes<2>, pg8::StaticOrder, true, true>(L, g, S, E);
    }
    SEAM(9);

    if (IN(10)) {
        const float* gf = p.in[27];
        const int gw = bx * 8 + wave, NGW = G * 8;
        f32x4 gv[4];
#pragma unroll
        for (int j = 0; j < 4; ++j) gv[j] = ((const f32x4*)gf)[lane + 64 * j];
        for (int m0 = gw; m0 < MT; m0 += 4 * NGW) {
            f32x4 v[4][4]; float r[4];
#pragma unroll
            for (int q = 0; q < 4; ++q) { const int m = m0 + q * NGW; if (m < MT) { const f32x4* y4 = (const f32x4*)(out + (size_t)m * DM) + lane; r[q] = row_rsq(ssq3, m);
#pragma unroll
                    for (int j = 0; j < 4; ++j) v[q][j] = y4[64 * j]; } }
#pragma unroll
            for (int q = 0; q < 4; ++q) { const int m = m0 + q * NGW; if (m < MT) { f32x4* y4 = (f32x4*)(out + (size_t)m * DM) + lane;
#pragma unroll
                    for (int j = 0; j < 4; ++j) y4[64 * j] = v[q][j] * r[q] * gv[j]; } }
        }
    }
#ifdef DBG_DUMP
    {
        GSYNC();
        const bf16_t* src = nullptr; int pitch = 1024;
        if (hi_ph == 2) src = uqkv; else if (hi_ph == 3) src = mix; else if (hi_ph == 4) src = x1b; else if (hi_ph == 5) src = mqb; else if (hi_ph == 6) src = mo; else if (hi_ph == 7) src = x2b; else if (hi_ph == 8 || hi_ph == 9) { src = hff; pitch = DFF; }
        if (src) for (size_t i = (size_t)bx * 512 + tid; i < (size_t)MT * 1024; i += (size_t)G * 512) { const size_t m = i >> 10, c = i & 1023; float v = __builtin_bit_cast(float, (unsigned)src[m * pitch + c] << 16); if (!(v == v)) v = 12345.f; if (fabsf(v) > 1e30f) v = 54321.f; out[i] = v; }
    }
#endif
#undef IN
#undef SEAM
}

extern "C" void kernel_launch(void* const* d_in, const int* in_sizes, int n_in, void* d_out, int out_size, void* d_ws, size_t ws_size, hipStream_t stream) {
    static int grid = 0;
    if (grid == 0) {
        if (n_in != 28 || (size_t)out_size != O_END || ws_size < WS_NEED) { fprintf(stderr, "kernel_launch: unexpected shapes (n_in %d, out %d, ws %zu); nothing launched\n", n_in, out_size, ws_size); grid = -1; return; }
        int dev = 0, cus = 0, per_cu = 0;
        hipGetDevice(&dev); hipDeviceGetAttribute(&cus, hipDeviceAttributeMultiprocessorCount, dev);
        hipFuncSetAttribute((const void*)fwd_kernel, hipFuncAttributeMaxDynamicSharedMemorySize, LDS_BYTES);
        hipOccupancyMaxActiveBlocksPerMultiprocessor(&per_cu, (const void*)fwd_kernel, 512, LDS_BYTES);
        if (per_cu < 1) { fprintf(stderr, "kernel_launch: occupancy query says %d blocks per CU\n", per_cu); per_cu = 1; }
        (void)hipGetLastError();
        grid = cus;
    }
    if (grid < 0) return;
    (void)hipMemsetAsync(d_ws, 0, 256, stream);
    Params p{};
    for (int i = 0; i < 28; ++i) p.in[i] = (const float*)d_in[i];
    p.out = (float*)d_out; p.ws = (unsigned char*)d_ws;
    void* args[] = {&p};
#ifdef PROBE_K
    p.ph_lo = 0; p.ph_hi = PROBE_K + 1;
    (void)hipLaunchCooperativeKernel((const void*)fwd_kernel, dim3(grid), dim3(512), args, LDS_BYTES, stream);
    (void)hipMemsetAsync(d_ws, 0, 256, stream);
    p.ph_lo = PROBE_K; p.ph_hi = 11;
#else
    p.ph_lo = 0; p.ph_hi = 11;
#endif
    hipError_t e = hipLaunchCooperativeKernel((const void*)fwd_kernel, dim3(grid), dim3(512), args, LDS_BYTES, stream);
    if (e != hipSuccess) fprintf(stderr, "cooperative launch failed: %s (grid %d)\n", hipGetErrorString(e), grid);
}
```

```cpp
#include <hip/hip_runtime.h>
#include <hip/hip_cooperative_groups.h>
#include <cstdio>
#include <cstdint>
namespace cg = cooperative_groups;
namespace pg8 {
#define PG8_LAS __attribute__((address_space(3)))
typedef unsigned short bf16_t;
typedef short bf16x8 __attribute__((ext_vector_type(8)));
typedef float f32x4 __attribute__((ext_vector_type(4)));
typedef unsigned u32x4 __attribute__((ext_vector_type(4)));
constexpr int BM = 256, BK = 64, HALF = 128, HTB = HALF * BK * 2  , STAGE_BYTES = 8 * HTB, NXCD = 8, WGM = 8;

__host__ __device__ __forceinline__ int lds_byte(int r, int c) { const int st = (r >> 4) * 2 + (c >> 5), rr = r & 15, cc = c & 31, ob = rr * 64 + cc * 2; return st * 1024 + (ob ^ (((ob >> 9) & 1) << 5)); }
__host__ __device__ __forceinline__ void stage_rc(int b, int& R, int& C) { const int st = b / 1024, sb = b % 1024, swz = sb ^ (((sb >> 9) & 1) << 5); R = (st >> 1) * 16 + swz / 64; C = (st & 1) * 32 + (swz % 64) / 2; }
__host__ __device__ __forceinline__ int perm32(int rho) { const int n = rho >> 4, i = rho & 15; return 8 * (i >> 2) + 4 * n + (i & 3); }

struct Unit { int pm, pn; };
struct Gemm { const bf16_t* A; const bf16_t* Bt; int M, N, K; };

struct StaticOrder {
    int nM, nN, nwg, G, c;
    __host__ __device__ void init(int M, int N, int G_, int c_) { nM = M / BM; nN = N / BM; nwg = nM * nN; G = G_; c = c_; }
    __host__ __device__ bool next(int i, Unit& u) const {
        const long L = (long)i * G + c; if (L >= nwg) return false;
        int wgid = (int)L; { const int q = nwg / NXCD, r = nwg % NXCD, xcd = wgid % NXCD, off = wgid / NXCD; wgid = (xcd < r ? xcd * (q + 1) : r * (q + 1) + (xcd - r) * q) + off; }
        const int nig = WGM * nN, gid = wgid / nig, fm = gid * WGM, gsz = (nM - fm) < WGM ? (nM - fm) : WGM;
        u.pm = fm + ((wgid % nig) % gsz); u.pn = (wgid % nig) / gsz; return true;
    }
    __device__ __forceinline__ void a_ready(const Unit&) const {}
    __device__ __forceinline__ void done(const Unit&) const {}
};

__device__ __forceinline__ unsigned cvt_pk_bf16(float lo, float hi) { unsigned r; asm volatile("v_cvt_pk_bf16_f32 %0, %1, %2" : "=v"(r) : "v"(lo), "v"(hi)); return r; }
typedef float f32x2 __attribute__((ext_vector_type(2)));
template <class Epi, class Sched, bool ALIGN_EPI = false, bool SP2 = false>
__device__ __forceinline__ void gemm_phase(PG8_LAS unsigned char* lds, const Gemm g, const Sched& S, const Epi& E) {
    const int tid = threadIdx.x, wid = __builtin_amdgcn_readfirstlane(tid >> 6), lane = tid & 63, wr = wid >> 2, wc = wid & 3, fr = lane & 15, fq = lane >> 4;
    const int K = g.K, nt = K / BK;
    unsigned voffA[2], voffB[2];
#pragma unroll
    for (int i = 0; i < 2; ++i) { int R, C; stage_rc(tid * 16 + i * 8192, R, C); const int Rb = Epi::PERM ? ((R & ~31) + perm32(R & 31)) : R;
        voffA[i] = (unsigned)(R * K + C) * 2u; voffB[i] = (unsigned)(Rb * K + C) * 2u; }
    const size_t kstep = (size_t)(BK * 2);
    const size_t hstep = (size_t)HALF * K * 2;
    const size_t tstep = 2 * hstep;
    const unsigned ldsw = (unsigned)wid * 1024u;
    const int aoff = lds_byte(wr * 64 + fr, fq * 8), boff = lds_byte(wc * 32 + fr, fq * 8);
#define PG8_SA(b, h) (((b) * 2 + (h)) * HTB)
#define PG8_SB(b, h) ((4 + (b) * 2 + (h)) * HTB)
#define PG8_STAGE(bufoff, gbase, voff) do { _Pragma("unroll") for (int _i = 0; _i < 2; ++_i) \
        __builtin_amdgcn_global_load_lds((const unsigned*)((const char*)(gbase) + (voff)[_i]), (PG8_LAS unsigned*)(lds + (bufoff) + ldsw + _i * 8192), 16, 0, 0); } while (0)
#define PG8_LDA(dst, b, h) do { _Pragma("unroll") for (int m = 0; m < 4; ++m) _Pragma("unroll") for (int k = 0; k < 2; ++k) dst[m][k] = *(const PG8_LAS bf16x8*)(lds + PG8_SA(b, h) + aoff + m * 2048 + k * 1024); } while (0)
#define PG8_LDB(dst, b, h) do { _Pragma("unroll") for (int n = 0; n < 2; ++n) _Pragma("unroll") for (int k = 0; k < 2; ++k) dst[n][k] = *(const PG8_LAS bf16x8*)(lds + PG8_SB(b, h) + boff + n * 2048 + k * 1024); } while (0)
#define PG8_MMA(ai, bj, At, Bt) do { __builtin_amdgcn_s_setprio(1); _Pragma("unroll") for (int m = 0; m < 4; ++m) _Pragma("unroll") for (int n = 0; n < 2; ++n) _Pragma("unroll") for (int k = 0; k < 2; ++k) \
        acc[ai][bj][m][n] = __builtin_amdgcn_mfma_f32_16x16x32_bf16(Bt[n][k], At[m][k], acc[ai][bj][m][n], 0, 0, 0); __builtin_amdgcn_s_setprio(0); } while (0)
#define PG8_WAIT_V(n) asm volatile("s_waitcnt vmcnt(" #n ")" ::: "memory")
#define PG8_WAIT_L(n) asm volatile("s_waitcnt lgkmcnt(" #n ")" ::: "memory")
#define PG8_BAR __builtin_amdgcn_s_barrier()
#define PG8_SCHED __builtin_amdgcn_sched_barrier(0)
    Unit cur, nxt; int ui = 0;
    if (!S.next(0, cur)) return;
    f32x4 acc[2][2][4][2];
#pragma unroll
    for (int a = 0; a < 2; ++a)
#pragma unroll
        for (int b = 0; b < 2; ++b)
#pragma unroll
            for (int m = 0; m < 4; ++m)
#pragma unroll
                for (int n = 0; n < 2; ++n) acc[a][b][m][n] = (f32x4){0.f, 0.f, 0.f, 0.f};
    bf16x8 At[4][2], B0[2][2], B1[2][2];
    const char* cA = (const char*)g.A + (size_t)cur.pm * tstep; const char* cB = (const char*)g.Bt + (size_t)cur.pn * tstep;
    S.a_ready(cur);
    if constexpr (SP2) {
        PG8_STAGE(PG8_SB(0, 0), cB, voffB); PG8_STAGE(PG8_SB(0, 1), cB + hstep, voffB); PG8_STAGE(PG8_SA(0, 0), cA, voffA); PG8_STAGE(PG8_SA(0, 1), cA + hstep, voffA);
        if (wr == 1) PG8_BAR;
        PG8_WAIT_V(2); PG8_BAR;
        PG8_STAGE(PG8_SB(1, 0), cB + kstep, voffB); PG8_STAGE(PG8_SA(1, 0), cA + kstep, voffA); PG8_STAGE(PG8_SB(1, 1), cB + hstep + kstep, voffB);
        PG8_WAIT_V(6); PG8_BAR;
    } else {
        PG8_STAGE(PG8_SB(0, 0), cB, voffB); PG8_STAGE(PG8_SA(0, 0), cA, voffA); PG8_STAGE(PG8_SB(0, 1), cB + hstep, voffB); PG8_STAGE(PG8_SA(0, 1), cA + hstep, voffA);
        if (wr == 1) PG8_BAR;
        PG8_WAIT_V(4); PG8_BAR;
        PG8_STAGE(PG8_SB(1, 0), cB + kstep, voffB); PG8_STAGE(PG8_SA(1, 0), cA + kstep, voffA); PG8_STAGE(PG8_SB(1, 1), cB + hstep + kstep, voffB);
        PG8_WAIT_V(6); PG8_BAR;
    }
    for (;;) {
        const bool has_next = S.next(ui + 1, nxt);
        const char* nA = has_next ? (const char*)g.A + (size_t)nxt.pm * tstep : cA; const char* nB = has_next ? (const char*)g.Bt + (size_t)nxt.pn * tstep : cB;
        for (int t = 0; t < nt; t += 2) {
            const bool last = (t == nt - 2);
            const char* a1 = cA + (size_t)(t + 1) * kstep;
            const char* a2 = last ? nA : cA + (size_t)(t + 2) * kstep; const char* b2 = last ? nB : cB + (size_t)(t + 2) * kstep;
            const char* a3 = a2 + kstep; const char* b3 = b2 + kstep;
            if (last && has_next) S.a_ready(nxt);
            if constexpr (SP2) {
            PG8_LDB(B0, 0, 0); PG8_LDB(B1, 0, 1); PG8_SCHED; PG8_LDA(At, 0, 0); PG8_STAGE(PG8_SA(1, 1), a1 + hstep, voffA);
            PG8_WAIT_V(8); PG8_WAIT_L(0); PG8_BAR; PG8_MMA(0, 0, At, B0); PG8_MMA(0, 1, At, B1); PG8_BAR; PG8_SCHED;
            PG8_LDA(At, 0, 1); PG8_STAGE(PG8_SB(0, 0), b2, voffB); PG8_STAGE(PG8_SB(0, 1), b2 + hstep, voffB); PG8_STAGE(PG8_SA(0, 0), a2, voffA);
            PG8_WAIT_V(8); PG8_WAIT_L(0); PG8_BAR; PG8_MMA(1, 0, At, B0); PG8_MMA(1, 1, At, B1); PG8_BAR; PG8_SCHED;
            PG8_LDB(B0, 1, 0); PG8_LDB(B1, 1, 1); PG8_SCHED; PG8_LDA(At, 1, 0); PG8_STAGE(PG8_SA(0, 1), a2 + hstep, voffA);
            PG8_WAIT_V(8); PG8_WAIT_L(0); PG8_BAR; PG8_MMA(0, 0, At, B0); PG8_MMA(0, 1, At, B1); PG8_BAR; PG8_SCHED;
            PG8_LDA(At, 1, 1); PG8_STAGE(PG8_SB(1, 0), b3, voffB); PG8_STAGE(PG8_SB(1, 1), b3 + hstep, voffB); PG8_STAGE(PG8_SA(1, 0), a3, voffA);
            PG8_WAIT_V(8); PG8_WAIT_L(0); PG8_BAR; PG8_MMA(1, 0, At, B0); PG8_MMA(1, 1, At, B1); PG8_BAR; PG8_SCHED;
            } else {
            PG8_LDB(B0, 0, 0); PG8_SCHED; PG8_LDA(At, 0, 0); PG8_STAGE(PG8_SA(1, 1), a1 + hstep, voffA);
            PG8_WAIT_L(8); PG8_BAR; PG8_WAIT_L(0); PG8_MMA(0, 0, At, B0); PG8_BAR; PG8_SCHED;
            PG8_LDB(B1, 0, 1); PG8_STAGE(PG8_SB(0, 0), b2, voffB);
            PG8_BAR; PG8_WAIT_L(0); PG8_MMA(0, 1, At, B1); PG8_BAR;
            PG8_LDA(At, 0, 1); PG8_STAGE(PG8_SA(0, 0), a2, voffA);
            PG8_BAR; PG8_WAIT_L(0); PG8_MMA(1, 0, At, B0); PG8_BAR; PG8_SCHED;
            PG8_STAGE(PG8_SB(0, 1), b2 + hstep, voffB);
            PG8_WAIT_V(6); PG8_BAR; PG8_MMA(1, 1, At, B1); PG8_BAR;
            PG8_LDB(B0, 1, 0); PG8_SCHED; PG8_LDA(At, 1, 0); PG8_STAGE(PG8_SA(0, 1), a2 + hstep, voffA);
            PG8_WAIT_L(8); PG8_BAR; PG8_WAIT_L(0); PG8_MMA(0, 0, At, B0); PG8_BAR; PG8_SCHED;
            PG8_LDB(B1, 1, 1); PG8_STAGE(PG8_SB(1, 0), b3, voffB);
            PG8_BAR; PG8_WAIT_L(0); PG8_MMA(0, 1, At, B1); PG8_BAR;
            PG8_LDA(At, 1, 1); PG8_STAGE(PG8_SA(1, 0), a3, voffA);
            PG8_BAR; PG8_WAIT_L(0); PG8_MMA(1, 0, At, B0); PG8_BAR; PG8_SCHED;
            PG8_STAGE(PG8_SB(1, 1), b3 + hstep, voffB);
            PG8_WAIT_V(6); PG8_BAR; PG8_MMA(1, 1, At, B1); PG8_BAR;
            }
        }
        if constexpr (ALIGN_EPI) { if (wr == 0) PG8_BAR; }
        if constexpr (!Epi::AFTER_DRAIN) { E(acc, cur, wr, wc, fr, fq); S.done(cur); }
        if (!has_next) break;
#pragma unroll
        for (int a = 0; a < 2; ++a)
#pragma unroll
            for (int b = 0; b < 2; ++b)
#pragma unroll
                for (int m = 0; m < 4; ++m)
#pragma unroll
                    for (int n = 0; n < 2; ++n) acc[a][b][m][n] = (f32x4){0.f, 0.f, 0.f, 0.f};
        cur = nxt; cA = nA; cB = nB; ++ui;
        if constexpr (ALIGN_EPI) { if (wr == 1) PG8_BAR; }
    }
    PG8_WAIT_V(0);
    if constexpr (!ALIGN_EPI) { if (wr == 0) PG8_BAR; }
    PG8_BAR;
    if constexpr (Epi::AFTER_DRAIN) { E.fused(acc, cur, wr, wc, fr, fq, lds, wid, lane); S.done(cur); }
#undef PG8_SA
#undef PG8_SB
#undef PG8_STAGE
#undef PG8_LDA
#undef PG8_LDB
#undef PG8_MMA
#undef PG8_WAIT_V
#undef PG8_WAIT_L
#undef PG8_BAR
#undef PG8_SCHED
}
}

using pg8::bf16_t; using pg8::bf16x8; using pg8::f32x4; using pg8::u32x4; using pg8::Unit;
typedef float f32x2_t __attribute__((ext_vector_type(2))); typedef __bf16 bf16x2_t __attribute__((ext_vector_type(2)));
__device__ __forceinline__ unsigned cvt_pk_bf16(float lo, float hi) { f32x2_t v = {lo, hi}; bf16x2_t b = __builtin_convertvector(v, bf16x2_t); return __builtin_bit_cast(unsigned, b); }
typedef float f32x16 __attribute__((ext_vector_type(16)));
typedef unsigned u32x2 __attribute__((ext_vector_type(2)));
#define LAS __attribute__((address_space(3)))

constexpr int DM = 1024, MP = 65536, MS = 1024, MT = MP + MS, SEQ = 2048, DSEQ = 64, PAST = 4096, NMEM = 256;
constexpr int DFF = 2816, NUP = 2 * DFF, NSEG = MT / 64;
constexpr float EPS = 1e-6f, LOG2E = 1.4426950408889634f;
constexpr float C2F = 0.125f * LOG2E, C2M = 0.0625f * LOG2E;
constexpr float NEGBIG = -1e30f;

constexpr size_t O_YP = 0, O_YS = O_YP + (size_t)MP * DM, O_KP = O_YS + (size_t)MS * DM, O_VP = O_KP + (size_t)MP * 512, O_LFP = O_VP + (size_t)MP * 512,
    O_PSP = O_LFP + (size_t)MP * 8, O_CSP = O_PSP + 32 * 15 * 512, O_MKP = O_CSP + 32 * 2 * DFF, O_MVP = O_MKP + (size_t)8192 * 1024, O_KS = O_MVP + (size_t)8192 * 1024,
    O_VS = O_KS + (size_t)MS * 512, O_LFS = O_VS + (size_t)MS * 512, O_PSS = O_LFS + MS * 8, O_CSS = O_PSS + 16 * 15 * 512, O_END = O_CSS + 16 * 2 * DFF;

constexpr size_t MiB = 1u << 20;
constexpr size_t WS_WIN = 1 * MiB, WS_WO = 5 * MiB, WS_WMQ = 7 * MiB, WS_WMO = 9 * MiB, WS_WMKV = 11 * MiB, WS_WUP = 15 * MiB, WS_WDN = 26 * MiB, WS_WPOOL = 32 * MiB;
constexpr size_t WS_USX = 34 * MiB;
constexpr size_t WS_MKB = 40 * MiB, WS_MVB = 64 * MiB;
constexpr size_t WS_SSQ1 = 88 * MiB, WS_SSQ2 = 93 * MiB, WS_SSQ3 = 98 * MiB;
constexpr size_t WS_KBP = 103 * MiB, WS_KBS = 105 * MiB;
constexpr size_t WS_AHEAD = 108 * MiB, WS_ATAIL = WS_AHEAD + 23 * MiB / 1 - MiB / 2, WS_BHEAD = WS_ATAIL + 23 * MiB - MiB / 2;
constexpr size_t WS_X1B = 176 * MiB, WS_KCB = 176 * MiB, WS_VCB = 240 * MiB;
constexpr size_t WS_X2B = 306 * MiB;
constexpr size_t WS_XB = 436 * MiB, WS_MQB = 436 * MiB, WS_HFF = 436 * MiB;
constexpr size_t WS_UQKV = 566 * MiB, WS_MO = 566 * MiB;
constexpr size_t WS_MIX = 826 * MiB, WS_MEMB = 956 * MiB, WS_NEED = 972 * MiB;
static_assert((size_t)NSEG * 2 * DFF * 4 <= 22 * MiB + MiB / 2, "side buffers");
static_assert(WS_BHEAD + 22 * MiB + MiB / 2 <= WS_X1B, "side buffers end");

#define P2_ATTN_P 1
#define P2_ATTN_S 1
#define P2_POOL 1
#define DBG_HI 11
#ifndef PHMASK
#define PHMASK 0x7ff
#endif
constexpr int LDS_BYTES = 147456;

struct Params { const float* in[28]; float* out; unsigned char* ws; int ph_lo, ph_hi; };

__device__ __forceinline__ float bf_lo(unsigned w) { return __builtin_bit_cast(float, w << 16); }
__device__ __forceinline__ float bf_hi(unsigned w) { return __builtin_bit_cast(float, w & 0xffff0000u); }
__device__ __forceinline__ int crow(int r, int hi) { return (r & 3) + 8 * (r >> 2) + 4 * hi; }
__device__ __forceinline__ float wave_sum(float v) {
#pragma unroll
    for (int o = 1; o < 64; o <<= 1) v += __shfl_xor(v, o);
    return v;
}
__device__ __forceinline__ float rsq(float ssq) { return 1.0f / sqrtf(ssq * (1.0f / 1024.0f) + EPS); }
#define LDS_WAIT() asm volatile("s_waitcnt lgkmcnt(0)" ::: "memory")

typedef const f32x4 (&AccRef)[2][2][4][2];

__device__ __forceinline__ u32x4 pack8(f32x4 v0, f32x4 v1) { u32x4 w; w.x = cvt_pk_bf16(v0[0], v0[1]); w.y = cvt_pk_bf16(v0[2], v0[3]); w.z = cvt_pk_bf16(v1[0], v1[1]); w.w = cvt_pk_bf16(v1[2], v1[3]); return w; }

struct EpiIn {
    static constexpr bool PERM = true, AFTER_DRAIN = false;
    bf16_t* uqkv; float* out; bf16_t* usx;
    __device__ __forceinline__ void operator()(AccRef acc, const Unit& u, int wr, int wc, int fr, int fq) const {
        const int t = u.pn >> 1;
        const int col0 = (u.pn & 1) * 256 + wc * 32 + 8 * fq;
        bf16_t* base = uqkv + (size_t)t * MT * 512;
        const float sc = (t == 1) ? C2F : 1.0f;
#pragma unroll
        for (int ai = 0; ai < 2; ++ai)
#pragma unroll
            for (int m = 0; m < 4; ++m) {
                const int row = u.pm * 256 + ai * 128 + wr * 64 + m * 16 + fr;
#pragma unroll
                for (int bj = 0; bj < 2; ++bj) {
                    const int col = col0 + bj * 128;
                    const f32x4 v0 = acc[ai][bj][m][0] * sc, v1 = acc[ai][bj][m][1] * sc;
                    *(u32x4*)(base + (size_t)row * 512 + col) = pack8(v0, v1);
                    if (t >= 2) {
                        float* o = (row < MP) ? out + (t == 2 ? O_KP : O_VP) + (size_t)row * 512 : out + (t == 2 ? O_KS : O_VS) + (size_t)(row - MP) * 512;
                        *(f32x4*)(o + col) = v0; *(f32x4*)(o + col + 4) = v1;
                    } else if (t == 0) {
                        if (row < MP) { const int tt = row & (SEQ - 1); if (tt >= SEQ - 15) { float* o = out + O_PSP + ((size_t)(row >> 11) * 15 + (tt - (SEQ - 15))) * 512 + col; *(f32x4*)o = v0; *(f32x4*)(o + 4) = v1; } }
                        else { const int rs = row - MP, tt = rs & 63; *(u32x4*)(usx + ((size_t)(rs >> 6) * 79 + 15 + tt) * 512 + col) = pack8(v0, v1); if (tt >= DSEQ - 15) { float* o = out + O_PSS + ((size_t)(rs >> 6) * 15 + (tt - (DSEQ - 15))) * 512 + col; *(f32x4*)o = v0; *(f32x4*)(o + 4) = v1; } }
                    }
                }
            }
    }
};
struct EpiMkv {
    static constexpr bool PERM = true, AFTER_DRAIN = false;
    bf16_t* mkb; bf16_t* mvb; float* out;
    __device__ __forceinline__ void operator()(AccRef acc, const Unit& u, int wr, int wc, int fr, int fq) const {
        const int t = u.pn >> 2;
        const int col0 = (u.pn & 3) * 256 + wc * 32 + 8 * fq;
        bf16_t* bb = t ? mvb : mkb; float* of = out + (t ? O_MVP : O_MKP);
#pragma unroll
        for (int ai = 0; ai < 2; ++ai)
#pragma unroll
            for (int m = 0; m < 4; ++m) {
                const int row = u.pm * 256 + ai * 128 + wr * 64 + m * 16 + fr;
#pragma unroll
                for (int bj = 0; bj < 2; ++bj) {
                    const int col = col0 + bj * 128;
                    const f32x4 v0 = acc[ai][bj][m][0], v1 = acc[ai][bj][m][1];
                    *(u32x4*)(bb + (size_t)row * 1024 + col) = pack8(v0, v1);
                    *(f32x4*)(of + (size_t)row * 1024 + col) = v0; *(f32x4*)(of + (size_t)row * 1024 + col + 4) = v1;
                }
            }
    }
};
template <int MODE> struct EpiRes {
    static constexpr bool PERM = true, AFTER_DRAIN = false;
    const float* xP; const float* xS; const bf16_t* resB; bf16_t* xo; float* yo; float* ssqp;
    __device__ __forceinline__ void operator()(AccRef acc, const Unit& u, int wr, int wc, int fr, int fq) const {
        const int col0 = u.pn * 256 + wc * 32 + 8 * fq;
#pragma unroll
        for (int ai = 0; ai < 2; ++ai)
#pragma unroll
            for (int m = 0; m < 4; ++m) {
                const int row = u.pm * 256 + ai * 128 + wr * 64 + m * 16 + fr;
                float ss = 0.f;
#pragma unroll
                for (int bj = 0; bj < 2; ++bj) {
                    const int col = col0 + bj * 128;
                    f32x4 r0, r1;
                    if (MODE == 0) { const float* xr = (row < MP) ? xP + (size_t)row * DM : xS + (size_t)(row - MP) * DM; r0 = *(const f32x4*)(xr + col); r1 = *(const f32x4*)(xr + col + 4); }
                    else { const u32x4 w = *(const u32x4*)(resB + (size_t)row * DM + col); r0 = (f32x4){bf_lo(w.x), bf_hi(w.x), bf_lo(w.y), bf_hi(w.y)}; r1 = (f32x4){bf_lo(w.z), bf_hi(w.z), bf_lo(w.w), bf_hi(w.w)}; }
                    const f32x4 v0 = acc[ai][bj][m][0] + r0, v1 = acc[ai][bj][m][1] + r1;
                    ss += (v0[0] * v0[0] + v0[1] * v0[1]) + (v0[2] * v0[2] + v0[3] * v0[3]) + (v1[0] * v1[0] + v1[1] * v1[1]) + (v1[2] * v1[2] + v1[3] * v1[3]);
                    if (MODE == 2) { float* yr = (row < MP) ? yo + O_YP + (size_t)row * DM : yo + O_YS + (size_t)(row - MP) * DM; *(f32x4*)(yr + col) = v0; *(f32x4*)(yr + col + 4) = v1; }
                    else *(u32x4*)(xo + (size_t)row * DM + col) = pack8(v0, v1);
                }
                ss += __shfl_xor(ss, 16); ss += __shfl_xor(ss, 32);
                if (fq == 0) ssqp[(size_t)row * 16 + u.pn * 4 + wc] = ss;
            }
    }
};
__device__ __forceinline__ float row_rsq(const float* ssqp, int row) {
    const f32x4* sp = (const f32x4*)(ssqp + (size_t)row * 16);
    const f32x4 a = sp[0], b = sp[1], c = sp[2], d = sp[3];
    const float s = ((a[0] + a[1]) + (a[2] + a[3])) + ((b[0] + b[1]) + (b[2] + b[3])) + ((c[0] + c[1]) + (c[2] + c[3])) + ((d[0] + d[1]) + (d[2] + d[3]));
    return rsq(s);
}
struct EpiMq {
    static constexpr bool PERM = true, AFTER_DRAIN = false;
    const float* ssqp; bf16_t* mq;
    __device__ __forceinline__ void operator()(AccRef acc, const Unit& u, int wr, int wc, int fr, int fq) const {
        const int col0 = u.pn * 256 + wc * 32 + 8 * fq;
#pragma unroll
        for (int ai = 0; ai < 2; ++ai)
#pragma unroll
            for (int m = 0; m < 4; ++m) {
                const int row = u.pm * 256 + ai * 128 + wr * 64 + m * 16 + fr;
                const float r = row_rsq(ssqp, row) * C2M;
#pragma unroll
                for (int bj = 0; bj < 2; ++bj) *(u32x4*)(mq + (size_t)row * DM + col0 + bj * 128) = pack8(acc[ai][bj][m][0] * r, acc[ai][bj][m][1] * r);
            }
    }
};
struct EpiUp {
    static constexpr bool PERM = true, AFTER_DRAIN = false;
    const float* ssqp; const float* cw; const float* cb; bf16_t* hff; float* ahead; float* atail; float* bhead;
    __device__ __forceinline__ void operator()(AccRef acc, const Unit& u, int wr, int wc, int fr, int fq) const {
        const int lane = fq * 16 + fr;
        const int c0 = u.pn * 128 + wc * 32 + 8 * fq;
        f32x4 w0[2], w1[2], w2[2], bb[2];
#pragma unroll
        for (int n = 0; n < 2; ++n) { w0[n] = *(const f32x4*)(cw + c0 + 4 * n); w1[n] = *(const f32x4*)(cw + DFF + c0 + 4 * n); w2[n] = *(const f32x4*)(cw + 2 * DFF + c0 + 4 * n); bb[n] = *(const f32x4*)(cb + c0 + 4 * n); }
        const int src1 = (lane & 48) | ((fr + 15) & 15), src2 = (lane & 48) | ((fr + 14) & 15);
#pragma unroll
        for (int ai = 0; ai < 2; ++ai) {
            const int seg = u.pm * 4 + ai * 2 + wr;
            const int rowb = u.pm * 256 + ai * 128 + wr * 64;
            f32x4 ap[2] = {{0.f, 0.f, 0.f, 0.f}, {0.f, 0.f, 0.f, 0.f}};
#pragma unroll
            for (int m = 0; m < 4; ++m) {
                const int row = rowb + m * 16 + fr;
                const float r = row_rsq(ssqp, row);
                f32x4 a[2], b[2], h[2];
#pragma unroll
                for (int n = 0; n < 2; ++n) {
                    a[n] = acc[ai][0][m][n] * r; b[n] = acc[ai][1][m][n] * r;
                    f32x4 a1, a2;
#pragma unroll
                    for (int e = 0; e < 4; ++e) {
                        const float x1 = (fr == 15) ? ap[n][e] : a[n][e]; a1[e] = __shfl(x1, src1);
                        const float x2 = (fr >= 14) ? ap[n][e] : a[n][e]; a2[e] = __shfl(x2, src2);
                    }
                    const f32x4 cv = bb[n] + w0[n] * a2 + w1[n] * a1 + w2[n] * a[n];
#pragma unroll
                    for (int e = 0; e < 4; ++e) h[n][e] = cv[e] * __builtin_amdgcn_rcpf(1.0f + __builtin_amdgcn_exp2f(-cv[e] * LOG2E)) * b[n][e];
                    ap[n] = a[n];
                }
                if (m == 0 && fr < 2) {
                    float* pa = ahead + ((size_t)seg * 2 + fr) * DFF + c0; float* pb = bhead + ((size_t)seg * 2 + fr) * DFF + c0;
                    *(f32x4*)pa = a[0]; *(f32x4*)(pa + 4) = a[1]; *(f32x4*)pb = b[0]; *(f32x4*)(pb + 4) = b[1];
                } else {
                    *(u32x4*)(hff + (size_t)row * DFF + c0) = pack8(h[0], h[1]);
                }
                if (m == 3 && fr >= 14) { float* pt = atail + ((size_t)seg * 2 + (fr - 14)) * DFF + c0; *(f32x4*)pt = a[0]; *(f32x4*)(pt + 4) = a[1]; }
            }
        }
    }
};

template <int D, int KT, int KG, bool PF, bool QLDS, bool CAUSAL, bool BIAS>
__device__ __forceinline__ void attn_unit(LAS unsigned char* L, const bf16_t* __restrict__ Q, int ldq, int nq,
                                          const bf16_t* __restrict__ K0, const bf16_t* __restrict__ V0, int nt0, const bf16_t* __restrict__ K1, const bf16_t* __restrict__ V1, int ldk, int ntiles,
                                          const float* __restrict__ kbias, int qpos0, bf16_t* __restrict__ O, int ldo) {
    constexpr int KS = D + 8, VS = KT + 4, CH = D / 8, NKI = KT * CH / 512, NVI = ((KT / 2) * CH + 511) / 512, NQF = (D == 64) ? 4 : 1, NP = KT / 32, QW = 8 / KG;
    constexpr int TILEB = KT * KS * 2 + D * VS * 2 + (BIAS ? KT * 4 : 0);
    constexpr int QBYTES = QLDS ? 32 * QW * KS * 2 : 0;
    constexpr int NG = (KG == 1) ? 2 : (!PF ? 1 : KG);
    const int tid = threadIdx.x, lane = tid & 63, wid = __builtin_amdgcn_readfirstlane(tid >> 6), r32 = lane & 31, hi = lane >> 5;
    const int qw = wid % QW, kg = wid / QW;
    const bool wact = qw * 32 < nq;
    LAS unsigned char* T = L + QBYTES;
    const LAS bf16_t* Qs = (const LAS bf16_t*)L + (qw * 32 + r32) * KS + hi * 8;
    const bf16_t* qrow = Q + (size_t)(qw * 32 + r32) * ldq + hi * 8;
    bf16x8 qf[NQF];
    if (D == 64 && !QLDS) {
#pragma unroll
        for (int ds = 0; ds < NQF; ++ds) qf[ds] = wact ? *(const bf16x8*)(qrow + ds * 16) : (bf16x8){0, 0, 0, 0, 0, 0, 0, 0};
    }
    if (QLDS) {
        __syncthreads();
        constexpr int NQI = 32 * QW * CH / 512;
#pragma unroll
        for (int i = 0; i < NQI; ++i) { const int id = tid + 512 * i, row = id / CH, ch = id % CH; if (row < nq) *(LAS u32x4*)((LAS bf16_t*)L + row * KS + ch * 8) = *(const u32x4*)(Q + (size_t)row * ldq + ch * 8); }
    }
    float ref = 0.f;
    if (BIAS) ref = wact ? kbias[qpos0 + qw * 32 + r32] : 0.f;
    f32x16 o[D / 32];
#pragma unroll
    for (int db = 0; db < D / 32; ++db)
#pragma unroll
        for (int r = 0; r < 16; ++r) o[db][r] = 0.f;
    float lrun = 0.f;
    u32x4 kreg[NG][NKI], vreg[NG][NVI][2]; float breg[NG];
#define ATT_LOAD(j, g) do { const bf16_t* Kt_ = ((j) < nt0) ? K0 + (size_t)(j) * KT * ldk : K1 + (size_t)((j) - nt0) * KT * ldk; \
        const bf16_t* Vg_ = ((j) < nt0) ? V0 + (size_t)(j) * KT * ldk : V1 + (size_t)((j) - nt0) * KT * ldk; \
        _Pragma("unroll") for (int i_ = 0; i_ < NKI; ++i_) { const int id_ = tid + 512 * i_, row_ = id_ / CH, ch_ = id_ % CH; kreg[g][i_] = *(const u32x4*)(Kt_ + (size_t)row_ * ldk + ch_ * 8); } \
        _Pragma("unroll") for (int i_ = 0; i_ < NVI; ++i_) { const int id_ = tid + 512 * i_; if (id_ < (KT / 2) * CH) { const int pr_ = id_ % (KT / 2), ch_ = id_ / (KT / 2); \
            vreg[g][i_][0] = *(const u32x4*)(Vg_ + (size_t)(2 * pr_) * ldk + ch_ * 8); vreg[g][i_][1] = *(const u32x4*)(Vg_ + (size_t)(2 * pr_ + 1) * ldk + ch_ * 8); } } \
        if (BIAS && tid < KT) breg[g] = kbias[(j) * KT + tid]; } while (0)
#define ATT_STORE(TB, g) do { LAS bf16_t* Ks_ = (LAS bf16_t*)(TB); LAS bf16_t* Vt_ = (LAS bf16_t*)((TB) + KT * KS * 2); \
        _Pragma("unroll") for (int i_ = 0; i_ < NKI; ++i_) { const int id_ = tid + 512 * i_, row_ = id_ / CH, ch_ = id_ % CH; *(LAS u32x4*)(Ks_ + row_ * KS + ch_ * 8) = kreg[g][i_]; } \
        _Pragma("unroll") for (int i_ = 0; i_ < NVI; ++i_) { const int id_ = tid + 512 * i_; if (id_ < (KT / 2) * CH) { const int pr_ = id_ % (KT / 2), ch_ = id_ / (KT / 2); \
            _Pragma("unroll") for (int e_ = 0; e_ < 4; ++e_) { const unsigned lo_ = vreg[g][i_][0][e_], h2_ = vreg[g][i_][1][e_]; \
                *(LAS unsigned*)(Vt_ + (ch_ * 8 + 2 * e_) * VS + 2 * pr_) = (lo_ & 0xffffu) | (h2_ << 16); \
                *(LAS unsigned*)(Vt_ + (ch_ * 8 + 2 * e_ + 1) * VS + 2 * pr_) = (lo_ >> 16) | (h2_ & 0xffff0000u); } } } \
        if (BIAS && tid < KT) ((LAS float*)((TB) + KT * KS * 2 + D * VS * 2))[tid] = breg[g]; } while (0)
#define ATT_COMPUTE(j, TB) do { const LAS bf16_t* Ks_ = (const LAS bf16_t*)(TB); const LAS bf16_t* Vt_ = (const LAS bf16_t*)((TB) + KT * KS * 2); const LAS float* Bs_ = (const LAS float*)((TB) + KT * KS * 2 + D * VS * 2); \
        if (wact && (!CAUSAL || KT * (j) <= qpos0 + qw * 32 + 31)) { \
            f32x16 p[NP]; \
            const bf16_t* qr_ = qrow; if (D != 64 && !QLDS) asm volatile("" : "+v"(qr_)); \
            _Pragma("unroll") for (int h_ = 0; h_ < NP; ++h_) { \
                if (BIAS) { _Pragma("unroll") for (int i_ = 0; i_ < 4; ++i_) { const f32x4 t0_ = *(const LAS f32x4*)(Bs_ + 32 * h_ + 8 * i_ + 4 * hi); \
                        _Pragma("unroll") for (int e_ = 0; e_ < 4; ++e_) p[h_][4 * i_ + e_] = t0_[e_] - ref; } } \
                else { _Pragma("unroll") for (int r_ = 0; r_ < 16; ++r_) p[h_][r_] = 0.f; } } \
            _Pragma("unroll") for (int ds_ = 0; ds_ < D / 16; ++ds_) { \
                bf16x8 qv_; if (QLDS) qv_ = *(const LAS bf16x8*)(Qs + ds_ * 16); else if (D == 64) qv_ = qf[ds_]; else qv_ = *(const bf16x8*)(qr_ + ds_ * 16); \
                _Pragma("unroll") for (int h_ = 0; h_ < NP; ++h_) { const bf16x8 kf_ = *(const LAS bf16x8*)(Ks_ + (32 * h_ + r32) * KS + ds_ * 16 + hi * 8); p[h_] = __builtin_amdgcn_mfma_f32_32x32x16_bf16(kf_, qv_, p[h_], 0, 0, 0); } } \
            if (CAUSAL && (KT * (j) + KT - 1 > qpos0 + qw * 32)) { const int lim_ = qpos0 + qw * 32 + r32 - KT * (j); \
                _Pragma("unroll") for (int h_ = 0; h_ < NP; ++h_) _Pragma("unroll") for (int r_ = 0; r_ < 16; ++r_) { if (crow(r_, hi) + 32 * h_ > lim_) p[h_][r_] = NEGBIG; } } \
            float sum_ = 0.f; \
            _Pragma("unroll") for (int h_ = 0; h_ < NP; ++h_) _Pragma("unroll") for (int r_ = 0; r_ < 16; ++r_) { p[h_][r_] = __builtin_amdgcn_exp2f(p[h_][r_]); sum_ += p[h_][r_]; } \
            lrun += sum_; \
            u32x4 pw_[2 * NP]; \
            _Pragma("unroll") for (int h_ = 0; h_ < NP; ++h_) _Pragma("unroll") for (int e_ = 0; e_ < 4; ++e_) { pw_[2 * h_][e_] = pg8::cvt_pk_bf16(p[h_][2 * e_], p[h_][2 * e_ + 1]); pw_[2 * h_ + 1][e_] = pg8::cvt_pk_bf16(p[h_][8 + 2 * e_], p[h_][9 + 2 * e_]); } \
            _Pragma("unroll") for (int db_ = 0; db_ < D / 32; ++db_) _Pragma("unroll") for (int ks_ = 0; ks_ < 2 * NP; ++ks_) { \
                const LAS bf16_t* vp_ = Vt_ + (db_ * 32 + r32) * VS + ks_ * 16 + hi * 4; \
                const u32x2 va_ = *(const LAS u32x2*)vp_, vb_ = *(const LAS u32x2*)(vp_ + 8); const u32x4 vv_ = {va_.x, va_.y, vb_.x, vb_.y}; \
                o[db_] = __builtin_amdgcn_mfma_f32_32x32x16_bf16(__builtin_bit_cast(bf16x8, vv_), __builtin_bit_cast(bf16x8, pw_[ks_]), o[db_], 0, 0, 0); } \
        } } while (0)
    if (KG == 1) {
        ATT_LOAD(0, 0); ATT_STORE(T, 0); if (ntiles > 1) ATT_LOAD(1, 1); if (ntiles > 2) ATT_LOAD(2, 0);
        __syncthreads();
        for (int j = 0; j < ntiles; j += 2) {
            if (j + 1 < ntiles) ATT_STORE(T + TILEB, 1);
            if (j + 3 < ntiles) ATT_LOAD(j + 3, 1);
            ATT_COMPUTE(j, T);
            __syncthreads();
            if (j + 1 < ntiles) {
                if (j + 2 < ntiles) ATT_STORE(T, 0);
                if (j + 4 < ntiles) ATT_LOAD(j + 4, 0);
                ATT_COMPUTE(j + 1, T + TILEB);
                __syncthreads();
            }
        }
    } else {
        const int nsteps = (ntiles + KG - 1) / KG;
        if (PF) {
#pragma unroll
            for (int g = 0; g < NG; ++g) { if (g < ntiles) ATT_LOAD(g, g); }
        }
        for (int s = 0; s < nsteps; ++s) {
            __syncthreads();
            if (PF) {
#pragma unroll
                for (int g = 0; g < NG; ++g) { if (s * KG + g < ntiles) ATT_STORE(T + g * TILEB, g); }
            } else {
#pragma unroll
                for (int g = 0; g < KG; ++g) { const int jt = s * KG + g; if (jt < ntiles) { ATT_LOAD(jt, 0); ATT_STORE(T + g * TILEB, 0); } }
            }
            __syncthreads();
            if (PF && s + 1 < nsteps) {
#pragma unroll
                for (int g = 0; g < NG; ++g) { const int jt = (s + 1) * KG + g; if (jt < ntiles) ATT_LOAD(jt, g); }
            }
            const int jm = s * KG + kg;
            if (jm < ntiles) ATT_COMPUTE(jm, T + kg * TILEB);
        }
        constexpr int MB = (D / 32 < 4) ? D / 32 : 4, MR = MB * 16 + 1;
        LAS float* Mg = (LAS float*)L;
#pragma unroll
        for (int d0 = 0; d0 < D / 32; d0 += MB) {
            __syncthreads();
#pragma unroll
            for (int db = 0; db < MB; ++db)
#pragma unroll
                for (int r = 0; r < 16; ++r) Mg[(wid * MR + db * 16 + r) * 64 + lane] = o[d0 + db][r];
            if (d0 == 0) Mg[(wid * MR + MB * 16) * 64 + lane] = lrun;
            __syncthreads();
            if (kg == 0) {
#pragma unroll
                for (int g = 1; g < KG; ++g) {
#pragma unroll
                    for (int db = 0; db < MB; ++db)
#pragma unroll
                        for (int r = 0; r < 16; ++r) o[d0 + db][r] += Mg[((g * QW + qw) * MR + db * 16 + r) * 64 + lane];
                    if (d0 == 0) lrun += Mg[((g * QW + qw) * MR + MB * 16) * 64 + lane];
                }
            }
        }
        __syncthreads();
    }
#undef ATT_LOAD
#undef ATT_STORE
#undef ATT_COMPUTE
    if (kg == 0 && wact) {
        const float lt = lrun + __shfl_xor(lrun, 32), inv = 1.0f / lt;
        bf16_t* orow = O + (size_t)(qw * 32 + r32) * ldo;
#pragma unroll
        for (int db = 0; db < D / 32; ++db)
#pragma unroll
            for (int i = 0; i < 4; ++i) { u32x2 w; w.x = pg8::cvt_pk_bf16(o[db][4 * i] * inv, o[db][4 * i + 1] * inv); w.y = pg8::cvt_pk_bf16(o[db][4 * i + 2] * inv, o[db][4 * i + 3] * inv);
                *(u32x2*)(orow + db * 32 + 8 * i + 4 * hi) = w; }
    }
}

constexpr int POOL_RS = 272, POOL_SLAB = 48 * POOL_RS;
template <int G>
__device__ __forceinline__ void pool_group(LAS unsigned char* slab, const char* __restrict__ ubase, unsigned rowoff0, int nprev0, int nprev, float icnt, const bf16_t* __restrict__ wpt, bf16_t* __restrict__ orow, int lane, int r32, int hi) {
    constexpr int w = 2 << G;
    {
        u32x4 st[12];
#pragma unroll
        for (int k = 0; k < 12; ++k) { const int id = lane + 64 * k, row = id >> 4, ch = id & 15; const int rr = (15 - row <= nprev0) ? row : 15;
            if (row < 47) st[k] = *(const u32x4*)(ubase + (rowoff0 + (unsigned)(rr - 15) * 1024u + (unsigned)(G * 256 + ch * 16))); }
#pragma unroll
        for (int k = 0; k < 12; ++k) { const int id = lane + 64 * k, row = id >> 4, ch = id & 15; if (row < 47) *(LAS u32x4*)(slab + row * POOL_RS + ch * 16) = st[k]; }
    }
    bf16x8 dfr[8];
#pragma unroll
    for (int ks = 0; ks < 8; ++ks) {
        const LAS unsigned char* cp = slab + (15 + r32) * POOL_RS + (ks * 16 + hi * 8) * 2;
        const u32x4 cu = *(const LAS u32x4*)cp;
        float s[8], cur[8];
        cur[0] = bf_lo(cu.x); cur[1] = bf_hi(cu.x); cur[2] = bf_lo(cu.y); cur[3] = bf_hi(cu.y); cur[4] = bf_lo(cu.z); cur[5] = bf_hi(cu.z); cur[6] = bf_lo(cu.w); cur[7] = bf_hi(cu.w);
#pragma unroll
        for (int e = 0; e < 8; ++e) s[e] = cur[e];
#pragma unroll
        for (int j = 1; j < w; ++j) {
            const float wt = (j <= nprev) ? 1.f : 0.f;
            const u32x4 v = *(const LAS u32x4*)(cp - j * POOL_RS);
            s[0] += wt * bf_lo(v.x); s[1] += wt * bf_hi(v.x); s[2] += wt * bf_lo(v.y); s[3] += wt * bf_hi(v.y); s[4] += wt * bf_lo(v.z); s[5] += wt * bf_hi(v.z); s[6] += wt * bf_lo(v.w); s[7] += wt * bf_hi(v.w);
        }
        u32x4 dv;
        dv.x = cvt_pk_bf16(s[0] * icnt - cur[0], s[1] * icnt - cur[1]); dv.y = cvt_pk_bf16(s[2] * icnt - cur[2], s[3] * icnt - cur[3]);
        dv.z = cvt_pk_bf16(s[4] * icnt - cur[4], s[5] * icnt - cur[5]); dv.w = cvt_pk_bf16(s[6] * icnt - cur[6], s[7] * icnt - cur[7]);
        dfr[ks] = __builtin_bit_cast(bf16x8, dv);
        __builtin_amdgcn_sched_barrier(0);
    }
#pragma unroll
    for (int nb = 0; nb < 4; ++nb) {
        f32x16 acc;
#pragma unroll
        for (int r = 0; r < 16; ++r) acc[r] = 0.f;
        const bf16_t* wrow = wpt + ((size_t)G * 128 + nb * 32 + r32) * 128 + hi * 8;
#pragma unroll
        for (int ks = 0; ks < 8; ++ks) acc = __builtin_amdgcn_mfma_f32_32x32x16_bf16(*(const bf16x8*)(wrow + ks * 16), dfr[ks], acc, 0, 0, 0);
#pragma unroll
        for (int i = 0; i < 4; ++i) { u32x2 wv; wv.x = cvt_pk_bf16(acc[4 * i], acc[4 * i + 1]); wv.y = cvt_pk_bf16(acc[4 * i + 2], acc[4 * i + 3]);
            *(u32x2*)(orow + G * 128 + nb * 32 + 8 * i + 4 * hi) = wv; }
    }
}
__device__ __forceinline__ void pool_unit(LAS unsigned char* L, int tile, const bf16_t* __restrict__ ub, const bf16_t* __restrict__ usx, const bf16_t* __restrict__ wpt, bf16_t* __restrict__ mix) {
    const int tid = threadIdx.x, lane = tid & 63, wid = __builtin_amdgcn_readfirstlane(tid >> 6), r32 = lane & 31, hi = lane >> 5;
    const int row0 = tile * 256 + wid * 32, row = row0 + r32;
    const bool samp = tile >= 256;
    const int b0 = samp ? (row0 - MP) >> 6 : row0 >> 11, t0 = samp ? (row0 - MP) & 63 : row0 & (SEQ - 1);
    const char* ubase = (const char*)(samp ? usx : ub);
    const unsigned rowoff0 = (samp ? (unsigned)(b0 * 79 + 15 + t0) : (unsigned)row0) * 1024u;
    const int nprev0 = samp ? t0 + 15 : t0, nprev = nprev0 + r32;
    bf16_t* orow = mix + (size_t)row * DM;
    const int np1 = nprev + 1;
    LAS unsigned char* slab = L + wid * POOL_SLAB;
    pool_group<0>(slab, ubase, rowoff0, nprev0, nprev, 1.0f / (float)(np1 < 2 ? np1 : 2), wpt, orow, lane, r32, hi);
    pool_group<1>(slab, ubase, rowoff0, nprev0, nprev, 1.0f / (float)(np1 < 4 ? np1 : 4), wpt, orow, lane, r32, hi);
    pool_group<2>(slab, ubase, rowoff0, nprev0, nprev, 1.0f / (float)(np1 < 8 ? np1 : 8), wpt, orow, lane, r32, hi);
    pool_group<3>(slab, ubase, rowoff0, nprev0, nprev, 1.0f / (float)(np1 < 16 ? np1 : 16), wpt, orow, lane, r32, hi);
}

template <int MODE>
__device__ __forceinline__ void transpose_item(const float* __restrict__ W, int K, int N, int nblk, bf16_t* __restrict__ WT, int row_off, const float* __restrict__ g, LAS float* scr, int item, int lane) {
    const int kb = item / nblk, nb = item % nblk, k0 = 64 * kb, n0 = 32 * nb;
#pragma unroll 8
    for (int i = 0; i < 32; ++i) { const int kk = 2 * i + (lane >> 5); float v = W[(size_t)(k0 + kk) * N + n0 + (lane & 31)]; if (g) v *= g[k0 + kk]; scr[kk * 33 + (lane & 31)] = v; }
    LDS_WAIT();
    const int c = lane & 7;
#pragma unroll
    for (int j = 0; j < 4; ++j) {
        const int n = (lane >> 3) + 8 * j; const LAS float* s = scr + (8 * c) * 33 + n;
        const int nn = n0 + n; int drow;
        if (MODE == 0) drow = row_off + nn; else { const int half = nn / DFF, cc = nn % DFF; drow = (cc >> 7) * 256 + half * 128 + (cc & 127); }
        u32x4 o; o.x = cvt_pk_bf16(s[0 * 33], s[1 * 33]); o.y = cvt_pk_bf16(s[2 * 33], s[3 * 33]); o.z = cvt_pk_bf16(s[4 * 33], s[5 * 33]); o.w = cvt_pk_bf16(s[6 * 33], s[7 * 33]);
        *(u32x4*)(WT + (size_t)drow * K + k0 + 8 * c) = o;
    }
    LDS_WAIT();
}
__device__ __forceinline__ void prepass_row(const float* __restrict__ xrow, bf16_t* __restrict__ orow, const LAS float* wf, const float* __restrict__ b_f, float* __restrict__ lf_out, int lane) {
    const f32x4* xr = (const f32x4*)xrow + lane;
    f32x4 v[4]; float s = 0.f;
#pragma unroll
    for (int j = 0; j < 4; ++j) { v[j] = xr[64 * j]; s += (v[j][0] * v[j][0] + v[j][1] * v[j][1]) + (v[j][2] * v[j][2] + v[j][3] * v[j][3]); }
    const float r = rsq(wave_sum(s));
    u32x2* o8 = (u32x2*)orow + lane;
#pragma unroll
    for (int j = 0; j < 4; ++j) { v[j] = v[j] * r; u32x2 w; w.x = cvt_pk_bf16(v[j][0], v[j][1]); w.y = cvt_pk_bf16(v[j][2], v[j][3]); o8[64 * j] = w; }
    if (wf) {
        f32x4 fa = {0.f, 0.f, 0.f, 0.f}, fb = {0.f, 0.f, 0.f, 0.f};
#pragma unroll
        for (int j = 0; j < 4; ++j)
#pragma unroll
            for (int e = 0; e < 4; ++e) { const int k = 4 * (lane + 64 * j) + e; const LAS f32x4* w = (const LAS f32x4*)(wf + k * 8); fa += w[0] * v[j][e]; fb += w[1] * v[j][e]; }
#pragma unroll
        for (int e = 0; e < 4; ++e) { fa[e] = wave_sum(fa[e]); fb[e] = wave_sum(fb[e]); }
        float z = fa[0];
        z = (lane == 1) ? fa[1] : z; z = (lane == 2) ? fa[2] : z; z = (lane == 3) ? fa[3] : z; z = (lane == 4) ? fb[0] : z; z = (lane == 5) ? fb[1] : z; z = (lane == 6) ? fb[2] : z; z = (lane == 7) ? fb[3] : z;
        if (lane < 8) { z += b_f[lane]; lf_out[lane] = fminf(z, 0.f) - log1pf(expf(-fabsf(z))); }
    }
}
__device__ __forceinline__ void scan_seq(const float* s0, int n0, const float* s1, int n1, float* dst, int lane) {
    const int n = n0 + n1, Lc = n >> 6;
    float s = 0.f;
    for (int i = 0; i < Lc; ++i) { const int t = lane * Lc + i; const float* ptr = (t < n0) ? (s0 + (size_t)t * 8) : (s1 + (size_t)(t - n0) * 8); s += *ptr; }
    float inc = s;
    for (int o = 1; o < 64; o <<= 1) { const float v = __shfl_up(inc, o); if (lane >= o) inc += v; }
    float run = inc - s;
    for (int i = 0; i < Lc; ++i) { const int t = lane * Lc + i; const float* ptr = (t < n0) ? (s0 + (size_t)t * 8) : (s1 + (size_t)(t - n0) * 8); run += *ptr; dst[t] = -run * LOG2E; }
}
__device__ __forceinline__ void cvt_flat(const float* __restrict__ src, bf16_t* __restrict__ dst, size_t n8, size_t gtid, size_t gn) {
    for (size_t i = gtid; i < n8; i += gn) { const f32x4 a = *(const f32x4*)(src + i * 8), b = *(const f32x4*)(src + i * 8 + 4); *(u32x4*)(dst + i * 8) = pack8(a, b); }
}

#define Wt_in ((bf16_t*)(ws + WS_WIN))
#define Wt_o ((bf16_t*)(ws + WS_WO))
#define Wt_mq ((bf16_t*)(ws + WS_WMQ))
#define Wt_mo ((bf16_t*)(ws + WS_WMO))
#define Wt_mkv ((bf16_t*)(ws + WS_WMKV))
#define Wt_up ((bf16_t*)(ws + WS_WUP))
#define Wt_dn ((bf16_t*)(ws + WS_WDN))
#define Wt_pool ((bf16_t*)(ws + WS_WPOOL))
#define usx ((bf16_t*)(ws + WS_USX))
#define mkb ((bf16_t*)(ws + WS_MKB))
#define mvb ((bf16_t*)(ws + WS_MVB))
#define ssq1 ((float*)(ws + WS_SSQ1))
#define ssq2 ((float*)(ws + WS_SSQ2))
#define ssq3 ((float*)(ws + WS_SSQ3))
#define kbP ((float*)(ws + WS_KBP))
#define kbS ((float*)(ws + WS_KBS))
#define ahead ((float*)(ws + WS_AHEAD))
#define atail ((float*)(ws + WS_ATAIL))
#define bhead ((float*)(ws + WS_BHEAD))
#define x1b ((bf16_t*)(ws + WS_X1B))
#define kcb ((bf16_t*)(ws + WS_KCB))
#define vcb ((bf16_t*)(ws + WS_VCB))
#define x2b ((bf16_t*)(ws + WS_X2B))
#define xb ((bf16_t*)(ws + WS_XB))
#define mqb ((bf16_t*)(ws + WS_MQB))
#define hff ((bf16_t*)(ws + WS_HFF))
#define uqkv ((bf16_t*)(ws + WS_UQKV))
#define mo ((bf16_t*)(ws + WS_MO))
#define mix ((bf16_t*)(ws + WS_MIX))
#define memb ((bf16_t*)(ws + WS_MEMB))
#define ub uqkv
#define qb (uqkv + (size_t)MT * 512)
#define kb (uqkv + (size_t)2 * MT * 512)
#define vb (uqkv + (size_t)3 * MT * 512)
__global__ void __launch_bounds__(512, 2) fwd_kernel(Params p) {
    extern __shared__ __attribute__((aligned(16))) unsigned char lds_raw[];
    LAS unsigned char* L = (LAS unsigned char*)lds_raw;
    cg::grid_group grid = cg::this_grid();
    const int tid = threadIdx.x, lane = tid & 63, wave = __builtin_amdgcn_readfirstlane(tid >> 6);
    const int G = gridDim.x, bx = blockIdx.x;
    unsigned char* ws = p.ws; float* out = p.out;
    const float* x_prompt = p.in[0]; const float* x_sample = p.in[1];
    const int lo = p.ph_lo, hi_ph = p.ph_hi;
    unsigned* gbar = (unsigned*)ws; unsigned nbar = 0u;
    if (lo < 0) grid.sync();
#define IN(k) (lo <= (k) && (k) < hi_ph && ((PHMASK >> (k)) & 1))
#define GSYNC() do { asm volatile("s_waitcnt vmcnt(0)" ::: "memory"); __syncthreads(); \
        if (tid == 0) { __builtin_amdgcn_fence(__ATOMIC_RELEASE, "agent"); asm volatile("s_waitcnt vmcnt(0)" ::: "memory"); \
            nbar += (unsigned)G; __hip_atomic_fetch_add(gbar, 1u, __ATOMIC_RELAXED, __HIP_MEMORY_SCOPE_AGENT); \
            while (__hip_atomic_load(gbar, __ATOMIC_RELAXED, __HIP_MEMORY_SCOPE_AGENT) < nbar) __builtin_amdgcn_s_sleep(6); \
            __builtin_amdgcn_fence(__ATOMIC_ACQUIRE, "agent"); asm volatile("s_waitcnt vmcnt(0)" ::: "memory"); } \
        __syncthreads(); } while (0)
#define SEAM(k) do { if (IN(k) && IN((k) + 1)) GSYNC(); } while (0)

    if (IN(0)) {
        const int gw = bx * 8 + wave, NGW = G * 8;
        LAS float* scr = (LAS float*)(L + wave * 8448);
        LAS float* wf = (LAS float*)(L + 8 * 8448);
        {
            const float* w_in = p.in[11]; const float* g_mix = p.in[10];
            for (int i = tid; i < 8192; i += 512) { const int k = i >> 3, h = i & 7; wf[i] = w_in[(size_t)k * 2056 + 2048 + h] * g_mix[k]; }
        }
        __syncthreads();
        constexpr int I_IN = 16 * 64, I_SQ = 16 * 32, I_UP = 16 * 176, I_DN = 44 * 32;
        constexpr int NITEMS = I_IN + 5 * I_SQ + I_UP + I_DN;
        for (int it = gw; it < NITEMS; it += NGW) {
            int r = it;
            if (r < I_IN) { transpose_item<0>(p.in[11], 1024, 2056, 64, Wt_in, 0, p.in[10], scr, r, lane); continue; } r -= I_IN;
            if (r < I_SQ) { transpose_item<0>(p.in[15], 1024, 1024, 32, Wt_o, 0, nullptr, scr, r, lane); continue; } r -= I_SQ;
            if (r < I_SQ) { transpose_item<0>(p.in[18], 1024, 1024, 32, Wt_mq, 0, p.in[16], scr, r, lane); continue; } r -= I_SQ;
            if (r < I_SQ) { transpose_item<0>(p.in[19], 1024, 1024, 32, Wt_mkv, 0, p.in[17], scr, r, lane); continue; } r -= I_SQ;
            if (r < I_SQ) { transpose_item<0>(p.in[20], 1024, 1024, 32, Wt_mkv, 1024, p.in[17], scr, r, lane); continue; } r -= I_SQ;
            if (r < I_SQ) { transpose_item<0>(p.in[21], 1024, 1024, 32, Wt_mo, 0, nullptr, scr, r, lane); continue; } r -= I_SQ;
            if (r < I_UP) { transpose_item<1>(p.in[23], 1024, NUP, 176, Wt_up, 0, p.in[22], scr, r, lane); continue; } r -= I_UP;
            transpose_item<0>(p.in[26], DFF, 1024, 32, Wt_dn, 0, nullptr, scr, r, lane);
        }
        {
            const float* w_pool = p.in[13]; const float* pscale = p.in[14];
            for (int i = bx * 512 + tid; i < 4 * 128 * 128; i += G * 512) { const int g = i >> 14, d = (i >> 7) & 127, c = i & 127; Wt_pool[i] = (bf16_t)(cvt_pk_bf16(w_pool[(g * 128 + c) * 128 + d] * pscale[g * 128 + d], 0.f) & 0xffffu); }
        }
        for (int m = gw; m < MT; m += NGW) {
            const float* xr = (m < MP) ? x_prompt + (size_t)m * DM : x_sample + (size_t)(m - MP) * DM;
            float* lf = (m < MP) ? out + O_LFP + (size_t)m * 8 : out + O_LFS + (size_t)(m - MP) * 8;
            prepass_row(xr, xb + (size_t)m * DM, wf, p.in[12], lf, lane);
        }
        for (int m = gw; m < 8192; m += NGW) prepass_row(p.in[9] + (size_t)m * DM, memb + (size_t)m * DM, (const LAS float*)nullptr, nullptr, nullptr, lane);
        const size_t gtid = (size_t)bx * 512 + tid, gn = (size_t)G * 512;
        for (size_t i = gtid; i < (size_t)16 * 15 * 512 / 8; i += gn) { const size_t e8 = i * 8, bb = e8 / (15 * 512), rem = e8 - bb * 15 * 512; const float* sp = p.in[5] + e8; *(u32x4*)(usx + bb * 79 * 512 + rem) = pack8(*(const f32x4*)sp, *(const f32x4*)(sp + 4)); }
        cvt_flat(p.in[2], kcb, (size_t)16 * PAST * 512 / 8, gtid, gn);
        cvt_flat(p.in[3], vcb, (size_t)16 * PAST * 512 / 8, gtid, gn);
        cvt_flat(p.in[7], mkb + (size_t)8192 * 1024, (size_t)4096 * 1024 / 8, gtid, gn);
        cvt_flat(p.in[8], mvb + (size_t)8192 * 1024, (size_t)4096 * 1024 / 8, gtid, gn);
        __syncthreads();
    }
    SEAM(0);

    if (IN(1)) {
        if (wave == 0) { const int s = bx; if (s < 256) scan_seq(out + O_LFP + (size_t)(s >> 3) * SEQ * 8 + (s & 7), SEQ, out + O_LFP, 0, kbP + (size_t)s * SEQ, lane); }
        if (wave == 1 && bx < 128) { const int s = bx; scan_seq(p.in[4] + (size_t)(s >> 3) * PAST * 8 + (s & 7), PAST, out + O_LFS + (size_t)(s >> 3) * DSEQ * 8 + (s & 7), DSEQ, kbS + (size_t)s * (PAST + DSEQ), lane); }
        {
            pg8::Gemm g{xb, Wt_in, MT, 2048, 1024}; pg8::StaticOrder S; S.init(MT, 2048, G, bx);
            EpiIn E{uqkv, out, usx};
            pg8::gemm_phase<EpiIn, pg8::StaticOrder, true, true>(L, g, S, E);
        }
        __syncthreads();
        {
            pg8::Gemm g{memb, Wt_mkv, 8192, 2048, 1024}; pg8::StaticOrder S; S.init(8192, 2048, G, bx);
            EpiMkv E{mkb, mvb, out};
            pg8::gemm_phase<EpiMkv, pg8::StaticOrder, true, true>(L, g, S, E);
        }
    }
    SEAM(1);

    if (IN(2)) {
        for (int it = 0; it < 8 * ((256 + G - 1) / G); ++it) {
            int bh, qk;
            if (G == 256) { const int xcd = bx & 7, l = bx >> 3, r = it >> 1, pi = l & 3; bh = xcd * 32 + r * 8 + (l >> 2); qk = (it & 1) ? pi : 7 - pi; }
            else { bh = bx + (it >> 3) * G; qk = 7 - (it & 7); if (bh >= 256) break; }
            const int b = bh >> 3, h = bh & 7;
            const bf16_t* Kh = kb + (size_t)b * SEQ * 512 + h * 64; const bf16_t* Vh = vb + (size_t)b * SEQ * 512 + h * 64;
            const size_t r0 = (size_t)b * SEQ + 256 * qk;
            attn_unit<64, 64, 1, true, false, true, true>(L, qb + r0 * 512 + h * 64, 512, 256, Kh, Vh, 4 * qk + 4, Kh, Vh, 512, 4 * qk + 4, kbP + (size_t)bh * SEQ, 256 * qk, mix + r0 * DM + 512 + h * 64, DM);
        }
        if (P2_ATTN_S) for (int bh = bx; bh < 128; bh += G) {
            const int b = bh >> 3, h = bh & 7;
            const size_t r0 = (size_t)MP + b * DSEQ;
            attn_unit<64, 64, 4, true, false, true, true>(L, qb + r0 * 512 + h * 64, 512, 64, kcb + (size_t)b * PAST * 512 + h * 64, vcb + (size_t)b * PAST * 512 + h * 64, 64,
                                      kb + r0 * 512 + h * 64, vb + r0 * 512 + h * 64, 512, 65, kbS + (size_t)bh * (PAST + DSEQ), PAST, mix + r0 * DM + 512 + h * 64, DM);
        }
        if (G == 256) { __syncthreads(); pool_unit(L, bx, ub, usx, Wt_pool, mix); if (bx >= 128 && bx < 132) pool_unit(L, 128 + bx, ub, usx, Wt_pool, mix); }
        else { __syncthreads(); for (int t = bx; t < MT / 256; t += G) pool_unit(L, t, ub, usx, Wt_pool, mix); }
        __syncthreads();
    }
    SEAM(2);

    if (IN(3)) {
        pg8::Gemm g{mix, Wt_o, MT, 1024, 1024}; pg8::StaticOrder S; S.init(MT, 1024, G, bx);
        EpiRes<0> E{x_prompt, x_sample, nullptr, x1b, nullptr, ssq1};
        pg8::gemm_phase<EpiRes<0>, pg8::StaticOrder, true, true>(L, g, S, E);
    }
    SEAM(3);

    if (IN(4)) {
        pg8::Gemm g{x1b, Wt_mq, MT, 1024, 1024}; pg8::StaticOrder S; S.init(MT, 1024, G, bx);
        EpiMq E{ssq1, mqb};
        pg8::gemm_phase<EpiMq, pg8::StaticOrder, true, true>(L, g, S, E);
    }
    SEAM(4);

    if (IN(5)) {
        for (int k5 = 0; k5 * G < 2048 + 64; ++k5) {
            const int un = (G == 256 && k5 < 8) ? (((k5 * 8 + (bx & 7)) * 32) + (bx >> 3)) : (k5 * G + bx);
            if (un >= 2048 + 64) break;
            if (un < 2048) {
                const int b = un >> 6, h = (un >> 4) & 3, qk = un & 15;
                const size_t r0 = (size_t)b * SEQ + 128 * qk;
                const bf16_t* Kh = mkb + (size_t)b * NMEM * 1024 + h * 256; const bf16_t* Vh = mvb + (size_t)b * NMEM * 1024 + h * 256;
                attn_unit<256, 32, 2, false, true, false, false>(L, mqb + r0 * DM + h * 256, DM, 128, Kh, Vh, 8, Kh, Vh, 1024, 8, nullptr, 0, mo + r0 * DM + h * 256, DM);
            } else {
                const int us = un - 2048, b = us >> 2, h = us & 3;
                const size_t r0 = (size_t)MP + b * DSEQ;
                const bf16_t* Kh = mkb + (size_t)(8192 + b * NMEM) * 1024 + h * 256; const bf16_t* Vh = mvb + (size_t)(8192 + b * NMEM) * 1024 + h * 256;
                attn_unit<256, 32, 2, false, true, false, false>(L, mqb + r0 * DM + h * 256, DM, 64, Kh, Vh, 8, Kh, Vh, 1024, 8, nullptr, 0, mo + r0 * DM + h * 256, DM);
            }
        }
        __syncthreads();
    }
    SEAM(5);

    if (IN(6)) {
        pg8::Gemm g{mo, Wt_mo, MT, 1024, 1024}; pg8::StaticOrder S; S.init(MT, 1024, G, bx);
        EpiRes<1> E{nullptr, nullptr, x1b, x2b, nullptr, ssq2};
        pg8::gemm_phase<EpiRes<1>, pg8::StaticOrder, true, true>(L, g, S, E);
    }
    SEAM(6);

    if (IN(7)) {
        pg8::Gemm g{x2b, Wt_up, MT, NUP, 1024}; pg8::StaticOrder S; S.init(MT, NUP, G, bx);
        EpiUp E{ssq2, p.in[24], p.in[25], hff, ahead, atail, bhead};
        pg8::gemm_phase<EpiUp, pg8::StaticOrder, true, true>(L, g, S, E);
    }
    SEAM(7);

    if (IN(8)) {
        const float* cw = p.in[24]; const float* cbias = p.in[25]; const float* chist = p.in[6];
        const int total4 = NSEG * 2 * (DFF / 4);
        for (int idx = bx * 512 + tid; idx < total4; idx += G * 512) {
            const int seg = idx / (2 * (DFF / 4)), rem = idx - seg * 2 * (DFF / 4), i = rem / (DFF / 4), c = (rem - i * (DFF / 4)) * 4;
            f32x4 prev1, prev2;
            if (seg < MP / 64) { if ((seg & 31) == 0) { prev1 = (f32x4){0.f, 0.f, 0.f, 0.f}; prev2 = prev1; } else { prev1 = *(const f32x4*)(atail + ((size_t)(seg - 1) * 2 + 1) * DFF + c); prev2 = *(const f32x4*)(atail + ((size_t)(seg - 1) * 2) * DFF + c); } }
            else { const int b = seg - MP / 64; prev1 = *(const f32x4*)(chist + ((size_t)b * 2 + 1) * DFF + c); prev2 = *(const f32x4*)(chist + ((size_t)b * 2) * DFF + c); }
            const f32x4 a_0 = *(const f32x4*)(ahead + ((size_t)seg * 2) * DFF + c);
            f32x4 am1, am2, a0;
            if (i == 0) { am1 = prev1; am2 = prev2; a0 = a_0; } else { am1 = a_0; am2 = prev1; a0 = *(const f32x4*)(ahead + ((size_t)seg * 2 + 1) * DFF + c); }
            const f32x4 cv = *(const f32x4*)(cbias + c) + *(const f32x4*)(cw + c) * am2 + *(const f32x4*)(cw + DFF + c) * am1 + *(const f32x4*)(cw + 2 * DFF + c) * a0;
            const f32x4 bh = *(const f32x4*)(bhead + ((size_t)seg * 2 + i) * DFF + c);
            f32x4 hv;
#pragma unroll
            for (int e = 0; e < 4; ++e) hv[e] = cv[e] / (1.0f + __builtin_amdgcn_exp2f(-cv[e] * LOG2E)) * bh[e];
            u32x2 w; w.x = cvt_pk_bf16(hv[0], hv[1]); w.y = cvt_pk_bf16(hv[2], hv[3]);
            *(u32x2*)(hff + ((size_t)seg * 64 + i) * DFF + c) = w;
        }
        for (int idx = bx * 512 + tid; idx < 48 * 2 * DFF; idx += G * 512) {
            const int bb = idx / (2 * DFF), rem = idx - bb * 2 * DFF;
            if (bb < 32) out[O_CSP + (size_t)bb * 2 * DFF + rem] = atail[((size_t)(32 * bb + 31) * 2) * DFF + rem];
            else out[O_CSS + (size_t)(bb - 32) * 2 * DFF + rem] = atail[((size_t)(MP / 64 + bb - 32) * 2) * DFF + rem];
        }
    }
    SEAM(8);

    if (IN(9)) {
        pg8::Gemm g{hff, Wt_dn, MT, 1024, DFF}; pg8::StaticOrder S; S.init(MT, 1024, G, bx);
        EpiRes<2> E{nullptr, nullptr, x2b, nullptr, out, ssq3};
        pg8::gemm_phase<EpiRes<2>, pg8::StaticOrder, true, true>(L, g, S, E);
    }
    SEAM(9);

    if (IN(10)) {
        const float* gf = p.in[27];
        const int gw = bx * 8 + wave, NGW = G * 8;
        f32x4 gv[4];
#pragma unroll
        for (int j = 0; j < 4; ++j) gv[j] = ((const f32x4*)gf)[lane + 64 * j];
        for (int m0 = gw; m0 < MT; m0 += 4 * NGW) {
            f32x4 v[4][4]; float r[4];
#pragma unroll
            for (int q = 0; q < 4; ++q) { const int m = m0 + q * NGW; if (m < MT) { const f32x4* y4 = (const f32x4*)(out + (size_t)m * DM) + lane; r[q] = row_rsq(ssq3, m);
#pragma unroll
                    for (int j = 0; j < 4; ++j) v[q][j] = y4[64 * j]; } }
#pragma unroll
            for (int q = 0; q < 4; ++q) { const int m = m0 + q * NGW; if (m < MT) { f32x4* y4 = (f32x4*)(out + (size_t)m * DM) + lane;
#pragma unroll
                    for (int j = 0; j < 4; ++j) y4[64 * j] = v[q][j] * r[q] * gv[j]; } }
        }
    }
#ifdef DBG_DUMP
    {
        GSYNC();
        const bf16_t* src = nullptr; int pitch = 1024;
        if (hi_ph == 2) src = uqkv; else if (hi_ph == 3) src = mix; else if (hi_ph == 4) src = x1b; else if (hi_ph == 5) src = mqb; else if (hi_ph == 6) src = mo; else if (hi_ph == 7) src = x2b; else if (hi_ph == 8 || hi_ph == 9) { src = hff; pitch = DFF; }
        if (src) for (size_t i = (size_t)bx * 512 + tid; i < (size_t)MT * 1024; i += (size_t)G * 512) { const size_t m = i >> 10, c = i & 1023; float v = __builtin_bit_cast(float, (unsigned)src[m * pitch + c] << 16); if (!(v == v)) v = 12345.f; if (fabsf(v) > 1e30f) v = 54321.f; out[i] = v; }
    }
#endif
#undef IN
#undef SEAM
}

extern "C" void kernel_launch(void* const* d_in, const int* in_sizes, int n_in, void* d_out, int out_size, void* d_ws, size_t ws_size, hipStream_t stream) {
    static int grid = 0;
    if (grid == 0) {
        if (n_in != 28 || (size_t)out_size != O_END || ws_size < WS_NEED) { fprintf(stderr, "kernel_launch: unexpected shapes (n_in %d, out %d, ws %zu); nothing launched\n", n_in, out_size, ws_size); grid = -1; return; }
        int dev = 0, cus = 0, per_cu = 0;
        hipGetDevice(&dev); hipDeviceGetAttribute(&cus, hipDeviceAttributeMultiprocessorCount, dev);
        hipFuncSetAttribute((const void*)fwd_kernel, hipFuncAttributeMaxDynamicSharedMemorySize, LDS_BYTES);
        hipOccupancyMaxActiveBlocksPerMultiprocessor(&per_cu, (const void*)fwd_kernel, 512, LDS_BYTES);
        if (per_cu < 1) { fprintf(stderr, "kernel_launch: occupancy query says %d blocks per CU\n", per_cu); per_cu = 1; }
        (void)hipGetLastError();
        grid = cus;
    }
    if (grid < 0) return;
    (void)hipMemsetAsync(d_ws, 0, 256, stream);
    Params p{};
    for (int i = 0; i < 28; ++i) p.in[i] = (const float*)d_in[i];
    p.out = (float*)d_out; p.ws = (unsigned char*)d_ws;
    void* args[] = {&p};
#ifdef PROBE_K
    p.ph_lo = 0; p.ph_hi = PROBE_K + 1;
    (void)hipLaunchCooperativeKernel((const void*)fwd_kernel, dim3(grid), dim3(512), args, LDS_BYTES, stream);
    (void)hipMemsetAsync(d_ws, 0, 256, stream);
    p.ph_lo = PROBE_K; p.ph_hi = 11;
#else
    p.ph_lo = 0; p.ph_hi = 11;
#endif
    hipError_t e = hipLaunchCooperativeKernel((const void*)fwd_kernel, dim3(grid), dim3(512), args, LDS_BYTES, stream);
    if (e != hipSuccess) fprintf(stderr, "cooperative launch failed: %s (grid %d)\n", hipGetErrorString(e), grid);
}
```

```cpp
#include <hip/hip_runtime.h>
#include <hip/hip_cooperative_groups.h>
#include <cstdio>
#include <cstdint>
namespace cg = cooperative_groups;
namespace pg8 {
#define PG8_LAS __attribute__((address_space(3)))
typedef unsigned short bf16_t;
typedef short bf16x8 __attribute__((ext_vector_type(8)));
typedef float f32x4 __attribute__((ext_vector_type(4)));
typedef unsigned u32x4 __attribute__((ext_vector_type(4)));
constexpr int BM = 256, BK = 64, HALF = 128, HTB = HALF * BK * 2  , STAGE_BYTES = 8 * HTB, NXCD = 8, WGM = 8;

__host__ __device__ __forceinline__ int lds_byte(int r, int c) { const int st = (r >> 4) * 2 + (c >> 5), rr = r & 15, cc = c & 31, ob = rr * 64 + cc * 2; return st * 1024 + (ob ^ (((ob >> 9) & 1) << 5)); }
__host__ __device__ __forceinline__ void stage_rc(int b, int& R, int& C) { const int st = b / 1024, sb = b % 1024, swz = sb ^ (((sb >> 9) & 1) << 5); R = (st >> 1) * 16 + swz / 64; C = (st & 1) * 32 + (swz % 64) / 2; }
__host__ __device__ __forceinline__ int perm32(int rho) { const int n = rho >> 4, i = rho & 15; return 8 * (i >> 2) + 4 * n + (i & 3); }

struct Unit { int pm, pn; };
struct Gemm { const bf16_t* A; const bf16_t* Bt; int M, N, K; };

struct StaticOrder {
    int nM, nN, nwg, G, c;
    __host__ __device__ void init(int M, int N, int G_, int c_) { nM = M / BM; nN = N / BM; nwg = nM * nN; G = G_; c = c_; }
    __host__ __device__ bool next(int i, Unit& u) const {
        const long L = (long)i * G + c; if (L >= nwg) return false;
        int wgid = (int)L; { const int q = nwg / NXCD, r = nwg % NXCD, xcd = wgid % NXCD, off = wgid / NXCD; wgid = (xcd < r ? xcd * (q + 1) : r * (q + 1) + (xcd - r) * q) + off; }
        const int nig = WGM * nN, gid = wgid / nig, fm = gid * WGM, gsz = (nM - fm) < WGM ? (nM - fm) : WGM;
        u.pm = fm + ((wgid % nig) % gsz); u.pn = (wgid % nig) / gsz; return true;
    }
    __device__ __forceinline__ void a_ready(const Unit&) const {}
    __device__ __forceinline__ void done(const Unit&) const {}
};

__device__ __forceinline__ unsigned cvt_pk_bf16(float lo, float hi) { unsigned r; asm volatile("v_cvt_pk_bf16_f32 %0, %1, %2" : "=v"(r) : "v"(lo), "v"(hi)); return r; }
typedef float f32x2 __attribute__((ext_vector_type(2)));
template <class Epi, class Sched, bool ALIGN_EPI = false, bool SP2 = false>
__device__ __forceinline__ void gemm_phase(PG8_LAS unsigned char* lds, const Gemm g, const Sched& S, const Epi& E) {
    const int tid = threadIdx.x, wid = __builtin_amdgcn_readfirstlane(tid >> 6), lane = tid & 63, wr = wid >> 2, wc = wid & 3, fr = lane & 15, fq = lane >> 4;
    const int K = g.K, nt = K / BK;
    unsigned voffA[2], voffB[2];
#pragma unroll
    for (int i = 0; i < 2; ++i) { int R, C; stage_rc(tid * 16 + i * 8192, R, C); const int Rb = Epi::PERM ? ((R & ~31) + perm32(R & 31)) : R;
        voffA[i] = (unsigned)(R * K + C) * 2u; voffB[i] = (unsigned)(Rb * K + C) * 2u; }
    const size_t kstep = (size_t)(BK * 2);
    const size_t hstep = (size_t)HALF * K * 2;
    const size_t tstep = 2 * hstep;
    const unsigned ldsw = (unsigned)wid * 1024u;
    const int aoff = lds_byte(wr * 64 + fr, fq * 8), boff = lds_byte(wc * 32 + fr, fq * 8);
#define PG8_SA(b, h) (((b) * 2 + (h)) * HTB)
#define PG8_SB(b, h) ((4 + (b) * 2 + (h)) * HTB)
#define PG8_STAGE(bufoff, gbase, voff) do { _Pragma("unroll") for (int _i = 0; _i < 2; ++_i) \
        __builtin_amdgcn_global_load_lds((const unsigned*)((const char*)(gbase) + (voff)[_i]), (PG8_LAS unsigned*)(lds + (bufoff) + ldsw + _i * 8192), 16, 0, 0); } while (0)
#define PG8_LDA(dst, b, h) do { _Pragma("unroll") for (int m = 0; m < 4; ++m) _Pragma("unroll") for (int k = 0; k < 2; ++k) dst[m][k] = *(const PG8_LAS bf16x8*)(lds + PG8_SA(b, h) + aoff + m * 2048 + k * 1024); } while (0)
#define PG8_LDB(dst, b, h) do { _Pragma("unroll") for (int n = 0; n < 2; ++n) _Pragma("unroll") for (int k = 0; k < 2; ++k) dst[n][k] = *(const PG8_LAS bf16x8*)(lds + PG8_SB(b, h) + boff + n * 2048 + k * 1024); } while (0)
#define PG8_MMA(ai, bj, At, Bt) do { __builtin_amdgcn_s_setprio(1); _Pragma("unroll") for (int m = 0; m < 4; ++m) _Pragma("unroll") for (int n = 0; n < 2; ++n) _Pragma("unroll") for (int k = 0; k < 2; ++k) \
        acc[ai][bj][m][n] = __builtin_amdgcn_mfma_f32_16x16x32_bf16(Bt[n][k], At[m][k], acc[ai][bj][m][n], 0, 0, 0); __builtin_amdgcn_s_setprio(0); } while (0)
#define PG8_WAIT_V(n) asm volatile("s_waitcnt vmcnt(" #n ")" ::: "memory")
#define PG8_WAIT_L(n) asm volatile("s_waitcnt lgkmcnt(" #n ")" ::: "memory")
#define PG8_BAR __builtin_amdgcn_s_barrier()
#define PG8_SCHED __builtin_amdgcn_sched_barrier(0)
    Unit cur, nxt; int ui = 0;
    if (!S.next(0, cur)) return;
    f32x4 acc[2][2][4][2];
#pragma unroll
    for (int a = 0; a < 2; ++a)
#pragma unroll
        for (int b = 0; b < 2; ++b)
#pragma unroll
            for (int m = 0; m < 4; ++m)
#pragma unroll
                for (int n = 0; n < 2; ++n) acc[a][b][m][n] = (f32x4){0.f, 0.f, 0.f, 0.f};
    bf16x8 At[4][2], B0[2][2], B1[2][2];
    const char* cA = (const char*)g.A + (size_t)cur.pm * tstep; const char* cB = (const char*)g.Bt + (size_t)cur.pn * tstep;
    S.a_ready(cur);
    if constexpr (SP2) {
        PG8_STAGE(PG8_SB(0, 0), cB, voffB); PG8_STAGE(PG8_SB(0, 1), cB + hstep, voffB); PG8_STAGE(PG8_SA(0, 0), cA, voffA); PG8_STAGE(PG8_SA(0, 1), cA + hstep, voffA);
        if (wr == 1) PG8_BAR;
        PG8_WAIT_V(2); PG8_BAR;
        PG8_STAGE(PG8_SB(1, 0), cB + kstep, voffB); PG8_STAGE(PG8_SA(1, 0), cA + kstep, voffA); PG8_STAGE(PG8_SB(1, 1), cB + hstep + kstep, voffB);
        PG8_WAIT_V(6); PG8_BAR;
    } else {
        PG8_STAGE(PG8_SB(0, 0), cB, voffB); PG8_STAGE(PG8_SA(0, 0), cA, voffA); PG8_STAGE(PG8_SB(0, 1), cB + hstep, voffB); PG8_STAGE(PG8_SA(0, 1), cA + hstep, voffA);
        if (wr == 1) PG8_BAR;
        PG8_WAIT_V(4); PG8_BAR;
        PG8_STAGE(PG8_SB(1, 0), cB + kstep, voffB); PG8_STAGE(PG8_SA(1, 0), cA + kstep, voffA); PG8_STAGE(PG8_SB(1, 1), cB + hstep + kstep, voffB);
        PG8_WAIT_V(6); PG8_BAR;
    }
    for (;;) {
        const bool has_next = S.next(ui + 1, nxt);
        const char* nA = has_next ? (const char*)g.A + (size_t)nxt.pm * tstep : cA; const char* nB = has_next ? (const char*)g.Bt + (size_t)nxt.pn * tstep : cB;
        for (int t = 0; t < nt; t += 2) {
            const bool last = (t == nt - 2);
            const char* a1 = cA + (size_t)(t + 1) * kstep;
            const char* a2 = last ? nA : cA + (size_t)(t + 2) * kstep; const char* b2 = last ? nB : cB + (size_t)(t + 2) * kstep;
            const char* a3 = a2 + kstep; const char* b3 = b2 + kstep;
            if (last && has_next) S.a_ready(nxt);
            if constexpr (SP2) {
            PG8_LDB(B0, 0, 0); PG8_LDB(B1, 0, 1); PG8_SCHED; PG8_LDA(At, 0, 0); PG8_STAGE(PG8_SA(1, 1), a1 + hstep, voffA);
            PG8_WAIT_V(8); PG8_WAIT_L(0); PG8_BAR; PG8_MMA(0, 0, At, B0); PG8_MMA(0, 1, At, B1); PG8_BAR; PG8_SCHED;
            PG8_LDA(At, 0, 1); PG8_STAGE(PG8_SB(0, 0), b2, voffB); PG8_STAGE(PG8_SB(0, 1), b2 + hstep, voffB); PG8_STAGE(PG8_SA(0, 0), a2, voffA);
            PG8_WAIT_V(8); PG8_WAIT_L(0); PG8_BAR; PG8_MMA(1, 0, At, B0); PG8_MMA(1, 1, At, B1); PG8_BAR; PG8_SCHED;
            PG8_LDB(B0, 1, 0); PG8_LDB(B1, 1, 1); PG8_SCHED; PG8_LDA(At, 1, 0); PG8_STAGE(PG8_SA(0, 1), a2 + hstep, voffA);
            PG8_WAIT_V(8); PG8_WAIT_L(0); PG8_BAR; PG8_MMA(0, 0, At, B0); PG8_MMA(0, 1, At, B1); PG8_BAR; PG8_SCHED;
            PG8_LDA(At, 1, 1); PG8_STAGE(PG8_SB(1, 0), b3, voffB); PG8_STAGE(PG8_SB(1, 1), b3 + hstep, voffB); PG8_STAGE(PG8_SA(1, 0), a3, voffA);
            PG8_WAIT_V(8); PG8_WAIT_L(0); PG8_BAR; PG8_MMA(1, 0, At, B0); PG8_MMA(1, 1, At, B1); PG8_BAR; PG8_SCHED;
            } else {
            PG8_LDB(B0, 0, 0); PG8_SCHED; PG8_LDA(At, 0, 0); PG8_STAGE(PG8_SA(1, 1), a1 + hstep, voffA);
            PG8_WAIT_L(8); PG8_BAR; PG8_WAIT_L(0); PG8_MMA(0, 0, At, B0); PG8_BAR; PG8_SCHED;
            PG8_LDB(B1, 0, 1); PG8_STAGE(PG8_SB(0, 0), b2, voffB);
            PG8_BAR; PG8_WAIT_L(0); PG8_MMA(0, 1, At, B1); PG8_BAR;
            PG8_LDA(At, 0, 1); PG8_STAGE(PG8_SA(0, 0), a2, voffA);
            PG8_BAR; PG8_WAIT_L(0); PG8_MMA(1, 0, At, B0); PG8_BAR; PG8_SCHED;
            PG8_STAGE(PG8_SB(0, 1), b2 + hstep, voffB);
            PG8_WAIT_V(6); PG8_BAR; PG8_MMA(1, 1, At, B1); PG8_BAR;
            PG8_LDB(B0, 1, 0); PG8_SCHED; PG8_LDA(At, 1, 0); PG8_STAGE(PG8_SA(0, 1), a2 + hstep, voffA);
            PG8_WAIT_L(8); PG8_BAR; PG8_WAIT_L(0); PG8_MMA(0, 0, At, B0); PG8_BAR; PG8_SCHED;
            PG8_LDB(B1, 1, 1); PG8_STAGE(PG8_SB(1, 0), b3, voffB);
            PG8_BAR; PG8_WAIT_L(0); PG8_MMA(0, 1, At, B1); PG8_BAR;
            PG8_LDA(At, 1, 1); PG8_STAGE(PG8_SA(1, 0), a3, voffA);
            PG8_BAR; PG8_WAIT_L(0); PG8_MMA(1, 0, At, B0); PG8_BAR; PG8_SCHED;
            PG8_STAGE(PG8_SB(1, 1), b3 + hstep, voffB);
            PG8_WAIT_V(6); PG8_BAR; PG8_MMA(1, 1, At, B1); PG8_BAR;
            }
        }
        if constexpr (ALIGN_EPI) { if (wr == 0) PG8_BAR; }
        if constexpr (!Epi::AFTER_DRAIN) { E(acc, cur, wr, wc, fr, fq); S.done(cur); }
        if (!has_next) break;
#pragma unroll
        for (int a = 0; a < 2; ++a)
#pragma unroll
            for (int b = 0; b < 2; ++b)
#pragma unroll
                for (int m = 0; m < 4; ++m)
#pragma unroll
                    for (int n = 0; n < 2; ++n) acc[a][b][m][n] = (f32x4){0.f, 0.f, 0.f, 0.f};
        cur = nxt; cA = nA; cB = nB; ++ui;
        if constexpr (ALIGN_EPI) { if (wr == 1) PG8_BAR; }
    }
    PG8_WAIT_V(0);
    if constexpr (!ALIGN_EPI) { if (wr == 0) PG8_BAR; }
    PG8_BAR;
    if constexpr (Epi::AFTER_DRAIN) { E.fused(acc, cur, wr, wc, fr, fq, lds, wid, lane); S.done(cur); }
#undef PG8_SA
#undef PG8_SB
#undef PG8_STAGE
#undef PG8_LDA
#undef PG8_LDB
#undef PG8_MMA
#undef PG8_WAIT_V
#undef PG8_WAIT_L
#undef PG8_BAR
#undef PG8_SCHED
}
}

using pg8::bf16_t; using pg8::bf16x8; using pg8::f32x4; using pg8::u32x4; using pg8::Unit;
typedef float f32x2_t __attribute__((ext_vector_type(2))); typedef __bf16 bf16x2_t __attribute__((ext_vector_type(2)));
__device__ __forceinline__ unsigned cvt_pk_bf16(float lo, float hi) { f32x2_t v = {lo, hi}; bf16x2_t b = __builtin_convertvector(v, bf16x2_t); return __builtin_bit_cast(unsigned, b); }
typedef float f32x16 __attribute__((ext_vector_type(16)));
typedef unsigned u32x2 __attribute__((ext_vector_type(2)));
#define LAS __attribute__((address_space(3)))

constexpr int DM = 1024, MP = 65536, MS = 1024, MT = MP + MS, SEQ = 2048, DSEQ = 64, PAST = 4096, NMEM = 256;
constexpr int DFF = 2816, NUP = 2 * DFF, NSEG = MT / 64;
constexpr float EPS = 1e-6f, LOG2E = 1.4426950408889634f;
constexpr float C2F = 0.125f * LOG2E, C2M = 0.0625f * LOG2E;
constexpr float NEGBIG = -1e30f;

constexpr size_t O_YP = 0, O_YS = O_YP + (size_t)MP * DM, O_KP = O_YS + (size_t)MS * DM, O_VP = O_KP + (size_t)MP * 512, O_LFP = O_VP + (size_t)MP * 512,
    O_PSP = O_LFP + (size_t)MP * 8, O_CSP = O_PSP + 32 * 15 * 512, O_MKP = O_CSP + 32 * 2 * DFF, O_MVP = O_MKP + (size_t)8192 * 1024, O_KS = O_MVP + (size_t)8192 * 1024,
    O_VS = O_KS + (size_t)MS * 512, O_LFS = O_VS + (size_t)MS * 512, O_PSS = O_LFS + MS * 8, O_CSS = O_PSS + 16 * 15 * 512, O_END = O_CSS + 16 * 2 * DFF;

constexpr size_t MiB = 1u << 20;
constexpr size_t WS_WIN = 1 * MiB, WS_WO = 5 * MiB, WS_WMQ = 7 * MiB, WS_WMO = 9 * MiB, WS_WMKV = 11 * MiB, WS_WUP = 15 * MiB, WS_WDN = 26 * MiB, WS_WPOOL = 32 * MiB;
constexpr size_t WS_USX = 34 * MiB;
constexpr size_t WS_MKB = 40 * MiB, WS_MVB = 64 * MiB;
constexpr size_t WS_SSQ1 = 88 * MiB, WS_SSQ2 = 93 * MiB, WS_SSQ3 = 98 * MiB;
constexpr size_t WS_KBP = 103 * MiB, WS_KBS = 105 * MiB;
constexpr size_t WS_AHEAD = 108 * MiB, WS_ATAIL = WS_AHEAD + 23 * MiB / 1 - MiB / 2, WS_BHEAD = WS_ATAIL + 23 * MiB - MiB / 2;
constexpr size_t WS_X1B = 176 * MiB, WS_KCB = 176 * MiB, WS_VCB = 240 * MiB;
constexpr size_t WS_X2B = 306 * MiB;
constexpr size_t WS_XB = 436 * MiB, WS_MQB = 436 * MiB, WS_HFF = 436 * MiB;
constexpr size_t WS_UQKV = 566 * MiB, WS_MO = 566 * MiB;
constexpr size_t WS_MIX = 826 * MiB, WS_MEMB = 956 * MiB, WS_NEED = 972 * MiB;
static_assert((size_t)NSEG * 2 * DFF * 4 <= 22 * MiB + MiB / 2, "side buffers");
static_assert(WS_BHEAD + 22 * MiB + MiB / 2 <= WS_X1B, "side buffers end");

#define P2_ATTN_P 1
#define P2_ATTN_S 1
#define P2_POOL 1
#define DBG_HI 11
#ifndef PHMASK
#define PHMASK 0x7ff
#endif
constexpr int LDS_BYTES = 147456;

struct Params { const float* in[28]; float* out; unsigned char* ws; int ph_lo, ph_hi; };

__device__ __forceinline__ float bf_lo(unsigned w) { return __builtin_bit_cast(float, w << 16); }
__device__ __forceinline__ float bf_hi(unsigned w) { return __builtin_bit_cast(float, w & 0xffff0000u); }
__device__ __forceinline__ int crow(int r, int hi) { return (r & 3) + 8 * (r >> 2) + 4 * hi; }
__device__ __forceinline__ float wave_sum(float v) {
#pragma unroll
    for (int o = 1; o < 64; o <<= 1) v += __shfl_xor(v, o);
    return v;
}
__device__ __forceinline__ float rsq(float ssq) { return 1.0f / sqrtf(ssq * (1.0f / 1024.0f) + EPS); }
#define LDS_WAIT() asm volatile("s_waitcnt lgkmcnt(0)" ::: "memory")

typedef const f32x4 (&AccRef)[2][2][4][2];

__device__ __forceinline__ u32x4 pack8(f32x4 v0, f32x4 v1) { u32x4 w; w.x = cvt_pk_bf16(v0[0], v0[1]); w.y = cvt_pk_bf16(v0[2], v0[3]); w.z = cvt_pk_bf16(v1[0], v1[1]); w.w = cvt_pk_bf16(v1[2], v1[3]); return w; }

struct EpiIn {
    static constexpr bool PERM = true, AFTER_DRAIN = false;
    bf16_t* uqkv; float* out; bf16_t* usx;
    __device__ __forceinline__ void operator()(AccRef acc, const Unit& u, int wr, int wc, int fr, int fq) const {
        const int t = u.pn >> 1;
        const int col0 = (u.pn & 1) * 256 + wc * 32 + 8 * fq;
        bf16_t* base = uqkv + (size_t)t * MT * 512;
        const float sc = (t == 1) ? C2F : 1.0f;
#pragma unroll
        for (int ai = 0; ai < 2; ++ai)
#pragma unroll
            for (int m = 0; m < 4; ++m) {
                const int row = u.pm * 256 + ai * 128 + wr * 64 + m * 16 + fr;
#pragma unroll
                for (int bj = 0; bj < 2; ++bj) {
                    const int col = col0 + bj * 128;
                    const f32x4 v0 = acc[ai][bj][m][0] * sc, v1 = acc[ai][bj][m][1] * sc;
                    *(u32x4*)(base + (size_t)row * 512 + col) = pack8(v0, v1);
                    if (t >= 2) {
                        float* o = (row < MP) ? out + (t == 2 ? O_KP : O_VP) + (size_t)row * 512 : out + (t == 2 ? O_KS : O_VS) + (size_t)(row - MP) * 512;
                        *(f32x4*)(o + col) = v0; *(f32x4*)(o + col + 4) = v1;
                    } else if (t == 0) {
                        if (row < MP) { const int tt = row & (SEQ - 1); if (tt >= SEQ - 15) { float* o = out + O_PSP + ((size_t)(row >> 11) * 15 + (tt - (SEQ - 15))) * 512 + col; *(f32x4*)o = v0; *(f32x4*)(o + 4) = v1; } }
                        else { const int rs = row - MP, tt = rs & 63; *(u32x4*)(usx + ((size_t)(rs >> 6) * 79 + 15 + tt) * 512 + col) = pack8(v0, v1); if (tt >= DSEQ - 15) { float* o = out + O_PSS + ((size_t)(rs >> 6) * 15 + (tt - (DSEQ - 15))) * 512 + col; *(f32x4*)o = v0; *(f32x4*)(o + 4) = v1; } }
                    }
                }
            }
    }
};
struct EpiMkv {
    static constexpr bool PERM = true, AFTER_DRAIN = false;
    bf16_t* mkb; bf16_t* mvb; float* out;
    __device__ __forceinline__ void operator()(AccRef acc, const Unit& u, int wr, int wc, int fr, int fq) const {
        const int t = u.pn >> 2;
        const int col0 = (u.pn & 3) * 256 + wc * 32 + 8 * fq;
        bf16_t* bb = t ? mvb : mkb; float* of = out + (t ? O_MVP : O_MKP);
#pragma unroll
        for (int ai = 0; ai < 2; ++ai)
#pragma unroll
            for (int m = 0; m < 4; ++m) {
                const int row = u.pm * 256 + ai * 128 + wr * 64 + m * 16 + fr;
#pragma unroll
                for (int bj = 0; bj < 2; ++bj) {
                    const int col = col0 + bj * 128;
                    const f32x4 v0 = acc[ai][bj][m][0], v1 = acc[ai][bj][m][1];
                    *(u32x4*)(bb + (size_t)row * 1024 + col) = pack8(v0, v1);
                    *(f32x4*)(of + (size_t)row * 1024 + col) = v0; *(f32x4*)(of + (size_t)row * 1024 + col + 4) = v1;
                }
            }
    }
};
template <int MODE> struct EpiRes {
    static constexpr bool PERM = true, AFTER_DRAIN = false;
    const float* xP; const float* xS; const bf16_t* resB; bf16_t* xo; float* yo; float* ssqp;
    __device__ __forceinline__ void operator()(AccRef acc, const Unit& u, int wr, int wc, int fr, int fq) const {
        const int col0 = u.pn * 256 + wc * 32 + 8 * fq;
#pragma unroll
        for (int ai = 0; ai < 2; ++ai)
#pragma unroll
            for (int m = 0; m < 4; ++m) {
                const int row = u.pm * 256 + ai * 128 + wr * 64 + m * 16 + fr;
                float ss = 0.f;
#pragma unroll
                for (int bj = 0; bj < 2; ++bj) {
                    const int col = col0 + bj * 128;
                    f32x4 r0, r1;
                    if (MODE == 0) { const float* xr = (row < MP) ? xP + (size_t)row * DM : xS + (size_t)(row - MP) * DM; r0 = *(const f32x4*)(xr + col); r1 = *(const f32x4*)(xr + col + 4); }
                    else { const u32x4 w = *(const u32x4*)(resB + (size_t)row * DM + col); r0 = (f32x4){bf_lo(w.x), bf_hi(w.x), bf_lo(w.y), bf_hi(w.y)}; r1 = (f32x4){bf_lo(w.z), bf_hi(w.z), bf_lo(w.w), bf_hi(w.w)}; }
                    const f32x4 v0 = acc[ai][bj][m][0] + r0, v1 = acc[ai][bj][m][1] + r1;
                    ss += (v0[0] * v0[0] + v0[1] * v0[1]) + (v0[2] * v0[2] + v0[3] * v0[3]) + (v1[0] * v1[0] + v1[1] * v1[1]) + (v1[2] * v1[2] + v1[3] * v1[3]);
                    if (MODE == 2) { float* yr = (row < MP) ? yo + O_YP + (size_t)row * DM : yo + O_YS + (size_t)(row - MP) * DM; *(f32x4*)(yr + col) = v0; *(f32x4*)(yr + col + 4) = v1; }
                    else *(u32x4*)(xo + (size_t)row * DM + col) = pack8(v0, v1);
                }
                ss += __shfl_xor(ss, 16); ss += __shfl_xor(ss, 32);
                if (fq == 0) ssqp[(size_t)row * 16 + u.pn * 4 + wc] = ss;
            }
    }
};
__device__ __forceinline__ float row_rsq(const float* ssqp, int row) {
    const f32x4* sp = (const f32x4*)(ssqp + (size_t)row * 16);
    const f32x4 a = sp[0], b = sp[1], c = sp[2], d = sp[3];
    const float s = ((a[0] + a[1]) + (a[2] + a[3])) + ((b[0] + b[1]) + (b[2] + b[3])) + ((c[0] + c[1]) + (c[2] + c[3])) + ((d[0] + d[1]) + (d[2] + d[3]));
    return rsq(s);
}
struct EpiMq {
    static constexpr bool PERM = true, AFTER_DRAIN = false;
    const float* ssqp; bf16_t* mq;
    __device__ __forceinline__ void operator()(AccRef acc, const Unit& u, int wr, int wc, int fr, int fq) const {
        const int col0 = u.pn * 256 + wc * 32 + 8 * fq;
#pragma unroll
        for (int ai = 0; ai < 2; ++ai)
#pragma unroll
            for (int m = 0; m < 4; ++m) {
                const int row = u.pm * 256 + ai * 128 + wr * 64 + m * 16 + fr;
                const float r = row_rsq(ssqp, row) * C2M;
#pragma unroll
                for (int bj = 0; bj < 2; ++bj) *(u32x4*)(mq + (size_t)row * DM + col0 + bj * 128) = pack8(acc[ai][bj][m][0] * r, acc[ai][bj][m][1] * r);
            }
    }
};
struct EpiUp {
    static constexpr bool PERM = true, AFTER_DRAIN = false;
    const float* ssqp; const float* cw; const float* cb; bf16_t* hff; float* ahead; float* atail; float* bhead;
    __device__ __forceinline__ void operator()(AccRef acc, const Unit& u, int wr, int wc, int fr, int fq) const {
        const int lane = fq * 16 + fr;
        const int c0 = u.pn * 128 + wc * 32 + 8 * fq;
        f32x4 w0[2], w1[2], w2[2], bb[2];
#pragma unroll
        for (int n = 0; n < 2; ++n) { w0[n] = *(const f32x4*)(cw + c0 + 4 * n); w1[n] = *(const f32x4*)(cw + DFF + c0 + 4 * n); w2[n] = *(const f32x4*)(cw + 2 * DFF + c0 + 4 * n); bb[n] = *(const f32x4*)(cb + c0 + 4 * n); }
        const int src1 = (lane & 48) | ((fr + 15) & 15), src2 = (lane & 48) | ((fr + 14) & 15);
#pragma unroll
        for (int ai = 0; ai < 2; ++ai) {
            const int seg = u.pm * 4 + ai * 2 + wr;
            const int rowb = u.pm * 256 + ai * 128 + wr * 64;
            f32x4 ap[2] = {{0.f, 0.f, 0.f, 0.f}, {0.f, 0.f, 0.f, 0.f}};
#pragma unroll
            for (int m = 0; m < 4; ++m) {
                const int row = rowb + m * 16 + fr;
                const float r = row_rsq(ssqp, row);
                f32x4 a[2], b[2], h[2];
#pragma unroll
                for (int n = 0; n < 2; ++n) {
                    a[n] = acc[ai][0][m][n] * r; b[n] = acc[ai][1][m][n] * r;
                    f32x4 a1, a2;
#pragma unroll
                    for (int e = 0; e < 4; ++e) {
                        const float x1 = (fr == 15) ? ap[n][e] : a[n][e]; a1[e] = __shfl(x1, src1);
                        const float x2 = (fr >= 14) ? ap[n][e] : a[n][e]; a2[e] = __shfl(x2, src2);
                    }
                    const f32x4 cv = bb[n] + w0[n] * a2 + w1[n] * a1 + w2[n] * a[n];
#pragma unroll
                    for (int e = 0; e < 4; ++e) h[n][e] = cv[e] * __builtin_amdgcn_rcpf(1.0f + __builtin_amdgcn_exp2f(-cv[e] * LOG2E)) * b[n][e];
                    ap[n] = a[n];
                }
                if (m == 0 && fr < 2) {
                    float* pa = ahead + ((size_t)seg * 2 + fr) * DFF + c0; float* pb = bhead + ((size_t)seg * 2 + fr) * DFF + c0;
                    *(f32x4*)pa = a[0]; *(f32x4*)(pa + 4) = a[1]; *(f32x4*)pb = b[0]; *(f32x4*)(pb + 4) = b[1];
                } else {
                    *(u32x4*)(hff + (size_t)row * DFF + c0) = pack8(h[0], h[1]);
                }
                if (m == 3 && fr >= 14) { float* pt = atail + ((size_t)seg * 2 + (fr - 14)) * DFF + c0; *(f32x4*)pt = a[0]; *(f32x4*)(pt + 4) = a[1]; }
            }
        }
    }
};

template <int MODE>
__device__ __forceinline__ void small_gemm_sample(LAS unsigned char* L, int tile, const bf16_t* __restrict__ A, int lda, const bf16_t* __restrict__ Bt, int ldb, int K,
                                                  const float* __restrict__ xS, const bf16_t* __restrict__ resB, bf16_t* __restrict__ xo, float* __restrict__ yo, float* __restrict__ ssq_out, const float* __restrict__ ssq_in) {
    const int tid = threadIdx.x, lane = tid & 63, wid = __builtin_amdgcn_readfirstlane(tid >> 6), r32 = lane & 31, hi = lane >> 5;
    const int rb = wid & 1, kq = wid >> 1, tm = tile >> 4, tn = tile & 15;
    const int row0 = MP + tm * 64 + rb * 32, col0 = tn * 64, kper = K >> 2, k0 = kq * kper;
    const bf16_t* ap = A + (size_t)(row0 + r32) * lda + k0 + hi * 8;
    const bf16_t* bp0 = Bt + (size_t)(col0 + r32) * ldb + k0 + hi * 8;
    const bf16_t* bp1 = bp0 + (size_t)32 * ldb;
    f32x16 acc0, acc1;
#pragma unroll
    for (int r = 0; r < 16; ++r) { acc0[r] = 0.f; acc1[r] = 0.f; }
    for (int s0 = 0; s0 < kper; s0 += 128) {
        const int nst = (kper - s0) >> 4;
        bf16x8 af[8], b0[8], b1[8];
#pragma unroll
        for (int i = 0; i < 8; ++i) { if (i < nst) { af[i] = *(const bf16x8*)(ap + s0 + 16 * i); b0[i] = *(const bf16x8*)(bp0 + s0 + 16 * i); b1[i] = *(const bf16x8*)(bp1 + s0 + 16 * i); } }
#pragma unroll
        for (int i = 0; i < 8; ++i) { if (i < nst) { acc0 = __builtin_amdgcn_mfma_f32_32x32x16_bf16(af[i], b0[i], acc0, 0, 0, 0); acc1 = __builtin_amdgcn_mfma_f32_32x32x16_bf16(af[i], b1[i], acc1, 0, 0, 0); } }
    }
    LAS float* Mg = (LAS float*)L;
    __syncthreads();
    if (kq > 0) {
#pragma unroll
        for (int r = 0; r < 16; ++r) { Mg[(wid * 33 + r) * 64 + lane] = acc0[r]; Mg[(wid * 33 + 16 + r) * 64 + lane] = acc1[r]; }
    }
    __syncthreads();
    if (kq == 0) {
#pragma unroll
        for (int g = 1; g < 4; ++g)
#pragma unroll
            for (int r = 0; r < 16; ++r) { acc0[r] += Mg[((2 * g + rb) * 33 + r) * 64 + lane]; acc1[r] += Mg[((2 * g + rb) * 33 + 16 + r) * 64 + lane]; }
#pragma unroll
        for (int r = 0; r < 16; ++r) {
            const int row = row0 + crow(r, hi), c0 = col0 + r32, c1 = c0 + 32;
            float v0 = acc0[r], v1 = acc1[r];
            if (MODE == 0) { v0 += xS[(size_t)(row - MP) * DM + c0]; v1 += xS[(size_t)(row - MP) * DM + c1]; }
            else if (MODE == 1 || MODE == 2) { v0 += bf_lo((unsigned)resB[(size_t)row * DM + c0]); v1 += bf_lo((unsigned)resB[(size_t)row * DM + c1]); }
            else { const float rs = row_rsq(ssq_in, row) * C2M; v0 *= rs; v1 *= rs; }
            if (MODE == 2) { yo[O_YS + (size_t)(row - MP) * DM + c0] = v0; yo[O_YS + (size_t)(row - MP) * DM + c1] = v1; }
            else { xo[(size_t)row * DM + c0] = (bf16_t)(cvt_pk_bf16(v0, 0.f) & 0xffffu); xo[(size_t)row * DM + c1] = (bf16_t)(cvt_pk_bf16(v1, 0.f) & 0xffffu); }
            if (MODE != 3) {
                float ss = v0 * v0 + v1 * v1;
                ss += __shfl_xor(ss, 1); ss += __shfl_xor(ss, 2); ss += __shfl_xor(ss, 4); ss += __shfl_xor(ss, 8); ss += __shfl_xor(ss, 16);
                if (r32 == 0) ssq_out[(size_t)row * 16 + tn] = ss;
            }
        }
    }
    __syncthreads();
}
template <int D, int KT, int KG, bool PF, bool QLDS, bool CAUSAL, bool BIAS>
__device__ __forceinline__ void attn_unit(LAS unsigned char* L, const bf16_t* __restrict__ Q, int ldq, int nq,
                                          const bf16_t* __restrict__ K0, const bf16_t* __restrict__ V0, int nt0, const bf16_t* __restrict__ K1, const bf16_t* __restrict__ V1, int ldk, int ntiles,
                                          const float* __restrict__ kbias, int qpos0, bf16_t* __restrict__ O, int ldo) {
    constexpr int KS = D + 8, VS = KT + 4, CH = D / 8, NKI = KT * CH / 512, NVI = ((KT / 2) * CH + 511) / 512, NQF = (D == 64) ? 4 : 1, NP = KT / 32, QW = 8 / KG;
    constexpr int TILEB = KT * KS * 2 + D * VS * 2 + (BIAS ? KT * 4 : 0);
    constexpr int QBYTES = QLDS ? 32 * QW * KS * 2 : 0;
    constexpr int NG = (KG == 1) ? 2 : (!PF ? 1 : KG);
    const int tid = threadIdx.x, lane = tid & 63, wid = __builtin_amdgcn_readfirstlane(tid >> 6), r32 = lane & 31, hi = lane >> 5;
    const int qw = wid % QW, kg = wid / QW;
    const bool wact = qw * 32 < nq;
    LAS unsigned char* T = L + QBYTES;
    const LAS bf16_t* Qs = (const LAS bf16_t*)L + (qw * 32 + r32) * KS + hi * 8;
    const bf16_t* qrow = Q + (size_t)(qw * 32 + r32) * ldq + hi * 8;
    bf16x8 qf[NQF];
    if (D == 64 && !QLDS) {
#pragma unroll
        for (int ds = 0; ds < NQF; ++ds) qf[ds] = wact ? *(const bf16x8*)(qrow + ds * 16) : (bf16x8){0, 0, 0, 0, 0, 0, 0, 0};
    }
    if (QLDS) {
        __syncthreads();
        constexpr int NQI = 32 * QW * CH / 512;
#pragma unroll
        for (int i = 0; i < NQI; ++i) { const int id = tid + 512 * i, row = id / CH, ch = id % CH; if (row < nq) *(LAS u32x4*)((LAS bf16_t*)L + row * KS + ch * 8) = *(const u32x4*)(Q + (size_t)row * ldq + ch * 8); }
    }
    float ref = 0.f;
    if (BIAS) ref = wact ? kbias[qpos0 + qw * 32 + r32] : 0.f;
    f32x16 o[D / 32];
#pragma unroll
    for (int db = 0; db < D / 32; ++db)
#pragma unroll
        for (int r = 0; r < 16; ++r) o[db][r] = 0.f;
    float lrun = 0.f;
    u32x4 kreg[NG][NKI], vreg[NG][NVI][2]; float breg[NG];
#define ATT_LOAD(j, g) do { const bf16_t* Kt_ = ((j) < nt0) ? K0 + (size_t)(j) * KT * ldk : K1 + (size_t)((j) - nt0) * KT * ldk; \
        const bf16_t* Vg_ = ((j) < nt0) ? V0 + (size_t)(j) * KT * ldk : V1 + (size_t)((j) - nt0) * KT * ldk; \
        _Pragma("unroll") for (int i_ = 0; i_ < NKI; ++i_) { const int id_ = tid + 512 * i_, row_ = id_ / CH, ch_ = id_ % CH; kreg[g][i_] = *(const u32x4*)(Kt_ + (size_t)row_ * ldk + ch_ * 8); } \
        _Pragma("unroll") for (int i_ = 0; i_ < NVI; ++i_) { const int id_ = tid + 512 * i_; if (id_ < (KT / 2) * CH) { const int pr_ = id_ % (KT / 2), ch_ = id_ / (KT / 2); \
            vreg[g][i_][0] = *(const u32x4*)(Vg_ + (size_t)(2 * pr_) * ldk + ch_ * 8); vreg[g][i_][1] = *(const u32x4*)(Vg_ + (size_t)(2 * pr_ + 1) * ldk + ch_ * 8); } } \
        if (BIAS && tid < KT) breg[g] = kbias[(j) * KT + tid]; } while (0)
#define ATT_STORE(TB, g) do { LAS bf16_t* Ks_ = (LAS bf16_t*)(TB); LAS bf16_t* Vt_ = (LAS bf16_t*)((TB) + KT * KS * 2); \
        _Pragma("unroll") for (int i_ = 0; i_ < NKI; ++i_) { const int id_ = tid + 512 * i_, row_ = id_ / CH, ch_ = id_ % CH; *(LAS u32x4*)(Ks_ + row_ * KS + ch_ * 8) = kreg[g][i_]; } \
        _Pragma("unroll") for (int i_ = 0; i_ < NVI; ++i_) { const int id_ = tid + 512 * i_; if (id_ < (KT / 2) * CH) { const int pr_ = id_ % (KT / 2), ch_ = id_ / (KT / 2); \
            _Pragma("unroll") for (int e_ = 0; e_ < 4; ++e_) { const unsigned lo_ = vreg[g][i_][0][e_], h2_ = vreg[g][i_][1][e_]; \
                *(LAS unsigned*)(Vt_ + (ch_ * 8 + 2 * e_) * VS + 2 * pr_) = (lo_ & 0xffffu) | (h2_ << 16); \
                *(LAS unsigned*)(Vt_ + (ch_ * 8 + 2 * e_ + 1) * VS + 2 * pr_) = (lo_ >> 16) | (h2_ & 0xffff0000u); } } } \
        if (BIAS && tid < KT) ((LAS float*)((TB) + KT * KS * 2 + D * VS * 2))[tid] = breg[g]; } while (0)
#define ATT_COMPUTE(j, TB) do { const LAS bf16_t* Ks_ = (const LAS bf16_t*)(TB); const LAS bf16_t* Vt_ = (const LAS bf16_t*)((TB) + KT * KS * 2); const LAS float* Bs_ = (const LAS float*)((TB) + KT * KS * 2 + D * VS * 2); \
        if (wact && (!CAUSAL || KT * (j) <= qpos0 + qw * 32 + 31)) { \
            f32x16 p[NP]; \
            const bf16_t* qr_ = qrow; if (D != 64 && !QLDS) asm volatile("" : "+v"(qr_)); \
            _Pragma("unroll") for (int h_ = 0; h_ < NP; ++h_) { \
                if (BIAS) { _Pragma("unroll") for (int i_ = 0; i_ < 4; ++i_) { const f32x4 t0_ = *(const LAS f32x4*)(Bs_ + 32 * h_ + 8 * i_ + 4 * hi); \
                        _Pragma("unroll") for (int e_ = 0; e_ < 4; ++e_) p[h_][4 * i_ + e_] = t0_[e_] - ref; } } \
                else { _Pragma("unroll") for (int r_ = 0; r_ < 16; ++r_) p[h_][r_] = 0.f; } } \
            _Pragma("unroll") for (int ds_ = 0; ds_ < D / 16; ++ds_) { \
                bf16x8 qv_; if (QLDS) qv_ = *(const LAS bf16x8*)(Qs + ds_ * 16); else if (D == 64) qv_ = qf[ds_]; else qv_ = *(const bf16x8*)(qr_ + ds_ * 16); \
                _Pragma("unroll") for (int h_ = 0; h_ < NP; ++h_) { const bf16x8 kf_ = *(const LAS bf16x8*)(Ks_ + (32 * h_ + r32) * KS + ds_ * 16 + hi * 8); p[h_] = __builtin_amdgcn_mfma_f32_32x32x16_bf16(kf_, qv_, p[h_], 0, 0, 0); } } \
            if (CAUSAL && (KT * (j) + KT - 1 > qpos0 + qw * 32)) { const int lim_ = qpos0 + qw * 32 + r32 - KT * (j); \
                _Pragma("unroll") for (int h_ = 0; h_ < NP; ++h_) _Pragma("unroll") for (int r_ = 0; r_ < 16; ++r_) { if (crow(r_, hi) + 32 * h_ > lim_) p[h_][r_] = NEGBIG; } } \
            float sum_ = 0.f; \
            _Pragma("unroll") for (int h_ = 0; h_ < NP; ++h_) _Pragma("unroll") for (int r_ = 0; r_ < 16; ++r_) { p[h_][r_] = __builtin_amdgcn_exp2f(p[h_][r_]); sum_ += p[h_][r_]; } \
            lrun += sum_; \
            u32x4 pw_[2 * NP]; \
            _Pragma("unroll") for (int h_ = 0; h_ < NP; ++h_) _Pragma("unroll") for (int e_ = 0; e_ < 4; ++e_) { pw_[2 * h_][e_] = pg8::cvt_pk_bf16(p[h_][2 * e_], p[h_][2 * e_ + 1]); pw_[2 * h_ + 1][e_] = pg8::cvt_pk_bf16(p[h_][8 + 2 * e_], p[h_][9 + 2 * e_]); } \
            _Pragma("unroll") for (int db_ = 0; db_ < D / 32; ++db_) _Pragma("unroll") for (int ks_ = 0; ks_ < 2 * NP; ++ks_) { \
                const LAS bf16_t* vp_ = Vt_ + (db_ * 32 + r32) * VS + ks_ * 16 + hi * 4; \
                const u32x2 va_ = *(const LAS u32x2*)vp_, vb_ = *(const LAS u32x2*)(vp_ + 8); const u32x4 vv_ = {va_.x, va_.y, vb_.x, vb_.y}; \
                o[db_] = __builtin_amdgcn_mfma_f32_32x32x16_bf16(__builtin_bit_cast(bf16x8, vv_), __builtin_bit_cast(bf16x8, pw_[ks_]), o[db_], 0, 0, 0); } \
        } } while (0)
    if (KG == 1) {
        ATT_LOAD(0, 0); ATT_STORE(T, 0); if (ntiles > 1) ATT_LOAD(1, 1); if (ntiles > 2) ATT_LOAD(2, 0);
        __syncthreads();
        for (int j = 0; j < ntiles; j += 2) {
            if (j + 1 < ntiles) ATT_STORE(T + TILEB, 1);
            if (j + 3 < ntiles) ATT_LOAD(j + 3, 1);
            ATT_COMPUTE(j, T);
            __syncthreads();
            if (j + 1 < ntiles) {
                if (j + 2 < ntiles) ATT_STORE(T, 0);
                if (j + 4 < ntiles) ATT_LOAD(j + 4, 0);
                ATT_COMPUTE(j + 1, T + TILEB);
                __syncthreads();
            }
        }
    } else {
        const int nsteps = (ntiles + KG - 1) / KG;
        if (PF) {
#pragma unroll
            for (int g = 0; g < NG; ++g) { if (g < ntiles) ATT_LOAD(g, g); }
        }
        for (int s = 0; s < nsteps; ++s) {
            __syncthreads();
            if (PF) {
#pragma unroll
                for (int g = 0; g < NG; ++g) { if (s * KG + g < ntiles) ATT_STORE(T + g * TILEB, g); }
            } else {
#pragma unroll
                for (int g = 0; g < KG; ++g) { const int jt = s * KG + g; if (jt < ntiles) { ATT_LOAD(jt, 0); ATT_STORE(T + g * TILEB, 0); } }
            }
            __syncthreads();
            if (PF && s + 1 < nsteps) {
#pragma unroll
                for (int g = 0; g < NG; ++g) { const int jt = (s + 1) * KG + g; if (jt < ntiles) ATT_LOAD(jt, g); }
            }
            const int jm = s * KG + kg;
            if (jm < ntiles) ATT_COMPUTE(jm, T + kg * TILEB);
        }
        constexpr int MB = (D / 32 < 4) ? D / 32 : 4, MR = MB * 16 + 1;
        LAS float* Mg = (LAS float*)L;
#pragma unroll
        for (int d0 = 0; d0 < D / 32; d0 += MB) {
            __syncthreads();
#pragma unroll
            for (int db = 0; db < MB; ++db)
#pragma unroll
                for (int r = 0; r < 16; ++r) Mg[(wid * MR + db * 16 + r) * 64 + lane] = o[d0 + db][r];
            if (d0 == 0) Mg[(wid * MR + MB * 16) * 64 + lane] = lrun;
            __syncthreads();
            if (kg == 0) {
#pragma unroll
                for (int g = 1; g < KG; ++g) {
#pragma unroll
                    for (int db = 0; db < MB; ++db)
#pragma unroll
                        for (int r = 0; r < 16; ++r) o[d0 + db][r] += Mg[((g * QW + qw) * MR + db * 16 + r) * 64 + lane];
                    if (d0 == 0) lrun += Mg[((g * QW + qw) * MR + MB * 16) * 64 + lane];
                }
            }
        }
        __syncthreads();
    }
#undef ATT_LOAD
#undef ATT_STORE
#undef ATT_COMPUTE
    if (kg == 0 && wact) {
        const float lt = lrun + __shfl_xor(lrun, 32), inv = 1.0f / lt;
        bf16_t* orow = O + (size_t)(qw * 32 + r32) * ldo;
#pragma unroll
        for (int db = 0; db < D / 32; ++db)
#pragma unroll
            for (int i = 0; i < 4; ++i) { u32x2 w; w.x = pg8::cvt_pk_bf16(o[db][4 * i] * inv, o[db][4 * i + 1] * inv); w.y = pg8::cvt_pk_bf16(o[db][4 * i + 2] * inv, o[db][4 * i + 3] * inv);
                *(u32x2*)(orow + db * 32 + 8 * i + 4 * hi) = w; }
    }
}

constexpr int POOL_RS = 272, POOL_SLAB = 48 * POOL_RS;
template <int G>
__device__ __forceinline__ void pool_group(LAS unsigned char* slab, const char* __restrict__ ubase, unsigned rowoff0, int nprev0, int nprev, float icnt, const bf16_t* __restrict__ wpt, bf16_t* __restrict__ orow, int lane, int r32, int hi) {
    constexpr int w = 2 << G;
    {
        u32x4 st[12];
#pragma unroll
        for (int k = 0; k < 12; ++k) { const int id = lane + 64 * k, row = id >> 4, ch = id & 15; const int rr = (15 - row <= nprev0) ? row : 15;
            if (row < 47) st[k] = *(const u32x4*)(ubase + (rowoff0 + (unsigned)(rr - 15) * 1024u + (unsigned)(G * 256 + ch * 16))); }
#pragma unroll
        for (int k = 0; k < 12; ++k) { const int id = lane + 64 * k, row = id >> 4, ch = id & 15; if (row < 47) *(LAS u32x4*)(slab + row * POOL_RS + ch * 16) = st[k]; }
    }
    bf16x8 dfr[8];
#pragma unroll
    for (int ks = 0; ks < 8; ++ks) {
        const LAS unsigned char* cp = slab + (15 + r32) * POOL_RS + (ks * 16 + hi * 8) * 2;
        const u32x4 cu = *(const LAS u32x4*)cp;
        float s[8], cur[8];
        cur[0] = bf_lo(cu.x); cur[1] = bf_hi(cu.x); cur[2] = bf_lo(cu.y); cur[3] = bf_hi(cu.y); cur[4] = bf_lo(cu.z); cur[5] = bf_hi(cu.z); cur[6] = bf_lo(cu.w); cur[7] = bf_hi(cu.w);
#pragma unroll
        for (int e = 0; e < 8; ++e) s[e] = cur[e];
#pragma unroll
        for (int j = 1; j < w; ++j) {
            const float wt = (j <= nprev) ? 1.f : 0.f;
            const u32x4 v = *(const LAS u32x4*)(cp - j * POOL_RS);
            s[0] += wt * bf_lo(v.x); s[1] += wt * bf_hi(v.x); s[2] += wt * bf_lo(v.y); s[3] += wt * bf_hi(v.y); s[4] += wt * bf_lo(v.z); s[5] += wt * bf_hi(v.z); s[6] += wt * bf_lo(v.w); s[7] += wt * bf_hi(v.w);
        }
        u32x4 dv;
        dv.x = cvt_pk_bf16(s[0] * icnt - cur[0], s[1] * icnt - cur[1]); dv.y = cvt_pk_bf16(s[2] * icnt - cur[2], s[3] * icnt - cur[3]);
        dv.z = cvt_pk_bf16(s[4] * icnt - cur[4], s[5] * icnt - cur[5]); dv.w = cvt_pk_bf16(s[6] * icnt - cur[6], s[7] * icnt - cur[7]);
        dfr[ks] = __builtin_bit_cast(bf16x8, dv);
        __builtin_amdgcn_sched_barrier(0);
    }
#pragma unroll
    for (int nb = 0; nb < 4; ++nb) {
        f32x16 acc;
#pragma unroll
        for (int r = 0; r < 16; ++r) acc[r] = 0.f;
        const bf16_t* wrow = wpt + ((size_t)G * 128 + nb * 32 + r32) * 128 + hi * 8;
#pragma unroll
        for (int ks = 0; ks < 8; ++ks) acc = __builtin_amdgcn_mfma_f32_32x32x16_bf16(*(const bf16x8*)(wrow + ks * 16), dfr[ks], acc, 0, 0, 0);
#pragma unroll
        for (int i = 0; i < 4; ++i) { u32x2 wv; wv.x = cvt_pk_bf16(acc[4 * i], acc[4 * i + 1]); wv.y = cvt_pk_bf16(acc[4 * i + 2], acc[4 * i + 3]);
            *(u32x2*)(orow + G * 128 + nb * 32 + 8 * i + 4 * hi) = wv; }
    }
}
__device__ __forceinline__ void pool_unit(LAS unsigned char* L, int tile, const bf16_t* __restrict__ ub, const bf16_t* __restrict__ usx, const bf16_t* __restrict__ wpt, bf16_t* __restrict__ mix) {
    const int tid = threadIdx.x, lane = tid & 63, wid = __builtin_amdgcn_readfirstlane(tid >> 6), r32 = lane & 31, hi = lane >> 5;
    const int row0 = tile * 256 + wid * 32, row = row0 + r32;
    const bool samp = tile >= 256;
    const int b0 = samp ? (row0 - MP) >> 6 : row0 >> 11, t0 = samp ? (row0 - MP) & 63 : row0 & (SEQ - 1);
    const char* ubase = (const char*)(samp ? usx : ub);
    const unsigned rowoff0 = (samp ? (unsigned)(b0 * 79 + 15 + t0) : (unsigned)row0) * 1024u;
    const int nprev0 = samp ? t0 + 15 : t0, nprev = nprev0 + r32;
    bf16_t* orow = mix + (size_t)row * DM;
    const int np1 = nprev + 1;
    LAS unsigned char* slab = L + wid * POOL_SLAB;
    pool_group<0>(slab, ubase, rowoff0, nprev0, nprev, 1.0f / (float)(np1 < 2 ? np1 : 2), wpt, orow, lane, r32, hi);
    pool_group<1>(slab, ubase, rowoff0, nprev0, nprev, 1.0f / (float)(np1 < 4 ? np1 : 4), wpt, orow, lane, r32, hi);
    pool_group<2>(slab, ubase, rowoff0, nprev0, nprev, 1.0f / (float)(np1 < 8 ? np1 : 8), wpt, orow, lane, r32, hi);
    pool_group<3>(slab, ubase, rowoff0, nprev0, nprev, 1.0f / (float)(np1 < 16 ? np1 : 16), wpt, orow, lane, r32, hi);
}

template <int MODE>
__device__ __forceinline__ void transpose_item(const float* __restrict__ W, int K, int N, int nblk, bf16_t* __restrict__ WT, int row_off, const float* __restrict__ g, LAS float* scr, int item, int lane) {
    const int kb = item / nblk, nb = item % nblk, k0 = 64 * kb, n0 = 32 * nb;
#pragma unroll 8
    for (int i = 0; i < 32; ++i) { const int kk = 2 * i + (lane >> 5); float v = W[(size_t)(k0 + kk) * N + n0 + (lane & 31)]; if (g) v *= g[k0 + kk]; scr[kk * 33 + (lane & 31)] = v; }
    LDS_WAIT();
    const int c = lane & 7;
#pragma unroll
    for (int j = 0; j < 4; ++j) {
        const int n = (lane >> 3) + 8 * j; const LAS float* s = scr + (8 * c) * 33 + n;
        const int nn = n0 + n; int drow;
        if (MODE == 0) drow = row_off + nn; else { const int half = nn / DFF, cc = nn % DFF; drow = (cc >> 7) * 256 + half * 128 + (cc & 127); }
        u32x4 o; o.x = cvt_pk_bf16(s[0 * 33], s[1 * 33]); o.y = cvt_pk_bf16(s[2 * 33], s[3 * 33]); o.z = cvt_pk_bf16(s[4 * 33], s[5 * 33]); o.w = cvt_pk_bf16(s[6 * 33], s[7 * 33]);
        *(u32x4*)(WT + (size_t)drow * K + k0 + 8 * c) = o;
    }
    LDS_WAIT();
}
__device__ __forceinline__ void prepass_row(const float* __restrict__ xrow, bf16_t* __restrict__ orow, const LAS float* wf, const float* __restrict__ b_f, float* __restrict__ lf_out, int lane) {
    const f32x4* xr = (const f32x4*)xrow + lane;
    f32x4 v[4]; float s = 0.f;
#pragma unroll
    for (int j = 0; j < 4; ++j) { v[j] = xr[64 * j]; s += (v[j][0] * v[j][0] + v[j][1] * v[j][1]) + (v[j][2] * v[j][2] + v[j][3] * v[j][3]); }
    const float r = rsq(wave_sum(s));
    u32x2* o8 = (u32x2*)orow + lane;
#pragma unroll
    for (int j = 0; j < 4; ++j) { v[j] = v[j] * r; u32x2 w; w.x = cvt_pk_bf16(v[j][0], v[j][1]); w.y = cvt_pk_bf16(v[j][2], v[j][3]); o8[64 * j] = w; }
    if (wf) {
        f32x4 fa = {0.f, 0.f, 0.f, 0.f}, fb = {0.f, 0.f, 0.f, 0.f};
#pragma unroll
        for (int j = 0; j < 4; ++j)
#pragma unroll
            for (int e = 0; e < 4; ++e) { const int k = 4 * (lane + 64 * j) + e; const LAS f32x4* w = (const LAS f32x4*)(wf + k * 8); fa += w[0] * v[j][e]; fb += w[1] * v[j][e]; }
#pragma unroll
        for (int e = 0; e < 4; ++e) { fa[e] = wave_sum(fa[e]); fb[e] = wave_sum(fb[e]); }
        float z = fa[0];
        z = (lane == 1) ? fa[1] : z; z = (lane == 2) ? fa[2] : z; z = (lane == 3) ? fa[3] : z; z = (lane == 4) ? fb[0] : z; z = (lane == 5) ? fb[1] : z; z = (lane == 6) ? fb[2] : z; z = (lane == 7) ? fb[3] : z;
        if (lane < 8) { z += b_f[lane]; lf_out[lane] = fminf(z, 0.f) - log1pf(expf(-fabsf(z))); }
    }
}
__device__ __forceinline__ void scan_seq(const float* s0, int n0, const float* s1, int n1, float* dst, int lane) {
    const int n = n0 + n1, Lc = n >> 6;
    float s = 0.f;
    for (int i = 0; i < Lc; ++i) { const int t = lane * Lc + i; const float* ptr = (t < n0) ? (s0 + (size_t)t * 8) : (s1 + (size_t)(t - n0) * 8); s += *ptr; }
    float inc = s;
    for (int o = 1; o < 64; o <<= 1) { const float v = __shfl_up(inc, o); if (lane >= o) inc += v; }
    float run = inc - s;
    for (int i = 0; i < Lc; ++i) { const int t = lane * Lc + i; const float* ptr = (t < n0) ? (s0 + (size_t)t * 8) : (s1 + (size_t)(t - n0) * 8); run += *ptr; dst[t] = -run * LOG2E; }
}
__device__ __forceinline__ void cvt_flat(const float* __restrict__ src, bf16_t* __restrict__ dst, size_t n8, size_t gtid, size_t gn) {
    for (size_t i = gtid; i < n8; i += gn) { const f32x4 a = *(const f32x4*)(src + i * 8), b = *(const f32x4*)(src + i * 8 + 4); *(u32x4*)(dst + i * 8) = pack8(a, b); }
}

#define Wt_in ((bf16_t*)(ws + WS_WIN))
#define Wt_o ((bf16_t*)(ws + WS_WO))
#define Wt_mq ((bf16_t*)(ws + WS_WMQ))
#define Wt_mo ((bf16_t*)(ws + WS_WMO))
#define Wt_mkv ((bf16_t*)(ws + WS_WMKV))
#define Wt_up ((bf16_t*)(ws + WS_WUP))
#define Wt_dn ((bf16_t*)(ws + WS_WDN))
#define Wt_pool ((bf16_t*)(ws + WS_WPOOL))
#define usx ((bf16_t*)(ws + WS_USX))
#define mkb ((bf16_t*)(ws + WS_MKB))
#define mvb ((bf16_t*)(ws + WS_MVB))
#define ssq1 ((float*)(ws + WS_SSQ1))
#define ssq2 ((float*)(ws + WS_SSQ2))
#define ssq3 ((float*)(ws + WS_SSQ3))
#define kbP ((float*)(ws + WS_KBP))
#define kbS ((float*)(ws + WS_KBS))
#define ahead ((float*)(ws + WS_AHEAD))
#define atail ((float*)(ws + WS_ATAIL))
#define bhead ((float*)(ws + WS_BHEAD))
#define x1b ((bf16_t*)(ws + WS_X1B))
#define kcb ((bf16_t*)(ws + WS_KCB))
#define vcb ((bf16_t*)(ws + WS_VCB))
#define x2b ((bf16_t*)(ws + WS_X2B))
#define xb ((bf16_t*)(ws + WS_XB))
#define mqb ((bf16_t*)(ws + WS_MQB))
#define hff ((bf16_t*)(ws + WS_HFF))
#define uqkv ((bf16_t*)(ws + WS_UQKV))
#define mo ((bf16_t*)(ws + WS_MO))
#define mix ((bf16_t*)(ws + WS_MIX))
#define memb ((bf16_t*)(ws + WS_MEMB))
#define ub uqkv
#define qb (uqkv + (size_t)MT * 512)
#define kb (uqkv + (size_t)2 * MT * 512)
#define vb (uqkv + (size_t)3 * MT * 512)
__global__ void __launch_bounds__(512, 2) fwd_kernel(Params p) {
    extern __shared__ __attribute__((aligned(16))) unsigned char lds_raw[];
    LAS unsigned char* L = (LAS unsigned char*)lds_raw;
    cg::grid_group grid = cg::this_grid();
    const int tid = threadIdx.x, lane = tid & 63, wave = __builtin_amdgcn_readfirstlane(tid >> 6);
    const int G = gridDim.x, bx = blockIdx.x;
    unsigned char* ws = p.ws; float* out = p.out;
    const float* x_prompt = p.in[0]; const float* x_sample = p.in[1];
    const int lo = p.ph_lo, hi_ph = p.ph_hi;
    unsigned* gbar = (unsigned*)ws; unsigned nbar = 0u;
    if (lo < 0) grid.sync();
#define IN(k) (lo <= (k) && (k) < hi_ph && ((PHMASK >> (k)) & 1))
#define GSYNC() do { asm volatile("s_waitcnt vmcnt(0)" ::: "memory"); __syncthreads(); \
        if (tid == 0) { __builtin_amdgcn_fence(__ATOMIC_RELEASE, "agent"); asm volatile("s_waitcnt vmcnt(0)" ::: "memory"); \
            nbar += (unsigned)G; __hip_atomic_fetch_add(gbar, 1u, __ATOMIC_RELAXED, __HIP_MEMORY_SCOPE_AGENT); \
            while (__hip_atomic_load(gbar, __ATOMIC_RELAXED, __HIP_MEMORY_SCOPE_AGENT) < nbar) __builtin_amdgcn_s_sleep(6); \
            __builtin_amdgcn_fence(__ATOMIC_ACQUIRE, "agent"); asm volatile("s_waitcnt vmcnt(0)" ::: "memory"); } \
        __syncthreads(); } while (0)
#define SEAM(k) do { if (IN(k) && IN((k) + 1)) GSYNC(); } while (0)

    if (IN(0)) {
        const int gw = bx * 8 + wave, NGW = G * 8;
        LAS float* scr = (LAS float*)(L + wave * 8448);
        LAS float* wf = (LAS float*)(L + 8 * 8448);
        {
            const float* w_in = p.in[11]; const float* g_mix = p.in[10];
            for (int i = tid; i < 8192; i += 512) { const int k = i >> 3, h = i & 7; wf[i] = w_in[(size_t)k * 2056 + 2048 + h] * g_mix[k]; }
        }
        __syncthreads();
        constexpr int I_IN = 16 * 64, I_SQ = 16 * 32, I_UP = 16 * 176, I_DN = 44 * 32;
        constexpr int NITEMS = I_IN + 5 * I_SQ + I_UP + I_DN;
        for (int it = gw; it < NITEMS; it += NGW) {
            int r = it;
            if (r < I_IN) { transpose_item<0>(p.in[11], 1024, 2056, 64, Wt_in, 0, p.in[10], scr, r, lane); continue; } r -= I_IN;
            if (r < I_SQ) { transpose_item<0>(p.in[15], 1024, 1024, 32, Wt_o, 0, nullptr, scr, r, lane); continue; } r -= I_SQ;
            if (r < I_SQ) { transpose_item<0>(p.in[18], 1024, 1024, 32, Wt_mq, 0, p.in[16], scr, r, lane); continue; } r -= I_SQ;
            if (r < I_SQ) { transpose_item<0>(p.in[19], 1024, 1024, 32, Wt_mkv, 0, p.in[17], scr, r, lane); continue; } r -= I_SQ;
            if (r < I_SQ) { transpose_item<0>(p.in[20], 1024, 1024, 32, Wt_mkv, 1024, p.in[17], scr, r, lane); continue; } r -= I_SQ;
            if (r < I_SQ) { transpose_item<0>(p.in[21], 1024, 1024, 32, Wt_mo, 0, nullptr, scr, r, lane); continue; } r -= I_SQ;
            if (r < I_UP) { transpose_item<1>(p.in[23], 1024, NUP, 176, Wt_up, 0, p.in[22], scr, r, lane); continue; } r -= I_UP;
            transpose_item<0>(p.in[26], DFF, 1024, 32, Wt_dn, 0, nullptr, scr, r, lane);
        }
        {
            const float* w_pool = p.in[13]; const float* pscale = p.in[14];
            for (int i = bx * 512 + tid; i < 4 * 128 * 128; i += G * 512) { const int g = i >> 14, d = (i >> 7) & 127, c = i & 127; Wt_pool[i] = (bf16_t)(cvt_pk_bf16(w_pool[(g * 128 + c) * 128 + d] * pscale[g * 128 + d], 0.f) & 0xffffu); }
        }
        for (int m = gw; m < MT; m += NGW) {
            const float* xr = (m < MP) ? x_prompt + (size_t)m * DM : x_sample + (size_t)(m - MP) * DM;
            float* lf = (m < MP) ? out + O_LFP + (size_t)m * 8 : out + O_LFS + (size_t)(m - MP) * 8;
            prepass_row(xr, xb + (size_t)m * DM, wf, p.in[12], lf, lane);
        }
        for (int m = gw; m < 8192; m += NGW) prepass_row(p.in[9] + (size_t)m * DM, memb + (size_t)m * DM, (const LAS float*)nullptr, nullptr, nullptr, lane);
        const size_t gtid = (size_t)bx * 512 + tid, gn = (size_t)G * 512;
        for (size_t i = gtid; i < (size_t)16 * 15 * 512 / 8; i += gn) { const size_t e8 = i * 8, bb = e8 / (15 * 512), rem = e8 - bb * 15 * 512; const float* sp = p.in[5] + e8; *(u32x4*)(usx + bb * 79 * 512 + rem) = pack8(*(const f32x4*)sp, *(const f32x4*)(sp + 4)); }
        cvt_flat(p.in[2], kcb, (size_t)16 * PAST * 512 / 8, gtid, gn);
        cvt_flat(p.in[3], vcb, (size_t)16 * PAST * 512 / 8, gtid, gn);
        cvt_flat(p.in[7], mkb + (size_t)8192 * 1024, (size_t)4096 * 1024 / 8, gtid, gn);
        cvt_flat(p.in[8], mvb + (size_t)8192 * 1024, (size_t)4096 * 1024 / 8, gtid, gn);
        __syncthreads();
    }
    SEAM(0);

    if (IN(1)) {
        if (wave == 0) { const int s = bx; if (s < 256) scan_seq(out + O_LFP + (size_t)(s >> 3) * SEQ * 8 + (s & 7), SEQ, out + O_LFP, 0, kbP + (size_t)s * SEQ, lane); }
        if (wave == 1 && bx < 128) { const int s = bx; scan_seq(p.in[4] + (size_t)(s >> 3) * PAST * 8 + (s & 7), PAST, out + O_LFS + (size_t)(s >> 3) * DSEQ * 8 + (s & 7), DSEQ, kbS + (size_t)s * (PAST + DSEQ), lane); }
        {
            pg8::Gemm g{xb, Wt_in, MT, 2048, 1024}; pg8::StaticOrder S; S.init(MT, 2048, G, bx);
            EpiIn E{uqkv, out, usx};
            pg8::gemm_phase<EpiIn, pg8::StaticOrder, true, true>(L, g, S, E);
        }
        __syncthreads();
        {
            pg8::Gemm g{memb, Wt_mkv, 8192, 2048, 1024}; pg8::StaticOrder S; S.init(8192, 2048, G, bx);
            EpiMkv E{mkb, mvb, out};
            pg8::gemm_phase<EpiMkv, pg8::StaticOrder, true, true>(L, g, S, E);
        }
    }
    SEAM(1);

    if (IN(2)) {
        for (int it = 0; it < 8 * ((256 + G - 1) / G); ++it) {
            int bh, qk;
            if (G == 256) { const int xcd = bx & 7, l = bx >> 3, r = it >> 1, pi = l & 3; bh = xcd * 32 + r * 8 + (l >> 2); qk = (it & 1) ? pi : 7 - pi; }
            else { bh = bx + (it >> 3) * G; qk = 7 - (it & 7); if (bh >= 256) break; }
            const int b = bh >> 3, h = bh & 7;
            const bf16_t* Kh = kb + (size_t)b * SEQ * 512 + h * 64; const bf16_t* Vh = vb + (size_t)b * SEQ * 512 + h * 64;
            const size_t r0 = (size_t)b * SEQ + 256 * qk;
            attn_unit<64, 64, 1, true, false, true, true>(L, qb + r0 * 512 + h * 64, 512, 256, Kh, Vh, 4 * qk + 4, Kh, Vh, 512, 4 * qk + 4, kbP + (size_t)bh * SEQ, 256 * qk, mix + r0 * DM + 512 + h * 64, DM);
        }
        if (P2_ATTN_S) for (int bh = bx; bh < 128; bh += G) {
            const int b = bh >> 3, h = bh & 7;
            const size_t r0 = (size_t)MP + b * DSEQ;
            attn_unit<64, 64, 4, true, false, true, true>(L, qb + r0 * 512 + h * 64, 512, 64, kcb + (size_t)b * PAST * 512 + h * 64, vcb + (size_t)b * PAST * 512 + h * 64, 64,
                                      kb + r0 * 512 + h * 64, vb + r0 * 512 + h * 64, 512, 65, kbS + (size_t)bh * (PAST + DSEQ), PAST, mix + r0 * DM + 512 + h * 64, DM);
        }
        if (G == 256) { __syncthreads(); pool_unit(L, bx, ub, usx, Wt_pool, mix); if (bx >= 128 && bx < 132) pool_unit(L, 128 + bx, ub, usx, Wt_pool, mix); }
        else { __syncthreads(); for (int t = bx; t < MT / 256; t += G) pool_unit(L, t, ub, usx, Wt_pool, mix); }
        __syncthreads();
    }
    SEAM(2);

    if (IN(3)) {
        const int MG = (G == 256) ? MP : MT;
        pg8::Gemm g{mix, Wt_o, MG, 1024, 1024}; pg8::StaticOrder S; S.init(MG, 1024, G, bx);
        EpiRes<0> E{x_prompt, x_sample, nullptr, x1b, nullptr, ssq1};
        pg8::gemm_phase<EpiRes<0>, pg8::StaticOrder, true, true>(L, g, S, E);
        if (G == 256) small_gemm_sample<0>(L, bx, mix, 1024, Wt_o, 1024, 1024, x_sample, nullptr, x1b, nullptr, ssq1, nullptr);
    }
    SEAM(3);

    if (IN(4)) {
        const int MG = (G == 256) ? MP : MT;
        pg8::Gemm g{x1b, Wt_mq, MG, 1024, 1024}; pg8::StaticOrder S; S.init(MG, 1024, G, bx);
        EpiMq E{ssq1, mqb};
        pg8::gemm_phase<EpiMq, pg8::StaticOrder, true, true>(L, g, S, E);
        if (G == 256) small_gemm_sample<3>(L, bx, x1b, 1024, Wt_mq, 1024, 1024, nullptr, nullptr, mqb, nullptr, nullptr, ssq1);
    }
    SEAM(4);

    if (IN(5)) {
        for (int k5 = 0; k5 * G < 2048 + 64; ++k5) {
            const int un = (G == 256 && k5 < 8) ? (((k5 * 8 + (bx & 7)) * 32) + (bx >> 3)) : (k5 * G + bx);
            if (un >= 2048 + 64) break;
            if (un < 2048) {
                const int b = un >> 6, h = (un >> 4) & 3, qk = un & 15;
                const size_t r0 = (size_t)b * SEQ + 128 * qk;
                const bf16_t* Kh = mkb + (size_t)b * NMEM * 1024 + h * 256; const bf16_t* Vh = mvb + (size_t)b * NMEM * 1024 + h * 256;
                attn_unit<256, 32, 2, false, true, false, false>(L, mqb + r0 * DM + h * 256, DM, 128, Kh, Vh, 8, Kh, Vh, 1024, 8, nullptr, 0, mo + r0 * DM + h * 256, DM);
            } else {
                const int us = un - 2048, b = us >> 2, h = us & 3;
                const size_t r0 = (size_t)MP + b * DSEQ;
                const bf16_t* Kh = mkb + (size_t)(8192 + b * NMEM) * 1024 + h * 256; const bf16_t* Vh = mvb + (size_t)(8192 + b * NMEM) * 1024 + h * 256;
                attn_unit<256, 32, 2, false, true, false, false>(L, mqb + r0 * DM + h * 256, DM, 64, Kh, Vh, 8, Kh, Vh, 1024, 8, nullptr, 0, mo + r0 * DM + h * 256, DM);
            }
        }
        __syncthreads();
    }
    SEAM(5);

    if (IN(6)) {
        const int MG = (G == 256) ? MP : MT;
        pg8::Gemm g{mo, Wt_mo, MG, 1024, 1024}; pg8::StaticOrder S; S.init(MG, 1024, G, bx);
        EpiRes<1> E{nullptr, nullptr, x1b, x2b, nullptr, ssq2};
        pg8::gemm_phase<EpiRes<1>, pg8::StaticOrder, true, true>(L, g, S, E);
        if (G == 256) small_gemm_sample<1>(L, bx, mo, 1024, Wt_mo, 1024, 1024, nullptr, x1b, x2b, nullptr, ssq2, nullptr);
    }
    SEAM(6);

    if (IN(7)) {
        pg8::Gemm g{x2b, Wt_up, MT, NUP, 1024}; pg8::StaticOrder S; S.init(MT, NUP, G, bx);
        EpiUp E{ssq2, p.in[24], p.in[25], hff, ahead, atail, bhead};
        pg8::gemm_phase<EpiUp, pg8::StaticOrder, true, true>(L, g, S, E);
    }
    SEAM(7);

    if (IN(8)) {
        const float* cw = p.in[24]; const float* cbias = p.in[25]; const float* chist = p.in[6];
        const int total4 = NSEG * 2 * (DFF / 4);
        for (int idx = bx * 512 + tid; idx < total4; idx += G * 512) {
            const int seg = idx / (2 * (DFF / 4)), rem = idx - seg * 2 * (DFF / 4), i = rem / (DFF / 4), c = (rem - i * (DFF / 4)) * 4;
            f32x4 prev1, prev2;
            if (seg < MP / 64) { if ((seg & 31) == 0) { prev1 = (f32x4){0.f, 0.f, 0.f, 0.f}; prev2 = prev1; } else { prev1 = *(const f32x4*)(atail + ((size_t)(seg - 1) * 2 + 1) * DFF + c); prev2 = *(const f32x4*)(atail + ((size_t)(seg - 1) * 2) * DFF + c); } }
            else { const int b = seg - MP / 64; prev1 = *(const f32x4*)(chist + ((size_t)b * 2 + 1) * DFF + c); prev2 = *(const f32x4*)(chist + ((size_t)b * 2) * DFF + c); }
            const f32x4 a_0 = *(const f32x4*)(ahead + ((size_t)seg * 2) * DFF + c);
            f32x4 am1, am2, a0;
            if (i == 0) { am1 = prev1; am2 = prev2; a0 = a_0; } else { am1 = a_0; am2 = prev1; a0 = *(const f32x4*)(ahead + ((size_t)seg * 2 + 1) * DFF + c); }
            const f32x4 cv = *(const f32x4*)(cbias + c) + *(const f32x4*)(cw + c) * am2 + *(const f32x4*)(cw + DFF + c) * am1 + *(const f32x4*)(cw + 2 * DFF + c) * a0;
            const f32x4 bh = *(const f32x4*)(bhead + ((size_t)seg * 2 + i) * DFF + c);
            f32x4 hv;
#pragma unroll
            for (int e = 0; e < 4; ++e) hv[e] = cv[e] / (1.0f + __builtin_amdgcn_exp2f(-cv[e] * LOG2E)) * bh[e];
            u32x2 w; w.x = cvt_pk_bf16(hv[0], hv[1]); w.y = cvt_pk_bf16(hv[2], hv[3]);
            *(u32x2*)(hff + ((size_t)seg * 64 + i) * DFF + c) = w;
        }
        for (int idx = bx * 512 + tid; idx < 48 * 2 * DFF; idx += G * 512) {
            const int bb = idx / (2 * DFF), rem = idx - bb * 2 * DFF;
            if (bb < 32) out[O_CSP + (size_t)bb * 2 * DFF + rem] = atail[((size_t)(32 * bb + 31) * 2) * DFF + rem];
            else out[O_CSS + (size_t)(bb - 32) * 2 * DFF + rem] = atail[((size_t)(MP / 64 + bb - 32) * 2) * DFF + rem];
        }
    }
    SEAM(8);

    if (IN(9)) {
        const int MG = (G == 256) ? MP : MT;
        pg8::Gemm g{hff, Wt_dn, MG, 1024, DFF}; pg8::StaticOrder S; S.init(MG, 1024, G, bx);
        EpiRes<2> E{nullptr, nullptr, x2b, nullptr, out, ssq3};
        pg8::gemm_phase<EpiRes<2>, pg8::StaticOrder, true, true>(L, g, S, E);
        if (G == 256) small_gemm_sample<2>(L, bx, hff, DFF, Wt_dn, DFF, DFF, nullptr, x2b, nullptr, out, ssq3, nullptr);
    }
    SEAM(9);

    if (IN(10)) {
        const float* gf = p.in[27];
        const int gw = bx * 8 + wave, NGW = G * 8;
        f32x4 gv[4];
#pragma unroll
        for (int j = 0; j < 4; ++j) gv[j] = ((const f32x4*)gf)[lane + 64 * j];
        for (int m0 = gw; m0 < MT; m0 += 4 * NGW) {
            f32x4 v[4][4]; float r[4];
#pragma unroll
            for (int q = 0; q < 4; ++q) { const int m = m0 + q * NGW; if (m < MT) { const f32x4* y4 = (const f32x4*)(out + (size_t)m * DM) + lane; r[q] = row_rsq(ssq3, m);
#pragma unroll
                    for (int j = 0; j < 4; ++j) v[q][j] = y4[64 * j]; } }
#pragma unroll
            for (int q = 0; q < 4; ++q) { const int m = m0 + q * NGW; if (m < MT) { f32x4* y4 = (f32x4*)(out + (size_t)m * DM) + lane;
#pragma unroll
                    for (int j = 0; j < 4; ++j) y4[64 * j] = v[q][j] * r[q] * gv[j]; } }
        }
    }
#ifdef DBG_DUMP
    {
        GSYNC();
        const bf16_t* src = nullptr; int pitch = 1024;
        if (hi_ph == 2) src = uqkv; else if (hi_ph == 3) src = mix; else if (hi_ph == 4) src = x1b; else if (hi_ph == 5) src = mqb; else if (hi_ph == 6) src = mo; else if (hi_ph == 7) src = x2b; else if (hi_ph == 8 || hi_ph == 9) { src = hff; pitch = DFF; }
        if (src) for (size_t i = (size_t)bx * 512 + tid; i < (size_t)MT * 1024; i += (size_t)G * 512) { const size_t m = i >> 10, c = i & 1023; float v = __builtin_bit_cast(float, (unsigned)src[m * pitch + c] << 16); if (!(v == v)) v = 12345.f; if (fabsf(v) > 1e30f) v = 54321.f; out[i] = v; }
    }
#endif
#undef IN
#undef SEAM
}

extern "C" void kernel_launch(void* const* d_in, const int* in_sizes, int n_in, void* d_out, int out_size, void* d_ws, size_t ws_size, hipStream_t stream) {
    static int grid = 0;
    if (grid == 0) {
        if (n_in != 28 || (size_t)out_size != O_END || ws_size < WS_NEED) { fprintf(stderr, "kernel_launch: unexpected shapes (n_in %d, out %d, ws %zu); nothing launched\n", n_in, out_size, ws_size); grid = -1; return; }
        int dev = 0, cus = 0, per_cu = 0;
        hipGetDevice(&dev); hipDeviceGetAttribute(&cus, hipDeviceAttributeMultiprocessorCount, dev);
        hipFuncSetAttribute((const void*)fwd_kernel, hipFuncAttributeMaxDynamicSharedMemorySize, LDS_BYTES);
        hipOccupancyMaxActiveBlocksPerMultiprocessor(&per_cu, (const void*)fwd_kernel, 512, LDS_BYTES);
        if (per_cu < 1) { fprintf(stderr, "kernel_launch: occupancy query says %d blocks per CU\n", per_cu); per_cu = 1; }
        (void)hipGetLastError();
        grid = cus;
    }
    if (grid < 0) return;
    (void)hipMemsetAsync(d_ws, 0, 256, stream);
    Params p{};
    for (int i = 0; i < 28; ++i) p.in[i] = (const float*)d_in[i];
    p.out = (float*)d_out; p.ws = (unsigned char*)d_ws;
    void* args[] = {&p};
#ifdef PROBE_K
    p.ph_lo = 0; p.ph_hi = PROBE_K + 1;
    (void)hipLaunchCooperativeKernel((const void*)fwd_kernel, dim3(grid), dim3(512), args, LDS_BYTES, stream);
    (void)hipMemsetAsync(d_ws, 0, 256, stream);
    p.ph_lo = PROBE_K; p.ph_hi = 11;
#else
    p.ph_lo = 0; p.ph_hi = 11;
#endif
    hipError_t e = hipLaunchCooperativeKernel((const void*)fwd_kernel, dim3(grid), dim3(512), args, LDS_BYTES, stream);
    if (e != hipSuccess) fprintf(stderr, "cooperative launch failed: %s (grid %d)\n", hipGetErrorString(e), grid);
}
```

```cpp
#include <hip/hip_runtime.h>
#include <hip/hip_cooperative_groups.h>
#include <cstdio>
#include <cstdint>
namespace cg = cooperative_groups;
namespace pg8 {
#define PG8_LAS __attribute__((address_space(3)))
typedef unsigned short bf16_t;
typedef short bf16x8 __attribute__((ext_vector_type(8)));
typedef float f32x4 __attribute__((ext_vector_type(4)));
typedef unsigned u32x4 __attribute__((ext_vector_type(4)));
constexpr int BM = 256, BK = 64, HALF = 128, HTB = HALF * BK * 2  , STAGE_BYTES = 8 * HTB, NXCD = 8, WGM = 8;

__host__ __device__ __forceinline__ int lds_byte(int r, int c) { const int st = (r >> 4) * 2 + (c >> 5), rr = r & 15, cc = c & 31, ob = rr * 64 + cc * 2; return st * 1024 + (ob ^ (((ob >> 9) & 1) << 5)); }
__host__ __device__ __forceinline__ void stage_rc(int b, int& R, int& C) { const int st = b / 1024, sb = b % 1024, swz = sb ^ (((sb >> 9) & 1) << 5); R = (st >> 1) * 16 + swz / 64; C = (st & 1) * 32 + (swz % 64) / 2; }
__host__ __device__ __forceinline__ int perm32(int rho) { const int n = rho >> 4, i = rho & 15; return 8 * (i >> 2) + 4 * n + (i & 3); }

struct Unit { int pm, pn; };
struct Gemm { const bf16_t* A; const bf16_t* Bt; int M, N, K; };

struct StaticOrder {
    int nM, nN, nwg, G, c;
    __host__ __device__ void init(int M, int N, int G_, int c_) { nM = M / BM; nN = N / BM; nwg = nM * nN; G = G_; c = c_; }
    __host__ __device__ bool next(int i, Unit& u) const {
        const long L = (long)i * G + c; if (L >= nwg) return false;
        int wgid = (int)L; { const int q = nwg / NXCD, r = nwg % NXCD, xcd = wgid % NXCD, off = wgid / NXCD; wgid = (xcd < r ? xcd * (q + 1) : r * (q + 1) + (xcd - r) * q) + off; }
        const int nig = WGM * nN, gid = wgid / nig, fm = gid * WGM, gsz = (nM - fm) < WGM ? (nM - fm) : WGM;
        u.pm = fm + ((wgid % nig) % gsz); u.pn = (wgid % nig) / gsz; return true;
    }
    __device__ __forceinline__ void a_ready(const Unit&) const {}
    __device__ __forceinline__ void done(const Unit&) const {}
};

__device__ __forceinline__ unsigned cvt_pk_bf16(float lo, float hi) { unsigned r; asm volatile("v_cvt_pk_bf16_f32 %0, %1, %2" : "=v"(r) : "v"(lo), "v"(hi)); return r; }
typedef float f32x2 __attribute__((ext_vector_type(2)));
template <class Epi, class Sched, bool ALIGN_EPI = false, bool SP2 = false>
__device__ __forceinline__ void gemm_phase(PG8_LAS unsigned char* lds, const Gemm g, const Sched& S, const Epi& E) {
    const int tid = threadIdx.x, wid = __builtin_amdgcn_readfirstlane(tid >> 6), lane = tid & 63, wr = wid >> 2, wc = wid & 3, fr = lane & 15, fq = lane >> 4;
    const int K = g.K, nt = K / BK;
    unsigned voffA[2], voffB[2];
#pragma unroll
    for (int i = 0; i < 2; ++i) { int R, C; stage_rc(tid * 16 + i * 8192, R, C); const int Rb = Epi::PERM ? ((R & ~31) + perm32(R & 31)) : R;
        voffA[i] = (unsigned)(R * K + C) * 2u; voffB[i] = (unsigned)(Rb * K + C) * 2u; }
    const size_t kstep = (size_t)(BK * 2);
    const size_t hstep = (size_t)HALF * K * 2;
    const size_t tstep = 2 * hstep;
    const unsigned ldsw = (unsigned)wid * 1024u;
    const int aoff = lds_byte(wr * 64 + fr, fq * 8), boff = lds_byte(wc * 32 + fr, fq * 8);
#define PG8_SA(b, h) (((b) * 2 + (h)) * HTB)
#define PG8_SB(b, h) ((4 + (b) * 2 + (h)) * HTB)
#define PG8_STAGE(bufoff, gbase, voff) do { _Pragma("unroll") for (int _i = 0; _i < 2; ++_i) \
        __builtin_amdgcn_global_load_lds((const unsigned*)((const char*)(gbase) + (voff)[_i]), (PG8_LAS unsigned*)(lds + (bufoff) + ldsw + _i * 8192), 16, 0, 0); } while (0)
#define PG8_LDA(dst, b, h) do { _Pragma("unroll") for (int m = 0; m < 4; ++m) _Pragma("unroll") for (int k = 0; k < 2; ++k) dst[m][k] = *(const PG8_LAS bf16x8*)(lds + PG8_SA(b, h) + aoff + m * 2048 + k * 1024); } while (0)
#define PG8_LDB(dst, b, h) do { _Pragma("unroll") for (int n = 0; n < 2; ++n) _Pragma("unroll") for (int k = 0; k < 2; ++k) dst[n][k] = *(const PG8_LAS bf16x8*)(lds + PG8_SB(b, h) + boff + n * 2048 + k * 1024); } while (0)
#define PG8_MMA(ai, bj, At, Bt) do { __builtin_amdgcn_s_setprio(1); _Pragma("unroll") for (int m = 0; m < 4; ++m) _Pragma("unroll") for (int n = 0; n < 2; ++n) _Pragma("unroll") for (int k = 0; k < 2; ++k) \
        acc[ai][bj][m][n] = __builtin_amdgcn_mfma_f32_16x16x32_bf16(Bt[n][k], At[m][k], acc[ai][bj][m][n], 0, 0, 0); __builtin_amdgcn_s_setprio(0); } while (0)
#define PG8_WAIT_V(n) asm volatile("s_waitcnt vmcnt(" #n ")" ::: "memory")
#define PG8_WAIT_L(n) asm volatile("s_waitcnt lgkmcnt(" #n ")" ::: "memory")
#define PG8_BAR __builtin_amdgcn_s_barrier()
#define PG8_SCHED __builtin_amdgcn_sched_barrier(0)
    Unit cur, nxt; int ui = 0;
    if (!S.next(0, cur)) return;
    f32x4 acc[2][2][4][2];
#pragma unroll
    for (int a = 0; a < 2; ++a)
#pragma unroll
        for (int b = 0; b < 2; ++b)
#pragma unroll
            for (int m = 0; m < 4; ++m)
#pragma unroll
                for (int n = 0; n < 2; ++n) acc[a][b][m][n] = (f32x4){0.f, 0.f, 0.f, 0.f};
    bf16x8 At[4][2], B0[2][2], B1[2][2];
    const char* cA = (const char*)g.A + (size_t)cur.pm * tstep; const char* cB = (const char*)g.Bt + (size_t)cur.pn * tstep;
    S.a_ready(cur);
    if constexpr (SP2) {
        PG8_STAGE(PG8_SB(0, 0), cB, voffB); PG8_STAGE(PG8_SB(0, 1), cB + hstep, voffB); PG8_STAGE(PG8_SA(0, 0), cA, voffA); PG8_STAGE(PG8_SA(0, 1), cA + hstep, voffA);
        if (wr == 1) PG8_BAR;
        PG8_WAIT_V(2); PG8_BAR;
        PG8_STAGE(PG8_SB(1, 0), cB + kstep, voffB); PG8_STAGE(PG8_SA(1, 0), cA + kstep, voffA); PG8_STAGE(PG8_SB(1, 1), cB + hstep + kstep, voffB);
        PG8_WAIT_V(6); PG8_BAR;
    } else {
        PG8_STAGE(PG8_SB(0, 0), cB, voffB); PG8_STAGE(PG8_SA(0, 0), cA, voffA); PG8_STAGE(PG8_SB(0, 1), cB + hstep, voffB); PG8_STAGE(PG8_SA(0, 1), cA + hstep, voffA);
        if (wr == 1) PG8_BAR;
        PG8_WAIT_V(4); PG8_BAR;
        PG8_STAGE(PG8_SB(1, 0), cB + kstep, voffB); PG8_STAGE(PG8_SA(1, 0), cA + kstep, voffA); PG8_STAGE(PG8_SB(1, 1), cB + hstep + kstep, voffB);
        PG8_WAIT_V(6); PG8_BAR;
    }
    for (;;) {
        const bool has_next = S.next(ui + 1, nxt);
        const char* nA = has_next ? (const char*)g.A + (size_t)nxt.pm * tstep : cA; const char* nB = has_next ? (const char*)g.Bt + (size_t)nxt.pn * tstep : cB;
        for (int t = 0; t < nt; t += 2) {
            const bool last = (t == nt - 2);
            const char* a1 = cA + (size_t)(t + 1) * kstep;
            const char* a2 = last ? nA : cA + (size_t)(t + 2) * kstep; const char* b2 = last ? nB : cB + (size_t)(t + 2) * kstep;
            const char* a3 = a2 + kstep; const char* b3 = b2 + kstep;
            if (last && has_next) S.a_ready(nxt);
            if constexpr (SP2) {
            PG8_LDB(B0, 0, 0); PG8_LDB(B1, 0, 1); PG8_SCHED; PG8_LDA(At, 0, 0); PG8_STAGE(PG8_SA(1, 1), a1 + hstep, voffA);
            PG8_WAIT_V(8); PG8_WAIT_L(0); PG8_BAR; PG8_MMA(0, 0, At, B0); PG8_MMA(0, 1, At, B1); PG8_BAR; PG8_SCHED;
            PG8_LDA(At, 0, 1); PG8_STAGE(PG8_SB(0, 0), b2, voffB); PG8_STAGE(PG8_SB(0, 1), b2 + hstep, voffB); PG8_STAGE(PG8_SA(0, 0), a2, voffA);
            PG8_WAIT_V(8); PG8_WAIT_L(0); PG8_BAR; PG8_MMA(1, 0, At, B0); PG8_MMA(1, 1, At, B1); PG8_BAR; PG8_SCHED;
            PG8_LDB(B0, 1, 0); PG8_LDB(B1, 1, 1); PG8_SCHED; PG8_LDA(At, 1, 0); PG8_STAGE(PG8_SA(0, 1), a2 + hstep, voffA);
            PG8_WAIT_V(8); PG8_WAIT_L(0); PG8_BAR; PG8_MMA(0, 0, At, B0); PG8_MMA(0, 1, At, B1); PG8_BAR; PG8_SCHED;
            PG8_LDA(At, 1, 1); PG8_STAGE(PG8_SB(1, 0), b3, voffB); PG8_STAGE(PG8_SB(1, 1), b3 + hstep, voffB); PG8_STAGE(PG8_SA(1, 0), a3, voffA);
            PG8_WAIT_V(8); PG8_WAIT_L(0); PG8_BAR; PG8_MMA(1, 0, At, B0); PG8_MMA(1, 1, At, B1); PG8_BAR; PG8_SCHED;
            } else {
            PG8_LDB(B0, 0, 0); PG8_SCHED; PG8_LDA(At, 0, 0); PG8_STAGE(PG8_SA(1, 1), a1 + hstep, voffA);
            PG8_WAIT_L(8); PG8_BAR; PG8_WAIT_L(0); PG8_MMA(0, 0, At, B0); PG8_BAR; PG8_SCHED;
            PG8_LDB(B1, 0, 1); PG8_STAGE(PG8_SB(0, 0), b2, voffB);
            PG8_BAR; PG8_WAIT_L(0); PG8_MMA(0, 1, At, B1); PG8_BAR;
            PG8_LDA(At, 0, 1); PG8_STAGE(PG8_SA(0, 0), a2, voffA);
            PG8_BAR; PG8_WAIT_L(0); PG8_MMA(1, 0, At, B0); PG8_BAR; PG8_SCHED;
            PG8_STAGE(PG8_SB(0, 1), b2 + hstep, voffB);
            PG8_WAIT_V(6); PG8_BAR; PG8_MMA(1, 1, At, B1); PG8_BAR;
            PG8_LDB(B0, 1, 0); PG8_SCHED; PG8_LDA(At, 1, 0); PG8_STAGE(PG8_SA(0, 1), a2 + hstep, voffA);
            PG8_WAIT_L(8); PG8_BAR; PG8_WAIT_L(0); PG8_MMA(0, 0, At, B0); PG8_BAR; PG8_SCHED;
            PG8_LDB(B1, 1, 1); PG8_STAGE(PG8_SB(1, 0), b3, voffB);
            PG8_BAR; PG8_WAIT_L(0); PG8_MMA(0, 1, At, B1); PG8_BAR;
            PG8_LDA(At, 1, 1); PG8_STAGE(PG8_SA(1, 0), a3, voffA);
            PG8_BAR; PG8_WAIT_L(0); PG8_MMA(1, 0, At, B0); PG8_BAR; PG8_SCHED;
            PG8_STAGE(PG8_SB(1, 1), b3 + hstep, voffB);
            PG8_WAIT_V(6); PG8_BAR; PG8_MMA(1, 1, At, B1); PG8_BAR;
            }
        }
        if constexpr (ALIGN_EPI) { if (wr == 0) PG8_BAR; }
        if constexpr (!Epi::AFTER_DRAIN) { E(acc, cur, wr, wc, fr, fq); S.done(cur); }
        if (!has_next) break;
#pragma unroll
        for (int a = 0; a < 2; ++a)
#pragma unroll
            for (int b = 0; b < 2; ++b)
#pragma unroll
                for (int m = 0; m < 4; ++m)
#pragma unroll
                    for (int n = 0; n < 2; ++n) acc[a][b][m][n] = (f32x4){0.f, 0.f, 0.f, 0.f};
        cur = nxt; cA = nA; cB = nB; ++ui;
        if constexpr (ALIGN_EPI) { if (wr == 1) PG8_BAR; }
    }
    PG8_WAIT_V(0);
    if constexpr (!ALIGN_EPI) { if (wr == 0) PG8_BAR; }
    PG8_BAR;
    if constexpr (Epi::AFTER_DRAIN) { E.fused(acc, cur, wr, wc, fr, fq, lds, wid, lane); S.done(cur); }
#undef PG8_SA
#undef PG8_SB
#undef PG8_STAGE
#undef PG8_LDA
#undef PG8_LDB
#undef PG8_MMA
#undef PG8_WAIT_V
#undef PG8_WAIT_L
#undef PG8_BAR
#undef PG8_SCHED
}
}

using pg8::bf16_t; using pg8::bf16x8; using pg8::f32x4; using pg8::u32x4; using pg8::Unit;
typedef float f32x2_t __attribute__((ext_vector_type(2))); typedef __bf16 bf16x2_t __attribute__((ext_vector_type(2)));
__device__ __forceinline__ unsigned cvt_pk_bf16(float lo, float hi) { f32x2_t v = {lo, hi}; bf16x2_t b = __builtin_convertvector(v, bf16x2_t); return __builtin_bit_cast(unsigned, b); }
typedef float f32x16 __attribute__((ext_vector_type(16)));
typedef unsigned u32x2 __attribute__((ext_vector_type(2)));
#define LAS __attribute__((address_space(3)))

constexpr int DM = 1024, MP = 65536, MS = 1024, MT = MP + MS, SEQ = 2048, DSEQ = 64, PAST = 4096, NMEM = 256;
constexpr int DFF = 2816, NUP = 2 * DFF, NSEG = MT / 64;
constexpr float EPS = 1e-6f, LOG2E = 1.4426950408889634f;
constexpr float C2F = 0.125f * LOG2E, C2M = 0.0625f * LOG2E;
constexpr float NEGBIG = -1e30f;

constexpr size_t O_YP = 0, O_YS = O_YP + (size_t)MP * DM, O_KP = O_YS + (size_t)MS * DM, O_VP = O_KP + (size_t)MP * 512, O_LFP = O_VP + (size_t)MP * 512,
    O_PSP = O_LFP + (size_t)MP * 8, O_CSP = O_PSP + 32 * 15 * 512, O_MKP = O_CSP + 32 * 2 * DFF, O_MVP = O_MKP + (size_t)8192 * 1024, O_KS = O_MVP + (size_t)8192 * 1024,
    O_VS = O_KS + (size_t)MS * 512, O_LFS = O_VS + (size_t)MS * 512, O_PSS = O_LFS + MS * 8, O_CSS = O_PSS + 16 * 15 * 512, O_END = O_CSS + 16 * 2 * DFF;

constexpr size_t MiB = 1u << 20;
constexpr size_t WS_WIN = 1 * MiB, WS_WO = 5 * MiB, WS_WMQ = 7 * MiB, WS_WMO = 9 * MiB, WS_WMKV = 11 * MiB, WS_WUP = 15 * MiB, WS_WDN = 26 * MiB, WS_WPOOL = 32 * MiB;
constexpr size_t WS_USX = 34 * MiB;
constexpr size_t WS_MKB = 40 * MiB, WS_MVB = 64 * MiB;
constexpr size_t WS_SSQ1 = 88 * MiB, WS_SSQ2 = 93 * MiB, WS_SSQ3 = 98 * MiB;
constexpr size_t WS_KBP = 103 * MiB, WS_KBS = 105 * MiB;
constexpr size_t WS_AHEAD = 108 * MiB, WS_ATAIL = WS_AHEAD + 23 * MiB / 1 - MiB / 2, WS_BHEAD = WS_ATAIL + 23 * MiB - MiB / 2;
constexpr size_t WS_X1B = 176 * MiB, WS_KCB = 176 * MiB, WS_VCB = 240 * MiB;
constexpr size_t WS_X2B = 306 * MiB;
constexpr size_t WS_XB = 436 * MiB, WS_MQB = 436 * MiB, WS_HFF = 436 * MiB;
constexpr size_t WS_UQKV = 566 * MiB, WS_MO = 566 * MiB;
constexpr size_t WS_MIX = 826 * MiB, WS_MEMB = 956 * MiB, WS_NEED = 972 * MiB;
static_assert((size_t)NSEG * 2 * DFF * 4 <= 22 * MiB + MiB / 2, "side buffers");
static_assert(WS_BHEAD + 22 * MiB + MiB / 2 <= WS_X1B, "side buffers end");

#define P2_ATTN_P 1
#define P2_ATTN_S 1
#define P2_POOL 1
#define DBG_HI 11
#ifndef SWPIPE
#define SWPIPE 0
#endif
#ifndef PHMASK
#define PHMASK 0x7ff
#endif
constexpr int LDS_BYTES = 147456;

struct Params { const float* in[28]; float* out; unsigned char* ws; int ph_lo, ph_hi; };

__device__ __forceinline__ float bf_lo(unsigned w) { return __builtin_bit_cast(float, w << 16); }
__device__ __forceinline__ float bf_hi(unsigned w) { return __builtin_bit_cast(float, w & 0xffff0000u); }
__device__ __forceinline__ int lane_op() { int l = (int)(threadIdx.x & 63u); asm volatile("" : "+v"(l)); return l; }
__device__ __forceinline__ int crow(int r, int hi) { return (r & 3) + 8 * (r >> 2) + 4 * hi; }
__device__ __forceinline__ float wave_sum(float v) {
#pragma unroll
    for (int o = 1; o < 64; o <<= 1) v += __shfl_xor(v, o);
    return v;
}
__device__ __forceinline__ float rsq(float ssq) { return 1.0f / sqrtf(ssq * (1.0f / 1024.0f) + EPS); }
#define LDS_WAIT() asm volatile("s_waitcnt lgkmcnt(0)" ::: "memory")

typedef const f32x4 (&AccRef)[2][2][4][2];

__device__ __forceinline__ u32x4 pack8(f32x4 v0, f32x4 v1) { u32x4 w; w.x = cvt_pk_bf16(v0[0], v0[1]); w.y = cvt_pk_bf16(v0[2], v0[3]); w.z = cvt_pk_bf16(v1[0], v1[1]); w.w = cvt_pk_bf16(v1[2], v1[3]); return w; }

struct EpiIn {
    static constexpr bool PERM = true, AFTER_DRAIN = false;
    bf16_t* uqkv; float* out; bf16_t* usx;
    __device__ __forceinline__ void operator()(AccRef acc, const Unit& u, int wr, int wc, int fr, int fq) const {
        const int t = u.pn >> 1;
        const int col0 = (u.pn & 1) * 256 + wc * 32 + 8 * fq;
        bf16_t* base = uqkv + (size_t)t * MT * 512;
        const float sc = (t == 1) ? C2F : 1.0f;
#pragma unroll
        for (int ai = 0; ai < 2; ++ai)
#pragma unroll
            for (int m = 0; m < 4; ++m) {
                const int row = u.pm * 256 + ai * 128 + wr * 64 + m * 16 + fr;
#pragma unroll
                for (int bj = 0; bj < 2; ++bj) {
                    const int col = col0 + bj * 128;
                    const f32x4 v0 = acc[ai][bj][m][0] * sc, v1 = acc[ai][bj][m][1] * sc;
                    *(u32x4*)(base + (size_t)row * 512 + col) = pack8(v0, v1);
                    if (t >= 2) {
                        float* o = (row < MP) ? out + (t == 2 ? O_KP : O_VP) + (size_t)row * 512 : out + (t == 2 ? O_KS : O_VS) + (size_t)(row - MP) * 512;
                        *(f32x4*)(o + col) = v0; *(f32x4*)(o + col + 4) = v1;
                    } else if (t == 0) {
                        if (row < MP) { const int tt = row & (SEQ - 1); if (tt >= SEQ - 15) { float* o = out + O_PSP + ((size_t)(row >> 11) * 15 + (tt - (SEQ - 15))) * 512 + col; *(f32x4*)o = v0; *(f32x4*)(o + 4) = v1; } }
                        else { const int rs = row - MP, tt = rs & 63; *(u32x4*)(usx + ((size_t)(rs >> 6) * 79 + 15 + tt) * 512 + col) = pack8(v0, v1); if (tt >= DSEQ - 15) { float* o = out + O_PSS + ((size_t)(rs >> 6) * 15 + (tt - (DSEQ - 15))) * 512 + col; *(f32x4*)o = v0; *(f32x4*)(o + 4) = v1; } }
                    }
                }
            }
    }
};
struct EpiMkv {
    static constexpr bool PERM = true, AFTER_DRAIN = false;
    bf16_t* mkb; bf16_t* mvb; float* out;
    __device__ __forceinline__ void operator()(AccRef acc, const Unit& u, int wr, int wc, int fr, int fq) const {
        const int t = u.pn >> 2;
        const int col0 = (u.pn & 3) * 256 + wc * 32 + 8 * fq;
        bf16_t* bb = t ? mvb : mkb; float* of = out + (t ? O_MVP : O_MKP);
#pragma unroll
        for (int ai = 0; ai < 2; ++ai)
#pragma unroll
            for (int m = 0; m < 4; ++m) {
                const int row = u.pm * 256 + ai * 128 + wr * 64 + m * 16 + fr;
#pragma unroll
                for (int bj = 0; bj < 2; ++bj) {
                    const int col = col0 + bj * 128;
                    const f32x4 v0 = acc[ai][bj][m][0], v1 = acc[ai][bj][m][1];
                    *(u32x4*)(bb + (size_t)row * 1024 + col) = pack8(v0, v1);
                    *(f32x4*)(of + (size_t)row * 1024 + col) = v0; *(f32x4*)(of + (size_t)row * 1024 + col + 4) = v1;
                }
            }
    }
};
template <int MODE> struct EpiRes {
    static constexpr bool PERM = true, AFTER_DRAIN = false;
    const float* xP; const float* xS; const bf16_t* resB; bf16_t* xo; float* yo; float* ssqp;
    __device__ __forceinline__ void operator()(AccRef acc, const Unit& u, int wr, int wc, int fr, int fq) const {
        const int col0 = u.pn * 256 + wc * 32 + 8 * fq;
#pragma unroll
        for (int ai = 0; ai < 2; ++ai)
#pragma unroll
            for (int m = 0; m < 4; ++m) {
                const int row = u.pm * 256 + ai * 128 + wr * 64 + m * 16 + fr;
                float ss = 0.f;
#pragma unroll
                for (int bj = 0; bj < 2; ++bj) {
                    const int col = col0 + bj * 128;
                    f32x4 r0, r1;
                    if (MODE == 0) { const float* xr = (row < MP) ? xP + (size_t)row * DM : xS + (size_t)(row - MP) * DM; r0 = *(const f32x4*)(xr + col); r1 = *(const f32x4*)(xr + col + 4); }
                    else { const u32x4 w = *(const u32x4*)(resB + (size_t)row * DM + col); r0 = (f32x4){bf_lo(w.x), bf_hi(w.x), bf_lo(w.y), bf_hi(w.y)}; r1 = (f32x4){bf_lo(w.z), bf_hi(w.z), bf_lo(w.w), bf_hi(w.w)}; }
                    const f32x4 v0 = acc[ai][bj][m][0] + r0, v1 = acc[ai][bj][m][1] + r1;
                    ss += (v0[0] * v0[0] + v0[1] * v0[1]) + (v0[2] * v0[2] + v0[3] * v0[3]) + (v1[0] * v1[0] + v1[1] * v1[1]) + (v1[2] * v1[2] + v1[3] * v1[3]);
                    if (MODE == 2) { float* yr = (row < MP) ? yo + O_YP + (size_t)row * DM : yo + O_YS + (size_t)(row - MP) * DM; *(f32x4*)(yr + col) = v0; *(f32x4*)(yr + col + 4) = v1; }
                    else *(u32x4*)(xo + (size_t)row * DM + col) = pack8(v0, v1);
                }
                ss += __shfl_xor(ss, 16); ss += __shfl_xor(ss, 32);
                if (fq == 0) ssqp[(size_t)row * 16 + u.pn * 4 + wc] = ss;
            }
    }
};
__device__ __forceinline__ float row_rsq(const float* ssqp, int row) {
    const f32x4* sp = (const f32x4*)(ssqp + (size_t)row * 16);
    const f32x4 a = sp[0], b = sp[1], c = sp[2], d = sp[3];
    const float s = ((a[0] + a[1]) + (a[2] + a[3])) + ((b[0] + b[1]) + (b[2] + b[3])) + ((c[0] + c[1]) + (c[2] + c[3])) + ((d[0] + d[1]) + (d[2] + d[3]));
    return rsq(s);
}
struct EpiMq {
    static constexpr bool PERM = true, AFTER_DRAIN = false;
    const float* ssqp; bf16_t* mq;
    __device__ __forceinline__ void operator()(AccRef acc, const Unit& u, int wr, int wc, int fr, int fq) const {
        const int col0 = u.pn * 256 + wc * 32 + 8 * fq;
#pragma unroll
        for (int ai = 0; ai < 2; ++ai)
#pragma unroll
            for (int m = 0; m < 4; ++m) {
                const int row = u.pm * 256 + ai * 128 + wr * 64 + m * 16 + fr;
                const float r = row_rsq(ssqp, row) * C2M;
#pragma unroll
                for (int bj = 0; bj < 2; ++bj) *(u32x4*)(mq + (size_t)row * DM + col0 + bj * 128) = pack8(acc[ai][bj][m][0] * r, acc[ai][bj][m][1] * r);
            }
    }
};
struct EpiUp {
    static constexpr bool PERM = true, AFTER_DRAIN = false;
    const float* ssqp; const float* cw; const float* cb; bf16_t* hff; float* ahead; float* atail; float* bhead;
    __device__ __forceinline__ void operator()(AccRef acc, const Unit& u, int wr, int wc, int fr, int fq) const {
        const int lane = fq * 16 + fr;
        const int c0 = u.pn * 128 + wc * 32 + 8 * fq;
        f32x4 w0[2], w1[2], w2[2], bb[2];
#pragma unroll
        for (int n = 0; n < 2; ++n) { w0[n] = *(const f32x4*)(cw + c0 + 4 * n); w1[n] = *(const f32x4*)(cw + DFF + c0 + 4 * n); w2[n] = *(const f32x4*)(cw + 2 * DFF + c0 + 4 * n); bb[n] = *(const f32x4*)(cb + c0 + 4 * n); }
        const int src1 = (lane & 48) | ((fr + 15) & 15), src2 = (lane & 48) | ((fr + 14) & 15);
#pragma unroll
        for (int ai = 0; ai < 2; ++ai) {
            const int seg = u.pm * 4 + ai * 2 + wr;
            const int rowb = u.pm * 256 + ai * 128 + wr * 64;
            f32x4 ap[2] = {{0.f, 0.f, 0.f, 0.f}, {0.f, 0.f, 0.f, 0.f}};
#pragma unroll
            for (int m = 0; m < 4; ++m) {
                const int row = rowb + m * 16 + fr;
                const float r = row_rsq(ssqp, row);
                f32x4 a[2], b[2], h[2];
#pragma unroll
                for (int n = 0; n < 2; ++n) {
                    a[n] = acc[ai][0][m][n] * r; b[n] = acc[ai][1][m][n] * r;
                    f32x4 a1, a2;
#pragma unroll
                    for (int e = 0; e < 4; ++e) {
                        const float x1 = (fr == 15) ? ap[n][e] : a[n][e]; a1[e] = __shfl(x1, src1);
                        const float x2 = (fr >= 14) ? ap[n][e] : a[n][e]; a2[e] = __shfl(x2, src2);
                    }
                    const f32x4 cv = bb[n] + w0[n] * a2 + w1[n] * a1 + w2[n] * a[n];
#pragma unroll
                    for (int e = 0; e < 4; ++e) h[n][e] = cv[e] * __builtin_amdgcn_rcpf(1.0f + __builtin_amdgcn_exp2f(-cv[e] * LOG2E)) * b[n][e];
                    ap[n] = a[n];
                }
                if (m == 0 && fr < 2) {
                    float* pa = ahead + ((size_t)seg * 2 + fr) * DFF + c0; float* pb = bhead + ((size_t)seg * 2 + fr) * DFF + c0;
                    *(f32x4*)pa = a[0]; *(f32x4*)(pa + 4) = a[1]; *(f32x4*)pb = b[0]; *(f32x4*)(pb + 4) = b[1];
                } else {
                    *(u32x4*)(hff + (size_t)row * DFF + c0) = pack8(h[0], h[1]);
                }
                if (m == 3 && fr >= 14) { float* pt = atail + ((size_t)seg * 2 + (fr - 14)) * DFF + c0; *(f32x4*)pt = a[0]; *(f32x4*)(pt + 4) = a[1]; }
            }
        }
    }
};

template <int MODE>
__device__ __forceinline__ void small_gemm_sample(LAS unsigned char* L, int tile, const bf16_t* __restrict__ A, int lda, const bf16_t* __restrict__ Bt, int ldb, int K,
                                                  const float* __restrict__ xS, const bf16_t* __restrict__ resB, bf16_t* __restrict__ xo, float* __restrict__ yo, float* __restrict__ ssq_out, const float* __restrict__ ssq_in) {
    const int tid = threadIdx.x, lane = lane_op(), wid = __builtin_amdgcn_readfirstlane(tid >> 6), r32 = lane & 31, hi = lane >> 5;
    const int rb = wid & 1, kq = wid >> 1, tm = tile >> 4, tn = tile & 15;
    const int row0 = MP + tm * 64 + rb * 32, col0 = tn * 64, kper = K >> 2, k0 = kq * kper;
    const bf16_t* ap = A + (size_t)(row0 + r32) * lda + k0 + hi * 8;
    const bf16_t* bp0 = Bt + (size_t)(col0 + r32) * ldb + k0 + hi * 8;
    const bf16_t* bp1 = bp0 + (size_t)32 * ldb;
    f32x16 acc0, acc1;
#pragma unroll
    for (int r = 0; r < 16; ++r) { acc0[r] = 0.f; acc1[r] = 0.f; }
    for (int s0 = 0; s0 < kper; s0 += 128) {
        const int nst = (kper - s0) >> 4;
        bf16x8 af[8], b0[8], b1[8];
#pragma unroll
        for (int i = 0; i < 8; ++i) { if (i < nst) { af[i] = *(const bf16x8*)(ap + s0 + 16 * i); b0[i] = *(const bf16x8*)(bp0 + s0 + 16 * i); b1[i] = *(const bf16x8*)(bp1 + s0 + 16 * i); } }
#pragma unroll
        for (int i = 0; i < 8; ++i) { if (i < nst) { acc0 = __builtin_amdgcn_mfma_f32_32x32x16_bf16(af[i], b0[i], acc0, 0, 0, 0); acc1 = __builtin_amdgcn_mfma_f32_32x32x16_bf16(af[i], b1[i], acc1, 0, 0, 0); } }
    }
    LAS float* Mg = (LAS float*)L;
    __syncthreads();
    if (kq > 0) {
#pragma unroll
        for (int r = 0; r < 16; ++r) { Mg[(wid * 33 + r) * 64 + lane] = acc0[r]; Mg[(wid * 33 + 16 + r) * 64 + lane] = acc1[r]; }
    }
    __syncthreads();
    if (kq == 0) {
#pragma unroll
        for (int g = 1; g < 4; ++g)
#pragma unroll
            for (int r = 0; r < 16; ++r) { acc0[r] += Mg[((2 * g + rb) * 33 + r) * 64 + lane]; acc1[r] += Mg[((2 * g + rb) * 33 + 16 + r) * 64 + lane]; }
#pragma unroll
        for (int r = 0; r < 16; ++r) {
            const int row = row0 + crow(r, hi), c0 = col0 + r32, c1 = c0 + 32;
            float v0 = acc0[r], v1 = acc1[r];
            if (MODE == 0) { v0 += xS[(size_t)(row - MP) * DM + c0]; v1 += xS[(size_t)(row - MP) * DM + c1]; }
            else if (MODE == 1 || MODE == 2) { v0 += bf_lo((unsigned)resB[(size_t)row * DM + c0]); v1 += bf_lo((unsigned)resB[(size_t)row * DM + c1]); }
            else { const float rs = row_rsq(ssq_in, row) * C2M; v0 *= rs; v1 *= rs; }
            if (MODE == 2) { yo[O_YS + (size_t)(row - MP) * DM + c0] = v0; yo[O_YS + (size_t)(row - MP) * DM + c1] = v1; }
            else { xo[(size_t)row * DM + c0] = (bf16_t)(cvt_pk_bf16(v0, 0.f) & 0xffffu); xo[(size_t)row * DM + c1] = (bf16_t)(cvt_pk_bf16(v1, 0.f) & 0xffffu); }
            if (MODE != 3) {
                float ss = v0 * v0 + v1 * v1;
                ss += __shfl_xor(ss, 1); ss += __shfl_xor(ss, 2); ss += __shfl_xor(ss, 4); ss += __shfl_xor(ss, 8); ss += __shfl_xor(ss, 16);
                if (r32 == 0) ssq_out[(size_t)row * 16 + tn] = ss;
            }
        }
    }
    __syncthreads();
}
template <int D, int KT, int KG, bool PF, bool QLDS, bool CAUSAL, bool BIAS>
__device__ __forceinline__ void attn_unit(LAS unsigned char* L, const bf16_t* __restrict__ Q, int ldq, int nq,
                                          const bf16_t* __restrict__ K0, const bf16_t* __restrict__ V0, int nt0, const bf16_t* __restrict__ K1, const bf16_t* __restrict__ V1, int ldk, int ntiles,
                                          const float* __restrict__ kbias, int qpos0, bf16_t* __restrict__ O, int ldo) {
    constexpr int KS = D + 8, VS = KT + 4, CH = D / 8, NKI = KT * CH / 512, NVI = ((KT / 2) * CH + 511) / 512, NQF = (D == 64) ? 4 : 1, NP = KT / 32, QW = 8 / KG;
    constexpr int TILEB = KT * KS * 2 + D * VS * 2 + (BIAS ? KT * 4 : 0);
    constexpr int QBYTES = QLDS ? 32 * QW * KS * 2 : 0;
    constexpr int NG = (KG == 1) ? 2 : (!PF ? 1 : KG);
    const int tid = threadIdx.x, lane = lane_op(), wid = __builtin_amdgcn_readfirstlane(tid >> 6), r32 = lane & 31, hi = lane >> 5;
    const int qw = wid % QW, kg = wid / QW;
    const bool wact = qw * 32 < nq;
    LAS unsigned char* T = L + QBYTES;
    const LAS bf16_t* Qs = (const LAS bf16_t*)L + (qw * 32 + r32) * KS + hi * 8;
    const bf16_t* qrow = Q + (size_t)(qw * 32 + r32) * ldq + hi * 8;
    bf16x8 qf[NQF];
    if (D == 64 && !QLDS) {
#pragma unroll
        for (int ds = 0; ds < NQF; ++ds) qf[ds] = wact ? *(const bf16x8*)(qrow + ds * 16) : (bf16x8){0, 0, 0, 0, 0, 0, 0, 0};
    }
    if (QLDS) {
        __syncthreads();
        constexpr int NQI = 32 * QW * CH / 512;
#pragma unroll
        for (int i = 0; i < NQI; ++i) { const int id = tid + 512 * i, row = id / CH, ch = id % CH; if (row < nq) *(LAS u32x4*)((LAS bf16_t*)L + row * KS + ch * 8) = *(const u32x4*)(Q + (size_t)row * ldq + ch * 8); }
    }
    float ref = 0.f;
    if (BIAS) ref = wact ? kbias[qpos0 + qw * 32 + r32] : 0.f;
    f32x16 o[D / 32];
#pragma unroll
    for (int db = 0; db < D / 32; ++db)
#pragma unroll
        for (int r = 0; r < 16; ++r) o[db][r] = 0.f;
    float lrun = 0.f;
    u32x4 kreg[NG][NKI], vreg[NG][NVI][2]; float breg[NG];
#define ATT_LOAD(j, g) do { const bf16_t* Kt_ = ((j) < nt0) ? K0 + (size_t)(j) * KT * ldk : K1 + (size_t)((j) - nt0) * KT * ldk; \
        const bf16_t* Vg_ = ((j) < nt0) ? V0 + (size_t)(j) * KT * ldk : V1 + (size_t)((j) - nt0) * KT * ldk; \
        _Pragma("unroll") for (int i_ = 0; i_ < NKI; ++i_) { const int id_ = tid + 512 * i_, row_ = id_ / CH, ch_ = id_ % CH; kreg[g][i_] = *(const u32x4*)(Kt_ + (size_t)row_ * ldk + ch_ * 8); } \
        _Pragma("unroll") for (int i_ = 0; i_ < NVI; ++i_) { const int id_ = tid + 512 * i_; if (id_ < (KT / 2) * CH) { const int pr_ = id_ % (KT / 2), ch_ = id_ / (KT / 2); \
            vreg[g][i_][0] = *(const u32x4*)(Vg_ + (size_t)(2 * pr_) * ldk + ch_ * 8); vreg[g][i_][1] = *(const u32x4*)(Vg_ + (size_t)(2 * pr_ + 1) * ldk + ch_ * 8); } } \
        if (BIAS && tid < KT) breg[g] = kbias[(j) * KT + tid]; } while (0)
#define ATT_STORE(TB, g) do { LAS bf16_t* Ks_ = (LAS bf16_t*)(TB); LAS bf16_t* Vt_ = (LAS bf16_t*)((TB) + KT * KS * 2); \
        _Pragma("unroll") for (int i_ = 0; i_ < NKI; ++i_) { const int id_ = tid + 512 * i_, row_ = id_ / CH, ch_ = id_ % CH; *(LAS u32x4*)(Ks_ + row_ * KS + ch_ * 8) = kreg[g][i_]; } \
        _Pragma("unroll") for (int i_ = 0; i_ < NVI; ++i_) { const int id_ = tid + 512 * i_; if (id_ < (KT / 2) * CH) { const int pr_ = id_ % (KT / 2), ch_ = id_ / (KT / 2); \
            _Pragma("unroll") for (int e_ = 0; e_ < 4; ++e_) { const unsigned lo_ = vreg[g][i_][0][e_], h2_ = vreg[g][i_][1][e_]; \
                *(LAS unsigned*)(Vt_ + (ch_ * 8 + 2 * e_) * VS + 2 * pr_) = (lo_ & 0xffffu) | (h2_ << 16); \
                *(LAS unsigned*)(Vt_ + (ch_ * 8 + 2 * e_ + 1) * VS + 2 * pr_) = (lo_ >> 16) | (h2_ & 0xffff0000u); } } } \
        if (BIAS && tid < KT) ((LAS float*)((TB) + KT * KS * 2 + D * VS * 2))[tid] = breg[g]; } while (0)
#define ATT_COMPUTE(j, TB) do { const LAS bf16_t* Ks_ = (const LAS bf16_t*)(TB); const LAS bf16_t* Vt_ = (const LAS bf16_t*)((TB) + KT * KS * 2); const LAS float* Bs_ = (const LAS float*)((TB) + KT * KS * 2 + D * VS * 2); \
        if (wact && (!CAUSAL || KT * (j) <= qpos0 + qw * 32 + 31)) { \
            f32x16 p[NP]; \
            const bf16_t* qr_ = qrow; if (D != 64 && !QLDS) asm volatile("" : "+v"(qr_)); \
            _Pragma("unroll") for (int h_ = 0; h_ < NP; ++h_) { \
                if (BIAS) { _Pragma("unroll") for (int i_ = 0; i_ < 4; ++i_) { const f32x4 t0_ = *(const LAS f32x4*)(Bs_ + 32 * h_ + 8 * i_ + 4 * hi); \
                        _Pragma("unroll") for (int e_ = 0; e_ < 4; ++e_) p[h_][4 * i_ + e_] = t0_[e_] - ref; } } \
                else { _Pragma("unroll") for (int r_ = 0; r_ < 16; ++r_) p[h_][r_] = 0.f; } } \
            _Pragma("unroll") for (int ds_ = 0; ds_ < D / 16; ++ds_) { \
                bf16x8 qv_; if (QLDS) qv_ = *(const LAS bf16x8*)(Qs + ds_ * 16); else if (D == 64) qv_ = qf[ds_]; else qv_ = *(const bf16x8*)(qr_ + ds_ * 16); \
                _Pragma("unroll") for (int h_ = 0; h_ < NP; ++h_) { const bf16x8 kf_ = *(const LAS bf16x8*)(Ks_ + (32 * h_ + r32) * KS + ds_ * 16 + hi * 8); p[h_] = __builtin_amdgcn_mfma_f32_32x32x16_bf16(kf_, qv_, p[h_], 0, 0, 0); } } \
            if (CAUSAL && (KT * (j) + KT - 1 > qpos0 + qw * 32)) { const int lim_ = qpos0 + qw * 32 + r32 - KT * (j); \
                _Pragma("unroll") for (int h_ = 0; h_ < NP; ++h_) _Pragma("unroll") for (int r_ = 0; r_ < 16; ++r_) { if (crow(r_, hi) + 32 * h_ > lim_) p[h_][r_] = NEGBIG; } } \
            float sum_ = 0.f; \
            _Pragma("unroll") for (int h_ = 0; h_ < NP; ++h_) _Pragma("unroll") for (int r_ = 0; r_ < 16; ++r_) { p[h_][r_] = __builtin_amdgcn_exp2f(p[h_][r_]); sum_ += p[h_][r_]; } \
            lrun += sum_; \
            u32x4 pw_[2 * NP]; \
            _Pragma("unroll") for (int h_ = 0; h_ < NP; ++h_) _Pragma("unroll") for (int e_ = 0; e_ < 4; ++e_) { pw_[2 * h_][e_] = pg8::cvt_pk_bf16(p[h_][2 * e_], p[h_][2 * e_ + 1]); pw_[2 * h_ + 1][e_] = pg8::cvt_pk_bf16(p[h_][8 + 2 * e_], p[h_][9 + 2 * e_]); } \
            _Pragma("unroll") for (int db_ = 0; db_ < D / 32; ++db_) _Pragma("unroll") for (int ks_ = 0; ks_ < 2 * NP; ++ks_) { \
                const LAS bf16_t* vp_ = Vt_ + (db_ * 32 + r32) * VS + ks_ * 16 + hi * 4; \
                const u32x2 va_ = *(const LAS u32x2*)vp_, vb_ = *(const LAS u32x2*)(vp_ + 8); const u32x4 vv_ = {va_.x, va_.y, vb_.x, vb_.y}; \
                o[db_] = __builtin_amdgcn_mfma_f32_32x32x16_bf16(__builtin_bit_cast(bf16x8, vv_), __builtin_bit_cast(bf16x8, pw_[ks_]), o[db_], 0, 0, 0); } \
        } } while (0)
#define ATT_ACT(j) (wact && (!CAUSAL || KT * (j) <= qpos0 + qw * 32 + 31))
#define ATT_QK(j, TB, P) do { if (ATT_ACT(j)) { const LAS bf16_t* Ks_ = (const LAS bf16_t*)(TB); const LAS float* Bs_ = (const LAS float*)((TB) + KT * KS * 2 + D * VS * 2); \
            _Pragma("unroll") for (int h_ = 0; h_ < NP; ++h_) { \
                if (BIAS) { _Pragma("unroll") for (int i_ = 0; i_ < 4; ++i_) { const f32x4 t0_ = *(const LAS f32x4*)(Bs_ + 32 * h_ + 8 * i_ + 4 * hi); \
                        _Pragma("unroll") for (int e_ = 0; e_ < 4; ++e_) P[h_][4 * i_ + e_] = t0_[e_] - ref; } } \
                else { _Pragma("unroll") for (int r_ = 0; r_ < 16; ++r_) P[h_][r_] = 0.f; } } \
            _Pragma("unroll") for (int ds_ = 0; ds_ < D / 16; ++ds_) { \
                const bf16x8 qv_ = qf[ds_ % NQF]; \
                _Pragma("unroll") for (int h_ = 0; h_ < NP; ++h_) { const bf16x8 kf_ = *(const LAS bf16x8*)(Ks_ + (32 * h_ + r32) * KS + ds_ * 16 + hi * 8); P[h_] = __builtin_amdgcn_mfma_f32_32x32x16_bf16(kf_, qv_, P[h_], 0, 0, 0); } } \
            if (CAUSAL && (KT * (j) + KT - 1 > qpos0 + qw * 32)) { const int lim_ = qpos0 + qw * 32 + r32 - KT * (j); \
                _Pragma("unroll") for (int h_ = 0; h_ < NP; ++h_) _Pragma("unroll") for (int r_ = 0; r_ < 16; ++r_) { if (crow(r_, hi) + 32 * h_ > lim_) P[h_][r_] = NEGBIG; } } \
        } } while (0)
#define ATT_SMPV(j, TB, P) do { if (ATT_ACT(j)) { const LAS bf16_t* Vt_ = (const LAS bf16_t*)((TB) + KT * KS * 2); \
            float sum_ = 0.f; \
            _Pragma("unroll") for (int h_ = 0; h_ < NP; ++h_) _Pragma("unroll") for (int r_ = 0; r_ < 16; ++r_) { P[h_][r_] = __builtin_amdgcn_exp2f(P[h_][r_]); sum_ += P[h_][r_]; } \
            lrun += sum_; \
            u32x4 pw_[2 * NP]; \
            _Pragma("unroll") for (int h_ = 0; h_ < NP; ++h_) _Pragma("unroll") for (int e_ = 0; e_ < 4; ++e_) { pw_[2 * h_][e_] = pg8::cvt_pk_bf16(P[h_][2 * e_], P[h_][2 * e_ + 1]); pw_[2 * h_ + 1][e_] = pg8::cvt_pk_bf16(P[h_][8 + 2 * e_], P[h_][9 + 2 * e_]); } \
            _Pragma("unroll") for (int db_ = 0; db_ < D / 32; ++db_) _Pragma("unroll") for (int ks_ = 0; ks_ < 2 * NP; ++ks_) { \
                const LAS bf16_t* vp_ = Vt_ + (db_ * 32 + r32) * VS + ks_ * 16 + hi * 4; \
                const u32x2 va_ = *(const LAS u32x2*)vp_, vb_ = *(const LAS u32x2*)(vp_ + 8); const u32x4 vv_ = {va_.x, va_.y, vb_.x, vb_.y}; \
                o[db_] = __builtin_amdgcn_mfma_f32_32x32x16_bf16(__builtin_bit_cast(bf16x8, vv_), __builtin_bit_cast(bf16x8, pw_[ks_]), o[db_], 0, 0, 0); } \
        } } while (0)
#define ATT_BUF(t) (T + ((t) % 3) * TILEB)
    if (KG == 1 && D == 64 && !QLDS && SWPIPE) {
        f32x16 pA[NP], pB[NP];
        ATT_LOAD(0, 0); ATT_STORE(ATT_BUF(0), 0);
        if (ntiles > 1) { ATT_LOAD(1, 1); ATT_STORE(ATT_BUF(1), 1); }
        if (ntiles > 2) ATT_LOAD(2, 0);
        if (ntiles > 3) ATT_LOAD(3, 1);
        __syncthreads();
        ATT_QK(0, ATT_BUF(0), pA);
        for (int j = 0; j < ntiles; j += 2) {
            if (j + 2 < ntiles) ATT_STORE(ATT_BUF(j + 2), 0);
            if (j + 4 < ntiles) ATT_LOAD(j + 4, 0);
            if (j + 1 < ntiles) ATT_QK(j + 1, ATT_BUF(j + 1), pB);
            ATT_SMPV(j, ATT_BUF(j), pA);
            __syncthreads();
            if (j + 1 < ntiles) {
                if (j + 3 < ntiles) ATT_STORE(ATT_BUF(j + 3), 1);
                if (j + 5 < ntiles) ATT_LOAD(j + 5, 1);
                if (j + 2 < ntiles) ATT_QK(j + 2, ATT_BUF(j + 2), pA);
                ATT_SMPV(j + 1, ATT_BUF(j + 1), pB);
                __syncthreads();
            }
        }
    } else if (KG == 1) {
        ATT_LOAD(0, 0); ATT_STORE(T, 0); if (ntiles > 1) ATT_LOAD(1, 1); if (ntiles > 2) ATT_LOAD(2, 0);
        __syncthreads();
        for (int j = 0; j < ntiles; j += 2) {
            if (j + 1 < ntiles) ATT_STORE(T + TILEB, 1);
            if (j + 3 < ntiles) ATT_LOAD(j + 3, 1);
            ATT_COMPUTE(j, T);
            __syncthreads();
            if (j + 1 < ntiles) {
                if (j + 2 < ntiles) ATT_STORE(T, 0);
                if (j + 4 < ntiles) ATT_LOAD(j + 4, 0);
                ATT_COMPUTE(j + 1, T + TILEB);
                __syncthreads();
            }
        }
    } else {
        const int nsteps = (ntiles + KG - 1) / KG;
        if (PF) {
#pragma unroll
            for (int g = 0; g < NG; ++g) { if (g < ntiles) ATT_LOAD(g, g); }
        }
        for (int s = 0; s < nsteps; ++s) {
            __syncthreads();
            if (PF) {
#pragma unroll
                for (int g = 0; g < NG; ++g) { if (s * KG + g < ntiles) ATT_STORE(T + g * TILEB, g); }
            } else {
#pragma unroll
                for (int g = 0; g < KG; ++g) { const int jt = s * KG + g; if (jt < ntiles) { ATT_LOAD(jt, 0); ATT_STORE(T + g * TILEB, 0); } }
            }
            __syncthreads();
            if (PF && s + 1 < nsteps) {
#pragma unroll
                for (int g = 0; g < NG; ++g) { const int jt = (s + 1) * KG + g; if (jt < ntiles) ATT_LOAD(jt, g); }
            }
            const int jm = s * KG + kg;
            if (jm < ntiles) ATT_COMPUTE(jm, T + kg * TILEB);
        }
        constexpr int MB = (D / 32 < 4) ? D / 32 : 4, MR = MB * 16 + 1;
        LAS float* Mg = (LAS float*)L;
#pragma unroll
        for (int d0 = 0; d0 < D / 32; d0 += MB) {
            __syncthreads();
#pragma unroll
            for (int db = 0; db < MB; ++db)
#pragma unroll
                for (int r = 0; r < 16; ++r) Mg[(wid * MR + db * 16 + r) * 64 + lane] = o[d0 + db][r];
            if (d0 == 0) Mg[(wid * MR + MB * 16) * 64 + lane] = lrun;
            __syncthreads();
            if (kg == 0) {
#pragma unroll
                for (int g = 1; g < KG; ++g) {
#pragma unroll
                    for (int db = 0; db < MB; ++db)
#pragma unroll
                        for (int r = 0; r < 16; ++r) o[d0 + db][r] += Mg[((g * QW + qw) * MR + db * 16 + r) * 64 + lane];
                    if (d0 == 0) lrun += Mg[((g * QW + qw) * MR + MB * 16) * 64 + lane];
                }
            }
        }
        __syncthreads();
    }
#undef ATT_LOAD
#undef ATT_STORE
#undef ATT_COMPUTE
#undef ATT_ACT
#undef ATT_QK
#undef ATT_SMPV
#undef ATT_BUF
    if (kg == 0 && wact) {
        const float lt = lrun + __shfl_xor(lrun, 32), inv = 1.0f / lt;
        bf16_t* orow = O + (size_t)(qw * 32 + r32) * ldo;
#pragma unroll
        for (int db = 0; db < D / 32; ++db)
#pragma unroll
            for (int i = 0; i < 4; ++i) { u32x2 w; w.x = pg8::cvt_pk_bf16(o[db][4 * i] * inv, o[db][4 * i + 1] * inv); w.y = pg8::cvt_pk_bf16(o[db][4 * i + 2] * inv, o[db][4 * i + 3] * inv);
                *(u32x2*)(orow + db * 32 + 8 * i + 4 * hi) = w; }
    }
}

constexpr int POOL_RS = 272, POOL_SLAB = 48 * POOL_RS;
template <int G>
__device__ __forceinline__ void pool_group(LAS unsigned char* slab, const char* __restrict__ ubase, unsigned rowoff0, int nprev0, int nprev, float icnt, const bf16_t* __restrict__ wpt, bf16_t* __restrict__ orow, int lane, int r32, int hi) {
    constexpr int w = 2 << G;
    {
        u32x4 st[12];
#pragma unroll
        for (int k = 0; k < 12; ++k) { const int id = lane + 64 * k, row = id >> 4, ch = id & 15; const int rr = (15 - row <= nprev0) ? row : 15;
            if (row < 47) st[k] = *(const u32x4*)(ubase + (rowoff0 + (unsigned)(rr - 15) * 1024u + (unsigned)(G * 256 + ch * 16))); }
#pragma unroll
        for (int k = 0; k < 12; ++k) { const int id = lane + 64 * k, row = id >> 4, ch = id & 15; if (row < 47) *(LAS u32x4*)(slab + row * POOL_RS + ch * 16) = st[k]; }
    }
    bf16x8 dfr[8];
#pragma unroll
    for (int ks = 0; ks < 8; ++ks) {
        const LAS unsigned char* cp = slab + (15 + r32) * POOL_RS + (ks * 16 + hi * 8) * 2;
        const u32x4 cu = *(const LAS u32x4*)cp;
        float s[8], cur[8];
        cur[0] = bf_lo(cu.x); cur[1] = bf_hi(cu.x); cur[2] = bf_lo(cu.y); cur[3] = bf_hi(cu.y); cur[4] = bf_lo(cu.z); cur[5] = bf_hi(cu.z); cur[6] = bf_lo(cu.w); cur[7] = bf_hi(cu.w);
#pragma unroll
        for (int e = 0; e < 8; ++e) s[e] = cur[e];
#pragma unroll
        for (int j = 1; j < w; ++j) {
            const float wt = (j <= nprev) ? 1.f : 0.f;
            const u32x4 v = *(const LAS u32x4*)(cp - j * POOL_RS);
            s[0] += wt * bf_lo(v.x); s[1] += wt * bf_hi(v.x); s[2] += wt * bf_lo(v.y); s[3] += wt * bf_hi(v.y); s[4] += wt * bf_lo(v.z); s[5] += wt * bf_hi(v.z); s[6] += wt * bf_lo(v.w); s[7] += wt * bf_hi(v.w);
        }
        u32x4 dv;
        dv.x = cvt_pk_bf16(s[0] * icnt - cur[0], s[1] * icnt - cur[1]); dv.y = cvt_pk_bf16(s[2] * icnt - cur[2], s[3] * icnt - cur[3]);
        dv.z = cvt_pk_bf16(s[4] * icnt - cur[4], s[5] * icnt - cur[5]); dv.w = cvt_pk_bf16(s[6] * icnt - cur[6], s[7] * icnt - cur[7]);
        dfr[ks] = __builtin_bit_cast(bf16x8, dv);
        __builtin_amdgcn_sched_barrier(0);
    }
#pragma unroll
    for (int nb = 0; nb < 4; ++nb) {
        f32x16 acc;
#pragma unroll
        for (int r = 0; r < 16; ++r) acc[r] = 0.f;
        const bf16_t* wrow = wpt + ((size_t)G * 128 + nb * 32 + r32) * 128 + hi * 8;
#pragma unroll
        for (int ks = 0; ks < 8; ++ks) acc = __builtin_amdgcn_mfma_f32_32x32x16_bf16(*(const bf16x8*)(wrow + ks * 16), dfr[ks], acc, 0, 0, 0);
#pragma unroll
        for (int i = 0; i < 4; ++i) { u32x2 wv; wv.x = cvt_pk_bf16(acc[4 * i], acc[4 * i + 1]); wv.y = cvt_pk_bf16(acc[4 * i + 2], acc[4 * i + 3]);
            *(u32x2*)(orow + G * 128 + nb * 32 + 8 * i + 4 * hi) = wv; }
    }
}
__device__ __forceinline__ void pool_unit(LAS unsigned char* L, int tile, const bf16_t* __restrict__ ub, const bf16_t* __restrict__ usx, const bf16_t* __restrict__ wpt, bf16_t* __restrict__ mix) {
    const int tid = threadIdx.x, lane = lane_op(), wid = __builtin_amdgcn_readfirstlane(tid >> 6), r32 = lane & 31, hi = lane >> 5;
    const int row0 = tile * 256 + wid * 32, row = row0 + r32;
    const bool samp = tile >= 256;
    const int b0 = samp ? (row0 - MP) >> 6 : row0 >> 11, t0 = samp ? (row0 - MP) & 63 : row0 & (SEQ - 1);
    const char* ubase = (const char*)(samp ? usx : ub);
    const unsigned rowoff0 = (samp ? (unsigned)(b0 * 79 + 15 + t0) : (unsigned)row0) * 1024u;
    const int nprev0 = samp ? t0 + 15 : t0, nprev = nprev0 + r32;
    bf16_t* orow = mix + (size_t)row * DM;
    const int np1 = nprev + 1;
    LAS unsigned char* slab = L + wid * POOL_SLAB;
    pool_group<0>(slab, ubase, rowoff0, nprev0, nprev, 1.0f / (float)(np1 < 2 ? np1 : 2), wpt, orow, lane, r32, hi);
    pool_group<1>(slab, ubase, rowoff0, nprev0, nprev, 1.0f / (float)(np1 < 4 ? np1 : 4), wpt, orow, lane, r32, hi);
    pool_group<2>(slab, ubase, rowoff0, nprev0, nprev, 1.0f / (float)(np1 < 8 ? np1 : 8), wpt, orow, lane, r32, hi);
    pool_group<3>(slab, ubase, rowoff0, nprev0, nprev, 1.0f / (float)(np1 < 16 ? np1 : 16), wpt, orow, lane, r32, hi);
}

template <int MODE>
__device__ __forceinline__ void transpose_item(const float* __restrict__ W, int K, int N, int nblk, bf16_t* __restrict__ WT, int row_off, const float* __restrict__ g, LAS float* scr, int item, int lane) {
    const int kb = item / nblk, nb = item % nblk, k0 = 64 * kb, n0 = 32 * nb;
#pragma unroll 8
    for (int i = 0; i < 32; ++i) { const int kk = 2 * i + (lane >> 5); float v = W[(size_t)(k0 + kk) * N + n0 + (lane & 31)]; if (g) v *= g[k0 + kk]; scr[kk * 33 + (lane & 31)] = v; }
    LDS_WAIT();
    const int c = lane & 7;
#pragma unroll
    for (int j = 0; j < 4; ++j) {
        const int n = (lane >> 3) + 8 * j; const LAS float* s = scr + (8 * c) * 33 + n;
        const int nn = n0 + n; int drow;
        if (MODE == 0) drow = row_off + nn; else { const int half = nn / DFF, cc = nn % DFF; drow = (cc >> 7) * 256 + half * 128 + (cc & 127); }
        u32x4 o; o.x = cvt_pk_bf16(s[0 * 33], s[1 * 33]); o.y = cvt_pk_bf16(s[2 * 33], s[3 * 33]); o.z = cvt_pk_bf16(s[4 * 33], s[5 * 33]); o.w = cvt_pk_bf16(s[6 * 33], s[7 * 33]);
        *(u32x4*)(WT + (size_t)drow * K + k0 + 8 * c) = o;
    }
    LDS_WAIT();
}
__device__ __forceinline__ void prepass_row(const float* __restrict__ xrow, bf16_t* __restrict__ orow, const LAS float* wf, const float* __restrict__ b_f, float* __restrict__ lf_out, int lane) {
    const f32x4* xr = (const f32x4*)xrow + lane;
    f32x4 v[4]; float s = 0.f;
#pragma unroll
    for (int j = 0; j < 4; ++j) { v[j] = xr[64 * j]; s += (v[j][0] * v[j][0] + v[j][1] * v[j][1]) + (v[j][2] * v[j][2] + v[j][3] * v[j][3]); }
    const float r = rsq(wave_sum(s));
    u32x2* o8 = (u32x2*)orow + lane;
#pragma unroll
    for (int j = 0; j < 4; ++j) { v[j] = v[j] * r; u32x2 w; w.x = cvt_pk_bf16(v[j][0], v[j][1]); w.y = cvt_pk_bf16(v[j][2], v[j][3]); o8[64 * j] = w; }
    if (wf) {
        f32x4 fa = {0.f, 0.f, 0.f, 0.f}, fb = {0.f, 0.f, 0.f, 0.f};
#pragma unroll
        for (int j = 0; j < 4; ++j)
#pragma unroll
            for (int e = 0; e < 4; ++e) { const int k = 4 * (lane + 64 * j) + e; const LAS f32x4* w = (const LAS f32x4*)(wf + k * 8); fa += w[0] * v[j][e]; fb += w[1] * v[j][e]; }
#pragma unroll
        for (int e = 0; e < 4; ++e) { fa[e] = wave_sum(fa[e]); fb[e] = wave_sum(fb[e]); }
        float z = fa[0];
        z = (lane == 1) ? fa[1] : z; z = (lane == 2) ? fa[2] : z; z = (lane == 3) ? fa[3] : z; z = (lane == 4) ? fb[0] : z; z = (lane == 5) ? fb[1] : z; z = (lane == 6) ? fb[2] : z; z = (lane == 7) ? fb[3] : z;
        if (lane < 8) { z += b_f[lane]; lf_out[lane] = fminf(z, 0.f) - log1pf(expf(-fabsf(z))); }
    }
}
__device__ __forceinline__ void scan_seq(const float* s0, int n0, const float* s1, int n1, float* dst, int lane) {
    const int n = n0 + n1, Lc = n >> 6;
    float s = 0.f;
    for (int i = 0; i < Lc; ++i) { const int t = lane * Lc + i; const float* ptr = (t < n0) ? (s0 + (size_t)t * 8) : (s1 + (size_t)(t - n0) * 8); s += *ptr; }
    float inc = s;
    for (int o = 1; o < 64; o <<= 1) { const float v = __shfl_up(inc, o); if (lane >= o) inc += v; }
    float run = inc - s;
    for (int i = 0; i < Lc; ++i) { const int t = lane * Lc + i; const float* ptr = (t < n0) ? (s0 + (size_t)t * 8) : (s1 + (size_t)(t - n0) * 8); run += *ptr; dst[t] = -run * LOG2E; }
}
__device__ __forceinline__ void cvt_flat(const float* __restrict__ src, bf16_t* __restrict__ dst, size_t n8, size_t gtid, size_t gn) {
    for (size_t i = gtid; i < n8; i += gn) { const f32x4 a = *(const f32x4*)(src + i * 8), b = *(const f32x4*)(src + i * 8 + 4); *(u32x4*)(dst + i * 8) = pack8(a, b); }
}

#define Wt_in ((bf16_t*)(ws + WS_WIN))
#define Wt_o ((bf16_t*)(ws + WS_WO))
#define Wt_mq ((bf16_t*)(ws + WS_WMQ))
#define Wt_mo ((bf16_t*)(ws + WS_WMO))
#define Wt_mkv ((bf16_t*)(ws + WS_WMKV))
#define Wt_up ((bf16_t*)(ws + WS_WUP))
#define Wt_dn ((bf16_t*)(ws + WS_WDN))
#define Wt_pool ((bf16_t*)(ws + WS_WPOOL))
#define usx ((bf16_t*)(ws + WS_USX))
#define mkb ((bf16_t*)(ws + WS_MKB))
#define mvb ((bf16_t*)(ws + WS_MVB))
#define ssq1 ((float*)(ws + WS_SSQ1))
#define ssq2 ((float*)(ws + WS_SSQ2))
#define ssq3 ((float*)(ws + WS_SSQ3))
#define kbP ((float*)(ws + WS_KBP))
#define kbS ((float*)(ws + WS_KBS))
#define ahead ((float*)(ws + WS_AHEAD))
#define atail ((float*)(ws + WS_ATAIL))
#define bhead ((float*)(ws + WS_BHEAD))
#define x1b ((bf16_t*)(ws + WS_X1B))
#define kcb ((bf16_t*)(ws + WS_KCB))
#define vcb ((bf16_t*)(ws + WS_VCB))
#define x2b ((bf16_t*)(ws + WS_X2B))
#define xb ((bf16_t*)(ws + WS_XB))
#define mqb ((bf16_t*)(ws + WS_MQB))
#define hff ((bf16_t*)(ws + WS_HFF))
#define uqkv ((bf16_t*)(ws + WS_UQKV))
#define mo ((bf16_t*)(ws + WS_MO))
#define mix ((bf16_t*)(ws + WS_MIX))
#define memb ((bf16_t*)(ws + WS_MEMB))
#define ub uqkv
#define qb (uqkv + (size_t)MT * 512)
#define kb (uqkv + (size_t)2 * MT * 512)
#define vb (uqkv + (size_t)3 * MT * 512)
__global__ void __launch_bounds__(512, 2) fwd_kernel(Params p) {
    extern __shared__ __attribute__((aligned(16))) unsigned char lds_raw[];
    LAS unsigned char* L = (LAS unsigned char*)lds_raw;
    cg::grid_group grid = cg::this_grid();
    const int tid = threadIdx.x, wave = __builtin_amdgcn_readfirstlane(tid >> 6);
    const int G = gridDim.x, bx = blockIdx.x;
    unsigned char* ws = p.ws; float* out = p.out;
    const float* x_prompt = p.in[0]; const float* x_sample = p.in[1];
    const int lo = p.ph_lo, hi_ph = p.ph_hi;
    unsigned* gbar = (unsigned*)ws; unsigned kbar = 0u;
    if (lo < 0) grid.sync();
#define IN(k) (lo <= (k) && (k) < hi_ph && ((PHMASK >> (k)) & 1))
#define GSYNC() do { asm volatile("s_waitcnt vmcnt(0)" ::: "memory"); __syncthreads(); \
        if (tid == 0) { __builtin_amdgcn_fence(__ATOMIC_RELEASE, "agent"); asm volatile("s_waitcnt vmcnt(0)" ::: "memory"); \
            ++kbar; const unsigned x_ = (unsigned)bx & 7u, gsz_ = ((unsigned)G - x_ + 7u) >> 3, ngr_ = (unsigned)G < 8u ? (unsigned)G : 8u; \
            const unsigned old_ = __hip_atomic_fetch_add(gbar + 64 * (1 + x_), 1u, __ATOMIC_RELAXED, __HIP_MEMORY_SCOPE_AGENT); \
            if (old_ + 1u == gsz_ * kbar) { \
                const unsigned t_ = __hip_atomic_fetch_add(gbar + 64 * 9, 1u, __ATOMIC_RELAXED, __HIP_MEMORY_SCOPE_AGENT); \
                if (t_ + 1u != ngr_ * kbar) { while (__hip_atomic_load(gbar + 64 * 9, __ATOMIC_RELAXED, __HIP_MEMORY_SCOPE_AGENT) < ngr_ * kbar) __builtin_amdgcn_s_sleep(2); } \
                __hip_atomic_store(gbar + 64 * (10 + x_), kbar, __ATOMIC_RELAXED, __HIP_MEMORY_SCOPE_AGENT); \
            } else { while (__hip_atomic_load(gbar + 64 * (10 + x_), __ATOMIC_RELAXED, __HIP_MEMORY_SCOPE_AGENT) < kbar) __builtin_amdgcn_s_sleep(2); } \
            __builtin_amdgcn_fence(__ATOMIC_ACQUIRE, "agent"); asm volatile("s_waitcnt vmcnt(0)" ::: "memory"); } \
        __syncthreads(); } while (0)
#define SEAM(k) do { if (IN(k) && IN((k) + 1)) GSYNC(); } while (0)

    if (IN(0)) {
        const int lane = lane_op();
        const int gw = bx * 8 + wave, NGW = G * 8;
        LAS float* scr = (LAS float*)(L + wave * 8448);
        LAS float* wf = (LAS float*)(L + 8 * 8448);
        {
            const float* w_in = p.in[11]; const float* g_mix = p.in[10];
            for (int i = tid; i < 8192; i += 512) { const int k = i >> 3, h = i & 7; wf[i] = w_in[(size_t)k * 2056 + 2048 + h] * g_mix[k]; }
        }
        __syncthreads();
        constexpr int I_IN = 16 * 64, I_SQ = 16 * 32, I_UP = 16 * 176, I_DN = 44 * 32;
        constexpr int NITEMS = I_IN + 5 * I_SQ + I_UP + I_DN;
        for (int it = gw; it < NITEMS; it += NGW) {
            int r = it;
            if (r < I_IN) { transpose_item<0>(p.in[11], 1024, 2056, 64, Wt_in, 0, p.in[10], scr, r, lane); continue; } r -= I_IN;
            if (r < I_SQ) { transpose_item<0>(p.in[15], 1024, 1024, 32, Wt_o, 0, nullptr, scr, r, lane); continue; } r -= I_SQ;
            if (r < I_SQ) { transpose_item<0>(p.in[18], 1024, 1024, 32, Wt_mq, 0, p.in[16], scr, r, lane); continue; } r -= I_SQ;
            if (r < I_SQ) { transpose_item<0>(p.in[19], 1024, 1024, 32, Wt_mkv, 0, p.in[17], scr, r, lane); continue; } r -= I_SQ;
            if (r < I_SQ) { transpose_item<0>(p.in[20], 1024, 1024, 32, Wt_mkv, 1024, p.in[17], scr, r, lane); continue; } r -= I_SQ;
            if (r < I_SQ) { transpose_item<0>(p.in[21], 1024, 1024, 32, Wt_mo, 0, nullptr, scr, r, lane); continue; } r -= I_SQ;
            if (r < I_UP) { transpose_item<1>(p.in[23], 1024, NUP, 176, Wt_up, 0, p.in[22], scr, r, lane); continue; } r -= I_UP;
            transpose_item<0>(p.in[26], DFF, 1024, 32, Wt_dn, 0, nullptr, scr, r, lane);
        }
        {
            const float* w_pool = p.in[13]; const float* pscale = p.in[14];
            for (int i = bx * 512 + tid; i < 4 * 128 * 128; i += G * 512) { const int g = i >> 14, d = (i >> 7) & 127, c = i & 127; Wt_pool[i] = (bf16_t)(cvt_pk_bf16(w_pool[(g * 128 + c) * 128 + d] * pscale[g * 128 + d], 0.f) & 0xffffu); }
        }
        for (int m = gw; m < MT; m += NGW) {
            const float* xr = (m < MP) ? x_prompt + (size_t)m * DM : x_sample + (size_t)(m - MP) * DM;
            float* lf = (m < MP) ? out + O_LFP + (size_t)m * 8 : out + O_LFS + (size_t)(m - MP) * 8;
            prepass_row(xr, xb + (size_t)m * DM, wf, p.in[12], lf, lane);
        }
        for (int m = gw; m < 8192; m += NGW) prepass_row(p.in[9] + (size_t)m * DM, memb + (size_t)m * DM, (const LAS float*)nullptr, nullptr, nullptr, lane);
        const size_t gtid = (size_t)bx * 512 + tid, gn = (size_t)G * 512;
        for (size_t i = gtid; i < (size_t)16 * 15 * 512 / 8; i += gn) { const size_t e8 = i * 8, bb = e8 / (15 * 512), rem = e8 - bb * 15 * 512; const float* sp = p.in[5] + e8; *(u32x4*)(usx + bb * 79 * 512 + rem) = pack8(*(const f32x4*)sp, *(const f32x4*)(sp + 4)); }
        cvt_flat(p.in[2], kcb, (size_t)16 * PAST * 512 / 8, gtid, gn);
        cvt_flat(p.in[3], vcb, (size_t)16 * PAST * 512 / 8, gtid, gn);
        cvt_flat(p.in[7], mkb + (size_t)8192 * 1024, (size_t)4096 * 1024 / 8, gtid, gn);
        cvt_flat(p.in[8], mvb + (size_t)8192 * 1024, (size_t)4096 * 1024 / 8, gtid, gn);
        __syncthreads();
    }
    SEAM(0);

    if (IN(1)) {
        const int lane = lane_op();
        if (wave == 0) { const int s = bx; if (s < 256) scan_seq(out + O_LFP + (size_t)(s >> 3) * SEQ * 8 + (s & 7), SEQ, out + O_LFP, 0, kbP + (size_t)s * SEQ, lane); }
        if (wave == 1 && bx < 128) { const int s = bx; scan_seq(p.in[4] + (size_t)(s >> 3) * PAST * 8 + (s & 7), PAST, out + O_LFS + (size_t)(s >> 3) * DSEQ * 8 + (s & 7), DSEQ, kbS + (size_t)s * (PAST + DSEQ), lane); }
        {
            pg8::Gemm g{xb, Wt_in, MT, 2048, 1024}; pg8::StaticOrder S; S.init(MT, 2048, G, bx);
            EpiIn E{uqkv, out, usx};
            pg8::gemm_phase<EpiIn, pg8::StaticOrder, true, true>(L, g, S, E);
        }
        __syncthreads();
        {
            pg8::Gemm g{memb, Wt_mkv, 8192, 2048, 1024}; pg8::StaticOrder S; S.init(8192, 2048, G, bx);
            EpiMkv E{mkb, mvb, out};
            pg8::gemm_phase<EpiMkv, pg8::StaticOrder, true, true>(L, g, S, E);
        }
    }
    SEAM(1);

    if (IN(2)) {
        for (int it = 0; it < 8 * ((256 + G - 1) / G); ++it) {
            int bh, qk;
            if (G == 256) { const int xcd = bx & 7, l = bx >> 3, r = it >> 1, pi = l & 3; bh = xcd * 32 + r * 8 + (l >> 2); qk = (it & 1) ? pi : 7 - pi; }
            else { bh = bx + (it >> 3) * G; qk = 7 - (it & 7); if (bh >= 256) break; }
            const int b = bh >> 3, h = bh & 7;
            const bf16_t* Kh = kb + (size_t)b * SEQ * 512 + h * 64; const bf16_t* Vh = vb + (size_t)b * SEQ * 512 + h * 64;
            const size_t r0 = (size_t)b * SEQ + 256 * qk;
            attn_unit<64, 64, 1, true, false, true, true>(L, qb + r0 * 512 + h * 64, 512, 256, Kh, Vh, 4 * qk + 4, Kh, Vh, 512, 4 * qk + 4, kbP + (size_t)bh * SEQ, 256 * qk, mix + r0 * DM + 512 + h * 64, DM);
        }
        if (P2_ATTN_S) for (int bh = bx; bh < 128; bh += G) {
            const int b = bh >> 3, h = bh & 7;
            const size_t r0 = (size_t)MP + b * DSEQ;
            attn_unit<64, 64, 4, true, false, true, true>(L, qb + r0 * 512 + h * 64, 512, 64, kcb + (size_t)b * PAST * 512 + h * 64, vcb + (size_t)b * PAST * 512 + h * 64, 64,
                                      kb + r0 * 512 + h * 64, vb + r0 * 512 + h * 64, 512, 65, kbS + (size_t)bh * (PAST + DSEQ), PAST, mix + r0 * DM + 512 + h * 64, DM);
        }
        if (G == 256) { __syncthreads(); pool_unit(L, bx, ub, usx, Wt_pool, mix); if (bx >= 128 && bx < 132) pool_unit(L, 128 + bx, ub, usx, Wt_pool, mix); }
        else { __syncthreads(); for (int t = bx; t < MT / 256; t += G) pool_unit(L, t, ub, usx, Wt_pool, mix); }
        __syncthreads();
    }
    SEAM(2);

    if (IN(3)) {
        const int MG = (G == 256) ? MP : MT;
        pg8::Gemm g{mix, Wt_o, MG, 1024, 1024}; pg8::StaticOrder S; S.init(MG, 1024, G, bx);
        EpiRes<0> E{x_prompt, x_sample, nullptr, x1b, nullptr, ssq1};
        pg8::gemm_phase<EpiRes<0>, pg8::StaticOrder, true, true>(L, g, S, E);
        if (G == 256) small_gemm_sample<0>(L, bx, mix, 1024, Wt_o, 1024, 1024, x_sample, nullptr, x1b, nullptr, ssq1, nullptr);
    }
    SEAM(3);

    if (IN(4)) {
        const int MG = (G == 256) ? MP : MT;
        pg8::Gemm g{x1b, Wt_mq, MG, 1024, 1024}; pg8::StaticOrder S; S.init(MG, 1024, G, bx);
        EpiMq E{ssq1, mqb};
        pg8::gemm_phase<EpiMq, pg8::StaticOrder, true, true>(L, g, S, E);
        if (G == 256) small_gemm_sample<3>(L, bx, x1b, 1024, Wt_mq, 1024, 1024, nullptr, nullptr, mqb, nullptr, nullptr, ssq1);
    }
    SEAM(4);

    if (IN(5)) {
        for (int k5 = 0; k5 * G < 2048 + 64; ++k5) {
            const int un = (G == 256 && k5 < 8) ? (((k5 * 8 + (bx & 7)) * 32) + (bx >> 3)) : (k5 * G + bx);
            if (un >= 2048 + 64) break;
            if (un < 2048) {
                const int b = un >> 6, h = (un >> 4) & 3, qk = un & 15;
                const size_t r0 = (size_t)b * SEQ + 128 * qk;
                const bf16_t* Kh = mkb + (size_t)b * NMEM * 1024 + h * 256; const bf16_t* Vh = mvb + (size_t)b * NMEM * 1024 + h * 256;
                attn_unit<256, 32, 2, false, true, false, false>(L, mqb + r0 * DM + h * 256, DM, 128, Kh, Vh, 8, Kh, Vh, 1024, 8, nullptr, 0, mo + r0 * DM + h * 256, DM);
            } else {
                const int us = un - 2048, b = us >> 2, h = us & 3;
                const size_t r0 = (size_t)MP + b * DSEQ;
                const bf16_t* Kh = mkb + (size_t)(8192 + b * NMEM) * 1024 + h * 256; const bf16_t* Vh = mvb + (size_t)(8192 + b * NMEM) * 1024 + h * 256;
                attn_unit<256, 32, 2, false, true, false, false>(L, mqb + r0 * DM + h * 256, DM, 64, Kh, Vh, 8, Kh, Vh, 1024, 8, nullptr, 0, mo + r0 * DM + h * 256, DM);
            }
        }
        __syncthreads();
    }
    SEAM(5);

    if (IN(6)) {
        const int MG = (G == 256) ? MP : MT;
        pg8::Gemm g{mo, Wt_mo, MG, 1024, 1024}; pg8::StaticOrder S; S.init(MG, 1024, G, bx);
        EpiRes<1> E{nullptr, nullptr, x1b, x2b, nullptr, ssq2};
        pg8::gemm_phase<EpiRes<1>, pg8::StaticOrder, true, true>(L, g, S, E);
        if (G == 256) small_gemm_sample<1>(L, bx, mo, 1024, Wt_mo, 1024, 1024, nullptr, x1b, x2b, nullptr, ssq2, nullptr);
    }
    SEAM(6);

    if (IN(7)) {
        pg8::Gemm g{x2b, Wt_up, MT, NUP, 1024}; pg8::StaticOrder S; S.init(MT, NUP, G, bx);
        EpiUp E{ssq2, p.in[24], p.in[25], hff, ahead, atail, bhead};
        pg8::gemm_phase<EpiUp, pg8::StaticOrder, true, true>(L, g, S, E);
    }
    SEAM(7);

    if (IN(8)) {
        const float* cw = p.in[24]; const float* cbias = p.in[25]; const float* chist = p.in[6];
        const int total4 = NSEG * 2 * (DFF / 4);
        for (int idx = bx * 512 + tid; idx < total4; idx += G * 512) {
            const int seg = idx / (2 * (DFF / 4)), rem = idx - seg * 2 * (DFF / 4), i = rem / (DFF / 4), c = (rem - i * (DFF / 4)) * 4;
            f32x4 prev1, prev2;
            if (seg < MP / 64) { if ((seg & 31) == 0) { prev1 = (f32x4){0.f, 0.f, 0.f, 0.f}; prev2 = prev1; } else { prev1 = *(const f32x4*)(atail + ((size_t)(seg - 1) * 2 + 1) * DFF + c); prev2 = *(const f32x4*)(atail + ((size_t)(seg - 1) * 2) * DFF + c); } }
            else { const int b = seg - MP / 64; prev1 = *(const f32x4*)(chist + ((size_t)b * 2 + 1) * DFF + c); prev2 = *(const f32x4*)(chist + ((size_t)b * 2) * DFF + c); }
            const f32x4 a_0 = *(const f32x4*)(ahead + ((size_t)seg * 2) * DFF + c);
            f32x4 am1, am2, a0;
            if (i == 0) { am1 = prev1; am2 = prev2; a0 = a_0; } else { am1 = a_0; am2 = prev1; a0 = *(const f32x4*)(ahead + ((size_t)seg * 2 + 1) * DFF + c); }
            const f32x4 cv = *(const f32x4*)(cbias + c) + *(const f32x4*)(cw + c) * am2 + *(const f32x4*)(cw + DFF + c) * am1 + *(const f32x4*)(cw + 2 * DFF + c) * a0;
            const f32x4 bh = *(const f32x4*)(bhead + ((size_t)seg * 2 + i) * DFF + c);
            f32x4 hv;
#pragma unroll
            for (int e = 0; e < 4; ++e) hv[e] = cv[e] / (1.0f + __builtin_amdgcn_exp2f(-cv[e] * LOG2E)) * bh[e];
            u32x2 w; w.x = cvt_pk_bf16(hv[0], hv[1]); w.y = cvt_pk_bf16(hv[2], hv[3]);
            *(u32x2*)(hff + ((size_t)seg * 64 + i) * DFF + c) = w;
        }
        for (int idx = bx * 512 + tid; idx < 48 * 2 * DFF; idx += G * 512) {
            const int bb = idx / (2 * DFF), rem = idx - bb * 2 * DFF;
            if (bb < 32) out[O_CSP + (size_t)bb * 2 * DFF + rem] = atail[((size_t)(32 * bb + 31) * 2) * DFF + rem];
            else out[O_CSS + (size_t)(bb - 32) * 2 * DFF + rem] = atail[((size_t)(MP / 64 + bb - 32) * 2) * DFF + rem];
        }
    }
    SEAM(8);

    if (IN(9)) {
        const int MG = (G == 256) ? MP : MT;
        pg8::Gemm g{hff, Wt_dn, MG, 1024, DFF}; pg8::StaticOrder S; S.init(MG, 1024, G, bx);
        EpiRes<2> E{nullptr, nullptr, x2b, nullptr, out, ssq3};
        pg8::gemm_phase<EpiRes<2>, pg8::StaticOrder, true, true>(L, g, S, E);
        if (G == 256) small_gemm_sample<2>(L, bx, hff, DFF, Wt_dn, DFF, DFF, nullptr, x2b, nullptr, out, ssq3, nullptr);
    }
    SEAM(9);

    if (IN(10)) {
        const float* gf = p.in[27];
        const int lane = lane_op();
        const int gw = bx * 8 + wave, NGW = G * 8;
        f32x4 gv[4];
#pragma unroll
        for (int j = 0; j < 4; ++j) gv[j] = ((const f32x4*)gf)[lane + 64 * j];
        for (int m0 = gw; m0 < MT; m0 += 4 * NGW) {
            f32x4 v[4][4]; float r[4];
#pragma unroll
            for (int q = 0; q < 4; ++q) { const int m = m0 + q * NGW; if (m < MT) { const f32x4* y4 = (const f32x4*)(out + (size_t)m * DM) + lane; r[q] = row_rsq(ssq3, m);
#pragma unroll
                    for (int j = 0; j < 4; ++j) v[q][j] = y4[64 * j]; } }
#pragma unroll
            for (int q = 0; q < 4; ++q) { const int m = m0 + q * NGW; if (m < MT) { f32x4* y4 = (f32x4*)(out + (size_t)m * DM) + lane;
#pragma unroll
                    for (int j = 0; j < 4; ++j) y4[64 * j] = v[q][j] * r[q] * gv[j]; } }
        }
    }
#ifdef DBG_DUMP
    {
        GSYNC();
        const bf16_t* src = nullptr; int pitch = 1024;
        if (hi_ph == 2) src = uqkv; else if (hi_ph == 3) src = mix; else if (hi_ph == 4) src = x1b; else if (hi_ph == 5) src = mqb; else if (hi_ph == 6) src = mo; else if (hi_ph == 7) src = x2b; else if (hi_ph == 8 || hi_ph == 9) { src = hff; pitch = DFF; }
        if (src) for (size_t i = (size_t)bx * 512 + tid; i < (size_t)MT * 1024; i += (size_t)G * 512) { const size_t m = i >> 10, c = i & 1023; float v = __builtin_bit_cast(float, (unsigned)src[m * pitch + c] << 16); if (!(v == v)) v = 12345.f; if (fabsf(v) > 1e30f) v = 54321.f; out[i] = v; }
    }
#endif
#undef IN
#undef SEAM
}

extern "C" void kernel_launch(void* const* d_in, const int* in_sizes, int n_in, void* d_out, int out_size, void* d_ws, size_t ws_size, hipStream_t stream) {
    static int grid = 0;
    if (grid == 0) {
        if (n_in != 28 || (size_t)out_size != O_END || ws_size < WS_NEED) { fprintf(stderr, "kernel_launch: unexpected shapes (n_in %d, out %d, ws %zu); nothing launched\n", n_in, out_size, ws_size); grid = -1; return; }
        int dev = 0, cus = 0, per_cu = 0;
        hipGetDevice(&dev); hipDeviceGetAttribute(&cus, hipDeviceAttributeMultiprocessorCount, dev);
        hipFuncSetAttribute((const void*)fwd_kernel, hipFuncAttributeMaxDynamicSharedMemorySize, LDS_BYTES);
        hipOccupancyMaxActiveBlocksPerMultiprocessor(&per_cu, (const void*)fwd_kernel, 512, LDS_BYTES);
        if (per_cu < 1) { fprintf(stderr, "kernel_launch: occupancy query says %d blocks per CU\n", per_cu); per_cu = 1; }
        (void)hipGetLastError();
        grid = cus;
    }
    if (grid < 0) return;
    (void)hipMemsetAsync(d_ws, 0, 8192, stream);
    Params p{};
    for (int i = 0; i < 28; ++i) p.in[i] = (const float*)d_in[i];
    p.out = (float*)d_out; p.ws = (unsigned char*)d_ws;
    void* args[] = {&p};
#ifdef PROBE_K
    p.ph_lo = 0; p.ph_hi = PROBE_K + 1;
    (void)hipLaunchCooperativeKernel((const void*)fwd_kernel, dim3(grid), dim3(512), args, LDS_BYTES, stream);
    (void)hipMemsetAsync(d_ws, 0, 8192, stream);
    p.ph_lo = PROBE_K; p.ph_hi = 11;
#else
    p.ph_lo = 0; p.ph_hi = 11;
#endif
    hipError_t e = hipLaunchCooperativeKernel((const void*)fwd_kernel, dim3(grid), dim3(512), args, LDS_BYTES, stream);
    if (e != hipSuccess) fprintf(stderr, "cooperative launch failed: %s (grid %d)\n", hipGetErrorString(e), grid);
}
```

```cpp
#include <hip/hip_runtime.h>
#include <hip/hip_cooperative_groups.h>
#include <cstdio>
#include <cstdint>
namespace cg = cooperative_groups;
namespace pg8 {
#define PG8_LAS __attribute__((address_space(3)))
typedef unsigned short bf16_t;
typedef short bf16x8 __attribute__((ext_vector_type(8)));
typedef float f32x4 __attribute__((ext_vector_type(4)));
typedef unsigned u32x4 __attribute__((ext_vector_type(4)));
constexpr int BM = 256, BK = 64, HALF = 128, HTB = HALF * BK * 2  , STAGE_BYTES = 8 * HTB, NXCD = 8, WGM = 8;

__host__ __device__ __forceinline__ int lds_byte(int r, int c) { const int st = (r >> 4) * 2 + (c >> 5), rr = r & 15, cc = c & 31, ob = rr * 64 + cc * 2; return st * 1024 + (ob ^ (((ob >> 9) & 1) << 5)); }
__host__ __device__ __forceinline__ void stage_rc(int b, int& R, int& C) { const int st = b / 1024, sb = b % 1024, swz = sb ^ (((sb >> 9) & 1) << 5); R = (st >> 1) * 16 + swz / 64; C = (st & 1) * 32 + (swz % 64) / 2; }
__host__ __device__ __forceinline__ int perm32(int rho) { const int n = rho >> 4, i = rho & 15; return 8 * (i >> 2) + 4 * n + (i & 3); }

struct Unit { int pm, pn; };
struct Gemm { const bf16_t* A; const bf16_t* Bt; int M, N, K; };

struct StaticOrder {
    int nM, nN, nwg, G, c;
    __host__ __device__ void init(int M, int N, int G_, int c_) { nM = M / BM; nN = N / BM; nwg = nM * nN; G = G_; c = c_; }
    __host__ __device__ bool next(int i, Unit& u) const {
        const long L = (long)i * G + c; if (L >= nwg) return false;
        int wgid = (int)L; { const int q = nwg / NXCD, r = nwg % NXCD, xcd = wgid % NXCD, off = wgid / NXCD; wgid = (xcd < r ? xcd * (q + 1) : r * (q + 1) + (xcd - r) * q) + off; }
        const int nig = WGM * nN, gid = wgid / nig, fm = gid * WGM, gsz = (nM - fm) < WGM ? (nM - fm) : WGM;
        u.pm = fm + ((wgid % nig) % gsz); u.pn = (wgid % nig) / gsz; return true;
    }
    __device__ __forceinline__ void a_ready(const Unit&) const {}
    __device__ __forceinline__ void done(const Unit&) const {}
};

__device__ __forceinline__ unsigned cvt_pk_bf16(float lo, float hi) { unsigned r; asm volatile("v_cvt_pk_bf16_f32 %0, %1, %2" : "=v"(r) : "v"(lo), "v"(hi)); return r; }
typedef float f32x2 __attribute__((ext_vector_type(2)));
template <class Epi, class Sched, bool ALIGN_EPI = false, bool SP2 = false>
__device__ __forceinline__ void gemm_phase(PG8_LAS unsigned char* lds, const Gemm g, const Sched& S, const Epi& E) {
    const int tid = threadIdx.x, wid = __builtin_amdgcn_readfirstlane(tid >> 6), lane = tid & 63, wr = wid >> 2, wc = wid & 3, fr = lane & 15, fq = lane >> 4;
    const int K = g.K, nt = K / BK;
    unsigned voffA[2], voffB[2];
#pragma unroll
    for (int i = 0; i < 2; ++i) { int R, C; stage_rc(tid * 16 + i * 8192, R, C); const int Rb = Epi::PERM ? ((R & ~31) + perm32(R & 31)) : R;
        voffA[i] = (unsigned)(R * K + C) * 2u; voffB[i] = (unsigned)(Rb * K + C) * 2u; }
    const size_t kstep = (size_t)(BK * 2);
    const size_t hstep = (size_t)HALF * K * 2;
    const size_t tstep = 2 * hstep;
    const unsigned ldsw = (unsigned)wid * 1024u;
    const int aoff = lds_byte(wr * 64 + fr, fq * 8), boff = lds_byte(wc * 32 + fr, fq * 8);
#define PG8_SA(b, h) (((b) * 2 + (h)) * HTB)
#define PG8_SB(b, h) ((4 + (b) * 2 + (h)) * HTB)
#define PG8_STAGE(bufoff, gbase, voff) do { _Pragma("unroll") for (int _i = 0; _i < 2; ++_i) \
        __builtin_amdgcn_global_load_lds((const unsigned*)((const char*)(gbase) + (voff)[_i]), (PG8_LAS unsigned*)(lds + (bufoff) + ldsw + _i * 8192), 16, 0, 0); } while (0)
#define PG8_LDA(dst, b, h) do { _Pragma("unroll") for (int m = 0; m < 4; ++m) _Pragma("unroll") for (int k = 0; k < 2; ++k) dst[m][k] = *(const PG8_LAS bf16x8*)(lds + PG8_SA(b, h) + aoff + m * 2048 + k * 1024); } while (0)
#define PG8_LDB(dst, b, h) do { _Pragma("unroll") for (int n = 0; n < 2; ++n) _Pragma("unroll") for (int k = 0; k < 2; ++k) dst[n][k] = *(const PG8_LAS bf16x8*)(lds + PG8_SB(b, h) + boff + n * 2048 + k * 1024); } while (0)
#define PG8_MMA(ai, bj, At, Bt) do { __builtin_amdgcn_s_setprio(1); _Pragma("unroll") for (int m = 0; m < 4; ++m) _Pragma("unroll") for (int n = 0; n < 2; ++n) _Pragma("unroll") for (int k = 0; k < 2; ++k) \
        acc[ai][bj][m][n] = __builtin_amdgcn_mfma_f32_16x16x32_bf16(Bt[n][k], At[m][k], acc[ai][bj][m][n], 0, 0, 0); __builtin_amdgcn_s_setprio(0); } while (0)
#define PG8_WAIT_V(n) asm volatile("s_waitcnt vmcnt(" #n ")" ::: "memory")
#define PG8_WAIT_L(n) asm volatile("s_waitcnt lgkmcnt(" #n ")" ::: "memory")
#define PG8_BAR __builtin_amdgcn_s_barrier()
#define PG8_SCHED __builtin_amdgcn_sched_barrier(0)
    Unit cur, nxt; int ui = 0;
    if (!S.next(0, cur)) return;
    f32x4 acc[2][2][4][2];
#pragma unroll
    for (int a = 0; a < 2; ++a)
#pragma unroll
        for (int b = 0; b < 2; ++b)
#pragma unroll
            for (int m = 0; m < 4; ++m)
#pragma unroll
                for (int n = 0; n < 2; ++n) acc[a][b][m][n] = (f32x4){0.f, 0.f, 0.f, 0.f};
    bf16x8 At[4][2], B0[2][2], B1[2][2];
    const char* cA = (const char*)g.A + (size_t)cur.pm * tstep; const char* cB = (const char*)g.Bt + (size_t)cur.pn * tstep;
    S.a_ready(cur);
    if constexpr (SP2) {
        PG8_STAGE(PG8_SB(0, 0), cB, voffB); PG8_STAGE(PG8_SB(0, 1), cB + hstep, voffB); PG8_STAGE(PG8_SA(0, 0), cA, voffA); PG8_STAGE(PG8_SA(0, 1), cA + hstep, voffA);
        if (wr == 1) PG8_BAR;
        PG8_WAIT_V(2); PG8_BAR;
        PG8_STAGE(PG8_SB(1, 0), cB + kstep, voffB); PG8_STAGE(PG8_SA(1, 0), cA + kstep, voffA); PG8_STAGE(PG8_SB(1, 1), cB + hstep + kstep, voffB);
        PG8_WAIT_V(6); PG8_BAR;
    } else {
        PG8_STAGE(PG8_SB(0, 0), cB, voffB); PG8_STAGE(PG8_SA(0, 0), cA, voffA); PG8_STAGE(PG8_SB(0, 1), cB + hstep, voffB); PG8_STAGE(PG8_SA(0, 1), cA + hstep, voffA);
        if (wr == 1) PG8_BAR;
        PG8_WAIT_V(4); PG8_BAR;
        PG8_STAGE(PG8_SB(1, 0), cB + kstep, voffB); PG8_STAGE(PG8_SA(1, 0), cA + kstep, voffA); PG8_STAGE(PG8_SB(1, 1), cB + hstep + kstep, voffB);
        PG8_WAIT_V(6); PG8_BAR;
    }
    for (;;) {
        const bool has_next = S.next(ui + 1, nxt);
        const char* nA = has_next ? (const char*)g.A + (size_t)nxt.pm * tstep : cA; const char* nB = has_next ? (const char*)g.Bt + (size_t)nxt.pn * tstep : cB;
        for (int t = 0; t < nt; t += 2) {
            const bool last = (t == nt - 2);
            const char* a1 = cA + (size_t)(t + 1) * kstep;
            const char* a2 = last ? nA : cA + (size_t)(t + 2) * kstep; const char* b2 = last ? nB : cB + (size_t)(t + 2) * kstep;
            const char* a3 = a2 + kstep; const char* b3 = b2 + kstep;
            if (last && has_next) S.a_ready(nxt);
            if constexpr (SP2) {
            PG8_LDB(B0, 0, 0); PG8_LDB(B1, 0, 1); PG8_SCHED; PG8_LDA(At, 0, 0); PG8_STAGE(PG8_SA(1, 1), a1 + hstep, voffA);
            PG8_WAIT_V(8); PG8_WAIT_L(0); PG8_BAR; PG8_MMA(0, 0, At, B0); PG8_MMA(0, 1, At, B1); PG8_BAR; PG8_SCHED;
            PG8_LDA(At, 0, 1); PG8_STAGE(PG8_SB(0, 0), b2, voffB); PG8_STAGE(PG8_SB(0, 1), b2 + hstep, voffB); PG8_STAGE(PG8_SA(0, 0), a2, voffA);
            PG8_WAIT_V(8); PG8_WAIT_L(0); PG8_BAR; PG8_MMA(1, 0, At, B0); PG8_MMA(1, 1, At, B1); PG8_BAR; PG8_SCHED;
            PG8_LDB(B0, 1, 0); PG8_LDB(B1, 1, 1); PG8_SCHED; PG8_LDA(At, 1, 0); PG8_STAGE(PG8_SA(0, 1), a2 + hstep, voffA);
            PG8_WAIT_V(8); PG8_WAIT_L(0); PG8_BAR; PG8_MMA(0, 0, At, B0); PG8_MMA(0, 1, At, B1); PG8_BAR; PG8_SCHED;
            PG8_LDA(At, 1, 1); PG8_STAGE(PG8_SB(1, 0), b3, voffB); PG8_STAGE(PG8_SB(1, 1), b3 + hstep, voffB); PG8_STAGE(PG8_SA(1, 0), a3, voffA);
            PG8_WAIT_V(8); PG8_WAIT_L(0); PG8_BAR; PG8_MMA(1, 0, At, B0); PG8_MMA(1, 1, At, B1); PG8_BAR; PG8_SCHED;
            } else {
            PG8_LDB(B0, 0, 0); PG8_SCHED; PG8_LDA(At, 0, 0); PG8_STAGE(PG8_SA(1, 1), a1 + hstep, voffA);
            PG8_WAIT_L(8); PG8_BAR; PG8_WAIT_L(0); PG8_MMA(0, 0, At, B0); PG8_BAR; PG8_SCHED;
            PG8_LDB(B1, 0, 1); PG8_STAGE(PG8_SB(0, 0), b2, voffB);
            PG8_BAR; PG8_WAIT_L(0); PG8_MMA(0, 1, At, B1); PG8_BAR;
            PG8_LDA(At, 0, 1); PG8_STAGE(PG8_SA(0, 0), a2, voffA);
            PG8_BAR; PG8_WAIT_L(0); PG8_MMA(1, 0, At, B0); PG8_BAR; PG8_SCHED;
            PG8_STAGE(PG8_SB(0, 1), b2 + hstep, voffB);
            PG8_WAIT_V(6); PG8_BAR; PG8_MMA(1, 1, At, B1); PG8_BAR;
            PG8_LDB(B0, 1, 0); PG8_SCHED; PG8_LDA(At, 1, 0); PG8_STAGE(PG8_SA(0, 1), a2 + hstep, voffA);
            PG8_WAIT_L(8); PG8_BAR; PG8_WAIT_L(0); PG8_MMA(0, 0, At, B0); PG8_BAR; PG8_SCHED;
            PG8_LDB(B1, 1, 1); PG8_STAGE(PG8_SB(1, 0), b3, voffB);
            PG8_BAR; PG8_WAIT_L(0); PG8_MMA(0, 1, At, B1); PG8_BAR;
            PG8_LDA(At, 1, 1); PG8_STAGE(PG8_SA(1, 0), a3, voffA);
            PG8_BAR; PG8_WAIT_L(0); PG8_MMA(1, 0, At, B0); PG8_BAR; PG8_SCHED;
            PG8_STAGE(PG8_SB(1, 1), b3 + hstep, voffB);
            PG8_WAIT_V(6); PG8_BAR; PG8_MMA(1, 1, At, B1); PG8_BAR;
            }
        }
        if constexpr (ALIGN_EPI) { if (wr == 0) PG8_BAR; }
        if constexpr (!Epi::AFTER_DRAIN) { E(acc, cur, wr, wc, fr, fq); S.done(cur); }
        if (!has_next) break;
#pragma unroll
        for (int a = 0; a < 2; ++a)
#pragma unroll
            for (int b = 0; b < 2; ++b)
#pragma unroll
                for (int m = 0; m < 4; ++m)
#pragma unroll
                    for (int n = 0; n < 2; ++n) acc[a][b][m][n] = (f32x4){0.f, 0.f, 0.f, 0.f};
        cur = nxt; cA = nA; cB = nB; ++ui;
        if constexpr (ALIGN_EPI) { if (wr == 1) PG8_BAR; }
    }
    PG8_WAIT_V(0);
    if constexpr (!ALIGN_EPI) { if (wr == 0) PG8_BAR; }
    PG8_BAR;
    if constexpr (Epi::AFTER_DRAIN) { E.fused(acc, cur, wr, wc, fr, fq, lds, wid, lane); S.done(cur); }
#undef PG8_SA
#undef PG8_SB
#undef PG8_STAGE
#undef PG8_LDA
#undef PG8_LDB
#undef PG8_MMA
#undef PG8_WAIT_V
#undef PG8_WAIT_L
#undef PG8_BAR
#undef PG8_SCHED
}
}

using pg8::bf16_t; using pg8::bf16x8; using pg8::f32x4; using pg8::u32x4; using pg8::Unit;
typedef float f32x2_t __attribute__((ext_vector_type(2))); typedef __bf16 bf16x2_t __attribute__((ext_vector_type(2)));
__device__ __forceinline__ unsigned cvt_pk_bf16(float lo, float hi) { f32x2_t v = {lo, hi}; bf16x2_t b = __builtin_convertvector(v, bf16x2_t); return __builtin_bit_cast(unsigned, b); }
typedef float f32x16 __attribute__((ext_vector_type(16)));
typedef unsigned u32x2 __attribute__((ext_vector_type(2)));
#define LAS __attribute__((address_space(3)))

constexpr int DM = 1024, MP = 65536, MS = 1024, MT = MP + MS, SEQ = 2048, DSEQ = 64, PAST = 4096, NMEM = 256;
constexpr int DFF = 2816, NUP = 2 * DFF, NSEG = MT / 64;
constexpr float EPS = 1e-6f, LOG2E = 1.4426950408889634f;
constexpr float C2F = 0.125f * LOG2E, C2M = 0.0625f * LOG2E;
constexpr float NEGBIG = -1e30f;

constexpr size_t O_YP = 0, O_YS = O_YP + (size_t)MP * DM, O_KP = O_YS + (size_t)MS * DM, O_VP = O_KP + (size_t)MP * 512, O_LFP = O_VP + (size_t)MP * 512,
    O_PSP = O_LFP + (size_t)MP * 8, O_CSP = O_PSP + 32 * 15 * 512, O_MKP = O_CSP + 32 * 2 * DFF, O_MVP = O_MKP + (size_t)8192 * 1024, O_KS = O_MVP + (size_t)8192 * 1024,
    O_VS = O_KS + (size_t)MS * 512, O_LFS = O_VS + (size_t)MS * 512, O_PSS = O_LFS + MS * 8, O_CSS = O_PSS + 16 * 15 * 512, O_END = O_CSS + 16 * 2 * DFF;

constexpr size_t MiB = 1u << 20;
constexpr size_t WS_WIN = 1 * MiB, WS_WO = 5 * MiB, WS_WMQ = 7 * MiB, WS_WMO = 9 * MiB, WS_WMKV = 11 * MiB, WS_WUP = 15 * MiB, WS_WDN = 26 * MiB, WS_WPOOL = 32 * MiB;
constexpr size_t WS_USX = 34 * MiB;
constexpr size_t WS_MKB = 40 * MiB, WS_MVB = 64 * MiB;
constexpr size_t WS_SSQ1 = 88 * MiB, WS_SSQ2 = 93 * MiB, WS_SSQ3 = 98 * MiB;
constexpr size_t WS_KBP = 103 * MiB, WS_KBS = 105 * MiB;
constexpr size_t WS_AHEAD = 108 * MiB, WS_ATAIL = WS_AHEAD + 23 * MiB / 1 - MiB / 2, WS_BHEAD = WS_ATAIL + 23 * MiB - MiB / 2;
constexpr size_t WS_X1B = 176 * MiB, WS_KCB = 176 * MiB, WS_VCB = 240 * MiB;
constexpr size_t WS_X2B = 306 * MiB;
constexpr size_t WS_XB = 436 * MiB, WS_MQB = 436 * MiB, WS_HFF = 436 * MiB;
constexpr size_t WS_UQKV = 566 * MiB, WS_MO = 566 * MiB;
constexpr size_t WS_MIX = 826 * MiB, WS_MEMB = 956 * MiB, WS_NEED = 972 * MiB;
static_assert((size_t)NSEG * 2 * DFF * 4 <= 22 * MiB + MiB / 2, "side buffers");
static_assert(WS_BHEAD + 22 * MiB + MiB / 2 <= WS_X1B, "side buffers end");

#define P2_ATTN_P 1
#define P2_ATTN_S 1
#define P2_POOL 1
#define DBG_HI 11
#ifndef SWPIPE
#define SWPIPE 0
#endif
#ifndef PHMASK
#define PHMASK 0x7ff
#endif
constexpr int LDS_BYTES = 147456;

struct Params { const float* in[28]; float* out; unsigned char* ws; int ph_lo, ph_hi; };

__device__ __forceinline__ float bf_lo(unsigned w) { return __builtin_bit_cast(float, w << 16); }
__device__ __forceinline__ float bf_hi(unsigned w) { return __builtin_bit_cast(float, w & 0xffff0000u); }
__device__ __forceinline__ int lane_op() { int l = (int)(threadIdx.x & 63u); asm volatile("" : "+v"(l)); return l; }
__device__ __forceinline__ int crow(int r, int hi) { return (r & 3) + 8 * (r >> 2) + 4 * hi; }
__device__ __forceinline__ float wave_sum(float v) {
#pragma unroll
    for (int o = 1; o < 64; o <<= 1) v += __shfl_xor(v, o);
    return v;
}
__device__ __forceinline__ float rsq(float ssq) { return 1.0f / sqrtf(ssq * (1.0f / 1024.0f) + EPS); }
#define LDS_WAIT() asm volatile("s_waitcnt lgkmcnt(0)" ::: "memory")

typedef const f32x4 (&AccRef)[2][2][4][2];

__device__ __forceinline__ u32x4 pack8(f32x4 v0, f32x4 v1) { u32x4 w; w.x = cvt_pk_bf16(v0[0], v0[1]); w.y = cvt_pk_bf16(v0[2], v0[3]); w.z = cvt_pk_bf16(v1[0], v1[1]); w.w = cvt_pk_bf16(v1[2], v1[3]); return w; }

struct EpiIn {
    static constexpr bool PERM = true, AFTER_DRAIN = false;
    bf16_t* uqkv; float* out; bf16_t* usx;
    __device__ __forceinline__ void operator()(AccRef acc, const Unit& u, int wr, int wc, int fr, int fq) const {
        const int t = u.pn >> 1;
        const int col0 = (u.pn & 1) * 256 + wc * 32 + 8 * fq;
        bf16_t* base = uqkv + (size_t)t * MT * 512;
        const float sc = (t == 1) ? C2F : 1.0f;
#pragma unroll
        for (int ai = 0; ai < 2; ++ai)
#pragma unroll
            for (int m = 0; m < 4; ++m) {
                const int row = u.pm * 256 + ai * 128 + wr * 64 + m * 16 + fr;
#pragma unroll
                for (int bj = 0; bj < 2; ++bj) {
                    const int col = col0 + bj * 128;
                    const f32x4 v0 = acc[ai][bj][m][0] * sc, v1 = acc[ai][bj][m][1] * sc;
                    *(u32x4*)(base + (size_t)row * 512 + col) = pack8(v0, v1);
                    if (t >= 2) {
                        float* o = (row < MP) ? out + (t == 2 ? O_KP : O_VP) + (size_t)row * 512 : out + (t == 2 ? O_KS : O_VS) + (size_t)(row - MP) * 512;
                        *(f32x4*)(o + col) = v0; *(f32x4*)(o + col + 4) = v1;
                    } else if (t == 0) {
                        if (row < MP) { const int tt = row & (SEQ - 1); if (tt >= SEQ - 15) { float* o = out + O_PSP + ((size_t)(row >> 11) * 15 + (tt - (SEQ - 15))) * 512 + col; *(f32x4*)o = v0; *(f32x4*)(o + 4) = v1; } }
                        else { const int rs = row - MP, tt = rs & 63; *(u32x4*)(usx + ((size_t)(rs >> 6) * 79 + 15 + tt) * 512 + col) = pack8(v0, v1); if (tt >= DSEQ - 15) { float* o = out + O_PSS + ((size_t)(rs >> 6) * 15 + (tt - (DSEQ - 15))) * 512 + col; *(f32x4*)o = v0; *(f32x4*)(o + 4) = v1; } }
                    }
                }
            }
    }
};
struct EpiMkv {
    static constexpr bool PERM = true, AFTER_DRAIN = false;
    bf16_t* mkb; bf16_t* mvb; float* out;
    __device__ __forceinline__ void operator()(AccRef acc, const Unit& u, int wr, int wc, int fr, int fq) const {
        const int t = u.pn >> 2;
        const int col0 = (u.pn & 3) * 256 + wc * 32 + 8 * fq;
        bf16_t* bb = t ? mvb : mkb; float* of = out + (t ? O_MVP : O_MKP);
#pragma unroll
        for (int ai = 0; ai < 2; ++ai)
#pragma unroll
            for (int m = 0; m < 4; ++m) {
                const int row = u.pm * 256 + ai * 128 + wr * 64 + m * 16 + fr;
#pragma unroll
                for (int bj = 0; bj < 2; ++bj) {
                    const int col = col0 + bj * 128;
                    const f32x4 v0 = acc[ai][bj][m][0], v1 = acc[ai][bj][m][1];
                    *(u32x4*)(bb + (size_t)row * 1024 + col) = pack8(v0, v1);
                    *(f32x4*)(of + (size_t)row * 1024 + col) = v0; *(f32x4*)(of + (size_t)row * 1024 + col + 4) = v1;
                }
            }
    }
};
template <int MODE> struct EpiRes {
    static constexpr bool PERM = true, AFTER_DRAIN = false;
    const float* xP; const float* xS; const bf16_t* resB; bf16_t* xo; float* yo; float* ssqp;
    __device__ __forceinline__ void operator()(AccRef acc, const Unit& u, int wr, int wc, int fr, int fq) const {
        const int col0 = u.pn * 256 + wc * 32 + 8 * fq;
#pragma unroll
        for (int ai = 0; ai < 2; ++ai)
#pragma unroll
            for (int m = 0; m < 4; ++m) {
                const int row = u.pm * 256 + ai * 128 + wr * 64 + m * 16 + fr;
                float ss = 0.f;
#pragma unroll
                for (int bj = 0; bj < 2; ++bj) {
                    const int col = col0 + bj * 128;
                    f32x4 r0, r1;
                    if (MODE == 0) { const float* xr = (row < MP) ? xP + (size_t)row * DM : xS + (size_t)(row - MP) * DM; r0 = *(const f32x4*)(xr + col); r1 = *(const f32x4*)(xr + col + 4); }
                    else { const u32x4 w = *(const u32x4*)(resB + (size_t)row * DM + col); r0 = (f32x4){bf_lo(w.x), bf_hi(w.x), bf_lo(w.y), bf_hi(w.y)}; r1 = (f32x4){bf_lo(w.z), bf_hi(w.z), bf_lo(w.w), bf_hi(w.w)}; }
                    const f32x4 v0 = acc[ai][bj][m][0] + r0, v1 = acc[ai][bj][m][1] + r1;
                    ss += (v0[0] * v0[0] + v0[1] * v0[1]) + (v0[2] * v0[2] + v0[3] * v0[3]) + (v1[0] * v1[0] + v1[1] * v1[1]) + (v1[2] * v1[2] + v1[3] * v1[3]);
                    if (MODE == 2) { float* yr = (row < MP) ? yo + O_YP + (size_t)row * DM : yo + O_YS + (size_t)(row - MP) * DM; *(f32x4*)(yr + col) = v0; *(f32x4*)(yr + col + 4) = v1; }
                    else *(u32x4*)(xo + (size_t)row * DM + col) = pack8(v0, v1);
                }
                ss += __shfl_xor(ss, 16); ss += __shfl_xor(ss, 32);
                if (fq == 0) ssqp[(size_t)row * 16 + u.pn * 4 + wc] = ss;
            }
    }
};
__device__ __forceinline__ float row_rsq(const float* ssqp, int row) {
    const f32x4* sp = (const f32x4*)(ssqp + (size_t)row * 16);
    const f32x4 a = sp[0], b = sp[1], c = sp[2], d = sp[3];
    const float s = ((a[0] + a[1]) + (a[2] + a[3])) + ((b[0] + b[1]) + (b[2] + b[3])) + ((c[0] + c[1]) + (c[2] + c[3])) + ((d[0] + d[1]) + (d[2] + d[3]));
    return rsq(s);
}
struct EpiMq {
    static constexpr bool PERM = true, AFTER_DRAIN = false;
    const float* ssqp; bf16_t* mq;
    __device__ __forceinline__ void operator()(AccRef acc, const Unit& u, int wr, int wc, int fr, int fq) const {
        const int col0 = u.pn * 256 + wc * 32 + 8 * fq;
#pragma unroll
        for (int ai = 0; ai < 2; ++ai)
#pragma unroll
            for (int m = 0; m < 4; ++m) {
                const int row = u.pm * 256 + ai * 128 + wr * 64 + m * 16 + fr;
                const float r = row_rsq(ssqp, row) * C2M;
#pragma unroll
                for (int bj = 0; bj < 2; ++bj) *(u32x4*)(mq + (size_t)row * DM + col0 + bj * 128) = pack8(acc[ai][bj][m][0] * r, acc[ai][bj][m][1] * r);
            }
    }
};
struct EpiUp {
    static constexpr bool PERM = true, AFTER_DRAIN = false;
    const float* ssqp; const float* cw; const float* cb; bf16_t* hff; float* ahead; float* atail; float* bhead;
    __device__ __forceinline__ void operator()(AccRef acc, const Unit& u, int wr, int wc, int fr, int fq) const {
        const int lane = fq * 16 + fr;
        const int c0 = u.pn * 128 + wc * 32 + 8 * fq;
        f32x4 w0[2], w1[2], w2[2], bb[2];
#pragma unroll
        for (int n = 0; n < 2; ++n) { w0[n] = *(const f32x4*)(cw + c0 + 4 * n); w1[n] = *(const f32x4*)(cw + DFF + c0 + 4 * n); w2[n] = *(const f32x4*)(cw + 2 * DFF + c0 + 4 * n); bb[n] = *(const f32x4*)(cb + c0 + 4 * n); }
        const int src1 = (lane & 48) | ((fr + 15) & 15), src2 = (lane & 48) | ((fr + 14) & 15);
#pragma unroll
        for (int ai = 0; ai < 2; ++ai) {
            const int seg = u.pm * 4 + ai * 2 + wr;
            const int rowb = u.pm * 256 + ai * 128 + wr * 64;
            f32x4 ap[2] = {{0.f, 0.f, 0.f, 0.f}, {0.f, 0.f, 0.f, 0.f}};
#pragma unroll
            for (int m = 0; m < 4; ++m) {
                const int row = rowb + m * 16 + fr;
                const float r = row_rsq(ssqp, row);
                f32x4 a[2], b[2], h[2];
#pragma unroll
                for (int n = 0; n < 2; ++n) {
                    a[n] = acc[ai][0][m][n] * r; b[n] = acc[ai][1][m][n] * r;
                    f32x4 a1, a2;
#pragma unroll
                    for (int e = 0; e < 4; ++e) {
                        const float x1 = (fr == 15) ? ap[n][e] : a[n][e]; a1[e] = __shfl(x1, src1);
                        const float x2 = (fr >= 14) ? ap[n][e] : a[n][e]; a2[e] = __shfl(x2, src2);
                    }
                    const f32x4 cv = bb[n] + w0[n] * a2 + w1[n] * a1 + w2[n] * a[n];
#pragma unroll
                    for (int e = 0; e < 4; ++e) h[n][e] = cv[e] * __builtin_amdgcn_rcpf(1.0f + __builtin_amdgcn_exp2f(-cv[e] * LOG2E)) * b[n][e];
                    ap[n] = a[n];
                }
                if (m == 0 && fr < 2) {
                    float* pa = ahead + ((size_t)seg * 2 + fr) * DFF + c0; float* pb = bhead + ((size_t)seg * 2 + fr) * DFF + c0;
                    *(f32x4*)pa = a[0]; *(f32x4*)(pa + 4) = a[1]; *(f32x4*)pb = b[0]; *(f32x4*)(pb + 4) = b[1];
                } else {
                    *(u32x4*)(hff + (size_t)row * DFF + c0) = pack8(h[0], h[1]);
                }
                if (m == 3 && fr >= 14) { float* pt = atail + ((size_t)seg * 2 + (fr - 14)) * DFF + c0; *(f32x4*)pt = a[0]; *(f32x4*)(pt + 4) = a[1]; }
            }
        }
    }
};

template <int MODE>
__device__ __forceinline__ void small_gemm_sample(LAS unsigned char* L, int tile, const bf16_t* __restrict__ A, int lda, const bf16_t* __restrict__ Bt, int ldb, int K,
                                                  const float* __restrict__ xS, const bf16_t* __restrict__ resB, bf16_t* __restrict__ xo, float* __restrict__ yo, float* __restrict__ ssq_out, const float* __restrict__ ssq_in) {
    const int tid = threadIdx.x, lane = lane_op(), wid = __builtin_amdgcn_readfirstlane(tid >> 6), r32 = lane & 31, hi = lane >> 5;
    const int rb = wid & 1, kq = wid >> 1, tm = tile >> 4, tn = tile & 15;
    const int row0 = MP + tm * 64 + rb * 32, col0 = tn * 64, kper = K >> 2, k0 = kq * kper;
    const bf16_t* ap = A + (size_t)(row0 + r32) * lda + k0 + hi * 8;
    const bf16_t* bp0 = Bt + (size_t)(col0 + r32) * ldb + k0 + hi * 8;
    const bf16_t* bp1 = bp0 + (size_t)32 * ldb;
    f32x16 acc0, acc1;
#pragma unroll
    for (int r = 0; r < 16; ++r) { acc0[r] = 0.f; acc1[r] = 0.f; }
    for (int s0 = 0; s0 < kper; s0 += 128) {
        const int nst = (kper - s0) >> 4;
        bf16x8 af[8], b0[8], b1[8];
#pragma unroll
        for (int i = 0; i < 8; ++i) { if (i < nst) { af[i] = *(const bf16x8*)(ap + s0 + 16 * i); b0[i] = *(const bf16x8*)(bp0 + s0 + 16 * i); b1[i] = *(const bf16x8*)(bp1 + s0 + 16 * i); } }
#pragma unroll
        for (int i = 0; i < 8; ++i) { if (i < nst) { acc0 = __builtin_amdgcn_mfma_f32_32x32x16_bf16(af[i], b0[i], acc0, 0, 0, 0); acc1 = __builtin_amdgcn_mfma_f32_32x32x16_bf16(af[i], b1[i], acc1, 0, 0, 0); } }
    }
    LAS float* Mg = (LAS float*)L;
    __syncthreads();
    if (kq > 0) {
#pragma unroll
        for (int r = 0; r < 16; ++r) { Mg[(wid * 33 + r) * 64 + lane] = acc0[r]; Mg[(wid * 33 + 16 + r) * 64 + lane] = acc1[r]; }
    }
    __syncthreads();
    if (kq == 0) {
#pragma unroll
        for (int g = 1; g < 4; ++g)
#pragma unroll
            for (int r = 0; r < 16; ++r) { acc0[r] += Mg[((2 * g + rb) * 33 + r) * 64 + lane]; acc1[r] += Mg[((2 * g + rb) * 33 + 16 + r) * 64 + lane]; }
#pragma unroll
        for (int r = 0; r < 16; ++r) {
            const int row = row0 + crow(r, hi), c0 = col0 + r32, c1 = c0 + 32;
            float v0 = acc0[r], v1 = acc1[r];
            if (MODE == 0) { v0 += xS[(size_t)(row - MP) * DM + c0]; v1 += xS[(size_t)(row - MP) * DM + c1]; }
            else if (MODE == 1 || MODE == 2) { v0 += bf_lo((unsigned)resB[(size_t)row * DM + c0]); v1 += bf_lo((unsigned)resB[(size_t)row * DM + c1]); }
            else { const float rs = row_rsq(ssq_in, row) * C2M; v0 *= rs; v1 *= rs; }
            if (MODE == 2) { yo[O_YS + (size_t)(row - MP) * DM + c0] = v0; yo[O_YS + (size_t)(row - MP) * DM + c1] = v1; }
            else { xo[(size_t)row * DM + c0] = (bf16_t)(cvt_pk_bf16(v0, 0.f) & 0xffffu); xo[(size_t)row * DM + c1] = (bf16_t)(cvt_pk_bf16(v1, 0.f) & 0xffffu); }
            if (MODE != 3) {
                float ss = v0 * v0 + v1 * v1;
                ss += __shfl_xor(ss, 1); ss += __shfl_xor(ss, 2); ss += __shfl_xor(ss, 4); ss += __shfl_xor(ss, 8); ss += __shfl_xor(ss, 16);
                if (r32 == 0) ssq_out[(size_t)row * 16 + tn] = ss;
            }
        }
    }
    __syncthreads();
}
template <int D, int KT, int KG, bool PF, bool QLDS, bool CAUSAL, bool BIAS>
__device__ __forceinline__ void attn_unit(LAS unsigned char* L, const bf16_t* __restrict__ Q, int ldq, int nq,
                                          const bf16_t* __restrict__ K0, const bf16_t* __restrict__ V0, int nt0, const bf16_t* __restrict__ K1, const bf16_t* __restrict__ V1, int ldk, int ntiles,
                                          const float* __restrict__ kbias, int qpos0, bf16_t* __restrict__ O, int ldo) {
    constexpr int KS = D + 8, VS = KT + 4, CH = D / 8, NKI = KT * CH / 512, NVI = ((KT / 2) * CH + 511) / 512, NQF = (D == 64) ? 4 : 1, NP = KT / 32, QW = 8 / KG;
    constexpr int TILEB = KT * KS * 2 + D * VS * 2 + (BIAS ? KT * 4 : 0);
    constexpr int QBYTES = QLDS ? 32 * QW * KS * 2 : 0;
    constexpr int NG = (KG == 1) ? 2 : (!PF ? 1 : KG);
    const int tid = threadIdx.x, lane = lane_op(), wid = __builtin_amdgcn_readfirstlane(tid >> 6), r32 = lane & 31, hi = lane >> 5;
    const int qw = wid % QW, kg = wid / QW;
    const bool wact = qw * 32 < nq;
    LAS unsigned char* T = L + QBYTES;
    const LAS bf16_t* Qs = (const LAS bf16_t*)L + (qw * 32 + r32) * KS + hi * 8;
    const bf16_t* qrow = Q + (size_t)(qw * 32 + r32) * ldq + hi * 8;
    bf16x8 qf[NQF];
    if (D == 64 && !QLDS) {
#pragma unroll
        for (int ds = 0; ds < NQF; ++ds) qf[ds] = wact ? *(const bf16x8*)(qrow + ds * 16) : (bf16x8){0, 0, 0, 0, 0, 0, 0, 0};
    }
    if (QLDS) {
        __syncthreads();
        constexpr int NQI = 32 * QW * CH / 512;
#pragma unroll
        for (int i = 0; i < NQI; ++i) { const int id = tid + 512 * i, row = id / CH, ch = id % CH; if (row < nq) *(LAS u32x4*)((LAS bf16_t*)L + row * KS + ch * 8) = *(const u32x4*)(Q + (size_t)row * ldq + ch * 8); }
    }
    float ref = 0.f;
    if (BIAS) ref = wact ? kbias[qpos0 + qw * 32 + r32] : 0.f;
    f32x16 o[D / 32];
#pragma unroll
    for (int db = 0; db < D / 32; ++db)
#pragma unroll
        for (int r = 0; r < 16; ++r) o[db][r] = 0.f;
    float lrun = 0.f;
    u32x4 kreg[NG][NKI], vreg[NG][NVI][2]; float breg[NG];
#define ATT_LOAD(j, g) do { const bf16_t* Kt_ = ((j) < nt0) ? K0 + (size_t)(j) * KT * ldk : K1 + (size_t)((j) - nt0) * KT * ldk; \
        const bf16_t* Vg_ = ((j) < nt0) ? V0 + (size_t)(j) * KT * ldk : V1 + (size_t)((j) - nt0) * KT * ldk; \
        _Pragma("unroll") for (int i_ = 0; i_ < NKI; ++i_) { const int id_ = tid + 512 * i_, row_ = id_ / CH, ch_ = id_ % CH; kreg[g][i_] = *(const u32x4*)(Kt_ + (size_t)row_ * ldk + ch_ * 8); } \
        _Pragma("unroll") for (int i_ = 0; i_ < NVI; ++i_) { const int id_ = tid + 512 * i_; if (id_ < (KT / 2) * CH) { const int pr_ = id_ % (KT / 2), ch_ = id_ / (KT / 2); \
            vreg[g][i_][0] = *(const u32x4*)(Vg_ + (size_t)(2 * pr_) * ldk + ch_ * 8); vreg[g][i_][1] = *(const u32x4*)(Vg_ + (size_t)(2 * pr_ + 1) * ldk + ch_ * 8); } } \
        if (BIAS && tid < KT) breg[g] = kbias[(j) * KT + tid]; } while (0)
#define ATT_STORE(TB, g) do { LAS bf16_t* Ks_ = (LAS bf16_t*)(TB); LAS bf16_t* Vt_ = (LAS bf16_t*)((TB) + KT * KS * 2); \
        _Pragma("unroll") for (int i_ = 0; i_ < NKI; ++i_) { const int id_ = tid + 512 * i_, row_ = id_ / CH, ch_ = id_ % CH; *(LAS u32x4*)(Ks_ + row_ * KS + ch_ * 8) = kreg[g][i_]; } \
        _Pragma("unroll") for (int i_ = 0; i_ < NVI; ++i_) { const int id_ = tid + 512 * i_; if (id_ < (KT / 2) * CH) { const int pr_ = id_ % (KT / 2), ch_ = id_ / (KT / 2); \
            _Pragma("unroll") for (int e_ = 0; e_ < 4; ++e_) { const unsigned lo_ = vreg[g][i_][0][e_], h2_ = vreg[g][i_][1][e_]; \
                *(LAS unsigned*)(Vt_ + (ch_ * 8 + 2 * e_) * VS + 2 * pr_) = (lo_ & 0xffffu) | (h2_ << 16); \
                *(LAS unsigned*)(Vt_ + (ch_ * 8 + 2 * e_ + 1) * VS + 2 * pr_) = (lo_ >> 16) | (h2_ & 0xffff0000u); } } } \
        if (BIAS && tid < KT) ((LAS float*)((TB) + KT * KS * 2 + D * VS * 2))[tid] = breg[g]; } while (0)
#define ATT_COMPUTE(j, TB) do { const LAS bf16_t* Ks_ = (const LAS bf16_t*)(TB); const LAS bf16_t* Vt_ = (const LAS bf16_t*)((TB) + KT * KS * 2); const LAS float* Bs_ = (const LAS float*)((TB) + KT * KS * 2 + D * VS * 2); \
        if (wact && (!CAUSAL || KT * (j) <= qpos0 + qw * 32 + 31)) { \
            f32x16 p[NP]; \
            const bf16_t* qr_ = qrow; if (D != 64 && !QLDS) asm volatile("" : "+v"(qr_)); \
            _Pragma("unroll") for (int h_ = 0; h_ < NP; ++h_) { \
                if (BIAS) { _Pragma("unroll") for (int i_ = 0; i_ < 4; ++i_) { const f32x4 t0_ = *(const LAS f32x4*)(Bs_ + 32 * h_ + 8 * i_ + 4 * hi); \
                        _Pragma("unroll") for (int e_ = 0; e_ < 4; ++e_) p[h_][4 * i_ + e_] = t0_[e_] - ref; } } \
                else { _Pragma("unroll") for (int r_ = 0; r_ < 16; ++r_) p[h_][r_] = 0.f; } } \
            _Pragma("unroll") for (int ds_ = 0; ds_ < D / 16; ++ds_) { \
                bf16x8 qv_; if (QLDS) qv_ = *(const LAS bf16x8*)(Qs + ds_ * 16); else if (D == 64) qv_ = qf[ds_]; else qv_ = *(const bf16x8*)(qr_ + ds_ * 16); \
                _Pragma("unroll") for (int h_ = 0; h_ < NP; ++h_) { const bf16x8 kf_ = *(const LAS bf16x8*)(Ks_ + (32 * h_ + r32) * KS + ds_ * 16 + hi * 8); p[h_] = __builtin_amdgcn_mfma_f32_32x32x16_bf16(kf_, qv_, p[h_], 0, 0, 0); } } \
            if (CAUSAL && (KT * (j) + KT - 1 > qpos0 + qw * 32)) { const int lim_ = qpos0 + qw * 32 + r32 - KT * (j); \
                _Pragma("unroll") for (int h_ = 0; h_ < NP; ++h_) _Pragma("unroll") for (int r_ = 0; r_ < 16; ++r_) { if (crow(r_, hi) + 32 * h_ > lim_) p[h_][r_] = NEGBIG; } } \
            float sum_ = 0.f; \
            _Pragma("unroll") for (int h_ = 0; h_ < NP; ++h_) _Pragma("unroll") for (int r_ = 0; r_ < 16; ++r_) { p[h_][r_] = __builtin_amdgcn_exp2f(p[h_][r_]); sum_ += p[h_][r_]; } \
            lrun += sum_; \
            u32x4 pw_[2 * NP]; \
            _Pragma("unroll") for (int h_ = 0; h_ < NP; ++h_) _Pragma("unroll") for (int e_ = 0; e_ < 4; ++e_) { pw_[2 * h_][e_] = pg8::cvt_pk_bf16(p[h_][2 * e_], p[h_][2 * e_ + 1]); pw_[2 * h_ + 1][e_] = pg8::cvt_pk_bf16(p[h_][8 + 2 * e_], p[h_][9 + 2 * e_]); } \
            _Pragma("unroll") for (int db_ = 0; db_ < D / 32; ++db_) _Pragma("unroll") for (int ks_ = 0; ks_ < 2 * NP; ++ks_) { \
                const LAS bf16_t* vp_ = Vt_ + (db_ * 32 + r32) * VS + ks_ * 16 + hi * 4; \
                const u32x2 va_ = *(const LAS u32x2*)vp_, vb_ = *(const LAS u32x2*)(vp_ + 8); const u32x4 vv_ = {va_.x, va_.y, vb_.x, vb_.y}; \
                o[db_] = __builtin_amdgcn_mfma_f32_32x32x16_bf16(__builtin_bit_cast(bf16x8, vv_), __builtin_bit_cast(bf16x8, pw_[ks_]), o[db_], 0, 0, 0); } \
        } } while (0)
#define ATT_ACT(j) (wact && (!CAUSAL || KT * (j) <= qpos0 + qw * 32 + 31))
#define ATT_QK(j, TB, P) do { if (ATT_ACT(j)) { const LAS bf16_t* Ks_ = (const LAS bf16_t*)(TB); const LAS float* Bs_ = (const LAS float*)((TB) + KT * KS * 2 + D * VS * 2); \
            _Pragma("unroll") for (int h_ = 0; h_ < NP; ++h_) { \
                if (BIAS) { _Pragma("unroll") for (int i_ = 0; i_ < 4; ++i_) { const f32x4 t0_ = *(const LAS f32x4*)(Bs_ + 32 * h_ + 8 * i_ + 4 * hi); \
                        _Pragma("unroll") for (int e_ = 0; e_ < 4; ++e_) P[h_][4 * i_ + e_] = t0_[e_] - ref; } } \
                else { _Pragma("unroll") for (int r_ = 0; r_ < 16; ++r_) P[h_][r_] = 0.f; } } \
            _Pragma("unroll") for (int ds_ = 0; ds_ < D / 16; ++ds_) { \
                const bf16x8 qv_ = qf[ds_ % NQF]; \
                _Pragma("unroll") for (int h_ = 0; h_ < NP; ++h_) { const bf16x8 kf_ = *(const LAS bf16x8*)(Ks_ + (32 * h_ + r32) * KS + ds_ * 16 + hi * 8); P[h_] = __builtin_amdgcn_mfma_f32_32x32x16_bf16(kf_, qv_, P[h_], 0, 0, 0); } } \
            if (CAUSAL && (KT * (j) + KT - 1 > qpos0 + qw * 32)) { const int lim_ = qpos0 + qw * 32 + r32 - KT * (j); \
                _Pragma("unroll") for (int h_ = 0; h_ < NP; ++h_) _Pragma("unroll") for (int r_ = 0; r_ < 16; ++r_) { if (crow(r_, hi) + 32 * h_ > lim_) P[h_][r_] = NEGBIG; } } \
        } } while (0)
#define ATT_SMPV(j, TB, P) do { if (ATT_ACT(j)) { const LAS bf16_t* Vt_ = (const LAS bf16_t*)((TB) + KT * KS * 2); \
            float sum_ = 0.f; \
            _Pragma("unroll") for (int h_ = 0; h_ < NP; ++h_) _Pragma("unroll") for (int r_ = 0; r_ < 16; ++r_) { P[h_][r_] = __builtin_amdgcn_exp2f(P[h_][r_]); sum_ += P[h_][r_]; } \
            lrun += sum_; \
            u32x4 pw_[2 * NP]; \
            _Pragma("unroll") for (int h_ = 0; h_ < NP; ++h_) _Pragma("unroll") for (int e_ = 0; e_ < 4; ++e_) { pw_[2 * h_][e_] = pg8::cvt_pk_bf16(P[h_][2 * e_], P[h_][2 * e_ + 1]); pw_[2 * h_ + 1][e_] = pg8::cvt_pk_bf16(P[h_][8 + 2 * e_], P[h_][9 + 2 * e_]); } \
            _Pragma("unroll") for (int db_ = 0; db_ < D / 32; ++db_) _Pragma("unroll") for (int ks_ = 0; ks_ < 2 * NP; ++ks_) { \
                const LAS bf16_t* vp_ = Vt_ + (db_ * 32 + r32) * VS + ks_ * 16 + hi * 4; \
                const u32x2 va_ = *(const LAS u32x2*)vp_, vb_ = *(const LAS u32x2*)(vp_ + 8); const u32x4 vv_ = {va_.x, va_.y, vb_.x, vb_.y}; \
                o[db_] = __builtin_amdgcn_mfma_f32_32x32x16_bf16(__builtin_bit_cast(bf16x8, vv_), __builtin_bit_cast(bf16x8, pw_[ks_]), o[db_], 0, 0, 0); } \
        } } while (0)
#define ATT_BUF(t) (T + ((t) % 3) * TILEB)
    if (KG == 1 && D == 64 && !QLDS && SWPIPE) {
        f32x16 pA[NP], pB[NP];
        ATT_LOAD(0, 0); ATT_STORE(ATT_BUF(0), 0);
        if (ntiles > 1) { ATT_LOAD(1, 1); ATT_STORE(ATT_BUF(1), 1); }
        if (ntiles > 2) ATT_LOAD(2, 0);
        if (ntiles > 3) ATT_LOAD(3, 1);
        __syncthreads();
        ATT_QK(0, ATT_BUF(0), pA);
        for (int j = 0; j < ntiles; j += 2) {
            if (j + 2 < ntiles) ATT_STORE(ATT_BUF(j + 2), 0);
            if (j + 4 < ntiles) ATT_LOAD(j + 4, 0);
            if (j + 1 < ntiles) ATT_QK(j + 1, ATT_BUF(j + 1), pB);
            ATT_SMPV(j, ATT_BUF(j), pA);
            __syncthreads();
            if (j + 1 < ntiles) {
                if (j + 3 < ntiles) ATT_STORE(ATT_BUF(j + 3), 1);
                if (j + 5 < ntiles) ATT_LOAD(j + 5, 1);
                if (j + 2 < ntiles) ATT_QK(j + 2, ATT_BUF(j + 2), pA);
                ATT_SMPV(j + 1, ATT_BUF(j + 1), pB);
                __syncthreads();
            }
        }
    } else if (KG == 1) {
        ATT_LOAD(0, 0); ATT_STORE(T, 0); if (ntiles > 1) ATT_LOAD(1, 1); if (ntiles > 2) ATT_LOAD(2, 0);
        __syncthreads();
        for (int j = 0; j < ntiles; j += 2) {
            if (j + 1 < ntiles) ATT_STORE(T + TILEB, 1);
            if (j + 3 < ntiles) ATT_LOAD(j + 3, 1);
            ATT_COMPUTE(j, T);
            __syncthreads();
            if (j + 1 < ntiles) {
                if (j + 2 < ntiles) ATT_STORE(T, 0);
                if (j + 4 < ntiles) ATT_LOAD(j + 4, 0);
                ATT_COMPUTE(j + 1, T + TILEB);
                __syncthreads();
            }
        }
    } else {
        const int nsteps = (ntiles + KG - 1) / KG;
        if (PF) {
#pragma unroll
            for (int g = 0; g < NG; ++g) { if (g < ntiles) ATT_LOAD(g, g); }
        }
        for (int s = 0; s < nsteps; ++s) {
            __syncthreads();
            if (PF) {
#pragma unroll
                for (int g = 0; g < NG; ++g) { if (s * KG + g < ntiles) ATT_STORE(T + g * TILEB, g); }
            } else {
#pragma unroll
                for (int g = 0; g < KG; ++g) { const int jt = s * KG + g; if (jt < ntiles) { ATT_LOAD(jt, 0); ATT_STORE(T + g * TILEB, 0); } }
            }
            __syncthreads();
            if (PF && s + 1 < nsteps) {
#pragma unroll
                for (int g = 0; g < NG; ++g) { const int jt = (s + 1) * KG + g; if (jt < ntiles) ATT_LOAD(jt, g); }
            }
            const int jm = s * KG + kg;
            if (jm < ntiles) ATT_COMPUTE(jm, T + kg * TILEB);
        }
        constexpr int MB = (D / 32 < 4) ? D / 32 : 4, MR = MB * 16 + 1;
        LAS float* Mg = (LAS float*)L;
#pragma unroll
        for (int d0 = 0; d0 < D / 32; d0 += MB) {
            __syncthreads();
#pragma unroll
            for (int db = 0; db < MB; ++db)
#pragma unroll
                for (int r = 0; r < 16; ++r) Mg[(wid * MR + db * 16 + r) * 64 + lane] = o[d0 + db][r];
            if (d0 == 0) Mg[(wid * MR + MB * 16) * 64 + lane] = lrun;
            __syncthreads();
            if (kg == 0) {
#pragma unroll
                for (int g = 1; g < KG; ++g) {
#pragma unroll
                    for (int db = 0; db < MB; ++db)
#pragma unroll
                        for (int r = 0; r < 16; ++r) o[d0 + db][r] += Mg[((g * QW + qw) * MR + db * 16 + r) * 64 + lane];
                    if (d0 == 0) lrun += Mg[((g * QW + qw) * MR + MB * 16) * 64 + lane];
                }
            }
        }
        __syncthreads();
    }
#undef ATT_LOAD
#undef ATT_STORE
#undef ATT_COMPUTE
#undef ATT_ACT
#undef ATT_QK
#undef ATT_SMPV
#undef ATT_BUF
    if (kg == 0 && wact) {
        const float lt = lrun + __shfl_xor(lrun, 32), inv = 1.0f / lt;
        bf16_t* orow = O + (size_t)(qw * 32 + r32) * ldo;
#pragma unroll
        for (int db = 0; db < D / 32; ++db)
#pragma unroll
            for (int i = 0; i < 4; ++i) { u32x2 w; w.x = pg8::cvt_pk_bf16(o[db][4 * i] * inv, o[db][4 * i + 1] * inv); w.y = pg8::cvt_pk_bf16(o[db][4 * i + 2] * inv, o[db][4 * i + 3] * inv);
                *(u32x2*)(orow + db * 32 + 8 * i + 4 * hi) = w; }
    }
}

constexpr int POOL_RS = 272, POOL_SLAB = 48 * POOL_RS;
template <int G>
__device__ __forceinline__ void pool_group(LAS unsigned char* slab, const char* __restrict__ ubase, unsigned rowoff0, int nprev0, int nprev, float icnt, const bf16_t* __restrict__ wpt, bf16_t* __restrict__ orow, int lane, int r32, int hi) {
    constexpr int w = 2 << G;
    {
        u32x4 st[12];
#pragma unroll
        for (int k = 0; k < 12; ++k) { const int id = lane + 64 * k, row = id >> 4, ch = id & 15; const int rr = (15 - row <= nprev0) ? row : 15;
            if (row < 47) st[k] = *(const u32x4*)(ubase + (rowoff0 + (unsigned)(rr - 15) * 1024u + (unsigned)(G * 256 + ch * 16))); }
#pragma unroll
        for (int k = 0; k < 12; ++k) { const int id = lane + 64 * k, row = id >> 4, ch = id & 15; if (row < 47) *(LAS u32x4*)(slab + row * POOL_RS + ch * 16) = st[k]; }
    }
    bf16x8 dfr[8];
#pragma unroll
    for (int ks = 0; ks < 8; ++ks) {
        const LAS unsigned char* cp = slab + (15 + r32) * POOL_RS + (ks * 16 + hi * 8) * 2;
        const u32x4 cu = *(const LAS u32x4*)cp;
        float s[8], cur[8];
        cur[0] = bf_lo(cu.x); cur[1] = bf_hi(cu.x); cur[2] = bf_lo(cu.y); cur[3] = bf_hi(cu.y); cur[4] = bf_lo(cu.z); cur[5] = bf_hi(cu.z); cur[6] = bf_lo(cu.w); cur[7] = bf_hi(cu.w);
#pragma unroll
        for (int e = 0; e < 8; ++e) s[e] = cur[e];
#pragma unroll
        for (int j = 1; j < w; ++j) {
            const float wt = (j <= nprev) ? 1.f : 0.f;
            const u32x4 v = *(const LAS u32x4*)(cp - j * POOL_RS);
            s[0] += wt * bf_lo(v.x); s[1] += wt * bf_hi(v.x); s[2] += wt * bf_lo(v.y); s[3] += wt * bf_hi(v.y); s[4] += wt * bf_lo(v.z); s[5] += wt * bf_hi(v.z); s[6] += wt * bf_lo(v.w); s[7] += wt * bf_hi(v.w);
        }
        u32x4 dv;
        dv.x = cvt_pk_bf16(s[0] * icnt - cur[0], s[1] * icnt - cur[1]); dv.y = cvt_pk_bf16(s[2] * icnt - cur[2], s[3] * icnt - cur[3]);
        dv.z = cvt_pk_bf16(s[4] * icnt - cur[4], s[5] * icnt - cur[5]); dv.w = cvt_pk_bf16(s[6] * icnt - cur[6], s[7] * icnt - cur[7]);
        dfr[ks] = __builtin_bit_cast(bf16x8, dv);
        __builtin_amdgcn_sched_barrier(0);
    }
#pragma unroll
    for (int nb = 0; nb < 4; ++nb) {
        f32x16 acc;
#pragma unroll
        for (int r = 0; r < 16; ++r) acc[r] = 0.f;
        const bf16_t* wrow = wpt + ((size_t)G * 128 + nb * 32 + r32) * 128 + hi * 8;
#pragma unroll
        for (int ks = 0; ks < 8; ++ks) acc = __builtin_amdgcn_mfma_f32_32x32x16_bf16(*(const bf16x8*)(wrow + ks * 16), dfr[ks], acc, 0, 0, 0);
#pragma unroll
        for (int i = 0; i < 4; ++i) { u32x2 wv; wv.x = cvt_pk_bf16(acc[4 * i], acc[4 * i + 1]); wv.y = cvt_pk_bf16(acc[4 * i + 2], acc[4 * i + 3]);
            *(u32x2*)(orow + G * 128 + nb * 32 + 8 * i + 4 * hi) = wv; }
    }
}
__device__ __forceinline__ void pool_unit(LAS unsigned char* L, int tile, const bf16_t* __restrict__ ub, const bf16_t* __restrict__ usx, const bf16_t* __restrict__ wpt, bf16_t* __restrict__ mix) {
    const int tid = threadIdx.x, lane = lane_op(), wid = __builtin_amdgcn_readfirstlane(tid >> 6), r32 = lane & 31, hi = lane >> 5;
    const int row0 = tile * 256 + wid * 32, row = row0 + r32;
    const bool samp = tile >= 256;
    const int b0 = samp ? (row0 - MP) >> 6 : row0 >> 11, t0 = samp ? (row0 - MP) & 63 : row0 & (SEQ - 1);
    const char* ubase = (const char*)(samp ? usx : ub);
    const unsigned rowoff0 = (samp ? (unsigned)(b0 * 79 + 15 + t0) : (unsigned)row0) * 1024u;
    const int nprev0 = samp ? t0 + 15 : t0, nprev = nprev0 + r32;
    bf16_t* orow = mix + (size_t)row * DM;
    const int np1 = nprev + 1;
    LAS unsigned char* slab = L + wid * POOL_SLAB;
    pool_group<0>(slab, ubase, rowoff0, nprev0, nprev, 1.0f / (float)(np1 < 2 ? np1 : 2), wpt, orow, lane, r32, hi);
    pool_group<1>(slab, ubase, rowoff0, nprev0, nprev, 1.0f / (float)(np1 < 4 ? np1 : 4), wpt, orow, lane, r32, hi);
    pool_group<2>(slab, ubase, rowoff0, nprev0, nprev, 1.0f / (float)(np1 < 8 ? np1 : 8), wpt, orow, lane, r32, hi);
    pool_group<3>(slab, ubase, rowoff0, nprev0, nprev, 1.0f / (float)(np1 < 16 ? np1 : 16), wpt, orow, lane, r32, hi);
}

template <int MODE>
__device__ __forceinline__ void transpose_item(const float* __restrict__ W, int K, int N, int nblk, bf16_t* __restrict__ WT, int row_off, const float* __restrict__ g, LAS float* scr, int item, int lane) {
    const int kb = item / nblk, nb = item % nblk, k0 = 64 * kb, n0 = 32 * nb;
#pragma unroll 8
    for (int i = 0; i < 32; ++i) { const int kk = 2 * i + (lane >> 5); float v = W[(size_t)(k0 + kk) * N + n0 + (lane & 31)]; if (g) v *= g[k0 + kk]; scr[kk * 33 + (lane & 31)] = v; }
    LDS_WAIT();
    const int c = lane & 7;
#pragma unroll
    for (int j = 0; j < 4; ++j) {
        const int n = (lane >> 3) + 8 * j; const LAS float* s = scr + (8 * c) * 33 + n;
        const int nn = n0 + n; int drow;
        if (MODE == 0) drow = row_off + nn; else { const int half = nn / DFF, cc = nn % DFF; drow = (cc >> 7) * 256 + half * 128 + (cc & 127); }
        u32x4 o; o.x = cvt_pk_bf16(s[0 * 33], s[1 * 33]); o.y = cvt_pk_bf16(s[2 * 33], s[3 * 33]); o.z = cvt_pk_bf16(s[4 * 33], s[5 * 33]); o.w = cvt_pk_bf16(s[6 * 33], s[7 * 33]);
        *(u32x4*)(WT + (size_t)drow * K + k0 + 8 * c) = o;
    }
    LDS_WAIT();
}
__device__ __forceinline__ void prepass_row(const float* __restrict__ xrow, bf16_t* __restrict__ orow, const LAS float* wf, const float* __restrict__ b_f, float* __restrict__ lf_out, int lane) {
    const f32x4* xr = (const f32x4*)xrow + lane;
    f32x4 v[4]; float s = 0.f;
#pragma unroll
    for (int j = 0; j < 4; ++j) { v[j] = xr[64 * j]; s += (v[j][0] * v[j][0] + v[j][1] * v[j][1]) + (v[j][2] * v[j][2] + v[j][3] * v[j][3]); }
    const float r = rsq(wave_sum(s));
    u32x2* o8 = (u32x2*)orow + lane;
#pragma unroll
    for (int j = 0; j < 4; ++j) { v[j] = v[j] * r; u32x2 w; w.x = cvt_pk_bf16(v[j][0], v[j][1]); w.y = cvt_pk_bf16(v[j][2], v[j][3]); o8[64 * j] = w; }
    if (wf) {
        f32x4 fa = {0.f, 0.f, 0.f, 0.f}, fb = {0.f, 0.f, 0.f, 0.f};
#pragma unroll
        for (int j = 0; j < 4; ++j)
#pragma unroll
            for (int e = 0; e < 4; ++e) { const int k = 4 * (lane + 64 * j) + e; const LAS f32x4* w = (const LAS f32x4*)(wf + k * 8); fa += w[0] * v[j][e]; fb += w[1] * v[j][e]; }
#pragma unroll
        for (int e = 0; e < 4; ++e) { fa[e] = wave_sum(fa[e]); fb[e] = wave_sum(fb[e]); }
        float z = fa[0];
        z = (lane == 1) ? fa[1] : z; z = (lane == 2) ? fa[2] : z; z = (lane == 3) ? fa[3] : z; z = (lane == 4) ? fb[0] : z; z = (lane == 5) ? fb[1] : z; z = (lane == 6) ? fb[2] : z; z = (lane == 7) ? fb[3] : z;
        if (lane < 8) { z += b_f[lane]; lf_out[lane] = fminf(z, 0.f) - log1pf(expf(-fabsf(z))); }
    }
}
__device__ __forceinline__ void scan_seq(const float* s0, int n0, const float* s1, int n1, float* dst, int lane) {
    const int n = n0 + n1, Lc = n >> 6;
    float s = 0.f;
    for (int i = 0; i < Lc; ++i) { const int t = lane * Lc + i; const float* ptr = (t < n0) ? (s0 + (size_t)t * 8) : (s1 + (size_t)(t - n0) * 8); s += *ptr; }
    float inc = s;
    for (int o = 1; o < 64; o <<= 1) { const float v = __shfl_up(inc, o); if (lane >= o) inc += v; }
    float run = inc - s;
    for (int i = 0; i < Lc; ++i) { const int t = lane * Lc + i; const float* ptr = (t < n0) ? (s0 + (size_t)t * 8) : (s1 + (size_t)(t - n0) * 8); run += *ptr; dst[t] = -run * LOG2E; }
}
__device__ __forceinline__ void cvt_flat(const float* __restrict__ src, bf16_t* __restrict__ dst, size_t n8, size_t gtid, size_t gn) {
    for (size_t i = gtid; i < n8; i += gn) { const f32x4 a = *(const f32x4*)(src + i * 8), b = *(const f32x4*)(src + i * 8 + 4); *(u32x4*)(dst + i * 8) = pack8(a, b); }
}

#define Wt_in ((bf16_t*)(ws + WS_WIN))
#define Wt_o ((bf16_t*)(ws + WS_WO))
#define Wt_mq ((bf16_t*)(ws + WS_WMQ))
#define Wt_mo ((bf16_t*)(ws + WS_WMO))
#define Wt_mkv ((bf16_t*)(ws + WS_WMKV))
#define Wt_up ((bf16_t*)(ws + WS_WUP))
#define Wt_dn ((bf16_t*)(ws + WS_WDN))
#define Wt_pool ((bf16_t*)(ws + WS_WPOOL))
#define usx ((bf16_t*)(ws + WS_USX))
#define mkb ((bf16_t*)(ws + WS_MKB))
#define mvb ((bf16_t*)(ws + WS_MVB))
#define ssq1 ((float*)(ws + WS_SSQ1))
#define ssq2 ((float*)(ws + WS_SSQ2))
#define ssq3 ((float*)(ws + WS_SSQ3))
#define kbP ((float*)(ws + WS_KBP))
#define kbS ((float*)(ws + WS_KBS))
#define ahead ((float*)(ws + WS_AHEAD))
#define atail ((float*)(ws + WS_ATAIL))
#define bhead ((float*)(ws + WS_BHEAD))
#define x1b ((bf16_t*)(ws + WS_X1B))
#define kcb ((bf16_t*)(ws + WS_KCB))
#define vcb ((bf16_t*)(ws + WS_VCB))
#define x2b ((bf16_t*)(ws + WS_X2B))
#define xb ((bf16_t*)(ws + WS_XB))
#define mqb ((bf16_t*)(ws + WS_MQB))
#define hff ((bf16_t*)(ws + WS_HFF))
#define uqkv ((bf16_t*)(ws + WS_UQKV))
#define mo ((bf16_t*)(ws + WS_MO))
#define mix ((bf16_t*)(ws + WS_MIX))
#define memb ((bf16_t*)(ws + WS_MEMB))
#define ub uqkv
#define qb (uqkv + (size_t)MT * 512)
#define kb (uqkv + (size_t)2 * MT * 512)
#define vb (uqkv + (size_t)3 * MT * 512)
__global__ void __launch_bounds__(512, 2) fwd_kernel(Params p) {
    extern __shared__ __attribute__((aligned(16))) unsigned char lds_raw[];
    LAS unsigned char* L = (LAS unsigned char*)lds_raw;
    cg::grid_group grid = cg::this_grid();
    const int tid = threadIdx.x, wave = __builtin_amdgcn_readfirstlane(tid >> 6);
    const int G = gridDim.x, bx = blockIdx.x;
    unsigned char* ws = p.ws; float* out = p.out;
    const float* x_prompt = p.in[0]; const float* x_sample = p.in[1];
    const int lo = p.ph_lo, hi_ph = p.ph_hi;
    unsigned* gbar = (unsigned*)ws; unsigned kbar = 0u;
    if (lo < 0) grid.sync();
#define IN(k) (lo <= (k) && (k) < hi_ph && ((PHMASK >> (k)) & 1))
#define GSYNC() do { asm volatile("s_waitcnt vmcnt(0)" ::: "memory"); __syncthreads(); \
        if (tid == 0) { __builtin_amdgcn_fence(__ATOMIC_RELEASE, "agent"); asm volatile("s_waitcnt vmcnt(0)" ::: "memory"); \
            ++kbar; const unsigned x_ = (unsigned)bx & 7u, gsz_ = ((unsigned)G - x_ + 7u) >> 3, ngr_ = (unsigned)G < 8u ? (unsigned)G : 8u; \
            const unsigned old_ = __hip_atomic_fetch_add(gbar + 64 * (1 + x_), 1u, __ATOMIC_RELAXED, __HIP_MEMORY_SCOPE_AGENT); \
            if (old_ + 1u == gsz_ * kbar) { \
                const unsigned t_ = __hip_atomic_fetch_add(gbar + 64 * 9, 1u, __ATOMIC_RELAXED, __HIP_MEMORY_SCOPE_AGENT); \
                if (t_ + 1u != ngr_ * kbar) { while (__hip_atomic_load(gbar + 64 * 9, __ATOMIC_RELAXED, __HIP_MEMORY_SCOPE_AGENT) < ngr_ * kbar) __builtin_amdgcn_s_sleep(2); } \
                __hip_atomic_store(gbar + 64 * (10 + x_), kbar, __ATOMIC_RELAXED, __HIP_MEMORY_SCOPE_AGENT); \
            } else { while (__hip_atomic_load(gbar + 64 * (10 + x_), __ATOMIC_RELAXED, __HIP_MEMORY_SCOPE_AGENT) < kbar) __builtin_amdgcn_s_sleep(2); } \
            __builtin_amdgcn_fence(__ATOMIC_ACQUIRE, "agent"); asm volatile("s_waitcnt vmcnt(0)" ::: "memory"); } \
        __syncthreads(); } while (0)
#define SEAM(k) do { if (IN(k) && IN((k) + 1)) GSYNC(); } while (0)

    if (IN(0)) {
        const int lane = lane_op();
        const int gw = bx * 8 + wave, NGW = G * 8;
        LAS float* scr = (LAS float*)(L + wave * 8448);
        LAS float* wf = (LAS float*)(L + 8 * 8448);
        {
            const float* w_in = p.in[11]; const float* g_mix = p.in[10];
            for (int i = tid; i < 8192; i += 512) { const int k = i >> 3, h = i & 7; wf[i] = w_in[(size_t)k * 2056 + 2048 + h] * g_mix[k]; }
        }
        __syncthreads();
        constexpr int I_IN = 16 * 64, I_SQ = 16 * 32, I_UP = 16 * 176, I_DN = 44 * 32;
        constexpr int NITEMS = I_IN + 5 * I_SQ + I_UP + I_DN;
        for (int it = gw; it < NITEMS; it += NGW) {
            int r = it;
            if (r < I_IN) { transpose_item<0>(p.in[11], 1024, 2056, 64, Wt_in, 0, p.in[10], scr, r, lane); continue; } r -= I_IN;
            if (r < I_SQ) { transpose_item<0>(p.in[15], 1024, 1024, 32, Wt_o, 0, nullptr, scr, r, lane); continue; } r -= I_SQ;
            if (r < I_SQ) { transpose_item<0>(p.in[18], 1024, 1024, 32, Wt_mq, 0, p.in[16], scr, r, lane); continue; } r -= I_SQ;
            if (r < I_SQ) { transpose_item<0>(p.in[19], 1024, 1024, 32, Wt_mkv, 0, p.in[17], scr, r, lane); continue; } r -= I_SQ;
            if (r < I_SQ) { transpose_item<0>(p.in[20], 1024, 1024, 32, Wt_mkv, 1024, p.in[17], scr, r, lane); continue; } r -= I_SQ;
            if (r < I_SQ) { transpose_item<0>(p.in[21], 1024, 1024, 32, Wt_mo, 0, nullptr, scr, r, lane); continue; } r -= I_SQ;
            if (r < I_UP) { transpose_item<1>(p.in[23], 1024, NUP, 176, Wt_up, 0, p.in[22], scr, r, lane); continue; } r -= I_UP;
            transpose_item<0>(p.in[26], DFF, 1024, 32, Wt_dn, 0, nullptr, scr, r, lane);
        }
        {
            const float* w_pool = p.in[13]; const float* pscale = p.in[14];
            for (int i = bx * 512 + tid; i < 4 * 128 * 128; i += G * 512) { const int g = i >> 14, d = (i >> 7) & 127, c = i & 127; Wt_pool[i] = (bf16_t)(cvt_pk_bf16(w_pool[(g * 128 + c) * 128 + d] * pscale[g * 128 + d], 0.f) & 0xffffu); }
        }
        for (int m = gw; m < MT; m += NGW) {
            const float* xr = (m < MP) ? x_prompt + (size_t)m * DM : x_sample + (size_t)(m - MP) * DM;
            float* lf = (m < MP) ? out + O_LFP + (size_t)m * 8 : out + O_LFS + (size_t)(m - MP) * 8;
            prepass_row(xr, xb + (size_t)m * DM, wf, p.in[12], lf, lane);
        }
        for (int m = gw; m < 8192; m += NGW) prepass_row(p.in[9] + (size_t)m * DM, memb + (size_t)m * DM, (const LAS float*)nullptr, nullptr, nullptr, lane);
        const size_t gtid = (size_t)bx * 512 + tid, gn = (size_t)G * 512;
        for (size_t i = gtid; i < (size_t)16 * 15 * 512 / 8; i += gn) { const size_t e8 = i * 8, bb = e8 / (15 * 512), rem = e8 - bb * 15 * 512; const float* sp = p.in[5] + e8; *(u32x4*)(usx + bb * 79 * 512 + rem) = pack8(*(const f32x4*)sp, *(const f32x4*)(sp + 4)); }
        cvt_flat(p.in[2], kcb, (size_t)16 * PAST * 512 / 8, gtid, gn);
        cvt_flat(p.in[3], vcb, (size_t)16 * PAST * 512 / 8, gtid, gn);
        cvt_flat(p.in[7], mkb + (size_t)8192 * 1024, (size_t)4096 * 1024 / 8, gtid, gn);
        cvt_flat(p.in[8], mvb + (size_t)8192 * 1024, (size_t)4096 * 1024 / 8, gtid, gn);
        __syncthreads();
    }
    SEAM(0);

    if (IN(1)) {
        const int lane = lane_op();
        if (wave == 0) { const int s = bx; if (s < 256) scan_seq(out + O_LFP + (size_t)(s >> 3) * SEQ * 8 + (s & 7), SEQ, out + O_LFP, 0, kbP + (size_t)s * SEQ, lane); }
        if (wave == 1 && bx < 128) { const int s = bx; scan_seq(p.in[4] + (size_t)(s >> 3) * PAST * 8 + (s & 7), PAST, out + O_LFS + (size_t)(s >> 3) * DSEQ * 8 + (s & 7), DSEQ, kbS + (size_t)s * (PAST + DSEQ), lane); }
        {
            pg8::Gemm g{xb, Wt_in, MT, 2048, 1024}; pg8::StaticOrder S; S.init(MT, 2048, G, bx);
            EpiIn E{uqkv, out, usx};
            pg8::gemm_phase<EpiIn, pg8::StaticOrder, true, true>(L, g, S, E);
        }
        __syncthreads();
        {
            pg8::Gemm g{memb, Wt_mkv, 8192, 2048, 1024}; pg8::StaticOrder S; S.init(8192, 2048, G, bx);
            EpiMkv E{mkb, mvb, out};
            pg8::gemm_phase<EpiMkv, pg8::StaticOrder, true, true>(L, g, S, E);
        }
    }
    SEAM(1);

    if (IN(2)) {
        for (int it = 0; it < 8 * ((256 + G - 1) / G); ++it) {
            int bh, qk;
            if (G == 256) { const int xcd = bx & 7, l = bx >> 3, r = it >> 1, pi = l & 3; bh = xcd * 32 + r * 8 + (l >> 2); qk = (it & 1) ? pi : 7 - pi; }
            else { bh = bx + (it >> 3) * G; qk = 7 - (it & 7); if (bh >= 256) break; }
            const int b = bh >> 3, h = bh & 7;
            const bf16_t* Kh = kb + (size_t)b * SEQ * 512 + h * 64; const bf16_t* Vh = vb + (size_t)b * SEQ * 512 + h * 64;
            const size_t r0 = (size_t)b * SEQ + 256 * qk;
            attn_unit<64, 64, 1, true, false, true, true>(L, qb + r0 * 512 + h * 64, 512, 256, Kh, Vh, 4 * qk + 4, Kh, Vh, 512, 4 * qk + 4, kbP + (size_t)bh * SEQ, 256 * qk, mix + r0 * DM + 512 + h * 64, DM);
        }
        if (P2_ATTN_S) for (int bh = bx; bh < 128; bh += G) {
            const int b = bh >> 3, h = bh & 7;
            const size_t r0 = (size_t)MP + b * DSEQ;
            attn_unit<64, 64, 4, true, false, true, true>(L, qb + r0 * 512 + h * 64, 512, 64, kcb + (size_t)b * PAST * 512 + h * 64, vcb + (size_t)b * PAST * 512 + h * 64, 64,
                                      kb + r0 * 512 + h * 64, vb + r0 * 512 + h * 64, 512, 65, kbS + (size_t)bh * (PAST + DSEQ), PAST, mix + r0 * DM + 512 + h * 64, DM);
        }
        if (G == 256) { __syncthreads(); pool_unit(L, bx, ub, usx, Wt_pool, mix); if (bx >= 128 && bx < 132) pool_unit(L, 128 + bx, ub, usx, Wt_pool, mix); }
        else { __syncthreads(); for (int t = bx; t < MT / 256; t += G) pool_unit(L, t, ub, usx, Wt_pool, mix); }
        __syncthreads();
    }
    SEAM(2);

    if (IN(3)) {
        const int MG = (G == 256) ? MP : MT;
        pg8::Gemm g{mix, Wt_o, MG, 1024, 1024}; pg8::StaticOrder S; S.init(MG, 1024, G, bx);
        EpiRes<0> E{x_prompt, x_sample, nullptr, x1b, nullptr, ssq1};
        pg8::gemm_phase<EpiRes<0>, pg8::StaticOrder, true, true>(L, g, S, E);
        if (G == 256) small_gemm_sample<0>(L, bx, mix, 1024, Wt_o, 1024, 1024, x_sample, nullptr, x1b, nullptr, ssq1, nullptr);
    }
    SEAM(3);

    if (IN(4)) {
        const int MG = (G == 256) ? MP : MT;
        pg8::Gemm g{x1b, Wt_mq, MG, 1024, 1024}; pg8::StaticOrder S; S.init(MG, 1024, G, bx);
        EpiMq E{ssq1, mqb};
        pg8::gemm_phase<EpiMq, pg8::StaticOrder, true, true>(L, g, S, E);
        if (G == 256) small_gemm_sample<3>(L, bx, x1b, 1024, Wt_mq, 1024, 1024, nullptr, nullptr, mqb, nullptr, nullptr, ssq1);
    }
    SEAM(4);

    if (IN(5)) {
        for (int k5 = 0; k5 * G < 2048 + 64; ++k5) {
            const int un = (G == 256 && k5 < 8) ? (((k5 * 8 + (bx & 7)) * 32) + (bx >> 3)) : (k5 * G + bx);
            if (un >= 2048 + 64) break;
            if (un < 2048) {
                const int b = un >> 6, h = (un >> 4) & 3, qk = un & 15;
                const size_t r0 = (size_t)b * SEQ + 128 * qk;
                const bf16_t* Kh = mkb + (size_t)b * NMEM * 1024 + h * 256; const bf16_t* Vh = mvb + (size_t)b * NMEM * 1024 + h * 256;
                attn_unit<256, 32, 2, true, true, false, false>(L, mqb + r0 * DM + h * 256, DM, 128, Kh, Vh, 8, Kh, Vh, 1024, 8, nullptr, 0, mo + r0 * DM + h * 256, DM);
            } else {
                const int us = un - 2048, b = us >> 2, h = us & 3;
                const size_t r0 = (size_t)MP + b * DSEQ;
                const bf16_t* Kh = mkb + (size_t)(8192 + b * NMEM) * 1024 + h * 256; const bf16_t* Vh = mvb + (size_t)(8192 + b * NMEM) * 1024 + h * 256;
                attn_unit<256, 32, 2, true, true, false, false>(L, mqb + r0 * DM + h * 256, DM, 64, Kh, Vh, 8, Kh, Vh, 1024, 8, nullptr, 0, mo + r0 * DM + h * 256, DM);
            }
        }
        __syncthreads();
    }
    SEAM(5);

    if (IN(6)) {
        const int MG = (G == 256) ? MP : MT;
        pg8::Gemm g{mo, Wt_mo, MG, 1024, 1024}; pg8::StaticOrder S; S.init(MG, 1024, G, bx);
        EpiRes<1> E{nullptr, nullptr, x1b, x2b, nullptr, ssq2};
        pg8::gemm_phase<EpiRes<1>, pg8::StaticOrder, true, true>(L, g, S, E);
        if (G == 256) small_gemm_sample<1>(L, bx, mo, 1024, Wt_mo, 1024, 1024, nullptr, x1b, x2b, nullptr, ssq2, nullptr);
    }
    SEAM(6);

    if (IN(7)) {
        pg8::Gemm g{x2b, Wt_up, MT, NUP, 1024}; pg8::StaticOrder S; S.init(MT, NUP, G, bx);
        EpiUp E{ssq2, p.in[24], p.in[25], hff, ahead, atail, bhead};
        pg8::gemm_phase<EpiUp, pg8::StaticOrder, true, true>(L, g, S, E);
    }
    SEAM(7);

    if (IN(8)) {
        const float* cw = p.in[24]; const float* cbias = p.in[25]; const float* chist = p.in[6];
        const int total4 = NSEG * 2 * (DFF / 4);
        for (int idx = bx * 512 + tid; idx < total4; idx += G * 512) {
            const int seg = idx / (2 * (DFF / 4)), rem = idx - seg * 2 * (DFF / 4), i = rem / (DFF / 4), c = (rem - i * (DFF / 4)) * 4;
            f32x4 prev1, prev2;
            if (seg < MP / 64) { if ((seg & 31) == 0) { prev1 = (f32x4){0.f, 0.f, 0.f, 0.f}; prev2 = prev1; } else { prev1 = *(const f32x4*)(atail + ((size_t)(seg - 1) * 2 + 1) * DFF + c); prev2 = *(const f32x4*)(atail + ((size_t)(seg - 1) * 2) * DFF + c); } }
            else { const int b = seg - MP / 64; prev1 = *(const f32x4*)(chist + ((size_t)b * 2 + 1) * DFF + c); prev2 = *(const f32x4*)(chist + ((size_t)b * 2) * DFF + c); }
            const f32x4 a_0 = *(const f32x4*)(ahead + ((size_t)seg * 2) * DFF + c);
            f32x4 am1, am2, a0;
            if (i == 0) { am1 = prev1; am2 = prev2; a0 = a_0; } else { am1 = a_0; am2 = prev1; a0 = *(const f32x4*)(ahead + ((size_t)seg * 2 + 1) * DFF + c); }
            const f32x4 cv = *(const f32x4*)(cbias + c) + *(const f32x4*)(cw + c) * am2 + *(const f32x4*)(cw + DFF + c) * am1 + *(const f32x4*)(cw + 2 * DFF + c) * a0;
            const f32x4 bh = *(const f32x4*)(bhead + ((size_t)seg * 2 + i) * DFF + c);
            f32x4 hv;
#pragma unroll
            for (int e = 0; e < 4; ++e) hv[e] = cv[e] / (1.0f + __builtin_amdgcn_exp2f(-cv[e] * LOG2E)) * bh[e];
            u32x2 w; w.x = cvt_pk_bf16(hv[0], hv[1]); w.y = cvt_pk_bf16(hv[2], hv[3]);
            *(u32x2*)(hff + ((size_t)seg * 64 + i) * DFF + c) = w;
        }
        for (int idx = bx * 512 + tid; idx < 48 * 2 * DFF; idx += G * 512) {
            const int bb = idx / (2 * DFF), rem = idx - bb * 2 * DFF;
            if (bb < 32) out[O_CSP + (size_t)bb * 2 * DFF + rem] = atail[((size_t)(32 * bb + 31) * 2) * DFF + rem];
            else out[O_CSS + (size_t)(bb - 32) * 2 * DFF + rem] = atail[((size_t)(MP / 64 + bb - 32) * 2) * DFF + rem];
        }
    }
    SEAM(8);

    if (IN(9)) {
        const int MG = (G == 256) ? MP : MT;
        pg8::Gemm g{hff, Wt_dn, MG, 1024, DFF}; pg8::StaticOrder S; S.init(MG, 1024, G, bx);
        EpiRes<2> E{nullptr, nullptr, x2b, nullptr, out, ssq3};
        pg8::gemm_phase<EpiRes<2>, pg8::StaticOrder, true, true>(L, g, S, E);
        if (G == 256) small_gemm_sample<2>(L, bx, hff, DFF, Wt_dn, DFF, DFF, nullptr, x2b, nullptr, out, ssq3, nullptr);
    }
    SEAM(9);

    if (IN(10)) {
        const float* gf = p.in[27];
        const int lane = lane_op();
        const int gw = bx * 8 + wave, NGW = G * 8;
        f32x4 gv[4];
#pragma unroll
        for (int j = 0; j < 4; ++j) gv[j] = ((const f32x4*)gf)[lane + 64 * j];
        for (int m0 = gw; m0 < MT; m0 += 4 * NGW) {
            f32x4 v[4][4]; float r[4];
#pragma unroll
            for (int q = 0; q < 4; ++q) { const int m = m0 + q * NGW; if (m < MT) { const f32x4* y4 = (const f32x4*)(out + (size_t)m * DM) + lane; r[q] = row_rsq(ssq3, m);
#pragma unroll
                    for (int j = 0; j < 4; ++j) v[q][j] = y4[64 * j]; } }
#pragma unroll
            for (int q = 0; q < 4; ++q) { const int m = m0 + q * NGW; if (m < MT) { f32x4* y4 = (f32x4*)(out + (size_t)m * DM) + lane;
#pragma unroll
                    for (int j = 0; j < 4; ++j) y4[64 * j] = v[q][j] * r[q] * gv[j]; } }
        }
    }
#ifdef DBG_DUMP
    {
        GSYNC();
        const bf16_t* src = nullptr; int pitch = 1024;
        if (hi_ph == 2) src = uqkv; else if (hi_ph == 3) src = mix; else if (hi_ph == 4) src = x1b; else if (hi_ph == 5) src = mqb; else if (hi_ph == 6) src = mo; else if (hi_ph == 7) src = x2b; else if (hi_ph == 8 || hi_ph == 9) { src = hff; pitch = DFF; }
        if (src) for (size_t i = (size_t)bx * 512 + tid; i < (size_t)MT * 1024; i += (size_t)G * 512) { const size_t m = i >> 10, c = i & 1023; float v = __builtin_bit_cast(float, (unsigned)src[m * pitch + c] << 16); if (!(v == v)) v = 12345.f; if (fabsf(v) > 1e30f) v = 54321.f; out[i] = v; }
    }
#endif
#undef IN
#undef SEAM
}

extern "C" void kernel_launch(void* const* d_in, const int* in_sizes, int n_in, void* d_out, int out_size, void* d_ws, size_t ws_size, hipStream_t stream) {
    static int grid = 0;
    if (grid == 0) {
        if (n_in != 28 || (size_t)out_size != O_END || ws_size < WS_NEED) { fprintf(stderr, "kernel_launch: unexpected shapes (n_in %d, out %d, ws %zu); nothing launched\n", n_in, out_size, ws_size); grid = -1; return; }
        int dev = 0, cus = 0, per_cu = 0;
        hipGetDevice(&dev); hipDeviceGetAttribute(&cus, hipDeviceAttributeMultiprocessorCount, dev);
        hipFuncSetAttribute((const void*)fwd_kernel, hipFuncAttributeMaxDynamicSharedMemorySize, LDS_BYTES);
        hipOccupancyMaxActiveBlocksPerMultiprocessor(&per_cu, (const void*)fwd_kernel, 512, LDS_BYTES);
        if (per_cu < 1) { fprintf(stderr, "kernel_launch: occupancy query says %d blocks per CU\n", per_cu); per_cu = 1; }
        (void)hipGetLastError();
        grid = cus;
    }
    if (grid < 0) return;
    (void)hipMemsetAsync(d_ws, 0, 8192, stream);
    Params p{};
    for (int i = 0; i < 28; ++i) p.in[i] = (const float*)d_in[i];
    p.out = (float*)d_out; p.ws = (unsigned char*)d_ws;
    void* args[] = {&p};
#ifdef PROBE_K
    p.ph_lo = 0; p.ph_hi = PROBE_K + 1;
    (void)hipLaunchCooperativeKernel((const void*)fwd_kernel, dim3(grid), dim3(512), args, LDS_BYTES, stream);
    (void)hipMemsetAsync(d_ws, 0, 8192, stream);
    p.ph_lo = PROBE_K; p.ph_hi = 11;
#else
    p.ph_lo = 0; p.ph_hi = 11;
#endif
    hipError_t e = hipLaunchCooperativeKernel((const void*)fwd_kernel, dim3(grid), dim3(512), args, LDS_BYTES, stream);
    if (e != hipSuccess) fprintf(stderr, "cooperative launch failed: %s (grid %d)\n", hipGetErrorString(e), grid);
}
```
